# Optimizing an MI355X kernel written in HIP

```python
import math
import jax, jax.numpy as jnp
from jax import lax
import numpy as np

D_MODEL = 2048
BATCH = 1
SEQ = 8192
DEPTH = 1

HEAD_DIM = 128
A_GROUPS = ((128, 1), (512, 4), (2048, 16))
A_HEADS_PER_GROUP = 4
A_HEADS = A_HEADS_PER_GROUP * len(A_GROUPS)
A_WIDTH = A_HEADS * HEAD_DIM
A_OUT_WIDTH = A_HEADS_PER_GROUP * HEAD_DIM
A_BLOCK = 64
B_Q_HEADS = 8
B_KV_HEADS = 2
B_Q_WIDTH = B_Q_HEADS * HEAD_DIM
B_KV_WIDTH = B_KV_HEADS * HEAD_DIM
B_Q_BLOCK = 128
ROPE_THETA = 10000.0
GRID_W = 64
QK_NORM_EPS = 1e-6
REL_BUCKETS = 32
REL_MAX_DIST = 1024
A_V_OFF = 2 * A_WIDTH
B_Q_OFF = 3 * A_WIDTH
B_V_OFF = B_Q_OFF + B_Q_WIDTH + B_KV_WIDTH
GATE_OFF = B_V_OFF + B_KV_WIDTH
IN_WIDTH = GATE_OFF + 2 * D_MODEL
N_EXPERTS = 32
TOP_K = 4
D_FF = D_MODEL
SWIGLU_LIMIT = 7.0
SWIGLU_ALPHA = 1.702
MOE_BLOCK = 128
LN_EPS = 1e-5

kernel_name = 'hybrid_dilated_swa_axial_gqa_moe_deepnorm'


def _layer_norm(x, g, b):
    xf = x.astype(jnp.float32)
    mu = jnp.mean(xf, axis=-1, keepdims=True)
    var = jnp.mean(jnp.square(xf - mu), axis=-1, keepdims=True)
    return ((xf - mu) * lax.rsqrt(var + LN_EPS) * g + b).astype(x.dtype)


def _rms_heads(t, g):
    tf = t.astype(jnp.float32)
    return (tf * lax.rsqrt(jnp.mean(tf * tf, axis=-1, keepdims=True) + QK_NORM_EPS) * g).astype(t.dtype)


def _t5_bucket(rel):
    nb = REL_BUCKETS // 2
    max_exact = nb // 2
    n = jnp.abs(rel)
    nf = jnp.maximum(n, 1).astype(jnp.float32)
    large = max_exact + (jnp.log(nf / max_exact) / math.log(REL_MAX_DIST / max_exact)
                         * (nb - max_exact)).astype(jnp.int32)
    large = jnp.minimum(large, nb - 1)
    return jnp.where(rel > 0, nb, 0) + jnp.where(n < max_exact, n, large)


def _dilated_group(q, k, v, bias_tab, dilation, half):
    b, s, h, hd = q.shape
    n = s // dilation

    def by_stride(t):
        return t.reshape(b, n, dilation, h, hd).transpose(0, 2, 1, 3, 4).reshape(b * dilation, n, h, hd)

    qs, ks, vs = by_stride(q), by_stride(k), by_stride(v)
    blk = math.gcd(n, A_BLOCK)
    nblk = n // blk
    span = blk + 2 * half
    pad = ((0, 0), (half, half), (0, 0), (0, 0))
    kidx = jnp.arange(nblk)[:, None] * blk + jnp.arange(span)[None, :]
    kb = jnp.pad(ks, pad)[:, kidx]
    vb = jnp.pad(vs, pad)[:, kidx]
    qb = qs.reshape(b * dilation, nblk, blk, h, hd)
    rel = jnp.arange(span)[None, :] - half - jnp.arange(blk)[:, None]
    bias = bias_tab[_t5_bucket(rel * dilation)].transpose(2, 0, 1).astype(jnp.float32)
    kpos = kidx - half
    valid = ((jnp.abs(rel)[None] <= half)
             & (kpos[:, None, :] >= 0) & (kpos[:, None, :] < n))
    logits = (jnp.einsum('znqhd,znkhd->znhqk', qb, kb).astype(jnp.float32) / math.sqrt(hd)
              + bias[None, None])
    logits = jnp.where(valid[None, :, None], logits, -jnp.inf)
    lse = jax.nn.logsumexp(logits, axis=-1)
    p = jnp.exp(logits - lse[..., None]).astype(v.dtype)
    out = jnp.einsum('znhqk,znkhd->znqhd', p, vb)
    out = out.reshape(b, dilation, n, h, hd).transpose(0, 2, 1, 3, 4).reshape(b, s, h, hd)
    lse = lse.transpose(0, 1, 3, 2).reshape(b, dilation, n, h).transpose(0, 2, 1, 3).reshape(b, s, h)
    return out, lse


def _dilated_mixer(qa, ka, va, rel_bias):
    b, s = qa.shape[:2]
    outs, lses = [], []
    for g, (window, dil) in enumerate(A_GROUPS):
        sl = slice(g * A_HEADS_PER_GROUP, (g + 1) * A_HEADS_PER_GROUP)
        o, l = _dilated_group(qa[:, :, sl], ka[:, :, sl], va[:, :, sl], rel_bias[:, sl], dil, window // (2 * dil))
        outs.append(o)
        lses.append(l)
    w = jax.nn.softmax(jnp.stack(lses, axis=0), axis=0)
    o = jnp.sum(w[..., None].astype(qa.dtype) * jnp.stack(outs, axis=0), axis=0)
    return o.reshape(b, s, A_OUT_WIDTH)


def _rope_axis(t, pos):
    dim = t.shape[-1]
    inv = ROPE_THETA ** (-jnp.arange(0, dim, 2, dtype=jnp.float32) / dim)
    ang = pos.astype(jnp.float32)[:, None] * inv[None, :]
    cos = jnp.cos(ang)[None, :, None, :]
    sin = jnp.sin(ang)[None, :, None, :]
    t1, t2 = jnp.split(t.astype(jnp.float32), 2, axis=-1)
    return jnp.concatenate([t1 * cos - t2 * sin, t1 * sin + t2 * cos], axis=-1).astype(t.dtype)


def _axial_rope(t, row_pos, col_pos):
    half = t.shape[-1] // 2
    return jnp.concatenate([_rope_axis(t[..., :half], row_pos), _rope_axis(t[..., half:], col_pos)], axis=-1)


def _gqa_blocks(q, k, v):
    b, s, hq, hd = q.shape
    hkv = k.shape[2]
    grp = hq // hkv
    nqb = s // B_Q_BLOCK
    qb = q.reshape(b, nqb, B_Q_BLOCK, hkv, grp, hd).transpose(1, 0, 2, 3, 4, 5)
    scale = 1.0 / math.sqrt(hd)

    def one_block(qblk):
        logits = jnp.einsum('bqkgd,bskd->bkgqs', qblk, k).astype(jnp.float32) * scale
        p = jax.nn.softmax(logits, axis=-1).astype(v.dtype)
        return jnp.einsum('bkgqs,bskd->bqkgd', p, v)

    out = lax.map(one_block, qb)
    return out.transpose(1, 0, 2, 3, 4, 5).reshape(b, s, hq * hd)


def _hybrid_mixer(x, w_in, b_gates, rel_bias, q_norm, k_norm, w_branch_a, w_branch_b, w_out, row_pos, col_pos):
    b, s, _ = x.shape
    proj = x @ w_in
    cuts = [A_WIDTH, 2 * A_WIDTH, B_Q_OFF, B_Q_OFF + B_Q_WIDTH, B_V_OFF, GATE_OFF]
    qa, ka, va, qb, kb, vb, gates = jnp.split(proj, cuts, axis=-1)
    heads = lambda t, h: t.reshape(b, s, h, HEAD_DIM)
    ya = _dilated_mixer(heads(qa, A_HEADS), heads(ka, A_HEADS), heads(va, A_HEADS), rel_bias)
    qb = _axial_rope(_rms_heads(heads(qb, B_Q_HEADS), q_norm), row_pos, col_pos)
    kb = _axial_rope(_rms_heads(heads(kb, B_KV_HEADS), k_norm), row_pos, col_pos)
    yb = _gqa_blocks(qb, kb, heads(vb, B_KV_HEADS))
    g_a, g_b = jnp.split(jax.nn.sigmoid(gates + b_gates), 2, axis=-1)
    y = g_a * (ya @ w_branch_a) + g_b * (yb @ w_branch_b)
    return y @ w_out


def _moe(x, w_router, b_router, w_gate, b_gate, w_lin, b_lin, w_down, b_down):
    b, s, d = x.shape
    t = b * s
    xf = x.reshape(t, d)
    logits = (xf @ w_router).astype(jnp.float32) + b_router.astype(jnp.float32)
    top_vals, top_idx = lax.top_k(logits, TOP_K)
    gate_w = jax.nn.softmax(top_vals, axis=-1)
    a = t * TOP_K
    flat_e = top_idx.reshape(a)
    order = jnp.argsort(flat_e)
    e_sorted = flat_e[order]
    tok_sorted = (order // TOP_K).astype(jnp.int32)
    w_sorted = gate_w.reshape(a)[order]
    sizes = jnp.bincount(flat_e, length=N_EXPERTS)
    padded = (sizes + MOE_BLOCK - 1) // MOE_BLOCK * MOE_BLOCK
    starts = jnp.cumsum(sizes) - sizes
    pends = jnp.cumsum(padded)
    pstarts = pends - padded
    dest = pstarts[e_sorted] + jnp.arange(a) - starts[e_sorted]
    p_slots = a + N_EXPERTS * MOE_BLOCK
    nblk = p_slots // MOE_BLOCK
    slot_tok = jnp.full((p_slots,), t, jnp.int32).at[dest].set(tok_sorted)
    slot_w = jnp.zeros((p_slots,), jnp.float32).at[dest].set(w_sorted)
    blk_e = jnp.clip(jnp.searchsorted(pends, jnp.arange(nblk) * MOE_BLOCK, side='right'), 0, N_EXPERTS - 1)
    xs = xf[jnp.minimum(slot_tok, t - 1)].reshape(nblk, MOE_BLOCK, d)

    def expert_block(args):
        xb, e = args
        g = jnp.minimum(xb @ w_gate[e] + b_gate[e], SWIGLU_LIMIT)
        lin = jnp.clip(xb @ w_lin[e] + b_lin[e], -SWIGLU_LIMIT, SWIGLU_LIMIT)
        h = (lin + 1.0) * (g * jax.nn.sigmoid(SWIGLU_ALPHA * g))
        return h @ w_down[e] + b_down[e]

    ys = lax.map(expert_block, (xs, blk_e)).reshape(p_slots, d)
    ys = ys * slot_w[:, None].astype(ys.dtype)
    out = jax.ops.segment_sum(ys, slot_tok, num_segments=t + 1)[:t]
    return out.reshape(b, s, d)


def setup_inputs(seed: int = 0) -> dict:
    key = jax.random.key(seed)
    ks = jax.random.split(key, 24)
    beta = (8.0 * DEPTH) ** -0.25
    f32 = jnp.float32

    def nrm(k, shape, fan_in, scale=1.0):
        return jax.random.normal(k, shape, f32) * (scale * fan_in ** -0.5)

    def small(k, shape, scale):
        return jax.random.normal(k, shape, f32) * scale

    col_scale = (jnp.ones((IN_WIDTH,), f32)
                 .at[A_V_OFF:A_V_OFF + A_WIDTH].set(beta)
                 .at[B_V_OFF:B_V_OFF + B_KV_WIDTH].set(beta))
    return {
        'x': jax.random.normal(ks[0], (BATCH, SEQ, D_MODEL), f32),
        'w_in': nrm(ks[1], (DEPTH, D_MODEL, IN_WIDTH), D_MODEL) * col_scale,
        'b_gates': small(ks[2], (DEPTH, 2 * D_MODEL), 0.1),
        'rel_bias': small(ks[3], (REL_BUCKETS, A_HEADS), 0.5),
        'q_norm': 1.0 + small(ks[4], (DEPTH, HEAD_DIM), 0.02),
        'k_norm': 1.0 + small(ks[5], (DEPTH, HEAD_DIM), 0.02),
        'w_branch_a': nrm(ks[6], (DEPTH, A_OUT_WIDTH, D_MODEL), A_OUT_WIDTH, beta),
        'w_branch_b': nrm(ks[7], (DEPTH, B_Q_WIDTH, D_MODEL), B_Q_WIDTH, beta),
        'w_out': nrm(ks[8], (DEPTH, D_MODEL, D_MODEL), D_MODEL, beta),
        'ln1_g': 1.0 + small(ks[9], (DEPTH, D_MODEL), 0.02),
        'ln1_b': small(ks[10], (DEPTH, D_MODEL), 0.02),
        'w_router': nrm(ks[11], (DEPTH, D_MODEL, N_EXPERTS), D_MODEL),
        'b_router': small(ks[12], (DEPTH, N_EXPERTS), 0.01),
        'w_gate': nrm(ks[13], (DEPTH, N_EXPERTS, D_MODEL, D_FF), D_MODEL),
        'b_gate': small(ks[14], (DEPTH, N_EXPERTS, D_FF), 0.02),
        'w_lin': nrm(ks[15], (DEPTH, N_EXPERTS, D_MODEL, D_FF), D_MODEL),
        'b_lin': small(ks[16], (DEPTH, N_EXPERTS, D_FF), 0.02),
        'w_down': nrm(ks[17], (DEPTH, N_EXPERTS, D_FF, D_MODEL), D_FF, beta),
        'b_down': small(ks[18], (DEPTH, N_EXPERTS, D_MODEL), 0.02),
        'ln2_g': 1.0 + small(ks[19], (DEPTH, D_MODEL), 0.02),
        'ln2_b': small(ks[20], (DEPTH, D_MODEL), 0.02),
    }


def reference(x, w_in, b_gates, rel_bias, q_norm, k_norm, w_branch_a, w_branch_b, w_out, ln1_g, ln1_b,
              w_router, b_router, w_gate, b_gate, w_lin, b_lin, w_down, b_down, ln2_g, ln2_b):
    alpha = (2.0 * DEPTH) ** 0.25
    s = x.shape[1]
    rows = s // GRID_W
    row_pos = jnp.repeat(jnp.arange(rows, dtype=jnp.int32), GRID_W)
    col_pos = jnp.tile(jnp.arange(GRID_W, dtype=jnp.int32), rows)
    for l in range(DEPTH):
        mix = _hybrid_mixer(x, w_in[l], b_gates[l], rel_bias, q_norm[l], k_norm[l],
                            w_branch_a[l], w_branch_b[l], w_out[l], row_pos, col_pos)
        x = _layer_norm(alpha * x + mix, ln1_g[l], ln1_b[l])
        ffn = _moe(x, w_router[l], b_router[l], w_gate[l], b_gate[l], w_lin[l], b_lin[l], w_down[l], b_down[l])
        x = _layer_norm(alpha * x + ffn, ln2_g[l], ln2_b[l])
    return x
```

```cpp
#include <hip/hip_runtime.h>
#include <hip/hip_bf16.h>
#include <cstdio>
#include <cstdint>
#define MK_CUTS 1
namespace pg8 {
#define PG8_LAS __attribute__((address_space(3)))
typedef unsigned short bf16_t;
typedef short bf16x8 __attribute__((ext_vector_type(8)));
typedef float f32x4 __attribute__((ext_vector_type(4)));
typedef unsigned u32x4 __attribute__((ext_vector_type(4)));
constexpr int BM = 256, BK = 64, HALF = 128, HTB = HALF * BK * 2  , STAGE_BYTES = 8 * HTB, NXCD = 8, WGM = 8;

__host__ __device__ __forceinline__ int lds_byte(int r, int c) { const int st = (r >> 4) * 2 + (c >> 5), rr = r & 15, cc = c & 31, ob = rr * 64 + cc * 2; return st * 1024 + (ob ^ (((ob >> 9) & 1) << 5)); }
__host__ __device__ __forceinline__ void stage_rc(int b, int& R, int& C) { const int st = b / 1024, sb = b % 1024, swz = sb ^ (((sb >> 9) & 1) << 5); R = (st >> 1) * 16 + swz / 64; C = (st & 1) * 32 + (swz % 64) / 2; }
__host__ __device__ __forceinline__ int perm32(int rho) { const int n = rho >> 4, i = rho & 15; return 8 * (i >> 2) + 4 * n + (i & 3); }

struct Unit { int pm, pn; };
struct Gemm { const bf16_t* A; const bf16_t* Bt; int M, N, K; };

struct StaticOrder {
    int nM, nN, nwg, G, c;
    __host__ __device__ void init(int M, int N, int G_, int c_) { nM = M / BM; nN = N / BM; nwg = nM * nN; G = G_; c = c_; }
    __host__ __device__ bool next(int i, Unit& u) const {
        const long L = (long)i * G + c; if (L >= nwg) return false;
        int wgid = (int)L; { const int q = nwg / NXCD, r = nwg % NXCD, xcd = wgid % NXCD, off = wgid / NXCD; wgid = (xcd < r ? xcd * (q + 1) : r * (q + 1) + (xcd - r) * q) + off; }
        const int nig = WGM * nN, gid = wgid / nig, fm = gid * WGM, gsz = (nM - fm) < WGM ? (nM - fm) : WGM;
        u.pm = fm + ((wgid % nig) % gsz); u.pn = (wgid % nig) / gsz; return true;
    }
    __device__ __forceinline__ void a_ready(const Unit&) const {}
    __device__ __forceinline__ size_t b_off(const Unit&) const { return 0; }
    __device__ __forceinline__ void done(const Unit&) const {}
};


typedef unsigned u32x2 __attribute__((ext_vector_type(2)));
__device__ __forceinline__ unsigned cvt_pk_bf16(float lo, float hi) { unsigned r; asm volatile("v_cvt_pk_bf16_f32 %0, %1, %2" : "=v"(r) : "v"(lo), "v"(hi)); return r; }
__device__ __forceinline__ float bf_lo(unsigned w) { return __builtin_bit_cast(float, w << 16); }
__device__ __forceinline__ float bf_hi(unsigned w) { return __builtin_bit_cast(float, w & 0xffff0000u); }
__device__ __forceinline__ float sigmoidf_(float v) { return __builtin_amdgcn_rcpf(1.0f + __expf(-v)); }

struct EpiStoreBf16 {
    static constexpr bool PERM = true, AFTER_DRAIN = false;
    bf16_t* O; int ldc;
    __device__ __forceinline__ void operator()(const f32x4 (&acc)[2][2][4][2], const Unit& u, int wr, int wc, int fr, int fq) const {
        const int row0 = u.pm * BM + wr * 64 + fr, col0 = u.pn * BM + wc * 32 + 8 * fq;
#pragma unroll
        for (int ai = 0; ai < 2; ++ai)
#pragma unroll
            for (int m = 0; m < 4; ++m) { bf16_t* rowp = O + (size_t)(row0 + ai * HALF + m * 16) * ldc + col0;
#pragma unroll
                for (int bj = 0; bj < 2; ++bj) { const f32x4 v0 = acc[ai][bj][m][0], v1 = acc[ai][bj][m][1];
                    u32x4 w; w.x = cvt_pk_bf16(v0[0], v0[1]); w.y = cvt_pk_bf16(v0[2], v0[3]); w.z = cvt_pk_bf16(v1[0], v1[1]); w.w = cvt_pk_bf16(v1[2], v1[3]);
                    *(u32x4*)(rowp + bj * HALF) = w; } }
    }
};

struct EpiGateA {
    static constexpr bool PERM = true, AFTER_DRAIN = false;
    const bf16_t* proj; int ldp; int gcol0; const float* bg; float* T1; int ldc;
    __device__ __forceinline__ void operator()(const f32x4 (&acc)[2][2][4][2], const Unit& u, int wr, int wc, int fr, int fq) const {
        const int row0 = u.pm * BM + wr * 64 + fr, col0 = u.pn * BM + wc * 32 + 8 * fq;
#pragma unroll
        for (int ai = 0; ai < 2; ++ai)
#pragma unroll
            for (int m = 0; m < 4; ++m) { const int row = row0 + ai * HALF + m * 16;
#pragma unroll
                for (int bj = 0; bj < 2; ++bj) { const int c = col0 + bj * HALF;
                    const u32x4 gw = *(const u32x4*)(proj + (size_t)row * ldp + gcol0 + c);
                    const f32x4 b0 = *(const f32x4*)(bg + c), b1 = *(const f32x4*)(bg + c + 4);
                    f32x4 g0, g1;
                    g0[0] = sigmoidf_(bf_lo(gw.x) + b0[0]); g0[1] = sigmoidf_(bf_hi(gw.x) + b0[1]); g0[2] = sigmoidf_(bf_lo(gw.y) + b0[2]); g0[3] = sigmoidf_(bf_hi(gw.y) + b0[3]);
                    g1[0] = sigmoidf_(bf_lo(gw.z) + b1[0]); g1[1] = sigmoidf_(bf_hi(gw.z) + b1[1]); g1[2] = sigmoidf_(bf_lo(gw.w) + b1[2]); g1[3] = sigmoidf_(bf_hi(gw.w) + b1[3]);
                    float* o = T1 + (size_t)row * ldc + c;
                    *(f32x4*)o = acc[ai][bj][m][0] * g0; *(f32x4*)(o + 4) = acc[ai][bj][m][1] * g1; } }
    }
};
struct EpiGateB {
    static constexpr bool PERM = true, AFTER_DRAIN = false;
    const bf16_t* proj; int ldp; int gcol0; const float* bg; const float* T1; bf16_t* Y; int ldc;
    __device__ __forceinline__ void operator()(const f32x4 (&acc)[2][2][4][2], const Unit& u, int wr, int wc, int fr, int fq) const {
        const int row0 = u.pm * BM + wr * 64 + fr, col0 = u.pn * BM + wc * 32 + 8 * fq;
#pragma unroll
        for (int ai = 0; ai < 2; ++ai)
#pragma unroll
            for (int m = 0; m < 4; ++m) { const int row = row0 + ai * HALF + m * 16;
#pragma unroll
                for (int bj = 0; bj < 2; ++bj) { const int c = col0 + bj * HALF;
                    const u32x4 gw = *(const u32x4*)(proj + (size_t)row * ldp + gcol0 + c);
                    const f32x4 b0 = *(const f32x4*)(bg + c), b1 = *(const f32x4*)(bg + c + 4);
                    const float* tp = T1 + (size_t)row * ldc + c;
                    const f32x4 t0 = *(const f32x4*)tp, t1 = *(const f32x4*)(tp + 4);
                    f32x4 g0, g1;
                    g0[0] = sigmoidf_(bf_lo(gw.x) + b0[0]); g0[1] = sigmoidf_(bf_hi(gw.x) + b0[1]); g0[2] = sigmoidf_(bf_lo(gw.y) + b0[2]); g0[3] = sigmoidf_(bf_hi(gw.y) + b0[3]);
                    g1[0] = sigmoidf_(bf_lo(gw.z) + b1[0]); g1[1] = sigmoidf_(bf_hi(gw.z) + b1[1]); g1[2] = sigmoidf_(bf_lo(gw.w) + b1[2]); g1[3] = sigmoidf_(bf_hi(gw.w) + b1[3]);
                    const f32x4 v0 = t0 + acc[ai][bj][m][0] * g0, v1 = t1 + acc[ai][bj][m][1] * g1;
                    u32x4 w; w.x = cvt_pk_bf16(v0[0], v0[1]); w.y = cvt_pk_bf16(v0[2], v0[3]); w.z = cvt_pk_bf16(v1[0], v1[1]); w.w = cvt_pk_bf16(v1[2], v1[3]);
                    *(u32x4*)(Y + (size_t)row * ldc + c) = w; } }
    }
};
struct EpiResF32 {
    static constexpr bool PERM = false, AFTER_DRAIN = false;
    const float* X; float* Z; int ldc; float alpha;
    __device__ __forceinline__ void operator()(const f32x4 (&acc)[2][2][4][2], const Unit& u, int wr, int wc, int fr, int fq) const {
        const int row0 = u.pm * BM + wr * 64 + fr, col0 = u.pn * BM + wc * 32 + 4 * fq;
#pragma unroll
        for (int ai = 0; ai < 2; ++ai)
#pragma unroll
            for (int m = 0; m < 4; ++m) { const size_t ro = (size_t)(row0 + ai * HALF + m * 16) * ldc + col0;
#pragma unroll
                for (int bj = 0; bj < 2; ++bj)
#pragma unroll
                    for (int n = 0; n < 2; ++n) { const f32x4 xv = *(const f32x4*)(X + ro + bj * HALF + n * 16);
                        *(f32x4*)(Z + ro + bj * HALF + n * 16) = xv * alpha + acc[ai][bj][m][n]; } }
    }
};
struct EpiSwiglu {
    static constexpr bool PERM = true, AFTER_DRAIN = false;
    const PG8_LAS int* tile_e; const float* bgate; const float* blin; bf16_t* H; int ldc;
    __device__ __forceinline__ void operator()(const f32x4 (&acc)[2][2][4][2], const Unit& u, int wr, int wc, int fr, int fq) const {
        const int e = tile_e[u.pm];
        const int row0 = u.pm * BM + wr * 64 + fr, j0 = u.pn * HALF + wc * 32 + 8 * fq;
        const f32x4 bg0 = *(const f32x4*)(bgate + (size_t)e * 2048 + j0), bg1 = *(const f32x4*)(bgate + (size_t)e * 2048 + j0 + 4);
        const f32x4 bl0 = *(const f32x4*)(blin + (size_t)e * 2048 + j0), bl1 = *(const f32x4*)(blin + (size_t)e * 2048 + j0 + 4);
#pragma unroll
        for (int ai = 0; ai < 2; ++ai)
#pragma unroll
            for (int m = 0; m < 4; ++m) { const int row = row0 + ai * HALF + m * 16;
                f32x4 h0, h1;
#pragma unroll
                for (int i = 0; i < 4; ++i) {
                    float g = fminf(acc[ai][0][m][0][i] + bg0[i], 7.0f); float l = fminf(fmaxf(acc[ai][1][m][0][i] + bl0[i], -7.0f), 7.0f);
                    h0[i] = (l + 1.0f) * (g * sigmoidf_(1.702f * g));
                    g = fminf(acc[ai][0][m][1][i] + bg1[i], 7.0f); l = fminf(fmaxf(acc[ai][1][m][1][i] + bl1[i], -7.0f), 7.0f);
                    h1[i] = (l + 1.0f) * (g * sigmoidf_(1.702f * g)); }
                u32x4 w; w.x = cvt_pk_bf16(h0[0], h0[1]); w.y = cvt_pk_bf16(h0[2], h0[3]); w.z = cvt_pk_bf16(h1[0], h1[1]); w.w = cvt_pk_bf16(h1[2], h1[3]);
                *(u32x4*)(H + (size_t)row * ldc + j0) = w; }
    }
};
struct EpiDown {
    static constexpr bool PERM = true, AFTER_DRAIN = false;
    const PG8_LAS int* tile_e; const float* bdown; const float* slot_w; bf16_t* YS; int ldc;
    __device__ __forceinline__ void operator()(const f32x4 (&acc)[2][2][4][2], const Unit& u, int wr, int wc, int fr, int fq) const {
        const int e = tile_e[u.pm];
        const int row0 = u.pm * BM + wr * 64 + fr, col0 = u.pn * BM + wc * 32 + 8 * fq;
        f32x4 bv[2][2];
#pragma unroll
        for (int bj = 0; bj < 2; ++bj)
#pragma unroll
            for (int n = 0; n < 2; ++n) bv[bj][n] = *(const f32x4*)(bdown + (size_t)e * 2048 + col0 + bj * HALF + 4 * n);
#pragma unroll
        for (int ai = 0; ai < 2; ++ai)
#pragma unroll
            for (int m = 0; m < 4; ++m) { const int row = row0 + ai * HALF + m * 16; const float sw = slot_w[row];
#pragma unroll
                for (int bj = 0; bj < 2; ++bj) { const f32x4 v0 = (acc[ai][bj][m][0] + bv[bj][0]) * sw, v1 = (acc[ai][bj][m][1] + bv[bj][1]) * sw;
                    u32x4 w; w.x = cvt_pk_bf16(v0[0], v0[1]); w.y = cvt_pk_bf16(v0[2], v0[3]); w.z = cvt_pk_bf16(v1[0], v1[1]); w.w = cvt_pk_bf16(v1[2], v1[3]);
                    *(u32x4*)(YS + (size_t)row * ldc + col0 + bj * HALF) = w; } }
    }
};
struct MoeOrder : StaticOrder {
    const PG8_LAS int* tile_e; size_t estride;
    __device__ __forceinline__ size_t b_off(const Unit& u) const { return (size_t)__builtin_amdgcn_readfirstlane(tile_e[u.pm]) * estride; }
};
template <class Epi, class Sched, bool ALIGN_EPI = false, bool SP2 = false>
__device__ __forceinline__ void gemm_phase(PG8_LAS unsigned char* lds, const Gemm g, const Sched& S, const Epi& E) {
    const int tid = threadIdx.x, wid = __builtin_amdgcn_readfirstlane(tid >> 6), lane = tid & 63, wr = wid >> 2, wc = wid & 3, fr = lane & 15, fq = lane >> 4;
    const int K = g.K, nt = K / BK;
    unsigned voffA[2], voffB[2];
#pragma unroll
    for (int i = 0; i < 2; ++i) { int R, C; stage_rc(tid * 16 + i * 8192, R, C); const int Rb = Epi::PERM ? ((R & ~31) + perm32(R & 31)) : R;
        voffA[i] = (unsigned)(R * K + C) * 2u; voffB[i] = (unsigned)(Rb * K + C) * 2u; }
    const size_t kstep = (size_t)(BK * 2);
    const size_t hstep = (size_t)HALF * K * 2;
    const size_t tstep = 2 * hstep;
    const unsigned ldsw = (unsigned)wid * 1024u;
    const int aoff = lds_byte(wr * 64 + fr, fq * 8), boff = lds_byte(wc * 32 + fr, fq * 8);
#define PG8_SA(b, h) (((b) * 2 + (h)) * HTB)
#define PG8_SB(b, h) ((4 + (b) * 2 + (h)) * HTB)
#define PG8_STAGE(bufoff, gbase, voff) do { _Pragma("unroll") for (int _i = 0; _i < 2; ++_i) \
        __builtin_amdgcn_global_load_lds((const unsigned*)((const char*)(gbase) + (voff)[_i]), (PG8_LAS unsigned*)(lds + (bufoff) + ldsw + _i * 8192), 16, 0, 0); } while (0)
#define PG8_LDA(dst, b, h) do { _Pragma("unroll") for (int m = 0; m < 4; ++m) _Pragma("unroll") for (int k = 0; k < 2; ++k) dst[m][k] = *(const PG8_LAS bf16x8*)(lds + PG8_SA(b, h) + aoff + m * 2048 + k * 1024); } while (0)
#define PG8_LDB(dst, b, h) do { _Pragma("unroll") for (int n = 0; n < 2; ++n) _Pragma("unroll") for (int k = 0; k < 2; ++k) dst[n][k] = *(const PG8_LAS bf16x8*)(lds + PG8_SB(b, h) + boff + n * 2048 + k * 1024); } while (0)
#define PG8_MMA(ai, bj, At, Bt) do { __builtin_amdgcn_s_setprio(1); _Pragma("unroll") for (int m = 0; m < 4; ++m) _Pragma("unroll") for (int n = 0; n < 2; ++n) _Pragma("unroll") for (int k = 0; k < 2; ++k) \
        acc[ai][bj][m][n] = __builtin_amdgcn_mfma_f32_16x16x32_bf16(Bt[n][k], At[m][k], acc[ai][bj][m][n], 0, 0, 0); __builtin_amdgcn_s_setprio(0); } while (0)
#define PG8_WAIT_V(n) asm volatile("s_waitcnt vmcnt(" #n ")" ::: "memory")
#define PG8_WAIT_L(n) asm volatile("s_waitcnt lgkmcnt(" #n ")" ::: "memory")
#define PG8_BAR __builtin_amdgcn_s_barrier()
#define PG8_SCHED __builtin_amdgcn_sched_barrier(0)
    Unit cur, nxt; int ui = 0;
    if (!S.next(0, cur)) return;
    f32x4 acc[2][2][4][2];
#pragma unroll
    for (int a = 0; a < 2; ++a)
#pragma unroll
        for (int b = 0; b < 2; ++b)
#pragma unroll
            for (int m = 0; m < 4; ++m)
#pragma unroll
                for (int n = 0; n < 2; ++n) acc[a][b][m][n] = (f32x4){0.f, 0.f, 0.f, 0.f};
    bf16x8 At[4][2], B0[2][2], B1[2][2];
    const char* cA = (const char*)g.A + (size_t)cur.pm * tstep; const char* cB = (const char*)g.Bt + S.b_off(cur) + (size_t)cur.pn * tstep;
    S.a_ready(cur);
    if constexpr (SP2) {
        PG8_STAGE(PG8_SB(0, 0), cB, voffB); PG8_STAGE(PG8_SB(0, 1), cB + hstep, voffB); PG8_STAGE(PG8_SA(0, 0), cA, voffA); PG8_STAGE(PG8_SA(0, 1), cA + hstep, voffA);
        if (wr == 1) PG8_BAR;
        PG8_WAIT_V(2); PG8_BAR;
        PG8_STAGE(PG8_SB(1, 0), cB + kstep, voffB); PG8_STAGE(PG8_SA(1, 0), cA + kstep, voffA); PG8_STAGE(PG8_SB(1, 1), cB + hstep + kstep, voffB);
        PG8_WAIT_V(6); PG8_BAR;
    } else {
        PG8_STAGE(PG8_SB(0, 0), cB, voffB); PG8_STAGE(PG8_SA(0, 0), cA, voffA); PG8_STAGE(PG8_SB(0, 1), cB + hstep, voffB); PG8_STAGE(PG8_SA(0, 1), cA + hstep, voffA);
        if (wr == 1) PG8_BAR;
        PG8_WAIT_V(4); PG8_BAR;
        PG8_STAGE(PG8_SB(1, 0), cB + kstep, voffB); PG8_STAGE(PG8_SA(1, 0), cA + kstep, voffA); PG8_STAGE(PG8_SB(1, 1), cB + hstep + kstep, voffB);
        PG8_WAIT_V(6); PG8_BAR;
    }
    for (;;) {
        const bool has_next = S.next(ui + 1, nxt);
        const char* nA = has_next ? (const char*)g.A + (size_t)nxt.pm * tstep : cA; const char* nB = has_next ? (const char*)g.Bt + S.b_off(nxt) + (size_t)nxt.pn * tstep : cB;
        for (int t = 0; t < nt; t += 2) {
            const bool last = (t == nt - 2);
            const char* a1 = cA + (size_t)(t + 1) * kstep;
            const char* a2 = last ? nA : cA + (size_t)(t + 2) * kstep; const char* b2 = last ? nB : cB + (size_t)(t + 2) * kstep;
            const char* a3 = a2 + kstep; const char* b3 = b2 + kstep;
            if (last && has_next) S.a_ready(nxt);
            if constexpr (SP2) {
            PG8_LDB(B0, 0, 0); PG8_LDB(B1, 0, 1); PG8_SCHED; PG8_LDA(At, 0, 0); PG8_STAGE(PG8_SA(1, 1), a1 + hstep, voffA);
            PG8_WAIT_V(8); PG8_WAIT_L(0); PG8_BAR; PG8_MMA(0, 0, At, B0); PG8_MMA(0, 1, At, B1); PG8_BAR; PG8_SCHED;
            PG8_LDA(At, 0, 1); PG8_STAGE(PG8_SB(0, 0), b2, voffB); PG8_STAGE(PG8_SB(0, 1), b2 + hstep, voffB); PG8_STAGE(PG8_SA(0, 0), a2, voffA);
            PG8_WAIT_V(8); PG8_WAIT_L(0); PG8_BAR; PG8_MMA(1, 0, At, B0); PG8_MMA(1, 1, At, B1); PG8_BAR; PG8_SCHED;
            PG8_LDB(B0, 1, 0); PG8_LDB(B1, 1, 1); PG8_SCHED; PG8_LDA(At, 1, 0); PG8_STAGE(PG8_SA(0, 1), a2 + hstep, voffA);
            PG8_WAIT_V(8); PG8_WAIT_L(0); PG8_BAR; PG8_MMA(0, 0, At, B0); PG8_MMA(0, 1, At, B1); PG8_BAR; PG8_SCHED;
            PG8_LDA(At, 1, 1); PG8_STAGE(PG8_SB(1, 0), b3, voffB); PG8_STAGE(PG8_SB(1, 1), b3 + hstep, voffB); PG8_STAGE(PG8_SA(1, 0), a3, voffA);
            PG8_WAIT_V(8); PG8_WAIT_L(0); PG8_BAR; PG8_MMA(1, 0, At, B0); PG8_MMA(1, 1, At, B1); PG8_BAR; PG8_SCHED;
            } else {
            PG8_LDB(B0, 0, 0); PG8_SCHED; PG8_LDA(At, 0, 0); PG8_STAGE(PG8_SA(1, 1), a1 + hstep, voffA);
            PG8_WAIT_L(8); PG8_BAR; PG8_WAIT_L(0); PG8_MMA(0, 0, At, B0); PG8_BAR; PG8_SCHED;
            PG8_LDB(B1, 0, 1); PG8_STAGE(PG8_SB(0, 0), b2, voffB);
            PG8_BAR; PG8_WAIT_L(0); PG8_MMA(0, 1, At, B1); PG8_BAR;
            PG8_LDA(At, 0, 1); PG8_STAGE(PG8_SA(0, 0), a2, voffA);
            PG8_BAR; PG8_WAIT_L(0); PG8_MMA(1, 0, At, B0); PG8_BAR; PG8_SCHED;
            PG8_STAGE(PG8_SB(0, 1), b2 + hstep, voffB);
            PG8_WAIT_V(6); PG8_BAR; PG8_MMA(1, 1, At, B1); PG8_BAR;
            PG8_LDB(B0, 1, 0); PG8_SCHED; PG8_LDA(At, 1, 0); PG8_STAGE(PG8_SA(0, 1), a2 + hstep, voffA);
            PG8_WAIT_L(8); PG8_BAR; PG8_WAIT_L(0); PG8_MMA(0, 0, At, B0); PG8_BAR; PG8_SCHED;
            PG8_LDB(B1, 1, 1); PG8_STAGE(PG8_SB(1, 0), b3, voffB);
            PG8_BAR; PG8_WAIT_L(0); PG8_MMA(0, 1, At, B1); PG8_BAR;
            PG8_LDA(At, 1, 1); PG8_STAGE(PG8_SA(1, 0), a3, voffA);
            PG8_BAR; PG8_WAIT_L(0); PG8_MMA(1, 0, At, B0); PG8_BAR; PG8_SCHED;
            PG8_STAGE(PG8_SB(1, 1), b3 + hstep, voffB);
            PG8_WAIT_V(6); PG8_BAR; PG8_MMA(1, 1, At, B1); PG8_BAR;
            }
        }
        if constexpr (ALIGN_EPI) { if (wr == 0) PG8_BAR; }
        if constexpr (!Epi::AFTER_DRAIN) { E(acc, cur, wr, wc, fr, fq); S.done(cur); }
        if (!has_next) break;
#pragma unroll
        for (int a = 0; a < 2; ++a)
#pragma unroll
            for (int b = 0; b < 2; ++b)
#pragma unroll
                for (int m = 0; m < 4; ++m)
#pragma unroll
                    for (int n = 0; n < 2; ++n) acc[a][b][m][n] = (f32x4){0.f, 0.f, 0.f, 0.f};
        cur = nxt; cA = nA; cB = nB; ++ui;
        if constexpr (ALIGN_EPI) { if (wr == 1) PG8_BAR; }
    }
    PG8_WAIT_V(0);
    if constexpr (!ALIGN_EPI) { if (wr == 0) PG8_BAR; }
    PG8_BAR;
    if constexpr (Epi::AFTER_DRAIN) { E.fused(acc, cur, wr, wc, fr, fq, lds, wid, lane); S.done(cur); }
#undef PG8_SA
#undef PG8_SB
#undef PG8_STAGE
#undef PG8_LDA
#undef PG8_LDB
#undef PG8_MMA
#undef PG8_WAIT_V
#undef PG8_WAIT_L
#undef PG8_BAR
#undef PG8_SCHED
}
}
namespace at {
using bf16 = __hip_bfloat16;
constexpr int   D = 128, NW = 8, QBLK = 32, KVBLK = 64;
constexpr float SCALE = 0.088388347648318440f;
constexpr float THR = 8.f;
constexpr int SDEPTH = 2;
constexpr size_t SHM_V = KVBLK * D * 2, SHM_K = KVBLK * D * 2, SHM_ATTN = 2 * SHM_V + 2 * SHM_K + NW * 64 * 4;
using bf16x8 = __attribute__((ext_vector_type(8))) short;
using s16x4  = __attribute__((ext_vector_type(4))) short;
using f32x16 = __attribute__((ext_vector_type(16))) float;
using f32x8  = __attribute__((ext_vector_type(8))) float;
using u32x4  = __attribute__((ext_vector_type(4))) unsigned;
#define KSWZ(row, colB) ((row) * 256 + ((colB) ^ (((row) & 7) << 4)))
#define SBAR() __builtin_amdgcn_sched_barrier(0)
__device__ __forceinline__ int crow(int r, int hi) { return (r & 3) + 8 * (r >> 2) + 4 * hi; }
__device__ __forceinline__ unsigned cvtpk(float lo, float hi) {
  unsigned r; asm volatile("v_cvt_pk_bf16_f32 %0, %1, %2" : "=v"(r) : "v"(lo), "v"(hi)); return r;
}
template <typename TIn> struct Stage;
template <> struct Stage<bf16>  { using T = bf16x8;
  __device__ static __forceinline__ T ld8(const bf16* p) { return *reinterpret_cast<const bf16x8*>(p); }
  __device__ static __forceinline__ bf16x8 tobf(T x) { return x; } };
template <> struct Stage<float> { using T = f32x8;
  __device__ static __forceinline__ T ld8(const float* p) { return *reinterpret_cast<const f32x8*>(p); }
  __device__ static __forceinline__ bf16x8 tobf(T x) {
    u32x4 w = {cvtpk(x[0], x[1]), cvtpk(x[2], x[3]), cvtpk(x[4], x[5]), cvtpk(x[6], x[7])}; return *reinterpret_cast<bf16x8*>(&w); } };

__device__ __forceinline__ void partialSM(f32x16& p0, f32x16& p1, float& m_reg, float& mn, float& alpha) {
  constexpr float C = SCALE * 1.4426950408889634f;
  float pmax = p0[0]; for (int r = 1; r < 16; ++r) pmax = fmaxf(pmax, p0[r]); for (int r = 0; r < 16; ++r) pmax = fmaxf(pmax, p1[r]);
  { auto rr = __builtin_amdgcn_permlane32_swap(__float_as_uint(pmax), __float_as_uint(pmax), false, false);
    pmax = fmaxf(__uint_as_float(rr[0]), __uint_as_float(rr[1])); }
  if (__builtin_expect(__all(pmax - m_reg <= THR / SCALE), 1)) { mn = m_reg; alpha = 1.f; }
  else { mn = fmaxf(m_reg, pmax); alpha = __builtin_amdgcn_exp2f((m_reg - mn) * C); m_reg = mn; }
  float mnC = -mn * C;
  for (int r = 0; r < 16; ++r) p0[r] = fmaf(p0[r], C, mnC); for (int r = 0; r < 16; ++r) p1[r] = fmaf(p1[r], C, mnC);
  for (int r = 0; r < 16; ++r) p0[r] = __builtin_amdgcn_exp2f(p0[r]);
}
__device__ __forceinline__ void finishSM(f32x16& p0, f32x16& p1, float alpha, float& l_reg, bf16x8& pa0, bf16x8& pa1, bf16x8& pa2, bf16x8& pa3) {
  for (int r = 0; r < 16; ++r) p1[r] = __builtin_amdgcn_exp2f(p1[r]);
  float ps = 0; for (int r = 0; r < 16; ++r) ps += p0[r]; for (int r = 0; r < 16; ++r) ps += p1[r];
  { auto rr = __builtin_amdgcn_permlane32_swap(__float_as_uint(ps), __float_as_uint(ps), false, false);
    ps = __uint_as_float(rr[0]) + __uint_as_float(rr[1]); }
  l_reg = l_reg * alpha + ps;
#define PK4(P, BASE, OUT) do { unsigned a0 = cvtpk(P[BASE + 0], P[BASE + 1]), a1 = cvtpk(P[BASE + 2], P[BASE + 3]);   \
    unsigned b0 = cvtpk(P[BASE + 4], P[BASE + 5]), b1 = cvtpk(P[BASE + 6], P[BASE + 7]);                              \
    auto r0 = __builtin_amdgcn_permlane32_swap(a0, b0, false, false); auto r1 = __builtin_amdgcn_permlane32_swap(a1, b1, false, false); \
    u32x4 w = {r0[0], r1[0], r0[1], r1[1]}; OUT = *reinterpret_cast<bf16x8*>(&w); } while (0)
  PK4(p0, 0, pa0); PK4(p0, 8, pa1); PK4(p1, 0, pa2); PK4(p1, 8, pa3);
#undef PK4
}
__device__ __forceinline__ void qkt(f32x16& p0, f32x16& p1, const bf16* Ks, const bf16x8* qr, int r32, int hi) {
  p0 = f32x16{}; p1 = f32x16{};
  for (int d0 = 0; d0 < 8; ++d0) { int cb = (d0 * 16 + hi * 8) * 2;
    bf16x8 b0 = *reinterpret_cast<const bf16x8*>((const char*)Ks + KSWZ(r32, cb));
    bf16x8 b1 = *reinterpret_cast<const bf16x8*>((const char*)Ks + KSWZ(32 + r32, cb));
    p0 = __builtin_amdgcn_mfma_f32_32x32x16_bf16(b0, qr[d0], p0, 0, 0, 0);
    p1 = __builtin_amdgcn_mfma_f32_32x32x16_bf16(b1, qr[d0], p1, 0, 0, 0); }
}
__device__ __forceinline__ int v_st(int k, int c) { const int kk = (k & ~0xC) | ((k & 4) << 1) | ((k & 8) >> 1); return ((kk >> 3) * 4 + (c >> 5)) * 512 + ((kk & 7) * 32 + (c & 31)) * 2; }
__device__ __forceinline__ int v_rd_base(int lane) { return ((lane & 3) << 3) | (((lane >> 2) & 3) << 6) | (((lane >> 4) & 1) << 5) | (((lane >> 5) & 1) << 8); }
constexpr int v_rd_off(int d0, int ks, int half) { return d0 * 512 + ks * 4096 + half * 2048; }
template <int OFF> __device__ __forceinline__ s16x4 tr_read(int vb) {
  s16x4 r; asm volatile("ds_read_b64_tr_b16 %0, %1 offset:%2" : "=&v"(r) : "v"(vb), "i"(OFF) : "memory"); return r;
}
template <int D0> __device__ __forceinline__ void pv_one(f32x16& od, int vb, bf16x8 pa0, bf16x8 pa1, bf16x8 pa2, bf16x8 pa3) {
  const s16x4 l0 = tr_read<v_rd_off(D0, 0, 0)>(vb), h0 = tr_read<v_rd_off(D0, 0, 1)>(vb), l1 = tr_read<v_rd_off(D0, 1, 0)>(vb), h1 = tr_read<v_rd_off(D0, 1, 1)>(vb);
  const s16x4 l2 = tr_read<v_rd_off(D0, 2, 0)>(vb), h2 = tr_read<v_rd_off(D0, 2, 1)>(vb), l3 = tr_read<v_rd_off(D0, 3, 0)>(vb), h3 = tr_read<v_rd_off(D0, 3, 1)>(vb);
  asm volatile("s_waitcnt lgkmcnt(0)" ::: "memory"); SBAR();
#define PK(L, H) (bf16x8){L[0], L[1], L[2], L[3], H[0], H[1], H[2], H[3]}
  od = __builtin_amdgcn_mfma_f32_32x32x16_bf16(pa0, PK(l0, h0), od, 0, 0, 0);
  od = __builtin_amdgcn_mfma_f32_32x32x16_bf16(pa1, PK(l1, h1), od, 0, 0, 0);
  od = __builtin_amdgcn_mfma_f32_32x32x16_bf16(pa2, PK(l2, h2), od, 0, 0, 0);
  od = __builtin_amdgcn_mfma_f32_32x32x16_bf16(pa3, PK(l3, h3), od, 0, 0, 0);
#undef PK
}
__device__ __forceinline__ void pv_d0(f32x16* o, int vb, bf16x8 pa0, bf16x8 pa1, bf16x8 pa2, bf16x8 pa3) {
  pv_one<0>(o[0], vb, pa0, pa1, pa2, pa3); pv_one<1>(o[1], vb, pa0, pa1, pa2, pa3); pv_one<2>(o[2], vb, pa0, pa1, pa2, pa3); pv_one<3>(o[3], vb, pa0, pa1, pa2, pa3);
}

template <int LDQ, int LDK, int LDV, int LDO>
__device__ __forceinline__ void attn_dense_body(const bf16* __restrict__ Qb, const bf16* __restrict__ Kh, const bf16* __restrict__ Vh,
                                                bf16* __restrict__ Ob, int seq, char* lds) {
  using St = Stage<bf16>; using SQ = Stage<bf16>;
  const int tid = threadIdx.x, wid = tid >> 6, lane = tid & 63, r32 = lane & 31, hi = lane >> 5;
  bf16* V_lds = (bf16*)lds; bf16* K_lds = (bf16*)(lds + 2 * SHM_V);
  float* ws = (float*)(lds + 2 * SHM_V + 2 * SHM_K) + wid * 64; float* li_l = ws; float* al_l = ws + 32;
  float m_reg = -1e30f, l_reg = 0; f32x16 o[4] = {}; bf16x8 qr[8];
  const bf16* Qw = Qb + (long)(wid * QBLK + r32) * LDQ + hi * 8;
#pragma unroll
  for (int d0 = 0; d0 < 8; ++d0) qr[d0] = SQ::tobf(SQ::ld8(Qw + d0 * 16));
  const int sr = tid >> 4, sc = (tid & 15) * 8, vst0 = v_st(sr, sc), vst1 = v_st(32 + sr, sc);
  const int vb0 = (int)(uintptr_t)V_lds + v_rd_base(lane);
  struct { typename St::T vs0, vs1, ks0, ks1; } sr_[SDEPTH];
#define SLOAD(i, k0) do { sr_[i].vs0 = St::ld8(&Vh[(long)((k0) + sr) * LDV + sc]); sr_[i].vs1 = St::ld8(&Vh[(long)((k0) + 32 + sr) * LDV + sc]); \
    sr_[i].ks0 = St::ld8(&Kh[(long)((k0) + sr) * LDK + sc]); sr_[i].ks1 = St::ld8(&Kh[(long)((k0) + 32 + sr) * LDK + sc]); } while (0)
#define SWRITE(b, i) do { *(bf16x8*)((char*)V_lds + (b) * SHM_V + vst0) = St::tobf(sr_[i].vs0);          \
    *(bf16x8*)((char*)V_lds + (b) * SHM_V + vst1) = St::tobf(sr_[i].vs1); int kc = sc * 2;               \
    *(bf16x8*)((char*)K_lds + (b) * SHM_K + KSWZ(sr, kc)) = St::tobf(sr_[i].ks0);                       \
    *(bf16x8*)((char*)K_lds + (b) * SHM_K + KSWZ(32 + sr, kc)) = St::tobf(sr_[i].ks1); } while (0)
#define SWAIT() do { if constexpr (SDEPTH == 2) asm volatile("s_waitcnt vmcnt(4)" ::: "memory"); else asm volatile("s_waitcnt vmcnt(0)" ::: "memory"); } while (0)
#define RESC(a) do { if (__any((a) < 1.f)) { if (hi == 0) al_l[r32] = (a); asm volatile("s_waitcnt lgkmcnt(0)" ::: "memory"); \
    for (int d = 0; d < 4; ++d) for (int r = 0; r < 16; ++r) o[d][r] *= al_l[crow(r, hi)]; } } while (0)
  f32x16 pA0, pA1, pB0, pB1; float mnA, mnB, alA, alB; bf16x8 pa0, pa1, pa2, pa3; const int NT = seq / KVBLK;
  constexpr int SE = 0, SO = SDEPTH - 1;
  SLOAD(SE, 0); asm volatile("s_waitcnt vmcnt(0)" ::: "memory"); SWRITE(0, SE); __syncthreads();
  qkt(pA0, pA1, K_lds, qr, r32, hi); partialSM(pA0, pA1, m_reg, mnA, alA);
  SLOAD(SO, KVBLK); if constexpr (SDEPTH == 2) { if (2 < NT) SLOAD(SE, 2 * KVBLK); }
  SWAIT(); SWRITE(1, SO); __syncthreads();
  for (int j = 1; j + 1 < NT; j += 2) {
    SBAR(); qkt(pB0, pB1, (bf16*)((char*)K_lds + SHM_K), qr, r32, hi);
    finishSM(pA0, pA1, alA, l_reg, pa0, pa1, pa2, pa3); SBAR();
    SLOAD(SO, (j + SDEPTH) * KVBLK); SBAR();
    pv_d0(o, vb0, pa0, pa1, pa2, pa3); partialSM(pB0, pB1, m_reg, mnB, alB);
    __syncthreads(); SWAIT(); SWRITE(0, SE);
    RESC(alB); __syncthreads();
    SBAR(); qkt(pA0, pA1, K_lds, qr, r32, hi);
    finishSM(pB0, pB1, alB, l_reg, pa0, pa1, pa2, pa3); SBAR();
    if (SDEPTH == 1 || j + 3 < NT) SLOAD(SE, (j + 1 + SDEPTH) * KVBLK); SBAR();
    pv_d0(o, vb0 + (int)SHM_V, pa0, pa1, pa2, pa3); partialSM(pA0, pA1, m_reg, mnA, alA);
    __syncthreads(); SWAIT(); SWRITE(1, SO);
    RESC(alA); __syncthreads();
  }
  SBAR(); qkt(pB0, pB1, (bf16*)((char*)K_lds + SHM_K), qr, r32, hi);
  finishSM(pA0, pA1, alA, l_reg, pa0, pa1, pa2, pa3); SBAR();
  pv_d0(o, vb0, pa0, pa1, pa2, pa3); partialSM(pB0, pB1, m_reg, mnB, alB);
  __syncthreads(); RESC(alB);
  finishSM(pB0, pB1, alB, l_reg, pa0, pa1, pa2, pa3); SBAR();
  pv_d0(o, vb0 + (int)SHM_V, pa0, pa1, pa2, pa3);
  if (hi == 0) li_l[r32] = l_reg; asm volatile("s_waitcnt lgkmcnt(0)" ::: "memory");
  float rli[16];
#pragma unroll
  for (int r = 0; r < 16; ++r) rli[r] = __builtin_amdgcn_rcpf(li_l[crow(r, hi)]);
  bf16* Ow = Ob + (long)(wid * QBLK) * LDO;
#pragma unroll
  for (int r = 0; r < 16; ++r) { int orow = crow(r, hi);
    for (int d0 = 0; d0 < 4; ++d0) Ow[(long)orow * LDO + d0 * 32 + r32] = __float2bfloat16(o[d0][r] * rli[r]); }
#undef SLOAD
#undef SWRITE
#undef SWAIT
#undef RESC
}


__device__ __forceinline__ void dilated_unit(const bf16* __restrict__ proj, const float* __restrict__ lutg, bf16* __restrict__ outg, float* __restrict__ lseg,
                                             int d, int hd12, int hh, int r, int i0, char* lds) {
  constexpr int LDP = 10240;
  constexpr float L2E = 1.4426950408889634f, C = SCALE * L2E;
  const int tid = threadIdx.x, wid = tid >> 6, lane = tid & 63, r32 = lane & 31, hi = lane >> 5;
  const int n = 8192 / d;
  char* KV = lds;
  float* lutx = (float*)(lds + 98304);
  float* wsx = (float*)(lds + 98304 + 2048) + wid * 64;
  const int qoff = hd12 * 128, koff = 1536 + hd12 * 128;
  if (tid < 320) { const int o = tid - 96; lutx[tid] = (o >= 0 && o <= 128) ? lutg[o] * L2E : -1e30f; }
  const int iq = i0 + wid * 32 + r32;
  const int sr = tid >> 4, sc = (tid & 15) * 8;
  f32x16 s00, s01, s10, s11, s20, s21;
  const int a = wid >> 1;
  {
    const bf16* Qw = proj + (size_t)(r + iq * d) * LDP + qoff + hi * 8;
    bf16x8 qr[8];
#pragma unroll
    for (int d0 = 0; d0 < 8; ++d0) qr[d0] = *reinterpret_cast<const bf16x8*>(Qw + d0 * 16);
#pragma unroll
    for (int ib = 0; ib < 12; ib += 6) {
      bf16x8 kv6[6];
#pragma unroll
      for (int i = 0; i < 6; ++i) { const int row = sr + 32 * (ib + i); int j = i0 - 64 + row; j = j < 0 ? 0 : (j >= n ? n - 1 : j);
        kv6[i] = *reinterpret_cast<const bf16x8*>(proj + (size_t)(r + j * d) * LDP + koff + sc); }
#pragma unroll
      for (int i = 0; i < 6; ++i) { const int row = sr + 32 * (ib + i);
        *reinterpret_cast<bf16x8*>(KV + (row >> 6) * 16384 + KSWZ(row & 63, sc * 2)) = kv6[i]; }
      SBAR();
    }
    __syncthreads();
    qkt(s00, s01, (const bf16*)(KV + (a + 0) * 16384), qr, r32, hi);
    qkt(s10, s11, (const bf16*)(KV + (a + 1) * 16384), qr, r32, hi);
    qkt(s20, s21, (const bf16*)(KV + (a + 2) * 16384), qr, r32, hi);
  }
  __syncthreads();
  SBAR();
  const int base = -32 * (wid & 1) - 64 - r32 + 4 * hi;
  const float* lp = lutx + (base + 160);
  float mx = -1e30f;
#define DIL_LOGITS(S, TT, HALF) _Pragma("unroll") for (int rr = 0; rr < 16; ++rr) { const float v = fmaf(S[rr], C, lp[64 * TT + 32 * HALF + (rr & 3) + 8 * (rr >> 2)]); S[rr] = v; }
  DIL_LOGITS(s00, 0, 0) DIL_LOGITS(s01, 0, 1) DIL_LOGITS(s10, 1, 0) DIL_LOGITS(s11, 1, 1) DIL_LOGITS(s20, 2, 0) DIL_LOGITS(s21, 2, 1)
#undef DIL_LOGITS
  if (i0 == 0 || i0 + 320 > n) {
    const int lo = -iq - base, hi_ = n - 1 - iq - base;
#define DIL_MASK(S, TT, HALF) _Pragma("unroll") for (int rr = 0; rr < 16; ++rr) { const int c = 64 * TT + 32 * HALF + (rr & 3) + 8 * (rr >> 2); S[rr] = (c >= lo && c <= hi_) ? S[rr] : -1e30f; }
    DIL_MASK(s00, 0, 0) DIL_MASK(s01, 0, 1) DIL_MASK(s10, 1, 0) DIL_MASK(s11, 1, 1) DIL_MASK(s20, 2, 0) DIL_MASK(s21, 2, 1)
#undef DIL_MASK
  }
#define DIL_MAX(S) _Pragma("unroll") for (int rr = 0; rr < 16; ++rr) mx = fmaxf(mx, S[rr]);
  DIL_MAX(s00) DIL_MAX(s01) DIL_MAX(s10) DIL_MAX(s11) DIL_MAX(s20) DIL_MAX(s21)
#undef DIL_MAX
  { auto rr = __builtin_amdgcn_permlane32_swap(__float_as_uint(mx), __float_as_uint(mx), false, false);
    mx = fmaxf(__uint_as_float(rr[0]), __uint_as_float(rr[1])); }
  float ps = 0.f;
#define DIL_EXP(S) _Pragma("unroll") for (int rr = 0; rr < 16; ++rr) { const float p = __builtin_amdgcn_exp2f(S[rr] - mx); S[rr] = p; ps += p; }
  DIL_EXP(s00) DIL_EXP(s01) DIL_EXP(s10) DIL_EXP(s11) DIL_EXP(s20) DIL_EXP(s21)
#undef DIL_EXP
  { auto rr = __builtin_amdgcn_permlane32_swap(__float_as_uint(ps), __float_as_uint(ps), false, false);
    ps = __uint_as_float(rr[0]) + __uint_as_float(rr[1]); }
  bf16x8 pa[12];
#define PK4(P, BASE, OUT) do { unsigned a0 = cvtpk(P[BASE + 0], P[BASE + 1]), a1 = cvtpk(P[BASE + 2], P[BASE + 3]);   \
    unsigned b0 = cvtpk(P[BASE + 4], P[BASE + 5]), b1 = cvtpk(P[BASE + 6], P[BASE + 7]);                              \
    auto r0 = __builtin_amdgcn_permlane32_swap(a0, b0, false, false); auto r1 = __builtin_amdgcn_permlane32_swap(a1, b1, false, false); \
    u32x4 w = {r0[0], r1[0], r0[1], r1[1]}; OUT = *reinterpret_cast<bf16x8*>(&w); } while (0)
  PK4(s00, 0, pa[0]); PK4(s00, 8, pa[1]); PK4(s01, 0, pa[2]); PK4(s01, 8, pa[3]);
  PK4(s10, 0, pa[4]); PK4(s10, 8, pa[5]); PK4(s11, 0, pa[6]); PK4(s11, 8, pa[7]);
  PK4(s20, 0, pa[8]); PK4(s20, 8, pa[9]); PK4(s21, 0, pa[10]); PK4(s21, 8, pa[11]);
#undef PK4
  SBAR();
#pragma unroll
  for (int ib = 0; ib < 12; ib += 6) {
    bf16x8 kv6[6];
#pragma unroll
    for (int i = 0; i < 6; ++i) { const int row = sr + 32 * (ib + i); int j = i0 - 64 + row; j = j < 0 ? 0 : (j >= n ? n - 1 : j);
      kv6[i] = *reinterpret_cast<const bf16x8*>(proj + (size_t)(r + j * d) * LDP + koff + 1536 + sc); }
#pragma unroll
    for (int i = 0; i < 6; ++i) { const int row = sr + 32 * (ib + i);
      *reinterpret_cast<bf16x8*>(KV + (row >> 6) * 16384 + v_st(row & 63, sc)) = kv6[i]; }
    SBAR();
  }
  if (hi == 0) wsx[r32] = ps;
  __syncthreads();
  f32x16 o[4] = {};
  const int vb = (int)(uintptr_t)KV + v_rd_base(lane);
  pv_d0(o, vb + (a + 0) * 16384, pa[0], pa[1], pa[2], pa[3]);
  pv_d0(o, vb + (a + 1) * 16384, pa[4], pa[5], pa[6], pa[7]);
  pv_d0(o, vb + (a + 2) * 16384, pa[8], pa[9], pa[10], pa[11]);
  float rli[16];
#pragma unroll
  for (int rr = 0; rr < 16; ++rr) rli[rr] = __builtin_amdgcn_rcpf(wsx[crow(rr, hi)]);
#pragma unroll
  for (int rr = 0; rr < 16; ++rr) { const int ir = i0 + wid * 32 + crow(rr, hi); bf16* orow = outg + (size_t)(r + ir * d) * 512 + hh * 128 + r32;
#pragma unroll
    for (int d0 = 0; d0 < 4; ++d0) orow[d0 * 32] = __float2bfloat16(o[d0][rr] * rli[rr]); }
  if (hi == 0) lseg[(size_t)(r + iq * d) * 4 + hh] = (mx + __builtin_amdgcn_logf(ps)) * 0.6931471805599453f;
  __syncthreads();
}
}

#define GAS __attribute__((address_space(1)))
#define LAS __attribute__((address_space(3)))
typedef unsigned short bf16;
typedef unsigned v4u __attribute__((ext_vector_type(4)));
typedef unsigned v2u __attribute__((ext_vector_type(2)));
typedef float f32x4 __attribute__((ext_vector_type(4)));
#define LDS_WAIT() asm volatile("s_waitcnt lgkmcnt(0)" ::: "memory")
#define VM_WAIT() asm volatile("s_waitcnt vmcnt(0)" ::: "memory")
__device__ __forceinline__ unsigned pk2(float lo, float hi) { return pg8::cvt_pk_bf16(lo, hi); }
__device__ __forceinline__ float bflo(unsigned w) { return __builtin_bit_cast(float, w << 16); }
__device__ __forceinline__ float bfhi(unsigned w) { return __builtin_bit_cast(float, w & 0xffff0000u); }
__device__ __forceinline__ float bf2f(bf16 b) { return __builtin_bit_cast(float, ((unsigned)b) << 16); }

#define XB_TMO      128
#define XB_XCNT(j)  (256  + 64 * (j))
#define XB_XSUB(j)  (1280 + 64 * (j))
#define XB_XGEN(j)  (2304 + 64 * (j))
#define XB_TOP      3328
#define XB_TOPGEN   3392
#define XCD_BAR_WORDS 3456
#define XB_SPIN_CAP (1u << 18)

__device__ __forceinline__ unsigned xb_ld(unsigned* p)              { return __hip_atomic_load(p, __ATOMIC_RELAXED, __HIP_MEMORY_SCOPE_AGENT); }
__device__ __forceinline__ unsigned xb_add(unsigned* p, unsigned v) { return __hip_atomic_fetch_add(p, v, __ATOMIC_RELAXED, __HIP_MEMORY_SCOPE_AGENT); }
__device__ __forceinline__ unsigned xb_xcc_id() { return (unsigned)__builtin_amdgcn_s_getreg((3 << 11) | 20) & 0xFu; }
#define XB_SPIN(cond, bar) do { unsigned _sp = 0; while (cond) { __builtin_amdgcn_s_sleep(1); \
    if ((++_sp & 255u) == 0u) { if (xb_ld(&(bar)[XB_TMO])) break; if (_sp > XB_SPIN_CAP) { atomicAdd(&(bar)[XB_TMO], 1u); break; } } } } while (0)

struct XcdBarrier {
    unsigned* bar; unsigned x;
    volatile LAS unsigned* st;
};

__device__ __forceinline__ XcdBarrier xcd_barrier_post(unsigned* bar, volatile LAS unsigned* st) {
    XcdBarrier b; b.bar = bar; b.x = xb_xcc_id(); b.st = st;
    if (threadIdx.x == 0) (void)xb_add(&bar[XB_XCNT(b.x)], 1u);
    return b;
}
__device__ __forceinline__ void xcd_barrier_complete(unsigned* bar, unsigned x, unsigned& nloc, unsigned& nx) {
    const unsigned G = gridDim.x * gridDim.y * gridDim.z;
    unsigned sum, cnt, mine, sp = 0u;
    for (;;) {
        sum = 0u; cnt = 0u; mine = 0u;
#pragma unroll
        for (unsigned j = 0; j < 16; ++j) { const unsigned c = xb_ld(&bar[XB_XCNT(j)]); sum += c; cnt += (c > 0u) ? 1u : 0u; mine = (j == x) ? c : mine; }
        if (sum == G) break;
        __builtin_amdgcn_s_sleep(1);
        if ((++sp & 255u) == 0u) { if (xb_ld(&bar[XB_TMO])) break; if (sp > XB_SPIN_CAP) { atomicAdd(&bar[XB_TMO], 1u); break; } }
    }
    nloc = mine > 0u ? mine : 1u; nx = cnt > 0u ? cnt : 1u;
}

__device__ __forceinline__ void xcd_barrier(const XcdBarrier& b) {
    asm volatile("s_waitcnt vmcnt(0)" ::: "memory");
    __syncthreads();
    if (threadIdx.x == 0) {
        unsigned* bar = b.bar;
        __builtin_amdgcn_s_waitcnt(0);
        unsigned nloc = b.st[0], nx = b.st[1];
        if (nloc == 0u) { xcd_barrier_complete(bar, b.x, nloc, nx); b.st[0] = nloc; b.st[1] = nx; }
        const unsigned old = xb_add(&bar[XB_XSUB(b.x)], 1u);
        const unsigned gen = old / nloc;
        if (old + 1u == (gen + 1u) * nloc) {
            __builtin_amdgcn_fence(__ATOMIC_RELEASE, "agent");
            asm volatile("s_waitcnt vmcnt(0)" ::: "memory");
            const unsigned og = xb_add(&bar[XB_TOP], 1u);
            const unsigned tg = og / nx;
            if (og + 1u == (tg + 1u) * nx) xb_add(&bar[XB_TOPGEN], 1u);
            else XB_SPIN(xb_ld(&bar[XB_TOPGEN]) == tg, bar);
            __builtin_amdgcn_fence(__ATOMIC_ACQUIRE, "agent");
            xb_add(&bar[XB_XGEN(b.x)], 1u);
            asm volatile("s_waitcnt vmcnt(0)" ::: "memory");
        } else {
            XB_SPIN(xb_ld(&bar[XB_XGEN(b.x)]) == gen, bar);
            __builtin_amdgcn_fence(__ATOMIC_ACQUIRE, "agent");
            asm volatile("s_waitcnt vmcnt(0)" ::: "memory");
        }
    }
    __syncthreads();
}

constexpr int S_ = 8192, DM = 2048, INW = 10240, NE = 32, TOPK = 4;
constexpr int A_W = 1536, A_V_OFF = 3072, B_Q_OFF = 4608, B_K_OFF = 5632, B_V_OFF = 5888, GATE_OFF = 6144;
constexpr int MAXSLOT = 40960;
constexpr float LN_EPS = 1e-5f, QK_EPS = 1e-6f;
constexpr float ALPHA = 1.189207115002721f;
constexpr int NPH = 11;

constexpr size_t MiB = 1u << 20;
constexpr size_t WS_CTL = 0, CTL_ZERO_BYTES = 64 * 1024;
constexpr int CW_BAR = 0;
constexpr int CW_CNT = 4096;
constexpr size_t WS_LUT = 1 * MiB;
constexpr size_t WS_ROPE = 1 * MiB + 8192;
constexpr size_t WS_WRT = 1 * MiB + 65536;
constexpr size_t WS_TOKE = 1 * MiB + 65536 + 262144;
constexpr size_t WS_TOKR = WS_TOKE + 131072;
constexpr size_t WS_TOKW = WS_TOKR + 131072;
constexpr size_t WS_TOKS = WS_TOKW + 131072;
constexpr size_t WS_SLOTW = WS_TOKS + 131072;
constexpr size_t WS_LSE = 3 * MiB;
constexpr size_t WS_XB = 4 * MiB;
constexpr size_t WS_WIN = WS_XB + 32 * MiB;
constexpr size_t WS_WA = WS_WIN + 40 * MiB;
constexpr size_t WS_WB = WS_WA + 2 * MiB;
constexpr size_t WS_WO = WS_WB + 4 * MiB;
constexpr size_t WS_WGL = WS_WO + 8 * MiB;
constexpr size_t WS_WD = WS_WGL + 512 * MiB;
constexpr size_t WS_PROJ = WS_WD + 256 * MiB;
constexpr size_t WS_QBR = WS_PROJ + 160 * MiB;
constexpr size_t WS_KBR = WS_QBR + 16 * MiB;
constexpr size_t WS_VBR = WS_KBR + 4 * MiB;
constexpr size_t WS_OUTA = WS_VBR + 4 * MiB;
constexpr size_t WS_YA = WS_OUTA + 24 * MiB;
constexpr size_t WS_YB = WS_YA + 8 * MiB;
constexpr size_t WS_T1 = WS_YB + 16 * MiB;
constexpr size_t WS_Y = WS_T1 + 64 * MiB;
constexpr size_t WS_X1 = WS_Y + 32 * MiB;
constexpr size_t WS_X1B = WS_X1 + 64 * MiB;
constexpr size_t WS_XS = WS_X1B + 32 * MiB;
constexpr size_t WS_H = WS_XS + 160 * MiB;
constexpr size_t WS_YS = WS_PROJ;
constexpr size_t WS_END = WS_H + 160 * MiB;

constexpr int RING_OFF = 0, RING_BYTES = 131072;
constexpr int L_XB = RING_BYTES;
constexpr int L_TILE = RING_BYTES + 64;
constexpr int L_PST = RING_BYTES + 1024;
constexpr int L_CNT = RING_BYTES + 1280;
constexpr int L_ASG = RING_BYTES + 2048;
constexpr int L_PTR = RING_BYTES + 3584;
constexpr int LDS_BYTES = 147456;

struct Frame {
    LAS unsigned char* lds; unsigned char* ldsg;
    unsigned char* ws; unsigned* ctl;
    int tid, lane, wave, G;
};
__device__ __forceinline__ const float* inp(const Frame& F, int i) {
    const LAS unsigned* p = (const LAS unsigned*)(F.lds + L_PTR) + 2 * i;
    const unsigned lo = __builtin_amdgcn_readfirstlane(p[0]), hi = __builtin_amdgcn_readfirstlane(p[1]);
    return (const float*)(((unsigned long long)hi << 32) | lo);
}
__device__ __forceinline__ float wave_sum(float v) {
#pragma unroll
    for (int o = 1; o < 64; o <<= 1) v += __shfl_xor(v, o);
    return v;
}

__device__ __forceinline__ void transpose_item(const float* __restrict__ W, int N, int k0, int n0, bf16* WT, int ldo, int orow0, int ocol0, LAS float* scr, int lane) {
    f32x4 v[8];
#pragma unroll
    for (int i = 0; i < 8; ++i) v[i] = *(const f32x4*)(W + (size_t)(k0 + 8 * i + (lane >> 3)) * N + n0 + 4 * (lane & 7));
#pragma unroll
    for (int i = 0; i < 8; ++i) { LAS float* s = scr + (8 * i + (lane >> 3)) * 33 + 4 * (lane & 7); s[0] = v[i][0]; s[1] = v[i][1]; s[2] = v[i][2]; s[3] = v[i][3]; }
    LDS_WAIT(); asm volatile("" ::: "memory");
    const int c = lane & 7;
#pragma unroll
    for (int j = 0; j < 4; ++j) { const int n = (lane >> 3) + 8 * j; const LAS float* s = scr + (8 * c) * 33 + n;
        v4u o; o.x = pk2(s[0 * 33], s[1 * 33]); o.y = pk2(s[2 * 33], s[3 * 33]); o.z = pk2(s[4 * 33], s[5 * 33]); o.w = pk2(s[6 * 33], s[7 * 33]);
        *(v4u*)(WT + (size_t)(orow0 + n) * ldo + ocol0 + 8 * c) = o; }
    LDS_WAIT(); asm volatile("" ::: "memory");
}
__device__ __forceinline__ int t5_bucket(int rel) {
    const int n = rel < 0 ? -rel : rel; const float nf = (float)(n < 1 ? 1 : n);
    int large = 8 + (int)(logf(nf / 8.0f) / 4.852030263919617f * 8.0f); large = large < 15 ? large : 15;
    return (rel > 0 ? 16 : 0) + (n < 8 ? n : large);
}
__device__ __forceinline__ void p0_prologue(Frame& F) {
    LAS float* scr = (LAS float*)(F.lds + RING_OFF + F.wave * 16384);
    const int gw = blockIdx.x * 8 + F.wave, NGW = F.G * 8;
    const int gt = blockIdx.x * 512 + F.tid, NGT = F.G * 512;
    bf16* XB = (bf16*)(F.ws + WS_XB); bf16* WIN = (bf16*)(F.ws + WS_WIN); bf16* WA = (bf16*)(F.ws + WS_WA); bf16* WB = (bf16*)(F.ws + WS_WB); bf16* WO = (bf16*)(F.ws + WS_WO);
    bf16* WGL = (bf16*)(F.ws + WS_WGL); bf16* WD = (bf16*)(F.ws + WS_WD);
    { float* lut = (float*)(F.ws + WS_LUT); const float* rb = inp(F, 3);
      for (int i = gt; i < 3 * 4 * 129; i += NGT) { const int g = i / 516, hh = (i / 129) % 4, j = i % 129; const int d = (g == 0) ? 1 : (g == 1 ? 4 : 16);
          lut[i] = rb[t5_bucket((j - 64) * d) * 12 + g * 4 + hh]; }
      float* rope = (float*)(F.ws + WS_ROPE);
      for (int i = gt; i < 128 * 32; i += NGT) { const int pos = i >> 5, fi = i & 31; const float inv = powf(10000.0f, -(float)(2 * fi) / 64.0f); const float ang = (float)pos * inv;
          rope[2 * i] = __cosf(ang); rope[2 * i + 1] = __sinf(ang); }
      float* wrt = (float*)(F.ws + WS_WRT); const float* wr = inp(F, 11);
      for (int i = gt; i < 32 * 2048; i += NGT) { const int e = i >> 11, c = i & 2047; wrt[i] = wr[c * 32 + e]; }
    }
    { const float* x = inp(F, 0);
      for (int i = gw; i < S_ * DM / 512; i += NGW) { const size_t o = (size_t)i * 512 + F.lane * 8; const f32x4 a = *(const f32x4*)(x + o), b = *(const f32x4*)(x + o + 4);
          v4u w; w.x = pk2(a[0], a[1]); w.y = pk2(a[2], a[3]); w.z = pk2(b[0], b[1]); w.w = pk2(b[2], b[3]); *(v4u*)(XB + o) = w; } }
    constexpr int I_WIN = 32 * 320, I_WA = 8 * 64, I_WB = 16 * 64, I_WO = 32 * 64, I_EXP = 32 * 64, I_MOE = 3 * 32 * I_EXP;
    constexpr int NITEMS = I_WIN + I_WA + I_WB + I_WO + I_MOE;
    const float* const w_in = inp(F, 1); const float* const w_ba = inp(F, 6); const float* const w_bb = inp(F, 7); const float* const w_o = inp(F, 8);
    const float* const w_g = inp(F, 13); const float* const w_l = inp(F, 15); const float* const w_d = inp(F, 17);
    for (int it = gw; it < NITEMS; it += NGW) {
        int r = it;
        if (r < I_WIN) { const int kb = r / 320, nb = r % 320; transpose_item(w_in, INW, 64 * kb, 32 * nb, WIN, 2048, 32 * nb, 64 * kb, scr, F.lane); continue; } r -= I_WIN;
        if (r < I_WA) { const int kb = r / 64, nb = r % 64; transpose_item(w_ba, DM, 64 * kb, 32 * nb, WA, 512, 32 * nb, 64 * kb, scr, F.lane); continue; } r -= I_WA;
        if (r < I_WB) { const int kb = r / 64, nb = r % 64; transpose_item(w_bb, DM, 64 * kb, 32 * nb, WB, 1024, 32 * nb, 64 * kb, scr, F.lane); continue; } r -= I_WB;
        if (r < I_WO) { const int kb = r / 64, nb = r % 64; transpose_item(w_o, DM, 64 * kb, 32 * nb, WO, 2048, 32 * nb, 64 * kb, scr, F.lane); continue; } r -= I_WO;
        const int which = r / (32 * I_EXP), rr = r % (32 * I_EXP), e = rr / I_EXP, q = rr % I_EXP, kb = q / 64, nb = q % 64, n0 = 32 * nb;
        const float* src = (which == 0 ? w_g : (which == 1 ? w_l : w_d)) + (size_t)e * DM * DM;
        if (which < 2) transpose_item(src, DM, 64 * kb, n0, WGL + (size_t)e * 4096 * 2048, 2048, (n0 >> 7) * 256 + which * 128 + (n0 & 127), 64 * kb, scr, F.lane);
        else transpose_item(src, DM, 64 * kb, n0, WD + (size_t)e * 2048 * 2048, 2048, n0, 64 * kb, scr, F.lane);
    }
}

__device__ __forceinline__ void p2_prep_dilated(Frame& F) {
    const bf16* proj = (const bf16*)(F.ws + WS_PROJ);
    bf16* QBR = (bf16*)(F.ws + WS_QBR); bf16* KBR = (bf16*)(F.ws + WS_KBR); bf16* VBR = (bf16*)(F.ws + WS_VBR);
    const float* rope = (const float*)(F.ws + WS_ROPE);
    const int gw = blockIdx.x * 8 + F.wave, NGW = F.G * 8;
    const int half = F.lane >> 5, fi = F.lane & 31, c1 = half * 64 + fi, c2 = c1 + 32;
    const float* const qn_g = inp(F, 4); const float* const kn_g = inp(F, 5);
    for (int it = gw; it < S_ * 12; it += NGW) {
        const int t = it / 12, h = it % 12;
        if (h >= 10) { const unsigned* vs = (const unsigned*)(proj + (size_t)t * INW + B_V_OFF + (h - 10) * 128); ((unsigned*)(VBR + (size_t)t * 256 + (h - 10) * 128))[F.lane] = vs[F.lane]; continue; }
        const bf16* src = proj + (size_t)t * INW + (h < 8 ? B_Q_OFF + h * 128 : B_K_OFF + (h - 8) * 128);
        const float* gn = h < 8 ? qn_g : kn_g;
        float v1 = bf2f(src[c1]), v2 = bf2f(src[c2]);
        const float ss = wave_sum(v1 * v1 + v2 * v2);
        const float rs = 1.0f / sqrtf(ss * (1.0f / 128.0f) + QK_EPS);
        v1 = v1 * rs * gn[c1]; v2 = v2 * rs * gn[c2];
        const int pos = half ? (t & 63) : (t >> 6);
        const float cs = rope[(pos * 32 + fi) * 2], sn = rope[(pos * 32 + fi) * 2 + 1];
        const float o1 = v1 * cs - v2 * sn, o2 = v1 * sn + v2 * cs;
        bf16* dst = h < 8 ? QBR + (size_t)t * 1024 + h * 128 : KBR + (size_t)t * 256 + (h - 8) * 128;
        dst[c1] = (bf16)(pk2(o1, 0.f) & 0xffffu); dst[c2] = (bf16)(pk2(o2, 0.f) & 0xffffu);
    }
    const float* lut = (const float*)(F.ws + WS_LUT);
    for (int u = blockIdx.x; u < 384; u += F.G) {
        const int gh = u >> 5, blk = u & 31, g = gh >> 2, hh = gh & 3, d = (g == 0) ? 1 : (g == 1 ? 4 : 16);
        const int bps = 32 / d, r = blk / bps, qb = blk % bps;
        at::dilated_unit((const at::bf16*)proj, lut + (g * 4 + hh) * 129, (at::bf16*)(F.ws + WS_OUTA) + (size_t)g * S_ * 512, (float*)(F.ws + WS_LSE) + (size_t)g * S_ * 4,
                         d, gh, hh, r, qb * 256, (char*)F.ldsg + RING_OFF);
    }
}

__device__ __forceinline__ void p3_attn_combine(Frame& F) {
    const at::bf16* QBR = (const at::bf16*)(F.ws + WS_QBR); const at::bf16* KBR = (const at::bf16*)(F.ws + WS_KBR); const at::bf16* VBR = (const at::bf16*)(F.ws + WS_VBR);
    at::bf16* YB = (at::bf16*)(F.ws + WS_YB);
    for (int u = blockIdx.x; u < 256; u += F.G) {
        const int h = u & 7, qb = u >> 3, kv = h >> 2;
        at::attn_dense_body<1024, 256, 256, 1024>(QBR + (size_t)qb * 256 * 1024 + h * 128, KBR + kv * 128, VBR + kv * 128, YB + (size_t)qb * 256 * 1024 + h * 128, S_, (char*)F.ldsg + RING_OFF);
        __syncthreads();
    }
    const bf16* OUTA = (const bf16*)(F.ws + WS_OUTA); const float* LSE = (const float*)(F.ws + WS_LSE); bf16* YA = (bf16*)(F.ws + WS_YA);
    for (int tb = blockIdx.x; tb < 256; tb += F.G) {
        const int t = tb * 32 + (F.tid >> 4), c0 = (F.tid & 15) * 32, hh = c0 >> 7;
        const float l0 = LSE[(size_t)t * 4 + hh], l1 = LSE[(size_t)(S_ + t) * 4 + hh], l2 = LSE[(size_t)(2 * S_ + t) * 4 + hh];
        const float m = fmaxf(l0, fmaxf(l1, l2)); float w0 = __expf(l0 - m), w1 = __expf(l1 - m), w2 = __expf(l2 - m); const float inv = 1.0f / (w0 + w1 + w2); w0 *= inv; w1 *= inv; w2 *= inv;
#pragma unroll
        for (int q = 0; q < 4; ++q) { const size_t o = (size_t)t * 512 + c0 + q * 8;
            const v4u a = *(const v4u*)(OUTA + o), b = *(const v4u*)(OUTA + (size_t)S_ * 512 + o), c = *(const v4u*)(OUTA + (size_t)2 * S_ * 512 + o);
            v4u w;
            w.x = pk2(w0 * bflo(a.x) + w1 * bflo(b.x) + w2 * bflo(c.x), w0 * bfhi(a.x) + w1 * bfhi(b.x) + w2 * bfhi(c.x));
            w.y = pk2(w0 * bflo(a.y) + w1 * bflo(b.y) + w2 * bflo(c.y), w0 * bfhi(a.y) + w1 * bfhi(b.y) + w2 * bfhi(c.y));
            w.z = pk2(w0 * bflo(a.z) + w1 * bflo(b.z) + w2 * bflo(c.z), w0 * bfhi(a.z) + w1 * bfhi(b.z) + w2 * bfhi(c.z));
            w.w = pk2(w0 * bflo(a.w) + w1 * bflo(b.w) + w2 * bflo(c.w), w0 * bfhi(a.w) + w1 * bfhi(b.w) + w2 * bfhi(c.w));
            *(v4u*)(YA + o) = w; }
    }
}

__device__ __forceinline__ void p6_ln_router(Frame& F) {
    LAS int* cntl = (LAS int*)(F.lds + L_CNT); LAS int* basel = cntl + 32;
    LAS int* asg_e = (LAS int*)(F.lds + L_ASG); LAS int* asg_lr = asg_e + 128; LAS float* asg_w = (LAS float*)(asg_lr + 128);
    const float* Z1 = (const float*)(F.ws + WS_T1); float* X1 = (float*)(F.ws + WS_X1); bf16* X1B = (bf16*)(F.ws + WS_X1B);
    const f32x4* G4 = (const f32x4*)inp(F, 9); const f32x4* B4 = (const f32x4*)inp(F, 10);
    const f32x4* WRT4 = (const f32x4*)(F.ws + WS_WRT); const float* br = inp(F, 12);
    unsigned* gcnt = F.ctl + CW_CNT;
    int* TOKE = (int*)(F.ws + WS_TOKE); int* TOKR = (int*)(F.ws + WS_TOKR); float* TOKW = (float*)(F.ws + WS_TOKW);
    for (int tb = blockIdx.x; tb < 256; tb += F.G) {
        if (F.tid < 32) cntl[F.tid] = 0;
        __syncthreads();
#pragma unroll 1
        for (int hp = 0; hp < 2; ++hp) {
        const int t0 = tb * 32 + F.wave * 4 + hp * 2;
        f32x4 xv[2][8];
#pragma unroll
        for (int tk = 0; tk < 2; ++tk) {
            const f32x4* zr = (const f32x4*)(Z1 + (size_t)(t0 + tk) * DM) + F.lane; float s = 0.f;
#pragma unroll
            for (int j = 0; j < 8; ++j) { xv[tk][j] = zr[64 * j]; s += (xv[tk][j][0] + xv[tk][j][1]) + (xv[tk][j][2] + xv[tk][j][3]); }
            const float mean = wave_sum(s) * (1.0f / DM); float s2 = 0.f;
#pragma unroll
            for (int j = 0; j < 8; ++j) { xv[tk][j] = xv[tk][j] - mean; s2 += (xv[tk][j][0] * xv[tk][j][0] + xv[tk][j][1] * xv[tk][j][1]) + (xv[tk][j][2] * xv[tk][j][2] + xv[tk][j][3] * xv[tk][j][3]); }
            const float rstd = 1.0f / sqrtf(wave_sum(s2) * (1.0f / DM) + LN_EPS);
            f32x4* xo = (f32x4*)(X1 + (size_t)(t0 + tk) * DM) + F.lane; v2u* xb = (v2u*)(X1B + (size_t)(t0 + tk) * DM) + F.lane;
#pragma unroll
            for (int j = 0; j < 8; ++j) { const f32x4 v = xv[tk][j] * rstd * G4[64 * j + F.lane] + B4[64 * j + F.lane]; xv[tk][j] = v; xo[64 * j] = v;
                v2u w; w.x = pk2(v[0], v[1]); w.y = pk2(v[2], v[3]); xb[64 * j] = w; }
        }
        float logit[2] = {-3.0e38f, -3.0e38f};
#pragma unroll 1
        for (int e = 0; e < 32; ++e) {
            f32x4 w[8];
#pragma unroll
            for (int j = 0; j < 8; ++j) w[j] = WRT4[e * 512 + 64 * j + F.lane];
            const float be = br[e];
#pragma unroll
            for (int tk = 0; tk < 2; ++tk) { float p = 0.f;
#pragma unroll
                for (int j = 0; j < 8; ++j) p += (xv[tk][j][0] * w[j][0] + xv[tk][j][1] * w[j][1]) + (xv[tk][j][2] * w[j][2] + xv[tk][j][3] * w[j][3]);
                const float sres = wave_sum(p) + be; logit[tk] = (F.lane == e) ? sres : logit[tk]; }
        }
#pragma unroll
        for (int tk = 0; tk < 2; ++tk) {
            float v = logit[tk]; float tv[4]; int ti[4];
#pragma unroll
            for (int k = 0; k < 4; ++k) { float bv = v; int bi = F.lane;
#pragma unroll
                for (int o = 1; o < 64; o <<= 1) { const float ov = __shfl_xor(bv, o); const int oi = __shfl_xor(bi, o); if (ov > bv || (ov == bv && oi < bi)) { bv = ov; bi = oi; } }
                tv[k] = bv; ti[k] = bi; if (F.lane == bi) v = -3.0e38f; }
            const float e1 = __expf(tv[1] - tv[0]), e2 = __expf(tv[2] - tv[0]), e3 = __expf(tv[3] - tv[0]); const float inv = 1.0f / (1.0f + e1 + e2 + e3);
            if (F.lane < 4) { const int me = F.lane == 0 ? ti[0] : (F.lane == 1 ? ti[1] : (F.lane == 2 ? ti[2] : ti[3]));
                const float mw = (F.lane == 0 ? 1.0f : (F.lane == 1 ? e1 : (F.lane == 2 ? e2 : e3))) * inv;
                const int lr = atomicAdd((int*)(cntl + me), 1);
                const int a = (F.wave * 4 + hp * 2 + tk) * 4 + F.lane; asg_e[a] = me; asg_lr[a] = lr; asg_w[a] = mw; }
        }
        }
        __syncthreads();
        if (F.tid < 32) basel[F.tid] = (int)atomicAdd(gcnt + F.tid, (unsigned)cntl[F.tid]);
        __syncthreads();
        if (F.tid < 128) { const int a = tb * 128 + F.tid; const int e = asg_e[F.tid]; TOKE[a] = e; TOKR[a] = basel[e] + asg_lr[F.tid]; TOKW[a] = asg_w[F.tid]; }
        __syncthreads();
    }
}

__device__ __forceinline__ void p7_gather(Frame& F) {
    LAS int* pst = (LAS int*)(F.lds + L_PST);
    const unsigned* gcnt = F.ctl + CW_CNT;
    if (F.tid == 0) { int acc = 0; for (int e = 0; e < 32; ++e) { pst[e] = acc; acc += ((int)gcnt[e] + 255) & ~255; } pst[32] = acc; }
    __syncthreads();
    const int* TOKE = (const int*)(F.ws + WS_TOKE); const int* TOKR = (const int*)(F.ws + WS_TOKR); const float* TOKW = (const float*)(F.ws + WS_TOKW);
    int* TOKS = (int*)(F.ws + WS_TOKS); float* SLOTW = (float*)(F.ws + WS_SLOTW);
    const bf16* X1B = (const bf16*)(F.ws + WS_X1B); bf16* XS = (bf16*)(F.ws + WS_XS);
    const int gw = blockIdx.x * 8 + F.wave, NGW = F.G * 8;
    for (int a = gw; a < S_ * TOPK; a += NGW) {
        const int t = a >> 2, e = TOKE[a]; const int slot = pst[e] + TOKR[a];
        if (F.lane == 0) { TOKS[a] = slot; SLOTW[slot] = TOKW[a]; }
        const v4u* src = (const v4u*)(X1B + (size_t)t * DM) + F.lane; v4u* dst = (v4u*)(XS + (size_t)slot * DM) + F.lane;
        const v4u a0 = src[0], a1 = src[64], a2 = src[128], a3 = src[192];
        dst[0] = a0; dst[64] = a1; dst[128] = a2; dst[192] = a3;
    }
}
__device__ __forceinline__ int moe_tiles(Frame& F) {
    LAS int* tile_e = (LAS int*)(F.lds + L_TILE);
    const unsigned* gcnt = F.ctl + CW_CNT;
    __syncthreads();
    if (F.tid == 0) { int ti = 0; for (int e = 0; e < 32; ++e) { const int nt = ((int)gcnt[e] + 255) >> 8; for (int k = 0; k < nt && ti < 160; ++k) tile_e[ti++] = e; } tile_e[160] = ti; }
    __syncthreads();
    return tile_e[160];
}

__device__ __forceinline__ void p10_final(Frame& F) {
    const float* X1 = (const float*)(F.ws + WS_X1); const bf16* YS = (const bf16*)(F.ws + WS_YS); const int* TOKS = (const int*)(F.ws + WS_TOKS);
    const f32x4* G4 = (const f32x4*)inp(F, 19); const f32x4* B4 = (const f32x4*)inp(F, 20);
    float* outp = (float*)inp(F, 21);
    const int gw = blockIdx.x * 8 + F.wave, NGW = F.G * 8;
    for (int t = gw; t < S_; t += NGW) {
        const int sl0 = TOKS[t * 4], sl1 = TOKS[t * 4 + 1], sl2 = TOKS[t * 4 + 2], sl3 = TOKS[t * 4 + 3];
        const f32x4* xr = (const f32x4*)(X1 + (size_t)t * DM) + F.lane;
        const v2u* y0 = (const v2u*)(YS + (size_t)sl0 * DM) + F.lane; const v2u* y1 = (const v2u*)(YS + (size_t)sl1 * DM) + F.lane;
        const v2u* y2 = (const v2u*)(YS + (size_t)sl2 * DM) + F.lane; const v2u* y3 = (const v2u*)(YS + (size_t)sl3 * DM) + F.lane;
        f32x4 v[8]; float s = 0.f;
#pragma unroll
        for (int j = 0; j < 8; ++j) { const v2u a = y0[64 * j], b = y1[64 * j], c = y2[64 * j], d = y3[64 * j]; f32x4 f;
            f[0] = (bflo(a.x) + bflo(b.x)) + (bflo(c.x) + bflo(d.x)); f[1] = (bfhi(a.x) + bfhi(b.x)) + (bfhi(c.x) + bfhi(d.x));
            f[2] = (bflo(a.y) + bflo(b.y)) + (bflo(c.y) + bflo(d.y)); f[3] = (bfhi(a.y) + bfhi(b.y)) + (bfhi(c.y) + bfhi(d.y));
            v[j] = xr[64 * j] * ALPHA + f; s += (v[j][0] + v[j][1]) + (v[j][2] + v[j][3]); }
        const float mean = wave_sum(s) * (1.0f / DM); float s2 = 0.f;
#pragma unroll
        for (int j = 0; j < 8; ++j) { v[j] = v[j] - mean; s2 += (v[j][0] * v[j][0] + v[j][1] * v[j][1]) + (v[j][2] * v[j][2] + v[j][3] * v[j][3]); }
        const float rstd = 1.0f / sqrtf(wave_sum(s2) * (1.0f / DM) + LN_EPS);
        f32x4* o = (f32x4*)(outp + (size_t)t * DM) + F.lane;
#pragma unroll
        for (int j = 0; j < 8; ++j) o[64 * j] = v[j] * rstd * G4[64 * j + F.lane] + B4[64 * j + F.lane];
    }
}

struct Args { const float* in[21]; float* out; unsigned char* ws; int ph_lo, ph_hi; };
__global__ void __launch_bounds__(512, 2) mk_fwd(Args args) {
    extern __shared__ __attribute__((aligned(16))) unsigned char lds[];
    Frame F;
    F.lds = (LAS unsigned char*)lds; F.ldsg = lds;
    F.tid = threadIdx.x; F.lane = F.tid & 63; F.wave = __builtin_amdgcn_readfirstlane(F.tid >> 6); F.G = gridDim.x;
    F.ws = args.ws; F.ctl = (unsigned*)(args.ws + WS_CTL);
    if (F.tid == 0) { LAS unsigned long long* pp = (LAS unsigned long long*)(F.lds + L_PTR);
#pragma unroll
        for (int i = 0; i < 21; ++i) pp[i] = (unsigned long long)args.in[i];
        pp[21] = (unsigned long long)args.out; }
    if (F.tid < 4) ((LAS unsigned*)(F.lds + L_XB))[F.tid] = 0u;
    __syncthreads();
    const int lo = args.ph_lo, hi = args.ph_hi;
    XcdBarrier bar; bar.bar = F.ctl + CW_BAR; bar.x = 0; bar.st = (volatile LAS unsigned*)(F.lds + L_XB);
    if (hi - lo > 1) bar = xcd_barrier_post(F.ctl + CW_BAR, (volatile LAS unsigned*)(F.lds + L_XB));
#ifndef MK_PHASE_MASK
#define MK_PHASE_MASK 0x7ff
#endif
#define IN(k) (((MK_PHASE_MASK >> (k)) & 1) && lo <= (k) && (k) < hi)
#define SEAM(k) do { if (IN(k) && IN((k) + 1)) xcd_barrier(bar); } while (0)
    LAS unsigned char* ring = F.lds + RING_OFF;
    const pg8::bf16_t* XB = (const pg8::bf16_t*)(F.ws + WS_XB);

    if (IN(0)) { p0_prologue(F); }
    SEAM(0);
    if (IN(1)) {
        pg8::Gemm g{XB, (const pg8::bf16_t*)(F.ws + WS_WIN), S_, INW, DM}; pg8::StaticOrder S; S.init(S_, INW, F.G, (int)blockIdx.x);
        pg8::EpiStoreBf16 E{(pg8::bf16_t*)(F.ws + WS_PROJ), INW};
        pg8::gemm_phase<pg8::EpiStoreBf16, pg8::StaticOrder, true, true>(ring, g, S, E);
    }
    SEAM(1);
    if (IN(2)) { p2_prep_dilated(F); }
    SEAM(2);
    if (IN(3)) { p3_attn_combine(F); }
    SEAM(3);
    if (IN(4)) {
        { pg8::Gemm g{(const pg8::bf16_t*)(F.ws + WS_YA), (const pg8::bf16_t*)(F.ws + WS_WA), S_, DM, 512}; pg8::StaticOrder S; S.init(S_, DM, F.G, (int)blockIdx.x);
          pg8::EpiGateA E{(const pg8::bf16_t*)(F.ws + WS_PROJ), INW, GATE_OFF, inp(F, 2), (float*)(F.ws + WS_T1), DM};
          pg8::gemm_phase<pg8::EpiGateA, pg8::StaticOrder, true, true>(ring, g, S, E); }
        { pg8::Gemm g{(const pg8::bf16_t*)(F.ws + WS_YB), (const pg8::bf16_t*)(F.ws + WS_WB), S_, DM, 1024}; pg8::StaticOrder S; S.init(S_, DM, F.G, (int)blockIdx.x);
          pg8::EpiGateB E{(const pg8::bf16_t*)(F.ws + WS_PROJ), INW, GATE_OFF + DM, inp(F, 2) + DM, (const float*)(F.ws + WS_T1), (pg8::bf16_t*)(F.ws + WS_Y), DM};
          pg8::gemm_phase<pg8::EpiGateB, pg8::StaticOrder, true, true>(ring, g, S, E); }
    }
    SEAM(4);
    if (IN(5)) {
        pg8::Gemm g{(const pg8::bf16_t*)(F.ws + WS_Y), (const pg8::bf16_t*)(F.ws + WS_WO), S_, DM, DM}; pg8::StaticOrder S; S.init(S_, DM, F.G, (int)blockIdx.x);
        pg8::EpiResF32 E{inp(F, 0), (float*)(F.ws + WS_T1), DM, ALPHA};
        pg8::gemm_phase<pg8::EpiResF32, pg8::StaticOrder, true, true>(ring, g, S, E);
    }
    SEAM(5);
    if (IN(6)) { p6_ln_router(F); }
    SEAM(6);
    if (IN(7)) { p7_gather(F); }
    SEAM(7);
    if (IN(8)) {
        const int nt = moe_tiles(F);
        pg8::Gemm g{(const pg8::bf16_t*)(F.ws + WS_XS), (const pg8::bf16_t*)(F.ws + WS_WGL), nt * 256, 4096, DM};
        pg8::MoeOrder S; S.init(nt * 256, 4096, F.G, (int)blockIdx.x); S.tile_e = (const LAS int*)(F.lds + L_TILE); S.estride = (size_t)4096 * 2048 * 2;
        pg8::EpiSwiglu E{(const LAS int*)(F.lds + L_TILE), inp(F, 14), inp(F, 16), (pg8::bf16_t*)(F.ws + WS_H), DM};
        pg8::gemm_phase<pg8::EpiSwiglu, pg8::MoeOrder, true, true>(ring, g, S, E);
    }
    SEAM(8);
    if (IN(9)) {
        const int nt = moe_tiles(F);
        pg8::Gemm g{(const pg8::bf16_t*)(F.ws + WS_H), (const pg8::bf16_t*)(F.ws + WS_WD), nt * 256, DM, DM};
        pg8::MoeOrder S; S.init(nt * 256, DM, F.G, (int)blockIdx.x); S.tile_e = (const LAS int*)(F.lds + L_TILE); S.estride = (size_t)2048 * 2048 * 2;
        pg8::EpiDown E{(const LAS int*)(F.lds + L_TILE), inp(F, 18), (const float*)(F.ws + WS_SLOTW), (pg8::bf16_t*)(F.ws + WS_YS), DM};
        pg8::gemm_phase<pg8::EpiDown, pg8::MoeOrder, true, true>(ring, g, S, E);
    }
    SEAM(9);
    if (IN(10)) { p10_final(F); }
#undef IN
#undef SEAM
}

#ifndef MK_CUTS
#define MK_CUTS 0
#endif
extern "C" void kernel_launch(void* const* d_in, const int* in_sizes, int n_in, void* d_out, int out_size, void* d_ws, size_t ws_size, hipStream_t stream) {
    static int grid = 0;
    if (grid == 0) {
        if (n_in != 21 || out_size != S_ * DM || ws_size < WS_END) { fprintf(stderr, "kernel_launch: unexpected shapes (n_in %d out %d ws %zu, need %zu)\n", n_in, out_size, ws_size, (size_t)WS_END); grid = -1; return; }
        int dev = 0, cus = 0, per_cu = 0;
        if (hipGetDevice(&dev) != hipSuccess || hipDeviceGetAttribute(&cus, hipDeviceAttributeMultiprocessorCount, dev) != hipSuccess) { grid = -1; return; }
        if (hipFuncSetAttribute((const void*)mk_fwd, hipFuncAttributeMaxDynamicSharedMemorySize, LDS_BYTES) != hipSuccess) { fprintf(stderr, "kernel_launch: hipFuncSetAttribute failed\n"); grid = -1; return; }
        if (hipOccupancyMaxActiveBlocksPerMultiprocessor(&per_cu, (const void*)mk_fwd, 512, LDS_BYTES) != hipSuccess || per_cu < 1) { fprintf(stderr, "kernel_launch: occupancy query says %d\n", per_cu); per_cu = 1; }
        (void)hipGetLastError();
        grid = cus;
    }
    if (grid < 0) return;
    (void)hipMemsetAsync((char*)d_ws + WS_CTL, 0, CTL_ZERO_BYTES, stream);
    Args a{};
    for (int i = 0; i < 21; ++i) a.in[i] = (const float*)d_in[i];
    a.out = (float*)d_out; a.ws = (unsigned char*)d_ws;
#if MK_CUTS
    for (int p = 0; p < NPH; ++p) { a.ph_lo = p; a.ph_hi = p + 1; hipLaunchKernelGGL(mk_fwd, dim3(grid), dim3(512), LDS_BYTES, stream, a); }
#else
    a.ph_lo = 0; a.ph_hi = NPH; hipLaunchKernelGGL(mk_fwd, dim3(grid), dim3(512), LDS_BYTES, stream, a);
#endif
}
```

```cpp
#include <hip/hip_runtime.h>
#include <hip/hip_bf16.h>
#include <cstdio>
#include <cstdint>
#define MK_CUTS 0
namespace pg8 {
#define PG8_LAS __attribute__((address_space(3)))
typedef unsigned short bf16_t;
typedef short bf16x8 __attribute__((ext_vector_type(8)));
typedef float f32x4 __attribute__((ext_vector_type(4)));
typedef unsigned u32x4 __attribute__((ext_vector_type(4)));
constexpr int BM = 256, BK = 64, HALF = 128, HTB = HALF * BK * 2  , STAGE_BYTES = 8 * HTB, NXCD = 8, WGM = 8;

__host__ __device__ __forceinline__ int lds_byte(int r, int c) { const int st = (r >> 4) * 2 + (c >> 5), rr = r & 15, cc = c & 31, ob = rr * 64 + cc * 2; return st * 1024 + (ob ^ (((ob >> 9) & 1) << 5)); }
__host__ __device__ __forceinline__ void stage_rc(int b, int& R, int& C) { const int st = b / 1024, sb = b % 1024, swz = sb ^ (((sb >> 9) & 1) << 5); R = (st >> 1) * 16 + swz / 64; C = (st & 1) * 32 + (swz % 64) / 2; }
__host__ __device__ __forceinline__ int perm32(int rho) { const int n = rho >> 4, i = rho & 15; return 8 * (i >> 2) + 4 * n + (i & 3); }

struct Unit { int pm, pn; };
struct Gemm { const bf16_t* A; const bf16_t* Bt; int M, N, K; };

struct StaticOrder {
    int nM, nN, nwg, G, c;
    __host__ __device__ void init(int M, int N, int G_, int c_) { nM = M / BM; nN = N / BM; nwg = nM * nN; G = G_; c = c_; }
    __host__ __device__ bool next(int i, Unit& u) const {
        const long L = (long)i * G + c; if (L >= nwg) return false;
        int wgid = (int)L; { const int q = nwg / NXCD, r = nwg % NXCD, xcd = wgid % NXCD, off = wgid / NXCD; wgid = (xcd < r ? xcd * (q + 1) : r * (q + 1) + (xcd - r) * q) + off; }
        const int nig = WGM * nN, gid = wgid / nig, fm = gid * WGM, gsz = (nM - fm) < WGM ? (nM - fm) : WGM;
        u.pm = fm + ((wgid % nig) % gsz); u.pn = (wgid % nig) / gsz; return true;
    }
    __device__ __forceinline__ void a_ready(const Unit&) const {}
    __device__ __forceinline__ size_t b_off(const Unit&) const { return 0; }
    __device__ __forceinline__ void done(const Unit&) const {}
};


typedef unsigned u32x2 __attribute__((ext_vector_type(2)));
__device__ __forceinline__ unsigned cvt_pk_bf16(float lo, float hi) { unsigned r; asm volatile("v_cvt_pk_bf16_f32 %0, %1, %2" : "=v"(r) : "v"(lo), "v"(hi)); return r; }
__device__ __forceinline__ float bf_lo(unsigned w) { return __builtin_bit_cast(float, w << 16); }
__device__ __forceinline__ float bf_hi(unsigned w) { return __builtin_bit_cast(float, w & 0xffff0000u); }
__device__ __forceinline__ float sigmoidf_(float v) { return __builtin_amdgcn_rcpf(1.0f + __expf(-v)); }

struct EpiStoreBf16 {
    static constexpr bool PERM = true, AFTER_DRAIN = false;
    bf16_t* O; int ldc;
    __device__ __forceinline__ void operator()(const f32x4 (&acc)[2][2][4][2], const Unit& u, int wr, int wc, int fr, int fq) const {
        const int row0 = u.pm * BM + wr * 64 + fr, col0 = u.pn * BM + wc * 32 + 8 * fq;
#pragma unroll
        for (int ai = 0; ai < 2; ++ai)
#pragma unroll
            for (int m = 0; m < 4; ++m) { bf16_t* rowp = O + (size_t)(row0 + ai * HALF + m * 16) * ldc + col0;
#pragma unroll
                for (int bj = 0; bj < 2; ++bj) { const f32x4 v0 = acc[ai][bj][m][0], v1 = acc[ai][bj][m][1];
                    u32x4 w; w.x = cvt_pk_bf16(v0[0], v0[1]); w.y = cvt_pk_bf16(v0[2], v0[3]); w.z = cvt_pk_bf16(v1[0], v1[1]); w.w = cvt_pk_bf16(v1[2], v1[3]);
                    *(u32x4*)(rowp + bj * HALF) = w; } }
    }
};

struct EpiGateA {
    static constexpr bool PERM = true, AFTER_DRAIN = false;
    const bf16_t* proj; int ldp; int gcol0; const float* bg; float* T1; int ldc;
    __device__ __forceinline__ void operator()(const f32x4 (&acc)[2][2][4][2], const Unit& u, int wr, int wc, int fr, int fq) const {
        const int row0 = u.pm * BM + wr * 64 + fr, col0 = u.pn * BM + wc * 32 + 8 * fq;
#pragma unroll
        for (int ai = 0; ai < 2; ++ai)
#pragma unroll
            for (int m = 0; m < 4; ++m) { const int row = row0 + ai * HALF + m * 16;
#pragma unroll
                for (int bj = 0; bj < 2; ++bj) { const int c = col0 + bj * HALF;
                    const u32x4 gw = *(const u32x4*)(proj + (size_t)row * ldp + gcol0 + c);
                    const f32x4 b0 = *(const f32x4*)(bg + c), b1 = *(const f32x4*)(bg + c + 4);
                    f32x4 g0, g1;
                    g0[0] = sigmoidf_(bf_lo(gw.x) + b0[0]); g0[1] = sigmoidf_(bf_hi(gw.x) + b0[1]); g0[2] = sigmoidf_(bf_lo(gw.y) + b0[2]); g0[3] = sigmoidf_(bf_hi(gw.y) + b0[3]);
                    g1[0] = sigmoidf_(bf_lo(gw.z) + b1[0]); g1[1] = sigmoidf_(bf_hi(gw.z) + b1[1]); g1[2] = sigmoidf_(bf_lo(gw.w) + b1[2]); g1[3] = sigmoidf_(bf_hi(gw.w) + b1[3]);
                    float* o = T1 + (size_t)row * ldc + c;
                    *(f32x4*)o = acc[ai][bj][m][0] * g0; *(f32x4*)(o + 4) = acc[ai][bj][m][1] * g1; } }
    }
};
struct EpiGateB {
    static constexpr bool PERM = true, AFTER_DRAIN = false;
    const bf16_t* proj; int ldp; int gcol0; const float* bg; const float* T1; bf16_t* Y; int ldc;
    __device__ __forceinline__ void operator()(const f32x4 (&acc)[2][2][4][2], const Unit& u, int wr, int wc, int fr, int fq) const {
        const int row0 = u.pm * BM + wr * 64 + fr, col0 = u.pn * BM + wc * 32 + 8 * fq;
#pragma unroll
        for (int ai = 0; ai < 2; ++ai)
#pragma unroll
            for (int m = 0; m < 4; ++m) { const int row = row0 + ai * HALF + m * 16;
#pragma unroll
                for (int bj = 0; bj < 2; ++bj) { const int c = col0 + bj * HALF;
                    const u32x4 gw = *(const u32x4*)(proj + (size_t)row * ldp + gcol0 + c);
                    const f32x4 b0 = *(const f32x4*)(bg + c), b1 = *(const f32x4*)(bg + c + 4);
                    const float* tp = T1 + (size_t)row * ldc + c;
                    const f32x4 t0 = *(const f32x4*)tp, t1 = *(const f32x4*)(tp + 4);
                    f32x4 g0, g1;
                    g0[0] = sigmoidf_(bf_lo(gw.x) + b0[0]); g0[1] = sigmoidf_(bf_hi(gw.x) + b0[1]); g0[2] = sigmoidf_(bf_lo(gw.y) + b0[2]); g0[3] = sigmoidf_(bf_hi(gw.y) + b0[3]);
                    g1[0] = sigmoidf_(bf_lo(gw.z) + b1[0]); g1[1] = sigmoidf_(bf_hi(gw.z) + b1[1]); g1[2] = sigmoidf_(bf_lo(gw.w) + b1[2]); g1[3] = sigmoidf_(bf_hi(gw.w) + b1[3]);
                    const f32x4 v0 = t0 + acc[ai][bj][m][0] * g0, v1 = t1 + acc[ai][bj][m][1] * g1;
                    u32x4 w; w.x = cvt_pk_bf16(v0[0], v0[1]); w.y = cvt_pk_bf16(v0[2], v0[3]); w.z = cvt_pk_bf16(v1[0], v1[1]); w.w = cvt_pk_bf16(v1[2], v1[3]);
                    *(u32x4*)(Y + (size_t)row * ldc + c) = w; } }
    }
};
struct EpiResF32 {
    static constexpr bool PERM = false, AFTER_DRAIN = false;
    const float* X; float* Z; int ldc; float alpha;
    __device__ __forceinline__ void operator()(const f32x4 (&acc)[2][2][4][2], const Unit& u, int wr, int wc, int fr, int fq) const {
        const int row0 = u.pm * BM + wr * 64 + fr, col0 = u.pn * BM + wc * 32 + 4 * fq;
#pragma unroll
        for (int ai = 0; ai < 2; ++ai)
#pragma unroll
            for (int m = 0; m < 4; ++m) { const size_t ro = (size_t)(row0 + ai * HALF + m * 16) * ldc + col0;
#pragma unroll
                for (int bj = 0; bj < 2; ++bj)
#pragma unroll
                    for (int n = 0; n < 2; ++n) { const f32x4 xv = *(const f32x4*)(X + ro + bj * HALF + n * 16);
                        *(f32x4*)(Z + ro + bj * HALF + n * 16) = xv * alpha + acc[ai][bj][m][n]; } }
    }
};
struct EpiSwiglu {
    static constexpr bool PERM = true, AFTER_DRAIN = false;
    const PG8_LAS int* tile_e; const float* bgate; const float* blin; bf16_t* H; int ldc;
    __device__ __forceinline__ void operator()(const f32x4 (&acc)[2][2][4][2], const Unit& u, int wr, int wc, int fr, int fq) const {
        const int e = tile_e[u.pm];
        const int row0 = u.pm * BM + wr * 64 + fr, j0 = u.pn * HALF + wc * 32 + 8 * fq;
        const f32x4 bg0 = *(const f32x4*)(bgate + (size_t)e * 2048 + j0), bg1 = *(const f32x4*)(bgate + (size_t)e * 2048 + j0 + 4);
        const f32x4 bl0 = *(const f32x4*)(blin + (size_t)e * 2048 + j0), bl1 = *(const f32x4*)(blin + (size_t)e * 2048 + j0 + 4);
#pragma unroll
        for (int ai = 0; ai < 2; ++ai)
#pragma unroll
            for (int m = 0; m < 4; ++m) { const int row = row0 + ai * HALF + m * 16;
                f32x4 h0, h1;
#pragma unroll
                for (int i = 0; i < 4; ++i) {
                    float g = fminf(acc[ai][0][m][0][i] + bg0[i], 7.0f); float l = fminf(fmaxf(acc[ai][1][m][0][i] + bl0[i], -7.0f), 7.0f);
                    h0[i] = (l + 1.0f) * (g * sigmoidf_(1.702f * g));
                    g = fminf(acc[ai][0][m][1][i] + bg1[i], 7.0f); l = fminf(fmaxf(acc[ai][1][m][1][i] + bl1[i], -7.0f), 7.0f);
                    h1[i] = (l + 1.0f) * (g * sigmoidf_(1.702f * g)); }
                u32x4 w; w.x = cvt_pk_bf16(h0[0], h0[1]); w.y = cvt_pk_bf16(h0[2], h0[3]); w.z = cvt_pk_bf16(h1[0], h1[1]); w.w = cvt_pk_bf16(h1[2], h1[3]);
                *(u32x4*)(H + (size_t)row * ldc + j0) = w; }
    }
};
struct EpiDown {
    static constexpr bool PERM = true, AFTER_DRAIN = false;
    const PG8_LAS int* tile_e; const float* bdown; const float* slot_w; bf16_t* YS; int ldc;
    __device__ __forceinline__ void operator()(const f32x4 (&acc)[2][2][4][2], const Unit& u, int wr, int wc, int fr, int fq) const {
        const int e = tile_e[u.pm];
        const int row0 = u.pm * BM + wr * 64 + fr, col0 = u.pn * BM + wc * 32 + 8 * fq;
        f32x4 bv[2][2];
#pragma unroll
        for (int bj = 0; bj < 2; ++bj)
#pragma unroll
            for (int n = 0; n < 2; ++n) bv[bj][n] = *(const f32x4*)(bdown + (size_t)e * 2048 + col0 + bj * HALF + 4 * n);
#pragma unroll
        for (int ai = 0; ai < 2; ++ai)
#pragma unroll
            for (int m = 0; m < 4; ++m) { const int row = row0 + ai * HALF + m * 16; const float sw = slot_w[row];
#pragma unroll
                for (int bj = 0; bj < 2; ++bj) { const f32x4 v0 = (acc[ai][bj][m][0] + bv[bj][0]) * sw, v1 = (acc[ai][bj][m][1] + bv[bj][1]) * sw;
                    u32x4 w; w.x = cvt_pk_bf16(v0[0], v0[1]); w.y = cvt_pk_bf16(v0[2], v0[3]); w.z = cvt_pk_bf16(v1[0], v1[1]); w.w = cvt_pk_bf16(v1[2], v1[3]);
                    *(u32x4*)(YS + (size_t)row * ldc + col0 + bj * HALF) = w; } }
    }
};
struct MoeOrder : StaticOrder {
    const PG8_LAS int* tile_e; size_t estride;
    __device__ __forceinline__ size_t b_off(const Unit& u) const { return (size_t)__builtin_amdgcn_readfirstlane(tile_e[u.pm]) * estride; }
};
template <class Epi, class Sched, bool ALIGN_EPI = false, bool SP2 = false>
__device__ __forceinline__ void gemm_phase(PG8_LAS unsigned char* lds, const Gemm g, const Sched& S, const Epi& E) {
    const int tid = threadIdx.x, wid = __builtin_amdgcn_readfirstlane(tid >> 6), lane = tid & 63, wr = wid >> 2, wc = wid & 3, fr = lane & 15, fq = lane >> 4;
    const int K = g.K, nt = K / BK;
    unsigned voffA[2], voffB[2];
#pragma unroll
    for (int i = 0; i < 2; ++i) { int R, C; stage_rc(tid * 16 + i * 8192, R, C); const int Rb = Epi::PERM ? ((R & ~31) + perm32(R & 31)) : R;
        voffA[i] = (unsigned)(R * K + C) * 2u; voffB[i] = (unsigned)(Rb * K + C) * 2u; }
    const size_t kstep = (size_t)(BK * 2);
    const size_t hstep = (size_t)HALF * K * 2;
    const size_t tstep = 2 * hstep;
    const unsigned ldsw = (unsigned)wid * 1024u;
    const int aoff = lds_byte(wr * 64 + fr, fq * 8), boff = lds_byte(wc * 32 + fr, fq * 8);
#define PG8_SA(b, h) (((b) * 2 + (h)) * HTB)
#define PG8_SB(b, h) ((4 + (b) * 2 + (h)) * HTB)
#define PG8_STAGE(bufoff, gbase, voff) do { _Pragma("unroll") for (int _i = 0; _i < 2; ++_i) \
        __builtin_amdgcn_global_load_lds((const unsigned*)((const char*)(gbase) + (voff)[_i]), (PG8_LAS unsigned*)(lds + (bufoff) + ldsw + _i * 8192), 16, 0, 0); } while (0)
#define PG8_LDA(dst, b, h) do { _Pragma("unroll") for (int m = 0; m < 4; ++m) _Pragma("unroll") for (int k = 0; k < 2; ++k) dst[m][k] = *(const PG8_LAS bf16x8*)(lds + PG8_SA(b, h) + aoff + m * 2048 + k * 1024); } while (0)
#define PG8_LDB(dst, b, h) do { _Pragma("unroll") for (int n = 0; n < 2; ++n) _Pragma("unroll") for (int k = 0; k < 2; ++k) dst[n][k] = *(const PG8_LAS bf16x8*)(lds + PG8_SB(b, h) + boff + n * 2048 + k * 1024); } while (0)
#define PG8_MMA(ai, bj, At, Bt) do { __builtin_amdgcn_s_setprio(1); _Pragma("unroll") for (int m = 0; m < 4; ++m) _Pragma("unroll") for (int n = 0; n < 2; ++n) _Pragma("unroll") for (int k = 0; k < 2; ++k) \
        acc[ai][bj][m][n] = __builtin_amdgcn_mfma_f32_16x16x32_bf16(Bt[n][k], At[m][k], acc[ai][bj][m][n], 0, 0, 0); __builtin_amdgcn_s_setprio(0); } while (0)
#define PG8_WAIT_V(n) asm volatile("s_waitcnt vmcnt(" #n ")" ::: "memory")
#define PG8_WAIT_L(n) asm volatile("s_waitcnt lgkmcnt(" #n ")" ::: "memory")
#define PG8_BAR __builtin_amdgcn_s_barrier()
#define PG8_SCHED __builtin_amdgcn_sched_barrier(0)
    Unit cur, nxt; int ui = 0;
    if (!S.next(0, cur)) return;
    f32x4 acc[2][2][4][2];
#pragma unroll
    for (int a = 0; a < 2; ++a)
#pragma unroll
        for (int b = 0; b < 2; ++b)
#pragma unroll
            for (int m = 0; m < 4; ++m)
#pragma unroll
                for (int n = 0; n < 2; ++n) acc[a][b][m][n] = (f32x4){0.f, 0.f, 0.f, 0.f};
    bf16x8 At[4][2], B0[2][2], B1[2][2];
    const char* cA = (const char*)g.A + (size_t)cur.pm * tstep; const char* cB = (const char*)g.Bt + S.b_off(cur) + (size_t)cur.pn * tstep;
    S.a_ready(cur);
    if constexpr (SP2) {
        PG8_STAGE(PG8_SB(0, 0), cB, voffB); PG8_STAGE(PG8_SB(0, 1), cB + hstep, voffB); PG8_STAGE(PG8_SA(0, 0), cA, voffA); PG8_STAGE(PG8_SA(0, 1), cA + hstep, voffA);
        if (wr == 1) PG8_BAR;
        PG8_WAIT_V(2); PG8_BAR;
        PG8_STAGE(PG8_SB(1, 0), cB + kstep, voffB); PG8_STAGE(PG8_SA(1, 0), cA + kstep, voffA); PG8_STAGE(PG8_SB(1, 1), cB + hstep + kstep, voffB);
        PG8_WAIT_V(6); PG8_BAR;
    } else {
        PG8_STAGE(PG8_SB(0, 0), cB, voffB); PG8_STAGE(PG8_SA(0, 0), cA, voffA); PG8_STAGE(PG8_SB(0, 1), cB + hstep, voffB); PG8_STAGE(PG8_SA(0, 1), cA + hstep, voffA);
        if (wr == 1) PG8_BAR;
        PG8_WAIT_V(4); PG8_BAR;
        PG8_STAGE(PG8_SB(1, 0), cB + kstep, voffB); PG8_STAGE(PG8_SA(1, 0), cA + kstep, voffA); PG8_STAGE(PG8_SB(1, 1), cB + hstep + kstep, voffB);
        PG8_WAIT_V(6); PG8_BAR;
    }
    for (;;) {
        const bool has_next = S.next(ui + 1, nxt);
        const char* nA = has_next ? (const char*)g.A + (size_t)nxt.pm * tstep : cA; const char* nB = has_next ? (const char*)g.Bt + S.b_off(nxt) + (size_t)nxt.pn * tstep : cB;
        for (int t = 0; t < nt; t += 2) {
            const bool last = (t == nt - 2);
            const char* a1 = cA + (size_t)(t + 1) * kstep;
            const char* a2 = last ? nA : cA + (size_t)(t + 2) * kstep; const char* b2 = last ? nB : cB + (size_t)(t + 2) * kstep;
            const char* a3 = a2 + kstep; const char* b3 = b2 + kstep;
            if (last && has_next) S.a_ready(nxt);
            if constexpr (SP2) {
            PG8_LDB(B0, 0, 0); PG8_LDB(B1, 0, 1); PG8_SCHED; PG8_LDA(At, 0, 0); PG8_STAGE(PG8_SA(1, 1), a1 + hstep, voffA);
            PG8_WAIT_V(8); PG8_WAIT_L(0); PG8_BAR; PG8_MMA(0, 0, At, B0); PG8_MMA(0, 1, At, B1); PG8_BAR; PG8_SCHED;
            PG8_LDA(At, 0, 1); PG8_STAGE(PG8_SB(0, 0), b2, voffB); PG8_STAGE(PG8_SB(0, 1), b2 + hstep, voffB); PG8_STAGE(PG8_SA(0, 0), a2, voffA);
            PG8_WAIT_V(8); PG8_WAIT_L(0); PG8_BAR; PG8_MMA(1, 0, At, B0); PG8_MMA(1, 1, At, B1); PG8_BAR; PG8_SCHED;
            PG8_LDB(B0, 1, 0); PG8_LDB(B1, 1, 1); PG8_SCHED; PG8_LDA(At, 1, 0); PG8_STAGE(PG8_SA(0, 1), a2 + hstep, voffA);
            PG8_WAIT_V(8); PG8_WAIT_L(0); PG8_BAR; PG8_MMA(0, 0, At, B0); PG8_MMA(0, 1, At, B1); PG8_BAR; PG8_SCHED;
            PG8_LDA(At, 1, 1); PG8_STAGE(PG8_SB(1, 0), b3, voffB); PG8_STAGE(PG8_SB(1, 1), b3 + hstep, voffB); PG8_STAGE(PG8_SA(1, 0), a3, voffA);
            PG8_WAIT_V(8); PG8_WAIT_L(0); PG8_BAR; PG8_MMA(1, 0, At, B0); PG8_MMA(1, 1, At, B1); PG8_BAR; PG8_SCHED;
            } else {
            PG8_LDB(B0, 0, 0); PG8_SCHED; PG8_LDA(At, 0, 0); PG8_STAGE(PG8_SA(1, 1), a1 + hstep, voffA);
            PG8_WAIT_L(8); PG8_BAR; PG8_WAIT_L(0); PG8_MMA(0, 0, At, B0); PG8_BAR; PG8_SCHED;
            PG8_LDB(B1, 0, 1); PG8_STAGE(PG8_SB(0, 0), b2, voffB);
            PG8_BAR; PG8_WAIT_L(0); PG8_MMA(0, 1, At, B1); PG8_BAR;
            PG8_LDA(At, 0, 1); PG8_STAGE(PG8_SA(0, 0), a2, voffA);
            PG8_BAR; PG8_WAIT_L(0); PG8_MMA(1, 0, At, B0); PG8_BAR; PG8_SCHED;
            PG8_STAGE(PG8_SB(0, 1), b2 + hstep, voffB);
            PG8_WAIT_V(6); PG8_BAR; PG8_MMA(1, 1, At, B1); PG8_BAR;
            PG8_LDB(B0, 1, 0); PG8_SCHED; PG8_LDA(At, 1, 0); PG8_STAGE(PG8_SA(0, 1), a2 + hstep, voffA);
            PG8_WAIT_L(8); PG8_BAR; PG8_WAIT_L(0); PG8_MMA(0, 0, At, B0); PG8_BAR; PG8_SCHED;
            PG8_LDB(B1, 1, 1); PG8_STAGE(PG8_SB(1, 0), b3, voffB);
            PG8_BAR; PG8_WAIT_L(0); PG8_MMA(0, 1, At, B1); PG8_BAR;
            PG8_LDA(At, 1, 1); PG8_STAGE(PG8_SA(1, 0), a3, voffA);
            PG8_BAR; PG8_WAIT_L(0); PG8_MMA(1, 0, At, B0); PG8_BAR; PG8_SCHED;
            PG8_STAGE(PG8_SB(1, 1), b3 + hstep, voffB);
            PG8_WAIT_V(6); PG8_BAR; PG8_MMA(1, 1, At, B1); PG8_BAR;
            }
        }
        if constexpr (ALIGN_EPI) { if (wr == 0) PG8_BAR; }
        if constexpr (!Epi::AFTER_DRAIN) { E(acc, cur, wr, wc, fr, fq); S.done(cur); }
        if (!has_next) break;
#pragma unroll
        for (int a = 0; a < 2; ++a)
#pragma unroll
            for (int b = 0; b < 2; ++b)
#pragma unroll
                for (int m = 0; m < 4; ++m)
#pragma unroll
                    for (int n = 0; n < 2; ++n) acc[a][b][m][n] = (f32x4){0.f, 0.f, 0.f, 0.f};
        cur = nxt; cA = nA; cB = nB; ++ui;
        if constexpr (ALIGN_EPI) { if (wr == 1) PG8_BAR; }
    }
    PG8_WAIT_V(0);
    if constexpr (!ALIGN_EPI) { if (wr == 0) PG8_BAR; }
    PG8_BAR;
    if constexpr (Epi::AFTER_DRAIN) { E.fused(acc, cur, wr, wc, fr, fq, lds, wid, lane); S.done(cur); }
#undef PG8_SA
#undef PG8_SB
#undef PG8_STAGE
#undef PG8_LDA
#undef PG8_LDB
#undef PG8_MMA
#undef PG8_WAIT_V
#undef PG8_WAIT_L
#undef PG8_BAR
#undef PG8_SCHED
}
}
namespace at {
using bf16 = __hip_bfloat16;
constexpr int   D = 128, NW = 8, QBLK = 32, KVBLK = 64;
constexpr float SCALE = 0.088388347648318440f;
constexpr float THR = 8.f;
constexpr int SDEPTH = 2;
constexpr size_t SHM_V = KVBLK * D * 2, SHM_K = KVBLK * D * 2, SHM_ATTN = 2 * SHM_V + 2 * SHM_K + NW * 64 * 4;
using bf16x8 = __attribute__((ext_vector_type(8))) short;
using s16x4  = __attribute__((ext_vector_type(4))) short;
using f32x16 = __attribute__((ext_vector_type(16))) float;
using f32x8  = __attribute__((ext_vector_type(8))) float;
using u32x4  = __attribute__((ext_vector_type(4))) unsigned;
#define KSWZ(row, colB) ((row) * 256 + ((colB) ^ (((row) & 7) << 4)))
#define SBAR() __builtin_amdgcn_sched_barrier(0)
__device__ __forceinline__ int crow(int r, int hi) { return (r & 3) + 8 * (r >> 2) + 4 * hi; }
__device__ __forceinline__ unsigned cvtpk(float lo, float hi) {
  unsigned r; asm volatile("v_cvt_pk_bf16_f32 %0, %1, %2" : "=v"(r) : "v"(lo), "v"(hi)); return r;
}
template <typename TIn> struct Stage;
template <> struct Stage<bf16>  { using T = bf16x8;
  __device__ static __forceinline__ T ld8(const bf16* p) { return *reinterpret_cast<const bf16x8*>(p); }
  __device__ static __forceinline__ bf16x8 tobf(T x) { return x; } };
template <> struct Stage<float> { using T = f32x8;
  __device__ static __forceinline__ T ld8(const float* p) { return *reinterpret_cast<const f32x8*>(p); }
  __device__ static __forceinline__ bf16x8 tobf(T x) {
    u32x4 w = {cvtpk(x[0], x[1]), cvtpk(x[2], x[3]), cvtpk(x[4], x[5]), cvtpk(x[6], x[7])}; return *reinterpret_cast<bf16x8*>(&w); } };

__device__ __forceinline__ void partialSM(f32x16& p0, f32x16& p1, float& m_reg, float& mn, float& alpha) {
  constexpr float C = SCALE * 1.4426950408889634f;
  float pmax = p0[0]; for (int r = 1; r < 16; ++r) pmax = fmaxf(pmax, p0[r]); for (int r = 0; r < 16; ++r) pmax = fmaxf(pmax, p1[r]);
  { auto rr = __builtin_amdgcn_permlane32_swap(__float_as_uint(pmax), __float_as_uint(pmax), false, false);
    pmax = fmaxf(__uint_as_float(rr[0]), __uint_as_float(rr[1])); }
  if (__builtin_expect(__all(pmax - m_reg <= THR / SCALE), 1)) { mn = m_reg; alpha = 1.f; }
  else { mn = fmaxf(m_reg, pmax); alpha = __builtin_amdgcn_exp2f((m_reg - mn) * C); m_reg = mn; }
  float mnC = -mn * C;
  for (int r = 0; r < 16; ++r) p0[r] = fmaf(p0[r], C, mnC); for (int r = 0; r < 16; ++r) p1[r] = fmaf(p1[r], C, mnC);
  for (int r = 0; r < 16; ++r) p0[r] = __builtin_amdgcn_exp2f(p0[r]);
}
__device__ __forceinline__ void finishSM(f32x16& p0, f32x16& p1, float alpha, float& l_reg, bf16x8& pa0, bf16x8& pa1, bf16x8& pa2, bf16x8& pa3) {
  for (int r = 0; r < 16; ++r) p1[r] = __builtin_amdgcn_exp2f(p1[r]);
  float ps = 0; for (int r = 0; r < 16; ++r) ps += p0[r]; for (int r = 0; r < 16; ++r) ps += p1[r];
  { auto rr = __builtin_amdgcn_permlane32_swap(__float_as_uint(ps), __float_as_uint(ps), false, false);
    ps = __uint_as_float(rr[0]) + __uint_as_float(rr[1]); }
  l_reg = l_reg * alpha + ps;
#define PK4(P, BASE, OUT) do { unsigned a0 = cvtpk(P[BASE + 0], P[BASE + 1]), a1 = cvtpk(P[BASE + 2], P[BASE + 3]);   \
    unsigned b0 = cvtpk(P[BASE + 4], P[BASE + 5]), b1 = cvtpk(P[BASE + 6], P[BASE + 7]);                              \
    auto r0 = __builtin_amdgcn_permlane32_swap(a0, b0, false, false); auto r1 = __builtin_amdgcn_permlane32_swap(a1, b1, false, false); \
    u32x4 w = {r0[0], r1[0], r0[1], r1[1]}; OUT = *reinterpret_cast<bf16x8*>(&w); } while (0)
  PK4(p0, 0, pa0); PK4(p0, 8, pa1); PK4(p1, 0, pa2); PK4(p1, 8, pa3);
#undef PK4
}
__device__ __forceinline__ void qkt(f32x16& p0, f32x16& p1, const bf16* Ks, const bf16x8* qr, int r32, int hi) {
  p0 = f32x16{}; p1 = f32x16{};
  for (int d0 = 0; d0 < 8; ++d0) { int cb = (d0 * 16 + hi * 8) * 2;
    bf16x8 b0 = *reinterpret_cast<const bf16x8*>((const char*)Ks + KSWZ(r32, cb));
    bf16x8 b1 = *reinterpret_cast<const bf16x8*>((const char*)Ks + KSWZ(32 + r32, cb));
    p0 = __builtin_amdgcn_mfma_f32_32x32x16_bf16(b0, qr[d0], p0, 0, 0, 0);
    p1 = __builtin_amdgcn_mfma_f32_32x32x16_bf16(b1, qr[d0], p1, 0, 0, 0); }
}
__device__ __forceinline__ int v_st(int k, int c) { const int kk = (k & ~0xC) | ((k & 4) << 1) | ((k & 8) >> 1); return ((kk >> 3) * 4 + (c >> 5)) * 512 + ((kk & 7) * 32 + (c & 31)) * 2; }
__device__ __forceinline__ int v_rd_base(int lane) { return ((lane & 3) << 3) | (((lane >> 2) & 3) << 6) | (((lane >> 4) & 1) << 5) | (((lane >> 5) & 1) << 8); }
constexpr int v_rd_off(int d0, int ks, int half) { return d0 * 512 + ks * 4096 + half * 2048; }
template <int OFF> __device__ __forceinline__ s16x4 tr_read(int vb) {
  s16x4 r; asm volatile("ds_read_b64_tr_b16 %0, %1 offset:%2" : "=&v"(r) : "v"(vb), "i"(OFF) : "memory"); return r;
}
template <int D0> __device__ __forceinline__ void pv_one(f32x16& od, int vb, bf16x8 pa0, bf16x8 pa1, bf16x8 pa2, bf16x8 pa3) {
  const s16x4 l0 = tr_read<v_rd_off(D0, 0, 0)>(vb), h0 = tr_read<v_rd_off(D0, 0, 1)>(vb), l1 = tr_read<v_rd_off(D0, 1, 0)>(vb), h1 = tr_read<v_rd_off(D0, 1, 1)>(vb);
  const s16x4 l2 = tr_read<v_rd_off(D0, 2, 0)>(vb), h2 = tr_read<v_rd_off(D0, 2, 1)>(vb), l3 = tr_read<v_rd_off(D0, 3, 0)>(vb), h3 = tr_read<v_rd_off(D0, 3, 1)>(vb);
  asm volatile("s_waitcnt lgkmcnt(0)" ::: "memory"); SBAR();
#define PK(L, H) (bf16x8){L[0], L[1], L[2], L[3], H[0], H[1], H[2], H[3]}
  od = __builtin_amdgcn_mfma_f32_32x32x16_bf16(pa0, PK(l0, h0), od, 0, 0, 0);
  od = __builtin_amdgcn_mfma_f32_32x32x16_bf16(pa1, PK(l1, h1), od, 0, 0, 0);
  od = __builtin_amdgcn_mfma_f32_32x32x16_bf16(pa2, PK(l2, h2), od, 0, 0, 0);
  od = __builtin_amdgcn_mfma_f32_32x32x16_bf16(pa3, PK(l3, h3), od, 0, 0, 0);
#undef PK
}
__device__ __forceinline__ void pv_d0(f32x16* o, int vb, bf16x8 pa0, bf16x8 pa1, bf16x8 pa2, bf16x8 pa3) {
  pv_one<0>(o[0], vb, pa0, pa1, pa2, pa3); pv_one<1>(o[1], vb, pa0, pa1, pa2, pa3); pv_one<2>(o[2], vb, pa0, pa1, pa2, pa3); pv_one<3>(o[3], vb, pa0, pa1, pa2, pa3);
}

template <int LDQ, int LDK, int LDV, int LDO>
__device__ __forceinline__ void attn_dense_body(const bf16* __restrict__ Qb, const bf16* __restrict__ Kh, const bf16* __restrict__ Vh,
                                                bf16* __restrict__ Ob, int seq, char* lds) {
  using St = Stage<bf16>; using SQ = Stage<bf16>;
  const int tid = threadIdx.x, wid = tid >> 6, lane = tid & 63, r32 = lane & 31, hi = lane >> 5;
  bf16* V_lds = (bf16*)lds; bf16* K_lds = (bf16*)(lds + 2 * SHM_V);
  float* ws = (float*)(lds + 2 * SHM_V + 2 * SHM_K) + wid * 64; float* li_l = ws; float* al_l = ws + 32;
  float m_reg = -1e30f, l_reg = 0; f32x16 o[4] = {}; bf16x8 qr[8];
  const bf16* Qw = Qb + (long)(wid * QBLK + r32) * LDQ + hi * 8;
#pragma unroll
  for (int d0 = 0; d0 < 8; ++d0) qr[d0] = SQ::tobf(SQ::ld8(Qw + d0 * 16));
  const int sr = tid >> 4, sc = (tid & 15) * 8, vst0 = v_st(sr, sc), vst1 = v_st(32 + sr, sc);
  const int vb0 = (int)(uintptr_t)V_lds + v_rd_base(lane);
  struct { typename St::T vs0, vs1, ks0, ks1; } sr_[SDEPTH];
#define SLOAD(i, k0) do { sr_[i].vs0 = St::ld8(&Vh[(long)((k0) + sr) * LDV + sc]); sr_[i].vs1 = St::ld8(&Vh[(long)((k0) + 32 + sr) * LDV + sc]); \
    sr_[i].ks0 = St::ld8(&Kh[(long)((k0) + sr) * LDK + sc]); sr_[i].ks1 = St::ld8(&Kh[(long)((k0) + 32 + sr) * LDK + sc]); } while (0)
#define SWRITE(b, i) do { *(bf16x8*)((char*)V_lds + (b) * SHM_V + vst0) = St::tobf(sr_[i].vs0);          \
    *(bf16x8*)((char*)V_lds + (b) * SHM_V + vst1) = St::tobf(sr_[i].vs1); int kc = sc * 2;               \
    *(bf16x8*)((char*)K_lds + (b) * SHM_K + KSWZ(sr, kc)) = St::tobf(sr_[i].ks0);                       \
    *(bf16x8*)((char*)K_lds + (b) * SHM_K + KSWZ(32 + sr, kc)) = St::tobf(sr_[i].ks1); } while (0)
#define SWAIT() do { if constexpr (SDEPTH == 2) asm volatile("s_waitcnt vmcnt(4)" ::: "memory"); else asm volatile("s_waitcnt vmcnt(0)" ::: "memory"); } while (0)
#define RESC(a) do { if (__any((a) < 1.f)) { if (hi == 0) al_l[r32] = (a); asm volatile("s_waitcnt lgkmcnt(0)" ::: "memory"); \
    for (int d = 0; d < 4; ++d) for (int r = 0; r < 16; ++r) o[d][r] *= al_l[crow(r, hi)]; } } while (0)
  f32x16 pA0, pA1, pB0, pB1; float mnA, mnB, alA, alB; bf16x8 pa0, pa1, pa2, pa3; const int NT = seq / KVBLK;
  constexpr int SE = 0, SO = SDEPTH - 1;
  SLOAD(SE, 0); asm volatile("s_waitcnt vmcnt(0)" ::: "memory"); SWRITE(0, SE); __syncthreads();
  qkt(pA0, pA1, K_lds, qr, r32, hi); partialSM(pA0, pA1, m_reg, mnA, alA);
  SLOAD(SO, KVBLK); if constexpr (SDEPTH == 2) { if (2 < NT) SLOAD(SE, 2 * KVBLK); }
  SWAIT(); SWRITE(1, SO); __syncthreads();
  for (int j = 1; j + 1 < NT; j += 2) {
    SBAR(); qkt(pB0, pB1, (bf16*)((char*)K_lds + SHM_K), qr, r32, hi);
    finishSM(pA0, pA1, alA, l_reg, pa0, pa1, pa2, pa3); SBAR();
    SLOAD(SO, (j + SDEPTH) * KVBLK); SBAR();
    pv_d0(o, vb0, pa0, pa1, pa2, pa3); partialSM(pB0, pB1, m_reg, mnB, alB);
    __syncthreads(); SWAIT(); SWRITE(0, SE);
    RESC(alB); __syncthreads();
    SBAR(); qkt(pA0, pA1, K_lds, qr, r32, hi);
    finishSM(pB0, pB1, alB, l_reg, pa0, pa1, pa2, pa3); SBAR();
    if (SDEPTH == 1 || j + 3 < NT) SLOAD(SE, (j + 1 + SDEPTH) * KVBLK); SBAR();
    pv_d0(o, vb0 + (int)SHM_V, pa0, pa1, pa2, pa3); partialSM(pA0, pA1, m_reg, mnA, alA);
    __syncthreads(); SWAIT(); SWRITE(1, SO);
    RESC(alA); __syncthreads();
  }
  SBAR(); qkt(pB0, pB1, (bf16*)((char*)K_lds + SHM_K), qr, r32, hi);
  finishSM(pA0, pA1, alA, l_reg, pa0, pa1, pa2, pa3); SBAR();
  pv_d0(o, vb0, pa0, pa1, pa2, pa3); partialSM(pB0, pB1, m_reg, mnB, alB);
  __syncthreads(); RESC(alB);
  finishSM(pB0, pB1, alB, l_reg, pa0, pa1, pa2, pa3); SBAR();
  pv_d0(o, vb0 + (int)SHM_V, pa0, pa1, pa2, pa3);
  if (hi == 0) li_l[r32] = l_reg; asm volatile("s_waitcnt lgkmcnt(0)" ::: "memory");
  float rli[16];
#pragma unroll
  for (int r = 0; r < 16; ++r) rli[r] = __builtin_amdgcn_rcpf(li_l[crow(r, hi)]);
  bf16* Ow = Ob + (long)(wid * QBLK) * LDO;
#pragma unroll
  for (int r = 0; r < 16; ++r) { int orow = crow(r, hi);
    for (int d0 = 0; d0 < 4; ++d0) Ow[(long)orow * LDO + d0 * 32 + r32] = __float2bfloat16(o[d0][r] * rli[r]); }
#undef SLOAD
#undef SWRITE
#undef SWAIT
#undef RESC
}


__device__ __forceinline__ void dilated_unit(const bf16* __restrict__ proj, const float* __restrict__ lutg, bf16* __restrict__ outg, float* __restrict__ lseg,
                                             int d, int hd12, int hh, int r, int i0, char* lds) {
  constexpr int LDP = 10240;
  constexpr float L2E = 1.4426950408889634f, C = SCALE * L2E;
  const int tid = threadIdx.x, wid = tid >> 6, lane = tid & 63, r32 = lane & 31, hi = lane >> 5;
  const int n = 8192 / d;
  char* KV = lds;
  float* lutx = (float*)(lds + 98304);
  float* wsx = (float*)(lds + 98304 + 2048) + wid * 64;
  const int qoff = hd12 * 128, koff = 1536 + hd12 * 128;
  if (tid < 320) { const int o = tid - 96; lutx[tid] = (o >= 0 && o <= 128) ? lutg[o] * L2E : -1e30f; }
  const int iq = i0 + wid * 32 + r32;
  const int sr = tid >> 4, sc = (tid & 15) * 8;
  f32x16 s00, s01, s10, s11, s20, s21;
  const int a = wid >> 1;
  {
    const bf16* Qw = proj + (size_t)(r + iq * d) * LDP + qoff + hi * 8;
    bf16x8 qr[8];
#pragma unroll
    for (int d0 = 0; d0 < 8; ++d0) qr[d0] = *reinterpret_cast<const bf16x8*>(Qw + d0 * 16);
#pragma unroll
    for (int ib = 0; ib < 12; ib += 6) {
      bf16x8 kv6[6];
#pragma unroll
      for (int i = 0; i < 6; ++i) { const int row = sr + 32 * (ib + i); int j = i0 - 64 + row; j = j < 0 ? 0 : (j >= n ? n - 1 : j);
        kv6[i] = *reinterpret_cast<const bf16x8*>(proj + (size_t)(r + j * d) * LDP + koff + sc); }
#pragma unroll
      for (int i = 0; i < 6; ++i) { const int row = sr + 32 * (ib + i);
        *reinterpret_cast<bf16x8*>(KV + (row >> 6) * 16384 + KSWZ(row & 63, sc * 2)) = kv6[i]; }
      SBAR();
    }
    __syncthreads();
    qkt(s00, s01, (const bf16*)(KV + (a + 0) * 16384), qr, r32, hi);
    qkt(s10, s11, (const bf16*)(KV + (a + 1) * 16384), qr, r32, hi);
    qkt(s20, s21, (const bf16*)(KV + (a + 2) * 16384), qr, r32, hi);
  }
  __syncthreads();
  SBAR();
  const int base = -32 * (wid & 1) - 64 - r32 + 4 * hi;
  const float* lp = lutx + (base + 160);
  float mx = -1e30f;
#define DIL_LOGITS(S, TT, HALF) _Pragma("unroll") for (int rr = 0; rr < 16; ++rr) { const float v = fmaf(S[rr], C, lp[64 * TT + 32 * HALF + (rr & 3) + 8 * (rr >> 2)]); S[rr] = v; }
  DIL_LOGITS(s00, 0, 0) DIL_LOGITS(s01, 0, 1) DIL_LOGITS(s10, 1, 0) DIL_LOGITS(s11, 1, 1) DIL_LOGITS(s20, 2, 0) DIL_LOGITS(s21, 2, 1)
#undef DIL_LOGITS
  if (i0 == 0 || i0 + 320 > n) {
    const int lo = -iq - base, hi_ = n - 1 - iq - base;
#define DIL_MASK(S, TT, HALF) _Pragma("unroll") for (int rr = 0; rr < 16; ++rr) { const int c = 64 * TT + 32 * HALF + (rr & 3) + 8 * (rr >> 2); S[rr] = (c >= lo && c <= hi_) ? S[rr] : -1e30f; }
    DIL_MASK(s00, 0, 0) DIL_MASK(s01, 0, 1) DIL_MASK(s10, 1, 0) DIL_MASK(s11, 1, 1) DIL_MASK(s20, 2, 0) DIL_MASK(s21, 2, 1)
#undef DIL_MASK
  }
#define DIL_MAX(S) _Pragma("unroll") for (int rr = 0; rr < 16; ++rr) mx = fmaxf(mx, S[rr]);
  DIL_MAX(s00) DIL_MAX(s01) DIL_MAX(s10) DIL_MAX(s11) DIL_MAX(s20) DIL_MAX(s21)
#undef DIL_MAX
  { auto rr = __builtin_amdgcn_permlane32_swap(__float_as_uint(mx), __float_as_uint(mx), false, false);
    mx = fmaxf(__uint_as_float(rr[0]), __uint_as_float(rr[1])); }
  float ps = 0.f;
#define DIL_EXP(S) _Pragma("unroll") for (int rr = 0; rr < 16; ++rr) { const float p = __builtin_amdgcn_exp2f(S[rr] - mx); S[rr] = p; ps += p; }
  DIL_EXP(s00) DIL_EXP(s01) DIL_EXP(s10) DIL_EXP(s11) DIL_EXP(s20) DIL_EXP(s21)
#undef DIL_EXP
  { auto rr = __builtin_amdgcn_permlane32_swap(__float_as_uint(ps), __float_as_uint(ps), false, false);
    ps = __uint_as_float(rr[0]) + __uint_as_float(rr[1]); }
  bf16x8 pa[12];
#define PK4(P, BASE, OUT) do { unsigned a0 = cvtpk(P[BASE + 0], P[BASE + 1]), a1 = cvtpk(P[BASE + 2], P[BASE + 3]);   \
    unsigned b0 = cvtpk(P[BASE + 4], P[BASE + 5]), b1 = cvtpk(P[BASE + 6], P[BASE + 7]);                              \
    auto r0 = __builtin_amdgcn_permlane32_swap(a0, b0, false, false); auto r1 = __builtin_amdgcn_permlane32_swap(a1, b1, false, false); \
    u32x4 w = {r0[0], r1[0], r0[1], r1[1]}; OUT = *reinterpret_cast<bf16x8*>(&w); } while (0)
  PK4(s00, 0, pa[0]); PK4(s00, 8, pa[1]); PK4(s01, 0, pa[2]); PK4(s01, 8, pa[3]);
  PK4(s10, 0, pa[4]); PK4(s10, 8, pa[5]); PK4(s11, 0, pa[6]); PK4(s11, 8, pa[7]);
  PK4(s20, 0, pa[8]); PK4(s20, 8, pa[9]); PK4(s21, 0, pa[10]); PK4(s21, 8, pa[11]);
#undef PK4
  SBAR();
#pragma unroll
  for (int ib = 0; ib < 12; ib += 6) {
    bf16x8 kv6[6];
#pragma unroll
    for (int i = 0; i < 6; ++i) { const int row = sr + 32 * (ib + i); int j = i0 - 64 + row; j = j < 0 ? 0 : (j >= n ? n - 1 : j);
      kv6[i] = *reinterpret_cast<const bf16x8*>(proj + (size_t)(r + j * d) * LDP + koff + 1536 + sc); }
#pragma unroll
    for (int i = 0; i < 6; ++i) { const int row = sr + 32 * (ib + i);
      *reinterpret_cast<bf16x8*>(KV + (row >> 6) * 16384 + v_st(row & 63, sc)) = kv6[i]; }
    SBAR();
  }
  if (hi == 0) wsx[r32] = ps;
  __syncthreads();
  f32x16 o[4] = {};
  const int vb = (int)(uintptr_t)KV + v_rd_base(lane);
  pv_d0(o, vb + (a + 0) * 16384, pa[0], pa[1], pa[2], pa[3]);
  pv_d0(o, vb + (a + 1) * 16384, pa[4], pa[5], pa[6], pa[7]);
  pv_d0(o, vb + (a + 2) * 16384, pa[8], pa[9], pa[10], pa[11]);
  float rli[16];
#pragma unroll
  for (int rr = 0; rr < 16; ++rr) rli[rr] = __builtin_amdgcn_rcpf(wsx[crow(rr, hi)]);
#pragma unroll
  for (int rr = 0; rr < 16; ++rr) { const int ir = i0 + wid * 32 + crow(rr, hi); bf16* orow = outg + (size_t)(r + ir * d) * 512 + hh * 128 + r32;
#pragma unroll
    for (int d0 = 0; d0 < 4; ++d0) orow[d0 * 32] = __float2bfloat16(o[d0][rr] * rli[rr]); }
  if (hi == 0) lseg[(size_t)(r + iq * d) * 4 + hh] = (mx + __builtin_amdgcn_logf(ps)) * 0.6931471805599453f;
  __syncthreads();
}
}

#define GAS __attribute__((address_space(1)))
#define LAS __attribute__((address_space(3)))
typedef unsigned short bf16;
typedef unsigned v4u __attribute__((ext_vector_type(4)));
typedef unsigned v2u __attribute__((ext_vector_type(2)));
typedef float f32x4 __attribute__((ext_vector_type(4)));
#define LDS_WAIT() asm volatile("s_waitcnt lgkmcnt(0)" ::: "memory")
#define VM_WAIT() asm volatile("s_waitcnt vmcnt(0)" ::: "memory")
__device__ __forceinline__ unsigned pk2(float lo, float hi) { return pg8::cvt_pk_bf16(lo, hi); }
__device__ __forceinline__ float bflo(unsigned w) { return __builtin_bit_cast(float, w << 16); }
__device__ __forceinline__ float bfhi(unsigned w) { return __builtin_bit_cast(float, w & 0xffff0000u); }
__device__ __forceinline__ float bf2f(bf16 b) { return __builtin_bit_cast(float, ((unsigned)b) << 16); }

#define XB_TMO      128
#define XB_XCNT(j)  (256  + 64 * (j))
#define XB_XSUB(j)  (1280 + 64 * (j))
#define XB_XGEN(j)  (2304 + 64 * (j))
#define XB_TOP      3328
#define XB_TOPGEN   3392
#define XCD_BAR_WORDS 3456
#define XB_SPIN_CAP (1u << 18)

__device__ __forceinline__ unsigned xb_ld(unsigned* p)              { return __hip_atomic_load(p, __ATOMIC_RELAXED, __HIP_MEMORY_SCOPE_AGENT); }
__device__ __forceinline__ unsigned xb_add(unsigned* p, unsigned v) { return __hip_atomic_fetch_add(p, v, __ATOMIC_RELAXED, __HIP_MEMORY_SCOPE_AGENT); }
__device__ __forceinline__ unsigned xb_xcc_id() { return (unsigned)__builtin_amdgcn_s_getreg((3 << 11) | 20) & 0xFu; }
#define XB_SPIN(cond, bar) do { unsigned _sp = 0; while (cond) { __builtin_amdgcn_s_sleep(1); \
    if ((++_sp & 255u) == 0u) { if (xb_ld(&(bar)[XB_TMO])) break; if (_sp > XB_SPIN_CAP) { atomicAdd(&(bar)[XB_TMO], 1u); break; } } } } while (0)

struct XcdBarrier {
    unsigned* bar; unsigned x;
    volatile LAS unsigned* st;
};

__device__ __forceinline__ XcdBarrier xcd_barrier_post(unsigned* bar, volatile LAS unsigned* st) {
    XcdBarrier b; b.bar = bar; b.x = xb_xcc_id(); b.st = st;
    if (threadIdx.x == 0) (void)xb_add(&bar[XB_XCNT(b.x)], 1u);
    return b;
}
__device__ __forceinline__ void xcd_barrier_complete(unsigned* bar, unsigned x, unsigned& nloc, unsigned& nx) {
    const unsigned G = gridDim.x * gridDim.y * gridDim.z;
    unsigned sum, cnt, mine, sp = 0u;
    for (;;) {
        sum = 0u; cnt = 0u; mine = 0u;
#pragma unroll
        for (unsigned j = 0; j < 16; ++j) { const unsigned c = xb_ld(&bar[XB_XCNT(j)]); sum += c; cnt += (c > 0u) ? 1u : 0u; mine = (j == x) ? c : mine; }
        if (sum == G) break;
        __builtin_amdgcn_s_sleep(1);
        if ((++sp & 255u) == 0u) { if (xb_ld(&bar[XB_TMO])) break; if (sp > XB_SPIN_CAP) { atomicAdd(&bar[XB_TMO], 1u); break; } }
    }
    nloc = mine > 0u ? mine : 1u; nx = cnt > 0u ? cnt : 1u;
}

__device__ __forceinline__ void xcd_barrier(const XcdBarrier& b) {
    asm volatile("s_waitcnt vmcnt(0)" ::: "memory");
    __syncthreads();
    if (threadIdx.x == 0) {
        unsigned* bar = b.bar;
        __builtin_amdgcn_s_waitcnt(0);
        unsigned nloc = b.st[0], nx = b.st[1];
        if (nloc == 0u) { xcd_barrier_complete(bar, b.x, nloc, nx); b.st[0] = nloc; b.st[1] = nx; }
        const unsigned old = xb_add(&bar[XB_XSUB(b.x)], 1u);
        const unsigned gen = old / nloc;
        if (old + 1u == (gen + 1u) * nloc) {
            __builtin_amdgcn_fence(__ATOMIC_RELEASE, "agent");
            asm volatile("s_waitcnt vmcnt(0)" ::: "memory");
            const unsigned og = xb_add(&bar[XB_TOP], 1u);
            const unsigned tg = og / nx;
            if (og + 1u == (tg + 1u) * nx) xb_add(&bar[XB_TOPGEN], 1u);
            else XB_SPIN(xb_ld(&bar[XB_TOPGEN]) == tg, bar);
            __builtin_amdgcn_fence(__ATOMIC_ACQUIRE, "agent");
            xb_add(&bar[XB_XGEN(b.x)], 1u);
            asm volatile("s_waitcnt vmcnt(0)" ::: "memory");
        } else {
            XB_SPIN(xb_ld(&bar[XB_XGEN(b.x)]) == gen, bar);
            __builtin_amdgcn_fence(__ATOMIC_ACQUIRE, "agent");
            asm volatile("s_waitcnt vmcnt(0)" ::: "memory");
        }
    }
    __syncthreads();
}

constexpr int S_ = 8192, DM = 2048, INW = 10240, NE = 32, TOPK = 4;
constexpr int A_W = 1536, A_V_OFF = 3072, B_Q_OFF = 4608, B_K_OFF = 5632, B_V_OFF = 5888, GATE_OFF = 6144;
constexpr int MAXSLOT = 40960;
constexpr float LN_EPS = 1e-5f, QK_EPS = 1e-6f;
constexpr float ALPHA = 1.189207115002721f;
constexpr int NPH = 11;

constexpr size_t MiB = 1u << 20;
constexpr size_t WS_CTL = 0, CTL_ZERO_BYTES = 64 * 1024;
constexpr int CW_BAR = 0;
constexpr int CW_CNT = 4096;
constexpr size_t WS_LUT = 1 * MiB;
constexpr size_t WS_ROPE = 1 * MiB + 8192;
constexpr size_t WS_WRT = 1 * MiB + 65536;
constexpr size_t WS_TOKE = 1 * MiB + 65536 + 262144;
constexpr size_t WS_TOKR = WS_TOKE + 131072;
constexpr size_t WS_TOKW = WS_TOKR + 131072;
constexpr size_t WS_TOKS = WS_TOKW + 131072;
constexpr size_t WS_SLOTW = WS_TOKS + 131072;
constexpr size_t WS_LSE = 3 * MiB;
constexpr size_t WS_XB = 4 * MiB;
constexpr size_t WS_WIN = WS_XB + 32 * MiB;
constexpr size_t WS_WA = WS_WIN + 40 * MiB;
constexpr size_t WS_WB = WS_WA + 2 * MiB;
constexpr size_t WS_WO = WS_WB + 4 * MiB;
constexpr size_t WS_WGL = WS_WO + 8 * MiB;
constexpr size_t WS_WD = WS_WGL + 512 * MiB;
constexpr size_t WS_PROJ = WS_WD + 256 * MiB;
constexpr size_t WS_QBR = WS_PROJ + 160 * MiB;
constexpr size_t WS_KBR = WS_QBR + 16 * MiB;
constexpr size_t WS_VBR = WS_KBR + 4 * MiB;
constexpr size_t WS_OUTA = WS_VBR + 4 * MiB;
constexpr size_t WS_YA = WS_OUTA + 24 * MiB;
constexpr size_t WS_YB = WS_YA + 8 * MiB;
constexpr size_t WS_T1 = WS_YB + 16 * MiB;
constexpr size_t WS_Y = WS_T1 + 64 * MiB;
constexpr size_t WS_X1 = WS_Y + 32 * MiB;
constexpr size_t WS_X1B = WS_X1 + 64 * MiB;
constexpr size_t WS_XS = WS_X1B + 32 * MiB;
constexpr size_t WS_H = WS_XS + 160 * MiB;
constexpr size_t WS_YS = WS_PROJ;
constexpr size_t WS_END = WS_H + 160 * MiB;

constexpr int RING_OFF = 0, RING_BYTES = 131072;
constexpr int L_XB = RING_BYTES;
constexpr int L_TILE = RING_BYTES + 64;
constexpr int L_PST = RING_BYTES + 1024;
constexpr int L_CNT = RING_BYTES + 1280;
constexpr int L_ASG = RING_BYTES + 2048;
constexpr int L_PTR = RING_BYTES + 3584;
constexpr int LDS_BYTES = 147456;

struct Frame {
    LAS unsigned char* lds; unsigned char* ldsg;
    unsigned char* ws; unsigned* ctl;
    int tid, lane, wave, G;
};
__device__ __forceinline__ const float* inp(const Frame& F, int i) {
    const LAS unsigned* p = (const LAS unsigned*)(F.lds + L_PTR) + 2 * i;
    const unsigned lo = __builtin_amdgcn_readfirstlane(p[0]), hi = __builtin_amdgcn_readfirstlane(p[1]);
    return (const float*)(((unsigned long long)hi << 32) | lo);
}
__device__ __forceinline__ float wave_sum(float v) {
#pragma unroll
    for (int o = 1; o < 64; o <<= 1) v += __shfl_xor(v, o);
    return v;
}

__device__ __forceinline__ void transpose_item(const float* __restrict__ W, int N, int k0, int n0, bf16* WT, int ldo, int orow0, int ocol0, LAS float* scr, int lane) {
    f32x4 v[8];
#pragma unroll
    for (int i = 0; i < 8; ++i) v[i] = *(const f32x4*)(W + (size_t)(k0 + 8 * i + (lane >> 3)) * N + n0 + 4 * (lane & 7));
#pragma unroll
    for (int i = 0; i < 8; ++i) { LAS float* s = scr + (8 * i + (lane >> 3)) * 33 + 4 * (lane & 7); s[0] = v[i][0]; s[1] = v[i][1]; s[2] = v[i][2]; s[3] = v[i][3]; }
    LDS_WAIT(); asm volatile("" ::: "memory");
    const int c = lane & 7;
#pragma unroll
    for (int j = 0; j < 4; ++j) { const int n = (lane >> 3) + 8 * j; const LAS float* s = scr + (8 * c) * 33 + n;
        v4u o; o.x = pk2(s[0 * 33], s[1 * 33]); o.y = pk2(s[2 * 33], s[3 * 33]); o.z = pk2(s[4 * 33], s[5 * 33]); o.w = pk2(s[6 * 33], s[7 * 33]);
        *(v4u*)(WT + (size_t)(orow0 + n) * ldo + ocol0 + 8 * c) = o; }
    LDS_WAIT(); asm volatile("" ::: "memory");
}
__device__ __forceinline__ int t5_bucket(int rel) {
    const int n = rel < 0 ? -rel : rel; const float nf = (float)(n < 1 ? 1 : n);
    int large = 8 + (int)(logf(nf / 8.0f) / 4.852030263919617f * 8.0f); large = large < 15 ? large : 15;
    return (rel > 0 ? 16 : 0) + (n < 8 ? n : large);
}
__device__ __forceinline__ void p0_prologue(Frame& F) {
    LAS float* scr = (LAS float*)(F.lds + RING_OFF + F.wave * 16384);
    const int gw = blockIdx.x * 8 + F.wave, NGW = F.G * 8;
    const int gt = blockIdx.x * 512 + F.tid, NGT = F.G * 512;
    bf16* XB = (bf16*)(F.ws + WS_XB); bf16* WIN = (bf16*)(F.ws + WS_WIN); bf16* WA = (bf16*)(F.ws + WS_WA); bf16* WB = (bf16*)(F.ws + WS_WB); bf16* WO = (bf16*)(F.ws + WS_WO);
    bf16* WGL = (bf16*)(F.ws + WS_WGL); bf16* WD = (bf16*)(F.ws + WS_WD);
    { float* lut = (float*)(F.ws + WS_LUT); const float* rb = inp(F, 3);
      for (int i = gt; i < 3 * 4 * 129; i += NGT) { const int g = i / 516, hh = (i / 129) % 4, j = i % 129; const int d = (g == 0) ? 1 : (g == 1 ? 4 : 16);
          lut[i] = rb[t5_bucket((j - 64) * d) * 12 + g * 4 + hh]; }
      float* rope = (float*)(F.ws + WS_ROPE);
      for (int i = gt; i < 128 * 32; i += NGT) { const int pos = i >> 5, fi = i & 31; const float inv = powf(10000.0f, -(float)(2 * fi) / 64.0f); const float ang = (float)pos * inv;
          rope[2 * i] = __cosf(ang); rope[2 * i + 1] = __sinf(ang); }
      float* wrt = (float*)(F.ws + WS_WRT); const float* wr = inp(F, 11);
      for (int i = gt; i < 32 * 2048; i += NGT) { const int e = i >> 11, c = i & 2047; wrt[i] = wr[c * 32 + e]; }
    }
    { const float* x = inp(F, 0);
      for (int i = gw; i < S_ * DM / 512; i += NGW) { const size_t o = (size_t)i * 512 + F.lane * 8; const f32x4 a = *(const f32x4*)(x + o), b = *(const f32x4*)(x + o + 4);
          v4u w; w.x = pk2(a[0], a[1]); w.y = pk2(a[2], a[3]); w.z = pk2(b[0], b[1]); w.w = pk2(b[2], b[3]); *(v4u*)(XB + o) = w; } }
    constexpr int I_WIN = 32 * 320, I_WA = 8 * 64, I_WB = 16 * 64, I_WO = 32 * 64, I_EXP = 32 * 64, I_MOE = 3 * 32 * I_EXP;
    constexpr int NITEMS = I_WIN + I_WA + I_WB + I_WO + I_MOE;
    const float* const w_in = inp(F, 1); const float* const w_ba = inp(F, 6); const float* const w_bb = inp(F, 7); const float* const w_o = inp(F, 8);
    const float* const w_g = inp(F, 13); const float* const w_l = inp(F, 15); const float* const w_d = inp(F, 17);
    for (int it = gw; it < NITEMS; it += NGW) {
        int r = it;
        if (r < I_WIN) { const int kb = r / 320, nb = r % 320; transpose_item(w_in, INW, 64 * kb, 32 * nb, WIN, 2048, 32 * nb, 64 * kb, scr, F.lane); continue; } r -= I_WIN;
        if (r < I_WA) { const int kb = r / 64, nb = r % 64; transpose_item(w_ba, DM, 64 * kb, 32 * nb, WA, 512, 32 * nb, 64 * kb, scr, F.lane); continue; } r -= I_WA;
        if (r < I_WB) { const int kb = r / 64, nb = r % 64; transpose_item(w_bb, DM, 64 * kb, 32 * nb, WB, 1024, 32 * nb, 64 * kb, scr, F.lane); continue; } r -= I_WB;
        if (r < I_WO) { const int kb = r / 64, nb = r % 64; transpose_item(w_o, DM, 64 * kb, 32 * nb, WO, 2048, 32 * nb, 64 * kb, scr, F.lane); continue; } r -= I_WO;
        const int which = r / (32 * I_EXP), rr = r % (32 * I_EXP), e = rr / I_EXP, q = rr % I_EXP, kb = q / 64, nb = q % 64, n0 = 32 * nb;
        const float* src = (which == 0 ? w_g : (which == 1 ? w_l : w_d)) + (size_t)e * DM * DM;
        if (which < 2) transpose_item(src, DM, 64 * kb, n0, WGL + (size_t)e * 4096 * 2048, 2048, (n0 >> 7) * 256 + which * 128 + (n0 & 127), 64 * kb, scr, F.lane);
        else transpose_item(src, DM, 64 * kb, n0, WD + (size_t)e * 2048 * 2048, 2048, n0, 64 * kb, scr, F.lane);
    }
}

__device__ __forceinline__ void p2_prep_dilated(Frame& F) {
    const bf16* proj = (const bf16*)(F.ws + WS_PROJ);
    bf16* QBR = (bf16*)(F.ws + WS_QBR); bf16* KBR = (bf16*)(F.ws + WS_KBR); bf16* VBR = (bf16*)(F.ws + WS_VBR);
    const float* rope = (const float*)(F.ws + WS_ROPE);
    const int gw = blockIdx.x * 8 + F.wave, NGW = F.G * 8;
    const int half = F.lane >> 5, fi = F.lane & 31, c1 = half * 64 + fi, c2 = c1 + 32;
    const float* const qn_g = inp(F, 4); const float* const kn_g = inp(F, 5);
    for (int it = gw; it < S_ * 12; it += NGW) {
        const int t = it / 12, h = it % 12;
        if (h >= 10) { const unsigned* vs = (const unsigned*)(proj + (size_t)t * INW + B_V_OFF + (h - 10) * 128); ((unsigned*)(VBR + (size_t)t * 256 + (h - 10) * 128))[F.lane] = vs[F.lane]; continue; }
        const bf16* src = proj + (size_t)t * INW + (h < 8 ? B_Q_OFF + h * 128 : B_K_OFF + (h - 8) * 128);
        const float* gn = h < 8 ? qn_g : kn_g;
        float v1 = bf2f(src[c1]), v2 = bf2f(src[c2]);
        const float ss = wave_sum(v1 * v1 + v2 * v2);
        const float rs = 1.0f / sqrtf(ss * (1.0f / 128.0f) + QK_EPS);
        v1 = v1 * rs * gn[c1]; v2 = v2 * rs * gn[c2];
        const int pos = half ? (t & 63) : (t >> 6);
        const float cs = rope[(pos * 32 + fi) * 2], sn = rope[(pos * 32 + fi) * 2 + 1];
        const float o1 = v1 * cs - v2 * sn, o2 = v1 * sn + v2 * cs;
        bf16* dst = h < 8 ? QBR + (size_t)t * 1024 + h * 128 : KBR + (size_t)t * 256 + (h - 8) * 128;
        dst[c1] = (bf16)(pk2(o1, 0.f) & 0xffffu); dst[c2] = (bf16)(pk2(o2, 0.f) & 0xffffu);
    }
    const float* lut = (const float*)(F.ws + WS_LUT);
    for (int u = blockIdx.x; u < 384; u += F.G) {
        const int gh = u >> 5, blk = u & 31, g = gh >> 2, hh = gh & 3, d = (g == 0) ? 1 : (g == 1 ? 4 : 16);
        const int bps = 32 / d, r = blk / bps, qb = blk % bps;
        at::dilated_unit((const at::bf16*)proj, lut + (g * 4 + hh) * 129, (at::bf16*)(F.ws + WS_OUTA) + (size_t)g * S_ * 512, (float*)(F.ws + WS_LSE) + (size_t)g * S_ * 4,
                         d, gh, hh, r, qb * 256, (char*)F.ldsg + RING_OFF);
    }
}

__device__ __forceinline__ void p3_attn_combine(Frame& F) {
    const at::bf16* QBR = (const at::bf16*)(F.ws + WS_QBR); const at::bf16* KBR = (const at::bf16*)(F.ws + WS_KBR); const at::bf16* VBR = (const at::bf16*)(F.ws + WS_VBR);
    at::bf16* YB = (at::bf16*)(F.ws + WS_YB);
    for (int u = blockIdx.x; u < 256; u += F.G) {
        const int h = u & 7, qb = u >> 3, kv = h >> 2;
        at::attn_dense_body<1024, 256, 256, 1024>(QBR + (size_t)qb * 256 * 1024 + h * 128, KBR + kv * 128, VBR + kv * 128, YB + (size_t)qb * 256 * 1024 + h * 128, S_, (char*)F.ldsg + RING_OFF);
        __syncthreads();
    }
    const bf16* OUTA = (const bf16*)(F.ws + WS_OUTA); const float* LSE = (const float*)(F.ws + WS_LSE); bf16* YA = (bf16*)(F.ws + WS_YA);
    for (int tb = blockIdx.x; tb < 256; tb += F.G) {
        const int t = tb * 32 + (F.tid >> 4), c0 = (F.tid & 15) * 32, hh = c0 >> 7;
        const float l0 = LSE[(size_t)t * 4 + hh], l1 = LSE[(size_t)(S_ + t) * 4 + hh], l2 = LSE[(size_t)(2 * S_ + t) * 4 + hh];
        const float m = fmaxf(l0, fmaxf(l1, l2)); float w0 = __expf(l0 - m), w1 = __expf(l1 - m), w2 = __expf(l2 - m); const float inv = 1.0f / (w0 + w1 + w2); w0 *= inv; w1 *= inv; w2 *= inv;
#pragma unroll
        for (int q = 0; q < 4; ++q) { const size_t o = (size_t)t * 512 + c0 + q * 8;
            const v4u a = *(const v4u*)(OUTA + o), b = *(const v4u*)(OUTA + (size_t)S_ * 512 + o), c = *(const v4u*)(OUTA + (size_t)2 * S_ * 512 + o);
            v4u w;
            w.x = pk2(w0 * bflo(a.x) + w1 * bflo(b.x) + w2 * bflo(c.x), w0 * bfhi(a.x) + w1 * bfhi(b.x) + w2 * bfhi(c.x));
            w.y = pk2(w0 * bflo(a.y) + w1 * bflo(b.y) + w2 * bflo(c.y), w0 * bfhi(a.y) + w1 * bfhi(b.y) + w2 * bfhi(c.y));
            w.z = pk2(w0 * bflo(a.z) + w1 * bflo(b.z) + w2 * bflo(c.z), w0 * bfhi(a.z) + w1 * bfhi(b.z) + w2 * bfhi(c.z));
            w.w = pk2(w0 * bflo(a.w) + w1 * bflo(b.w) + w2 * bflo(c.w), w0 * bfhi(a.w) + w1 * bfhi(b.w) + w2 * bfhi(c.w));
            *(v4u*)(YA + o) = w; }
    }
}

__device__ __forceinline__ void p6_ln_router(Frame& F) {
    LAS int* cntl = (LAS int*)(F.lds + L_CNT); LAS int* basel = cntl + 32;
    LAS int* asg_e = (LAS int*)(F.lds + L_ASG); LAS int* asg_lr = asg_e + 128; LAS float* asg_w = (LAS float*)(asg_lr + 128);
    const float* Z1 = (const float*)(F.ws + WS_T1); float* X1 = (float*)(F.ws + WS_X1); bf16* X1B = (bf16*)(F.ws + WS_X1B);
    const f32x4* G4 = (const f32x4*)inp(F, 9); const f32x4* B4 = (const f32x4*)inp(F, 10);
    const f32x4* WRT4 = (const f32x4*)(F.ws + WS_WRT); const float* br = inp(F, 12);
    unsigned* gcnt = F.ctl + CW_CNT;
    int* TOKE = (int*)(F.ws + WS_TOKE); int* TOKR = (int*)(F.ws + WS_TOKR); float* TOKW = (float*)(F.ws + WS_TOKW);
    for (int tb = blockIdx.x; tb < 256; tb += F.G) {
        if (F.tid < 32) cntl[F.tid] = 0;
        __syncthreads();
#pragma unroll 1
        for (int hp = 0; hp < 2; ++hp) {
        const int t0 = tb * 32 + F.wave * 4 + hp * 2;
        f32x4 xv[2][8];
#pragma unroll
        for (int tk = 0; tk < 2; ++tk) {
            const f32x4* zr = (const f32x4*)(Z1 + (size_t)(t0 + tk) * DM) + F.lane; float s = 0.f;
#pragma unroll
            for (int j = 0; j < 8; ++j) { xv[tk][j] = zr[64 * j]; s += (xv[tk][j][0] + xv[tk][j][1]) + (xv[tk][j][2] + xv[tk][j][3]); }
            const float mean = wave_sum(s) * (1.0f / DM); float s2 = 0.f;
#pragma unroll
            for (int j = 0; j < 8; ++j) { xv[tk][j] = xv[tk][j] - mean; s2 += (xv[tk][j][0] * xv[tk][j][0] + xv[tk][j][1] * xv[tk][j][1]) + (xv[tk][j][2] * xv[tk][j][2] + xv[tk][j][3] * xv[tk][j][3]); }
            const float rstd = 1.0f / sqrtf(wave_sum(s2) * (1.0f / DM) + LN_EPS);
            f32x4* xo = (f32x4*)(X1 + (size_t)(t0 + tk) * DM) + F.lane; v2u* xb = (v2u*)(X1B + (size_t)(t0 + tk) * DM) + F.lane;
#pragma unroll
            for (int j = 0; j < 8; ++j) { const f32x4 v = xv[tk][j] * rstd * G4[64 * j + F.lane] + B4[64 * j + F.lane]; xv[tk][j] = v; xo[64 * j] = v;
                v2u w; w.x = pk2(v[0], v[1]); w.y = pk2(v[2], v[3]); xb[64 * j] = w; }
        }
        float logit[2] = {-3.0e38f, -3.0e38f};
#pragma unroll 1
        for (int e = 0; e < 32; ++e) {
            f32x4 w[8];
#pragma unroll
            for (int j = 0; j < 8; ++j) w[j] = WRT4[e * 512 + 64 * j + F.lane];
            const float be = br[e];
#pragma unroll
            for (int tk = 0; tk < 2; ++tk) { float p = 0.f;
#pragma unroll
                for (int j = 0; j < 8; ++j) p += (xv[tk][j][0] * w[j][0] + xv[tk][j][1] * w[j][1]) + (xv[tk][j][2] * w[j][2] + xv[tk][j][3] * w[j][3]);
                const float sres = wave_sum(p) + be; logit[tk] = (F.lane == e) ? sres : logit[tk]; }
        }
#pragma unroll
        for (int tk = 0; tk < 2; ++tk) {
            float v = logit[tk]; float tv[4]; int ti[4];
#pragma unroll
            for (int k = 0; k < 4; ++k) { float bv = v; int bi = F.lane;
#pragma unroll
                for (int o = 1; o < 64; o <<= 1) { const float ov = __shfl_xor(bv, o); const int oi = __shfl_xor(bi, o); if (ov > bv || (ov == bv && oi < bi)) { bv = ov; bi = oi; } }
                tv[k] = bv; ti[k] = bi; if (F.lane == bi) v = -3.0e38f; }
            const float e1 = __expf(tv[1] - tv[0]), e2 = __expf(tv[2] - tv[0]), e3 = __expf(tv[3] - tv[0]); const float inv = 1.0f / (1.0f + e1 + e2 + e3);
            if (F.lane < 4) { const int me = F.lane == 0 ? ti[0] : (F.lane == 1 ? ti[1] : (F.lane == 2 ? ti[2] : ti[3]));
                const float mw = (F.lane == 0 ? 1.0f : (F.lane == 1 ? e1 : (F.lane == 2 ? e2 : e3))) * inv;
                const int lr = atomicAdd((int*)(cntl + me), 1);
                const int a = (F.wave * 4 + hp * 2 + tk) * 4 + F.lane; asg_e[a] = me; asg_lr[a] = lr; asg_w[a] = mw; }
        }
        }
        __syncthreads();
        if (F.tid < 32) basel[F.tid] = (int)atomicAdd(gcnt + F.tid, (unsigned)cntl[F.tid]);
        __syncthreads();
        if (F.tid < 128) { const int a = tb * 128 + F.tid; const int e = asg_e[F.tid]; TOKE[a] = e; TOKR[a] = basel[e] + asg_lr[F.tid]; TOKW[a] = asg_w[F.tid]; }
        __syncthreads();
    }
}

__device__ __forceinline__ void p7_gather(Frame& F) {
    LAS int* pst = (LAS int*)(F.lds + L_PST);
    const unsigned* gcnt = F.ctl + CW_CNT;
    if (F.tid == 0) { int acc = 0; for (int e = 0; e < 32; ++e) { pst[e] = acc; acc += ((int)gcnt[e] + 255) & ~255; } pst[32] = acc; }
    __syncthreads();
    const int* TOKE = (const int*)(F.ws + WS_TOKE); const int* TOKR = (const int*)(F.ws + WS_TOKR); const float* TOKW = (const float*)(F.ws + WS_TOKW);
    int* TOKS = (int*)(F.ws + WS_TOKS); float* SLOTW = (float*)(F.ws + WS_SLOTW);
    const bf16* X1B = (const bf16*)(F.ws + WS_X1B); bf16* XS = (bf16*)(F.ws + WS_XS);
    const int gw = blockIdx.x * 8 + F.wave, NGW = F.G * 8;
    for (int a = gw; a < S_ * TOPK; a += NGW) {
        const int t = a >> 2, e = TOKE[a]; const int slot = pst[e] + TOKR[a];
        if (F.lane == 0) { TOKS[a] = slot; SLOTW[slot] = TOKW[a]; }
        const v4u* src = (const v4u*)(X1B + (size_t)t * DM) + F.lane; v4u* dst = (v4u*)(XS + (size_t)slot * DM) + F.lane;
        const v4u a0 = src[0], a1 = src[64], a2 = src[128], a3 = src[192];
        dst[0] = a0; dst[64] = a1; dst[128] = a2; dst[192] = a3;
    }
}
__device__ __forceinline__ int moe_tiles(Frame& F) {
    LAS int* tile_e = (LAS int*)(F.lds + L_TILE);
    const unsigned* gcnt = F.ctl + CW_CNT;
    __syncthreads();
    if (F.tid == 0) { int ti = 0; for (int e = 0; e < 32; ++e) { const int nt = ((int)gcnt[e] + 255) >> 8; for (int k = 0; k < nt && ti < 160; ++k) tile_e[ti++] = e; } tile_e[160] = ti; }
    __syncthreads();
    return tile_e[160];
}

__device__ __forceinline__ void p10_final(Frame& F) {
    const float* X1 = (const float*)(F.ws + WS_X1); const bf16* YS = (const bf16*)(F.ws + WS_YS); const int* TOKS = (const int*)(F.ws + WS_TOKS);
    const f32x4* G4 = (const f32x4*)inp(F, 19); const f32x4* B4 = (const f32x4*)inp(F, 20);
    float* outp = (float*)inp(F, 21);
    const int gw = blockIdx.x * 8 + F.wave, NGW = F.G * 8;
    for (int t = gw; t < S_; t += NGW) {
        const int sl0 = TOKS[t * 4], sl1 = TOKS[t * 4 + 1], sl2 = TOKS[t * 4 + 2], sl3 = TOKS[t * 4 + 3];
        const f32x4* xr = (const f32x4*)(X1 + (size_t)t * DM) + F.lane;
        const v2u* y0 = (const v2u*)(YS + (size_t)sl0 * DM) + F.lane; const v2u* y1 = (const v2u*)(YS + (size_t)sl1 * DM) + F.lane;
        const v2u* y2 = (const v2u*)(YS + (size_t)sl2 * DM) + F.lane; const v2u* y3 = (const v2u*)(YS + (size_t)sl3 * DM) + F.lane;
        f32x4 v[8]; float s = 0.f;
#pragma unroll
        for (int j = 0; j < 8; ++j) { const v2u a = y0[64 * j], b = y1[64 * j], c = y2[64 * j], d = y3[64 * j]; f32x4 f;
            f[0] = (bflo(a.x) + bflo(b.x)) + (bflo(c.x) + bflo(d.x)); f[1] = (bfhi(a.x) + bfhi(b.x)) + (bfhi(c.x) + bfhi(d.x));
            f[2] = (bflo(a.y) + bflo(b.y)) + (bflo(c.y) + bflo(d.y)); f[3] = (bfhi(a.y) + bfhi(b.y)) + (bfhi(c.y) + bfhi(d.y));
            v[j] = xr[64 * j] * ALPHA + f; s += (v[j][0] + v[j][1]) + (v[j][2] + v[j][3]); }
        const float mean = wave_sum(s) * (1.0f / DM); float s2 = 0.f;
#pragma unroll
        for (int j = 0; j < 8; ++j) { v[j] = v[j] - mean; s2 += (v[j][0] * v[j][0] + v[j][1] * v[j][1]) + (v[j][2] * v[j][2] + v[j][3] * v[j][3]); }
        const float rstd = 1.0f / sqrtf(wave_sum(s2) * (1.0f / DM) + LN_EPS);
        f32x4* o = (f32x4*)(outp + (size_t)t * DM) + F.lane;
#pragma unroll
        for (int j = 0; j < 8; ++j) o[64 * j] = v[j] * rstd * G4[64 * j + F.lane] + B4[64 * j + F.lane];
    }
}

struct Args { const float* in[21]; float* out; unsigned char* ws; int ph_lo, ph_hi; };
__global__ void __launch_bounds__(512, 2) mk_fwd(Args args) {
    extern __shared__ __attribute__((aligned(16))) unsigned char lds[];
    Frame F;
    F.lds = (LAS unsigned char*)lds; F.ldsg = lds;
    F.tid = threadIdx.x; F.lane = F.tid & 63; F.wave = __builtin_amdgcn_readfirstlane(F.tid >> 6); F.G = gridDim.x;
    F.ws = args.ws; F.ctl = (unsigned*)(args.ws + WS_CTL);
    if (F.tid == 0) { LAS unsigned long long* pp = (LAS unsigned long long*)(F.lds + L_PTR);
#pragma unroll
        for (int i = 0; i < 21; ++i) pp[i] = (unsigned long long)args.in[i];
        pp[21] = (unsigned long long)args.out; }
    if (F.tid < 4) ((LAS unsigned*)(F.lds + L_XB))[F.tid] = 0u;
    __syncthreads();
    const int lo = args.ph_lo, hi = args.ph_hi;
    XcdBarrier bar; bar.bar = F.ctl + CW_BAR; bar.x = 0; bar.st = (volatile LAS unsigned*)(F.lds + L_XB);
    if (hi - lo > 1) bar = xcd_barrier_post(F.ctl + CW_BAR, (volatile LAS unsigned*)(F.lds + L_XB));
#ifndef MK_PHASE_MASK
#define MK_PHASE_MASK 0x7ff
#endif
#define IN(k) (((MK_PHASE_MASK >> (k)) & 1) && lo <= (k) && (k) < hi)
#define SEAM(k) do { if (IN(k) && IN((k) + 1)) xcd_barrier(bar); } while (0)
    LAS unsigned char* ring = F.lds + RING_OFF;
    const pg8::bf16_t* XB = (const pg8::bf16_t*)(F.ws + WS_XB);

    if (IN(0)) { p0_prologue(F); }
    SEAM(0);
    if (IN(1)) {
        pg8::Gemm g{XB, (const pg8::bf16_t*)(F.ws + WS_WIN), S_, INW, DM}; pg8::StaticOrder S; S.init(S_, INW, F.G, (int)blockIdx.x);
        pg8::EpiStoreBf16 E{(pg8::bf16_t*)(F.ws + WS_PROJ), INW};
        pg8::gemm_phase<pg8::EpiStoreBf16, pg8::StaticOrder, true, true>(ring, g, S, E);
    }
    SEAM(1);
    if (IN(2)) { p2_prep_dilated(F); }
    SEAM(2);
    if (IN(3)) { p3_attn_combine(F); }
    SEAM(3);
    if (IN(4)) {
        { pg8::Gemm g{(const pg8::bf16_t*)(F.ws + WS_YA), (const pg8::bf16_t*)(F.ws + WS_WA), S_, DM, 512}; pg8::StaticOrder S; S.init(S_, DM, F.G, (int)blockIdx.x);
          pg8::EpiGateA E{(const pg8::bf16_t*)(F.ws + WS_PROJ), INW, GATE_OFF, inp(F, 2), (float*)(F.ws + WS_T1), DM};
          pg8::gemm_phase<pg8::EpiGateA, pg8::StaticOrder, true, true>(ring, g, S, E); }
        { pg8::Gemm g{(const pg8::bf16_t*)(F.ws + WS_YB), (const pg8::bf16_t*)(F.ws + WS_WB), S_, DM, 1024}; pg8::StaticOrder S; S.init(S_, DM, F.G, (int)blockIdx.x);
          pg8::EpiGateB E{(const pg8::bf16_t*)(F.ws + WS_PROJ), INW, GATE_OFF + DM, inp(F, 2) + DM, (const float*)(F.ws + WS_T1), (pg8::bf16_t*)(F.ws + WS_Y), DM};
          pg8::gemm_phase<pg8::EpiGateB, pg8::StaticOrder, true, true>(ring, g, S, E); }
    }
    SEAM(4);
    if (IN(5)) {
        pg8::Gemm g{(const pg8::bf16_t*)(F.ws + WS_Y), (const pg8::bf16_t*)(F.ws + WS_WO), S_, DM, DM}; pg8::StaticOrder S; S.init(S_, DM, F.G, (int)blockIdx.x);
        pg8::EpiResF32 E{inp(F, 0), (float*)(F.ws + WS_T1), DM, ALPHA};
        pg8::gemm_phase<pg8::EpiResF32, pg8::StaticOrder, true, true>(ring, g, S, E);
    }
    SEAM(5);
    if (IN(6)) { p6_ln_router(F); }
    SEAM(6);
    if (IN(7)) { p7_gather(F); }
    SEAM(7);
    if (IN(8)) {
        const int nt = moe_tiles(F);
        pg8::Gemm g{(const pg8::bf16_t*)(F.ws + WS_XS), (const pg8::bf16_t*)(F.ws + WS_WGL), nt * 256, 4096, DM};
        pg8::MoeOrder S; S.init(nt * 256, 4096, F.G, (int)blockIdx.x); S.tile_e = (const LAS int*)(F.lds + L_TILE); S.estride = (size_t)4096 * 2048 * 2;
        pg8::EpiSwiglu E{(const LAS int*)(F.lds + L_TILE), inp(F, 14), inp(F, 16), (pg8::bf16_t*)(F.ws + WS_H), DM};
        pg8::gemm_phase<pg8::EpiSwiglu, pg8::MoeOrder, true, true>(ring, g, S, E);
    }
    SEAM(8);
    if (IN(9)) {
        const int nt = moe_tiles(F);
        pg8::Gemm g{(const pg8::bf16_t*)(F.ws + WS_H), (const pg8::bf16_t*)(F.ws + WS_WD), nt * 256, DM, DM};
        pg8::MoeOrder S; S.init(nt * 256, DM, F.G, (int)blockIdx.x); S.tile_e = (const LAS int*)(F.lds + L_TILE); S.estride = (size_t)2048 * 2048 * 2;
        pg8::EpiDown E{(const LAS int*)(F.lds + L_TILE), inp(F, 18), (const float*)(F.ws + WS_SLOTW), (pg8::bf16_t*)(F.ws + WS_YS), DM};
        pg8::gemm_phase<pg8::EpiDown, pg8::MoeOrder, true, true>(ring, g, S, E);
    }
    SEAM(9);
    if (IN(10)) { p10_final(F); }
#undef IN
#undef SEAM
}

#ifndef MK_CUTS
#define MK_CUTS 0
#endif
extern "C" void kernel_launch(void* const* d_in, const int* in_sizes, int n_in, void* d_out, int out_size, void* d_ws, size_t ws_size, hipStream_t stream) {
    static int grid = 0;
    if (grid == 0) {
        if (n_in != 21 || out_size != S_ * DM || ws_size < WS_END) { fprintf(stderr, "kernel_launch: unexpected shapes (n_in %d out %d ws %zu, need %zu)\n", n_in, out_size, ws_size, (size_t)WS_END); grid = -1; return; }
        int dev = 0, cus = 0, per_cu = 0;
        if (hipGetDevice(&dev) != hipSuccess || hipDeviceGetAttribute(&cus, hipDeviceAttributeMultiprocessorCount, dev) != hipSuccess) { grid = -1; return; }
        if (hipFuncSetAttribute((const void*)mk_fwd, hipFuncAttributeMaxDynamicSharedMemorySize, LDS_BYTES) != hipSuccess) { fprintf(stderr, "kernel_launch: hipFuncSetAttribute failed\n"); grid = -1; return; }
        if (hipOccupancyMaxActiveBlocksPerMultiprocessor(&per_cu, (const void*)mk_fwd, 512, LDS_BYTES) != hipSuccess || per_cu < 1) { fprintf(stderr, "kernel_launch: occupancy query says %d\n", per_cu); per_cu = 1; }
        (void)hipGetLastError();
        grid = cus;
    }
    if (grid < 0) return;
    (void)hipMemsetAsync((char*)d_ws + WS_CTL, 0, CTL_ZERO_BYTES, stream);
    Args a{};
    for (int i = 0; i < 21; ++i) a.in[i] = (const float*)d_in[i];
    a.out = (float*)d_out; a.ws = (unsigned char*)d_ws;
#if MK_CUTS
    for (int p = 0; p < NPH; ++p) { a.ph_lo = p; a.ph_hi = p + 1; hipLaunchKernelGGL(mk_fwd, dim3(grid), dim3(512), LDS_BYTES, stream, a); }
#else
    a.ph_lo = 0; a.ph_hi = NPH; hipLaunchKernelGGL(mk_fwd, dim3(grid), dim3(512), LDS_BYTES, stream, a);
#endif
}
```

```cpp
#include <hip/hip_runtime.h>
#include <hip/hip_bf16.h>
#include <cstdio>
#include <cstdint>
#define MK_CUTS 0
namespace pg8 {
#define PG8_LAS __attribute__((address_space(3)))
typedef unsigned short bf16_t;
typedef short bf16x8 __attribute__((ext_vector_type(8)));
typedef float f32x4 __attribute__((ext_vector_type(4)));
typedef unsigned u32x4 __attribute__((ext_vector_type(4)));
constexpr int BM = 256, BK = 64, HALF = 128, HTB = HALF * BK * 2  , STAGE_BYTES = 8 * HTB, NXCD = 8, WGM = 8;

__host__ __device__ __forceinline__ int lds_byte(int r, int c) { const int st = (r >> 4) * 2 + (c >> 5), rr = r & 15, cc = c & 31, ob = rr * 64 + cc * 2; return st * 1024 + (ob ^ (((ob >> 9) & 1) << 5)); }
__host__ __device__ __forceinline__ void stage_rc(int b, int& R, int& C) { const int st = b / 1024, sb = b % 1024, swz = sb ^ (((sb >> 9) & 1) << 5); R = (st >> 1) * 16 + swz / 64; C = (st & 1) * 32 + (swz % 64) / 2; }
__host__ __device__ __forceinline__ int perm32(int rho) { const int n = rho >> 4, i = rho & 15; return 8 * (i >> 2) + 4 * n + (i & 3); }

struct Unit { int pm, pn; };
struct Gemm { const bf16_t* A; const bf16_t* Bt; int M, N, K; };

struct StaticOrder {
    int nM, nN, nwg, G, c;
    __host__ __device__ void init(int M, int N, int G_, int c_) { nM = M / BM; nN = N / BM; nwg = nM * nN; G = G_; c = c_; }
    __host__ __device__ bool next(int i, Unit& u) const {
        const long L = (long)i * G + c; if (L >= nwg) return false;
        int wgid = (int)L; { const int q = nwg / NXCD, r = nwg % NXCD, xcd = wgid % NXCD, off = wgid / NXCD; wgid = (xcd < r ? xcd * (q + 1) : r * (q + 1) + (xcd - r) * q) + off; }
        const int nig = WGM * nN, gid = wgid / nig, fm = gid * WGM, gsz = (nM - fm) < WGM ? (nM - fm) : WGM;
        u.pm = fm + ((wgid % nig) % gsz); u.pn = (wgid % nig) / gsz; return true;
    }
    __device__ __forceinline__ void a_ready(const Unit&) const {}
    __device__ __forceinline__ size_t b_off(const Unit&) const { return 0; }
    __device__ __forceinline__ void done(const Unit&) const {}
};


typedef unsigned u32x2 __attribute__((ext_vector_type(2)));
__device__ __forceinline__ unsigned cvt_pk_bf16(float lo, float hi) { unsigned r; asm volatile("v_cvt_pk_bf16_f32 %0, %1, %2" : "=v"(r) : "v"(lo), "v"(hi)); return r; }
__device__ __forceinline__ unsigned pk4_fp8_(float a, float b, float c, float d) { int w = __builtin_amdgcn_cvt_pk_fp8_f32(a, b, 0, false); w = __builtin_amdgcn_cvt_pk_fp8_f32(c, d, w, true); return (unsigned)w; }
__device__ __forceinline__ float bf_lo(unsigned w) { return __builtin_bit_cast(float, w << 16); }
__device__ __forceinline__ float bf_hi(unsigned w) { return __builtin_bit_cast(float, w & 0xffff0000u); }
__device__ __forceinline__ float sigmoidf_(float v) { return __builtin_amdgcn_rcpf(1.0f + __expf(-v)); }

struct EpiStoreBf16 {
    static constexpr bool PERM = true, AFTER_DRAIN = false;
    bf16_t* O; int ldc; float sc;
    __device__ __forceinline__ void operator()(const f32x4 (&acc)[2][2][4][2], const Unit& u, int wr, int wc, int fr, int fq) const {
        const int row0 = u.pm * BM + wr * 64 + fr, col0 = u.pn * BM + wc * 32 + 8 * fq;
#pragma unroll
        for (int ai = 0; ai < 2; ++ai)
#pragma unroll
            for (int m = 0; m < 4; ++m) { bf16_t* rowp = O + (size_t)(row0 + ai * HALF + m * 16) * ldc + col0;
#pragma unroll
                for (int bj = 0; bj < 2; ++bj) { const f32x4 v0 = acc[ai][bj][m][0] * sc, v1 = acc[ai][bj][m][1] * sc;
                    u32x4 w; w.x = cvt_pk_bf16(v0[0], v0[1]); w.y = cvt_pk_bf16(v0[2], v0[3]); w.z = cvt_pk_bf16(v1[0], v1[1]); w.w = cvt_pk_bf16(v1[2], v1[3]);
                    *(u32x4*)(rowp + bj * HALF) = w; } }
    }
};

struct EpiGateA {
    static constexpr bool PERM = true, AFTER_DRAIN = false;
    const bf16_t* proj; int ldp; int gcol0; const float* bg; float* T1; int ldc; float sc;
    __device__ __forceinline__ void operator()(const f32x4 (&acc)[2][2][4][2], const Unit& u, int wr, int wc, int fr, int fq) const {
        const int row0 = u.pm * BM + wr * 64 + fr, col0 = u.pn * BM + wc * 32 + 8 * fq;
#pragma unroll
        for (int ai = 0; ai < 2; ++ai)
#pragma unroll
            for (int m = 0; m < 4; ++m) { const int row = row0 + ai * HALF + m * 16;
#pragma unroll
                for (int bj = 0; bj < 2; ++bj) { const int c = col0 + bj * HALF;
                    const u32x4 gw = *(const u32x4*)(proj + (size_t)row * ldp + gcol0 + c);
                    const f32x4 b0 = *(const f32x4*)(bg + c), b1 = *(const f32x4*)(bg + c + 4);
                    f32x4 g0, g1;
                    g0[0] = sigmoidf_(bf_lo(gw.x) + b0[0]); g0[1] = sigmoidf_(bf_hi(gw.x) + b0[1]); g0[2] = sigmoidf_(bf_lo(gw.y) + b0[2]); g0[3] = sigmoidf_(bf_hi(gw.y) + b0[3]);
                    g1[0] = sigmoidf_(bf_lo(gw.z) + b1[0]); g1[1] = sigmoidf_(bf_hi(gw.z) + b1[1]); g1[2] = sigmoidf_(bf_lo(gw.w) + b1[2]); g1[3] = sigmoidf_(bf_hi(gw.w) + b1[3]);
                    float* o = T1 + (size_t)row * ldc + c;
                    *(f32x4*)o = acc[ai][bj][m][0] * sc * g0; *(f32x4*)(o + 4) = acc[ai][bj][m][1] * sc * g1; } }
    }
};
struct EpiGateB {
    static constexpr bool PERM = true, AFTER_DRAIN = false;
    const bf16_t* proj; int ldp; int gcol0; const float* bg; const float* T1; unsigned char* Y; int ldc; float sc;
    __device__ __forceinline__ void operator()(const f32x4 (&acc)[2][2][4][2], const Unit& u, int wr, int wc, int fr, int fq) const {
        const int row0 = u.pm * BM + wr * 64 + fr, col0 = u.pn * BM + wc * 32 + 8 * fq;
#pragma unroll
        for (int ai = 0; ai < 2; ++ai)
#pragma unroll
            for (int m = 0; m < 4; ++m) { const int row = row0 + ai * HALF + m * 16;
#pragma unroll
                for (int bj = 0; bj < 2; ++bj) { const int c = col0 + bj * HALF;
                    const u32x4 gw = *(const u32x4*)(proj + (size_t)row * ldp + gcol0 + c);
                    const f32x4 b0 = *(const f32x4*)(bg + c), b1 = *(const f32x4*)(bg + c + 4);
                    const float* tp = T1 + (size_t)row * ldc + c;
                    const f32x4 t0 = *(const f32x4*)tp, t1 = *(const f32x4*)(tp + 4);
                    f32x4 g0, g1;
                    g0[0] = sigmoidf_(bf_lo(gw.x) + b0[0]); g0[1] = sigmoidf_(bf_hi(gw.x) + b0[1]); g0[2] = sigmoidf_(bf_lo(gw.y) + b0[2]); g0[3] = sigmoidf_(bf_hi(gw.y) + b0[3]);
                    g1[0] = sigmoidf_(bf_lo(gw.z) + b1[0]); g1[1] = sigmoidf_(bf_hi(gw.z) + b1[1]); g1[2] = sigmoidf_(bf_lo(gw.w) + b1[2]); g1[3] = sigmoidf_(bf_hi(gw.w) + b1[3]);
                    const f32x4 v0 = (t0 + acc[ai][bj][m][0] * sc * g0) * 64.0f, v1 = (t1 + acc[ai][bj][m][1] * sc * g1) * 64.0f;
                    u32x2 w; w.x = pk4_fp8_(v0[0], v0[1], v0[2], v0[3]); w.y = pk4_fp8_(v1[0], v1[1], v1[2], v1[3]);
                    *(u32x2*)(Y + (size_t)row * ldc + c) = w; } }
    }
};
struct EpiResF32 {
    static constexpr bool PERM = false, AFTER_DRAIN = false;
    const float* X; float* Z; int ldc; float alpha; float sc;
    __device__ __forceinline__ void operator()(const f32x4 (&acc)[2][2][4][2], const Unit& u, int wr, int wc, int fr, int fq) const {
        const int row0 = u.pm * BM + wr * 64 + fr, col0 = u.pn * BM + wc * 32 + 4 * fq;
#pragma unroll
        for (int ai = 0; ai < 2; ++ai)
#pragma unroll
            for (int m = 0; m < 4; ++m) { const size_t ro = (size_t)(row0 + ai * HALF + m * 16) * ldc + col0;
#pragma unroll
                for (int bj = 0; bj < 2; ++bj)
#pragma unroll
                    for (int n = 0; n < 2; ++n) { const f32x4 xv = *(const f32x4*)(X + ro + bj * HALF + n * 16);
                        *(f32x4*)(Z + ro + bj * HALF + n * 16) = xv * alpha + acc[ai][bj][m][n] * sc; } }
    }
};
struct EpiSwiglu {
    static constexpr bool PERM = true, AFTER_DRAIN = false;
    const PG8_LAS int* tile_e; const float* bgate; const float* blin; unsigned char* H; int ldc; float sc;
    __device__ __forceinline__ void operator()(const f32x4 (&acc)[2][2][4][2], const Unit& u, int wr, int wc, int fr, int fq) const {
        const int e = tile_e[u.pm];
        const int row0 = u.pm * BM + wr * 64 + fr, j0 = u.pn * HALF + wc * 32 + 8 * fq;
        const f32x4 bg0 = *(const f32x4*)(bgate + (size_t)e * 2048 + j0), bg1 = *(const f32x4*)(bgate + (size_t)e * 2048 + j0 + 4);
        const f32x4 bl0 = *(const f32x4*)(blin + (size_t)e * 2048 + j0), bl1 = *(const f32x4*)(blin + (size_t)e * 2048 + j0 + 4);
#pragma unroll
        for (int ai = 0; ai < 2; ++ai)
#pragma unroll
            for (int m = 0; m < 4; ++m) { const int row = row0 + ai * HALF + m * 16;
                f32x4 h0, h1;
#pragma unroll
                for (int i = 0; i < 4; ++i) {
                    float g = fminf(acc[ai][0][m][0][i] * sc + bg0[i], 7.0f); float l = fminf(fmaxf(acc[ai][1][m][0][i] * sc + bl0[i], -7.0f), 7.0f);
                    h0[i] = (l + 1.0f) * (g * sigmoidf_(1.702f * g));
                    g = fminf(acc[ai][0][m][1][i] * sc + bg1[i], 7.0f); l = fminf(fmaxf(acc[ai][1][m][1][i] * sc + bl1[i], -7.0f), 7.0f);
                    h1[i] = (l + 1.0f) * (g * sigmoidf_(1.702f * g)); }
                u32x2 w; w.x = pk4_fp8_(h0[0], h0[1], h0[2], h0[3]); w.y = pk4_fp8_(h1[0], h1[1], h1[2], h1[3]);
                *(u32x2*)(H + (size_t)row * ldc + j0) = w; }
    }
};
struct EpiDown {
    static constexpr bool PERM = true, AFTER_DRAIN = false;
    const PG8_LAS int* tile_e; const float* bdown; const float* slot_w; bf16_t* YS; int ldc; float sc;
    __device__ __forceinline__ void operator()(const f32x4 (&acc)[2][2][4][2], const Unit& u, int wr, int wc, int fr, int fq) const {
        const int e = tile_e[u.pm];
        const int row0 = u.pm * BM + wr * 64 + fr, col0 = u.pn * BM + wc * 32 + 8 * fq;
        f32x4 bv[2][2];
#pragma unroll
        for (int bj = 0; bj < 2; ++bj)
#pragma unroll
            for (int n = 0; n < 2; ++n) bv[bj][n] = *(const f32x4*)(bdown + (size_t)e * 2048 + col0 + bj * HALF + 4 * n);
#pragma unroll
        for (int ai = 0; ai < 2; ++ai)
#pragma unroll
            for (int m = 0; m < 4; ++m) { const int row = row0 + ai * HALF + m * 16; const float sw = slot_w[row];
#pragma unroll
                for (int bj = 0; bj < 2; ++bj) { const f32x4 v0 = (acc[ai][bj][m][0] * sc + bv[bj][0]) * sw, v1 = (acc[ai][bj][m][1] * sc + bv[bj][1]) * sw;
                    u32x4 w; w.x = cvt_pk_bf16(v0[0], v0[1]); w.y = cvt_pk_bf16(v0[2], v0[3]); w.z = cvt_pk_bf16(v1[0], v1[1]); w.w = cvt_pk_bf16(v1[2], v1[3]);
                    *(u32x4*)(YS + (size_t)row * ldc + col0 + bj * HALF) = w; } }
    }
};
struct MoeOrder : StaticOrder {
    const PG8_LAS int* tile_e; size_t estride;
    __device__ __forceinline__ size_t b_off(const Unit& u) const { return (size_t)__builtin_amdgcn_readfirstlane(tile_e[u.pm]) * estride; }
};
typedef int i32x4_ __attribute__((ext_vector_type(4)));
typedef int i32x8_ __attribute__((ext_vector_type(8)));
#define PG8_CAT(lo, hi) __builtin_shufflevector(__builtin_bit_cast(i32x4_, lo), __builtin_bit_cast(i32x4_, hi), 0, 1, 2, 3, 4, 5, 6, 7)
template <class Epi, class Sched, bool ALIGN_EPI = false, bool SP2 = false, bool FP8 = false>
__device__ __forceinline__ void gemm_phase(PG8_LAS unsigned char* lds, const Gemm g, const Sched& S, const Epi& E) {
    const int tid = threadIdx.x, wid = __builtin_amdgcn_readfirstlane(tid >> 6), lane = tid & 63, wr = wid >> 2, wc = wid & 3, fr = lane & 15, fq = lane >> 4;
    const int K = g.K, nt = K / BK;
    unsigned voffA[2], voffB[2];
#pragma unroll
    for (int i = 0; i < 2; ++i) { int R, C; stage_rc(tid * 16 + i * 8192, R, C); const int Rb = Epi::PERM ? ((R & ~31) + perm32(R & 31)) : R;
        voffA[i] = (unsigned)(R * K + C) * 2u; voffB[i] = (unsigned)(Rb * K + C) * 2u; }
    const size_t kstep = (size_t)(BK * 2);
    const size_t hstep = (size_t)HALF * K * 2;
    const size_t tstep = 2 * hstep;
    const unsigned ldsw = (unsigned)wid * 1024u;
    const int aoff = lds_byte(wr * 64 + fr, fq * 8), boff = lds_byte(wc * 32 + fr, fq * 8);
#define PG8_SA(b, h) (((b) * 2 + (h)) * HTB)
#define PG8_SB(b, h) ((4 + (b) * 2 + (h)) * HTB)
#define PG8_STAGE(bufoff, gbase, voff) do { _Pragma("unroll") for (int _i = 0; _i < 2; ++_i) \
        __builtin_amdgcn_global_load_lds((const unsigned*)((const char*)(gbase) + (voff)[_i]), (PG8_LAS unsigned*)(lds + (bufoff) + ldsw + _i * 8192), 16, 0, 0); } while (0)
#define PG8_LDA(dst, b, h) do { _Pragma("unroll") for (int m = 0; m < 4; ++m) _Pragma("unroll") for (int k = 0; k < 2; ++k) dst[m][k] = *(const PG8_LAS bf16x8*)(lds + PG8_SA(b, h) + aoff + m * 2048 + k * 1024); } while (0)
#define PG8_LDB(dst, b, h) do { _Pragma("unroll") for (int n = 0; n < 2; ++n) _Pragma("unroll") for (int k = 0; k < 2; ++k) dst[n][k] = *(const PG8_LAS bf16x8*)(lds + PG8_SB(b, h) + boff + n * 2048 + k * 1024); } while (0)
#define PG8_MFMA8(C, Bv, Av) asm volatile("v_mfma_f32_16x16x128_f8f6f4 %0, %1, %2, %0" : "+v"(C) : "v"(Bv), "v"(Av))
#define PG8_MMA(ai, bj, At, Bt) do { __builtin_amdgcn_s_setprio(1); if constexpr (FP8) { const i32x8_ b0_ = PG8_CAT(Bt[0][0], Bt[0][1]), b1_ = PG8_CAT(Bt[1][0], Bt[1][1]); _Pragma("unroll") for (int m = 0; m < 4; ++m) { \
        const i32x8_ a_ = PG8_CAT(At[m][0], At[m][1]); PG8_MFMA8(acc[ai][bj][m][0], b0_, a_); PG8_MFMA8(acc[ai][bj][m][1], b1_, a_); } } else { \
        _Pragma("unroll") for (int m = 0; m < 4; ++m) _Pragma("unroll") for (int n = 0; n < 2; ++n) _Pragma("unroll") for (int k = 0; k < 2; ++k) \
        acc[ai][bj][m][n] = __builtin_amdgcn_mfma_f32_16x16x32_bf16(Bt[n][k], At[m][k], acc[ai][bj][m][n], 0, 0, 0); } __builtin_amdgcn_s_setprio(0); } while (0)
#define PG8_WAIT_V(n) asm volatile("s_waitcnt vmcnt(" #n ")" ::: "memory")
#define PG8_WAIT_L(n) asm volatile("s_waitcnt lgkmcnt(" #n ")" ::: "memory")
#define PG8_BAR __builtin_amdgcn_s_barrier()
#define PG8_SCHED __builtin_amdgcn_sched_barrier(0)
    Unit cur, nxt; int ui = 0;
    if (!S.next(0, cur)) return;
    f32x4 acc[2][2][4][2];
#pragma unroll
    for (int a = 0; a < 2; ++a)
#pragma unroll
        for (int b = 0; b < 2; ++b)
#pragma unroll
            for (int m = 0; m < 4; ++m)
#pragma unroll
                for (int n = 0; n < 2; ++n) acc[a][b][m][n] = (f32x4){0.f, 0.f, 0.f, 0.f};
    bf16x8 At[4][2], B0[2][2], B1[2][2];
    const char* cA = (const char*)g.A + (size_t)cur.pm * tstep; const char* cB = (const char*)g.Bt + S.b_off(cur) + (size_t)cur.pn * tstep;
    S.a_ready(cur);
    if constexpr (SP2) {
        PG8_STAGE(PG8_SB(0, 0), cB, voffB); PG8_STAGE(PG8_SB(0, 1), cB + hstep, voffB); PG8_STAGE(PG8_SA(0, 0), cA, voffA); PG8_STAGE(PG8_SA(0, 1), cA + hstep, voffA);
        if (wr == 1) PG8_BAR;
        PG8_WAIT_V(2); PG8_BAR;
        PG8_STAGE(PG8_SB(1, 0), cB + kstep, voffB); PG8_STAGE(PG8_SA(1, 0), cA + kstep, voffA); PG8_STAGE(PG8_SB(1, 1), cB + hstep + kstep, voffB);
        PG8_WAIT_V(6); PG8_BAR;
    } else {
        PG8_STAGE(PG8_SB(0, 0), cB, voffB); PG8_STAGE(PG8_SA(0, 0), cA, voffA); PG8_STAGE(PG8_SB(0, 1), cB + hstep, voffB); PG8_STAGE(PG8_SA(0, 1), cA + hstep, voffA);
        if (wr == 1) PG8_BAR;
        PG8_WAIT_V(4); PG8_BAR;
        PG8_STAGE(PG8_SB(1, 0), cB + kstep, voffB); PG8_STAGE(PG8_SA(1, 0), cA + kstep, voffA); PG8_STAGE(PG8_SB(1, 1), cB + hstep + kstep, voffB);
        PG8_WAIT_V(6); PG8_BAR;
    }
    for (;;) {
        const bool has_next = S.next(ui + 1, nxt);
        const char* nA = has_next ? (const char*)g.A + (size_t)nxt.pm * tstep : cA; const char* nB = has_next ? (const char*)g.Bt + S.b_off(nxt) + (size_t)nxt.pn * tstep : cB;
        for (int t = 0; t < nt; t += 2) {
            const bool last = (t == nt - 2);
            const char* a1 = cA + (size_t)(t + 1) * kstep;
            const char* a2 = last ? nA : cA + (size_t)(t + 2) * kstep; const char* b2 = last ? nB : cB + (size_t)(t + 2) * kstep;
            const char* a3 = a2 + kstep; const char* b3 = b2 + kstep;
            if (last && has_next) S.a_ready(nxt);
            if constexpr (SP2) {
            PG8_LDB(B0, 0, 0); PG8_LDB(B1, 0, 1); PG8_SCHED; PG8_LDA(At, 0, 0); PG8_STAGE(PG8_SA(1, 1), a1 + hstep, voffA);
            PG8_WAIT_V(8); PG8_WAIT_L(0); PG8_BAR; PG8_MMA(0, 0, At, B0); PG8_MMA(0, 1, At, B1); PG8_BAR; PG8_SCHED;
            PG8_LDA(At, 0, 1); PG8_STAGE(PG8_SB(0, 0), b2, voffB); PG8_STAGE(PG8_SB(0, 1), b2 + hstep, voffB); PG8_STAGE(PG8_SA(0, 0), a2, voffA);
            PG8_WAIT_V(8); PG8_WAIT_L(0); PG8_BAR; PG8_MMA(1, 0, At, B0); PG8_MMA(1, 1, At, B1); PG8_BAR; PG8_SCHED;
            PG8_LDB(B0, 1, 0); PG8_LDB(B1, 1, 1); PG8_SCHED; PG8_LDA(At, 1, 0); PG8_STAGE(PG8_SA(0, 1), a2 + hstep, voffA);
            PG8_WAIT_V(8); PG8_WAIT_L(0); PG8_BAR; PG8_MMA(0, 0, At, B0); PG8_MMA(0, 1, At, B1); PG8_BAR; PG8_SCHED;
            PG8_LDA(At, 1, 1); PG8_STAGE(PG8_SB(1, 0), b3, voffB); PG8_STAGE(PG8_SB(1, 1), b3 + hstep, voffB); PG8_STAGE(PG8_SA(1, 0), a3, voffA);
            PG8_WAIT_V(8); PG8_WAIT_L(0); PG8_BAR; PG8_MMA(1, 0, At, B0); PG8_MMA(1, 1, At, B1); PG8_BAR; PG8_SCHED;
            } else {
            PG8_LDB(B0, 0, 0); PG8_SCHED; PG8_LDA(At, 0, 0); PG8_STAGE(PG8_SA(1, 1), a1 + hstep, voffA);
            PG8_WAIT_L(8); PG8_BAR; PG8_WAIT_L(0); PG8_MMA(0, 0, At, B0); PG8_BAR; PG8_SCHED;
            PG8_LDB(B1, 0, 1); PG8_STAGE(PG8_SB(0, 0), b2, voffB);
            PG8_BAR; PG8_WAIT_L(0); PG8_MMA(0, 1, At, B1); PG8_BAR;
            PG8_LDA(At, 0, 1); PG8_STAGE(PG8_SA(0, 0), a2, voffA);
            PG8_BAR; PG8_WAIT_L(0); PG8_MMA(1, 0, At, B0); PG8_BAR; PG8_SCHED;
            PG8_STAGE(PG8_SB(0, 1), b2 + hstep, voffB);
            PG8_WAIT_V(6); PG8_BAR; PG8_MMA(1, 1, At, B1); PG8_BAR;
            PG8_LDB(B0, 1, 0); PG8_SCHED; PG8_LDA(At, 1, 0); PG8_STAGE(PG8_SA(0, 1), a2 + hstep, voffA);
            PG8_WAIT_L(8); PG8_BAR; PG8_WAIT_L(0); PG8_MMA(0, 0, At, B0); PG8_BAR; PG8_SCHED;
            PG8_LDB(B1, 1, 1); PG8_STAGE(PG8_SB(1, 0), b3, voffB);
            PG8_BAR; PG8_WAIT_L(0); PG8_MMA(0, 1, At, B1); PG8_BAR;
            PG8_LDA(At, 1, 1); PG8_STAGE(PG8_SA(1, 0), a3, voffA);
            PG8_BAR; PG8_WAIT_L(0); PG8_MMA(1, 0, At, B0); PG8_BAR; PG8_SCHED;
            PG8_STAGE(PG8_SB(1, 1), b3 + hstep, voffB);
            PG8_WAIT_V(6); PG8_BAR; PG8_MMA(1, 1, At, B1); PG8_BAR;
            }
        }
        if constexpr (ALIGN_EPI) { if (wr == 0) PG8_BAR; }
        if constexpr (FP8) { asm volatile("s_nop 15\n\ts_nop 7" ::: "memory"); PG8_SCHED; }
        if constexpr (!Epi::AFTER_DRAIN) { E(acc, cur, wr, wc, fr, fq); S.done(cur); }
        if (!has_next) break;
#pragma unroll
        for (int a = 0; a < 2; ++a)
#pragma unroll
            for (int b = 0; b < 2; ++b)
#pragma unroll
                for (int m = 0; m < 4; ++m)
#pragma unroll
                    for (int n = 0; n < 2; ++n) acc[a][b][m][n] = (f32x4){0.f, 0.f, 0.f, 0.f};
        cur = nxt; cA = nA; cB = nB; ++ui;
        if constexpr (ALIGN_EPI) { if (wr == 1) PG8_BAR; }
    }
    PG8_WAIT_V(0);
    if constexpr (!ALIGN_EPI) { if (wr == 0) PG8_BAR; }
    PG8_BAR;
    if constexpr (Epi::AFTER_DRAIN) { E.fused(acc, cur, wr, wc, fr, fq, lds, wid, lane); S.done(cur); }
#undef PG8_SA
#undef PG8_SB
#undef PG8_STAGE
#undef PG8_LDA
#undef PG8_LDB
#undef PG8_MMA
#undef PG8_WAIT_V
#undef PG8_WAIT_L
#undef PG8_BAR
#undef PG8_SCHED
}
}
namespace at {
using bf16 = __hip_bfloat16;
constexpr int   D = 128, NW = 8, QBLK = 32, KVBLK = 64;
constexpr float SCALE = 0.088388347648318440f;
constexpr float THR = 8.f;
constexpr int SDEPTH = 2;
constexpr size_t SHM_V = KVBLK * D * 2, SHM_K = KVBLK * D * 2, SHM_ATTN = 2 * SHM_V + 2 * SHM_K + NW * 64 * 4;
using bf16x8 = __attribute__((ext_vector_type(8))) short;
using s16x4  = __attribute__((ext_vector_type(4))) short;
using f32x16 = __attribute__((ext_vector_type(16))) float;
using f32x8  = __attribute__((ext_vector_type(8))) float;
using u32x4  = __attribute__((ext_vector_type(4))) unsigned;
#define KSWZ(row, colB) ((row) * 256 + ((colB) ^ (((row) & 7) << 4)))
#define SBAR() __builtin_amdgcn_sched_barrier(0)
__device__ __forceinline__ int crow(int r, int hi) { return (r & 3) + 8 * (r >> 2) + 4 * hi; }
__device__ __forceinline__ unsigned cvtpk(float lo, float hi) {
  unsigned r; asm volatile("v_cvt_pk_bf16_f32 %0, %1, %2" : "=v"(r) : "v"(lo), "v"(hi)); return r;
}
template <typename TIn> struct Stage;
template <> struct Stage<bf16>  { using T = bf16x8;
  __device__ static __forceinline__ T ld8(const bf16* p) { return *reinterpret_cast<const bf16x8*>(p); }
  __device__ static __forceinline__ bf16x8 tobf(T x) { return x; } };
template <> struct Stage<float> { using T = f32x8;
  __device__ static __forceinline__ T ld8(const float* p) { return *reinterpret_cast<const f32x8*>(p); }
  __device__ static __forceinline__ bf16x8 tobf(T x) {
    u32x4 w = {cvtpk(x[0], x[1]), cvtpk(x[2], x[3]), cvtpk(x[4], x[5]), cvtpk(x[6], x[7])}; return *reinterpret_cast<bf16x8*>(&w); } };

__device__ __forceinline__ void partialSM(f32x16& p0, f32x16& p1, float& m_reg, float& mn, float& alpha) {
  constexpr float C = SCALE * 1.4426950408889634f;
  float pmax = p0[0]; for (int r = 1; r < 16; ++r) pmax = fmaxf(pmax, p0[r]); for (int r = 0; r < 16; ++r) pmax = fmaxf(pmax, p1[r]);
  { auto rr = __builtin_amdgcn_permlane32_swap(__float_as_uint(pmax), __float_as_uint(pmax), false, false);
    pmax = fmaxf(__uint_as_float(rr[0]), __uint_as_float(rr[1])); }
  if (__builtin_expect(__all(pmax - m_reg <= THR / SCALE), 1)) { mn = m_reg; alpha = 1.f; }
  else { mn = fmaxf(m_reg, pmax); alpha = __builtin_amdgcn_exp2f((m_reg - mn) * C); m_reg = mn; }
  float mnC = -mn * C;
  for (int r = 0; r < 16; ++r) p0[r] = fmaf(p0[r], C, mnC); for (int r = 0; r < 16; ++r) p1[r] = fmaf(p1[r], C, mnC);
  for (int r = 0; r < 16; ++r) p0[r] = __builtin_amdgcn_exp2f(p0[r]);
}
__device__ __forceinline__ void finishSM(f32x16& p0, f32x16& p1, float alpha, float& l_reg, bf16x8& pa0, bf16x8& pa1, bf16x8& pa2, bf16x8& pa3) {
  for (int r = 0; r < 16; ++r) p1[r] = __builtin_amdgcn_exp2f(p1[r]);
  float ps = 0; for (int r = 0; r < 16; ++r) ps += p0[r]; for (int r = 0; r < 16; ++r) ps += p1[r];
  { auto rr = __builtin_amdgcn_permlane32_swap(__float_as_uint(ps), __float_as_uint(ps), false, false);
    ps = __uint_as_float(rr[0]) + __uint_as_float(rr[1]); }
  l_reg = l_reg * alpha + ps;
#define PK4(P, BASE, OUT) do { unsigned a0 = cvtpk(P[BASE + 0], P[BASE + 1]), a1 = cvtpk(P[BASE + 2], P[BASE + 3]);   \
    unsigned b0 = cvtpk(P[BASE + 4], P[BASE + 5]), b1 = cvtpk(P[BASE + 6], P[BASE + 7]);                              \
    auto r0 = __builtin_amdgcn_permlane32_swap(a0, b0, false, false); auto r1 = __builtin_amdgcn_permlane32_swap(a1, b1, false, false); \
    u32x4 w = {r0[0], r1[0], r0[1], r1[1]}; OUT = *reinterpret_cast<bf16x8*>(&w); } while (0)
  PK4(p0, 0, pa0); PK4(p0, 8, pa1); PK4(p1, 0, pa2); PK4(p1, 8, pa3);
#undef PK4
}
__device__ __forceinline__ void qkt(f32x16& p0, f32x16& p1, const bf16* Ks, const bf16x8* qr, int r32, int hi) {
  p0 = f32x16{}; p1 = f32x16{};
  for (int d0 = 0; d0 < 8; ++d0) { int cb = (d0 * 16 + hi * 8) * 2;
    bf16x8 b0 = *reinterpret_cast<const bf16x8*>((const char*)Ks + KSWZ(r32, cb));
    bf16x8 b1 = *reinterpret_cast<const bf16x8*>((const char*)Ks + KSWZ(32 + r32, cb));
    p0 = __builtin_amdgcn_mfma_f32_32x32x16_bf16(b0, qr[d0], p0, 0, 0, 0);
    p1 = __builtin_amdgcn_mfma_f32_32x32x16_bf16(b1, qr[d0], p1, 0, 0, 0); }
}
__device__ __forceinline__ int v_st(int k, int c) { const int kk = (k & ~0xC) | ((k & 4) << 1) | ((k & 8) >> 1); return ((kk >> 3) * 4 + (c >> 5)) * 512 + ((kk & 7) * 32 + (c & 31)) * 2; }
__device__ __forceinline__ int v_rd_base(int lane) { return ((lane & 3) << 3) | (((lane >> 2) & 3) << 6) | (((lane >> 4) & 1) << 5) | (((lane >> 5) & 1) << 8); }
constexpr int v_rd_off(int d0, int ks, int half) { return d0 * 512 + ks * 4096 + half * 2048; }
template <int OFF> __device__ __forceinline__ s16x4 tr_read(int vb) {
  s16x4 r; asm volatile("ds_read_b64_tr_b16 %0, %1 offset:%2" : "=&v"(r) : "v"(vb), "i"(OFF) : "memory"); return r;
}
template <int D0> __device__ __forceinline__ void pv_one(f32x16& od, int vb, bf16x8 pa0, bf16x8 pa1, bf16x8 pa2, bf16x8 pa3) {
  const s16x4 l0 = tr_read<v_rd_off(D0, 0, 0)>(vb), h0 = tr_read<v_rd_off(D0, 0, 1)>(vb), l1 = tr_read<v_rd_off(D0, 1, 0)>(vb), h1 = tr_read<v_rd_off(D0, 1, 1)>(vb);
  const s16x4 l2 = tr_read<v_rd_off(D0, 2, 0)>(vb), h2 = tr_read<v_rd_off(D0, 2, 1)>(vb), l3 = tr_read<v_rd_off(D0, 3, 0)>(vb), h3 = tr_read<v_rd_off(D0, 3, 1)>(vb);
  asm volatile("s_waitcnt lgkmcnt(0)" ::: "memory"); SBAR();
#define PK(L, H) (bf16x8){L[0], L[1], L[2], L[3], H[0], H[1], H[2], H[3]}
  od = __builtin_amdgcn_mfma_f32_32x32x16_bf16(pa0, PK(l0, h0), od, 0, 0, 0);
  od = __builtin_amdgcn_mfma_f32_32x32x16_bf16(pa1, PK(l1, h1), od, 0, 0, 0);
  od = __builtin_amdgcn_mfma_f32_32x32x16_bf16(pa2, PK(l2, h2), od, 0, 0, 0);
  od = __builtin_amdgcn_mfma_f32_32x32x16_bf16(pa3, PK(l3, h3), od, 0, 0, 0);
#undef PK
}
__device__ __forceinline__ void pv_d0(f32x16* o, int vb, bf16x8 pa0, bf16x8 pa1, bf16x8 pa2, bf16x8 pa3) {
  pv_one<0>(o[0], vb, pa0, pa1, pa2, pa3); pv_one<1>(o[1], vb, pa0, pa1, pa2, pa3); pv_one<2>(o[2], vb, pa0, pa1, pa2, pa3); pv_one<3>(o[3], vb, pa0, pa1, pa2, pa3);
}

template <int LDQ, int LDK, int LDV, int LDO>
__device__ __forceinline__ void attn_dense_body(const bf16* __restrict__ Qb, const bf16* __restrict__ Kh, const bf16* __restrict__ Vh,
                                                unsigned char* __restrict__ Ob, int seq, char* lds) {
  using St = Stage<bf16>; using SQ = Stage<bf16>;
  const int tid = threadIdx.x, wid = tid >> 6, lane = tid & 63, r32 = lane & 31, hi = lane >> 5;
  bf16* V_lds = (bf16*)lds; bf16* K_lds = (bf16*)(lds + 2 * SHM_V);
  float* ws = (float*)(lds + 2 * SHM_V + 2 * SHM_K) + wid * 64; float* li_l = ws; float* al_l = ws + 32;
  float m_reg = -1e30f, l_reg = 0; f32x16 o[4] = {}; bf16x8 qr[8];
  const bf16* Qw = Qb + (long)(wid * QBLK + r32) * LDQ + hi * 8;
#pragma unroll
  for (int d0 = 0; d0 < 8; ++d0) qr[d0] = SQ::tobf(SQ::ld8(Qw + d0 * 16));
  const int sr = tid >> 4, sc = (tid & 15) * 8, vst0 = v_st(sr, sc), vst1 = v_st(32 + sr, sc);
  const int vb0 = (int)(uintptr_t)V_lds + v_rd_base(lane);
  struct { typename St::T vs0, vs1, ks0, ks1; } sr_[SDEPTH];
#define SLOAD(i, k0) do { sr_[i].vs0 = St::ld8(&Vh[(long)((k0) + sr) * LDV + sc]); sr_[i].vs1 = St::ld8(&Vh[(long)((k0) + 32 + sr) * LDV + sc]); \
    sr_[i].ks0 = St::ld8(&Kh[(long)((k0) + sr) * LDK + sc]); sr_[i].ks1 = St::ld8(&Kh[(long)((k0) + 32 + sr) * LDK + sc]); } while (0)
#define SWRITE(b, i) do { *(bf16x8*)((char*)V_lds + (b) * SHM_V + vst0) = St::tobf(sr_[i].vs0);          \
    *(bf16x8*)((char*)V_lds + (b) * SHM_V + vst1) = St::tobf(sr_[i].vs1); int kc = sc * 2;               \
    *(bf16x8*)((char*)K_lds + (b) * SHM_K + KSWZ(sr, kc)) = St::tobf(sr_[i].ks0);                       \
    *(bf16x8*)((char*)K_lds + (b) * SHM_K + KSWZ(32 + sr, kc)) = St::tobf(sr_[i].ks1); } while (0)
#define SWAIT() do { if constexpr (SDEPTH == 2) asm volatile("s_waitcnt vmcnt(4)" ::: "memory"); else asm volatile("s_waitcnt vmcnt(0)" ::: "memory"); } while (0)
#define RESC(a) do { if (__any((a) < 1.f)) { if (hi == 0) al_l[r32] = (a); asm volatile("s_waitcnt lgkmcnt(0)" ::: "memory"); \
    for (int d = 0; d < 4; ++d) for (int r = 0; r < 16; ++r) o[d][r] *= al_l[crow(r, hi)]; } } while (0)
  f32x16 pA0, pA1, pB0, pB1; float mnA, mnB, alA, alB; bf16x8 pa0, pa1, pa2, pa3; const int NT = seq / KVBLK;
  constexpr int SE = 0, SO = SDEPTH - 1;
  SLOAD(SE, 0); asm volatile("s_waitcnt vmcnt(0)" ::: "memory"); SWRITE(0, SE); __syncthreads();
  qkt(pA0, pA1, K_lds, qr, r32, hi); partialSM(pA0, pA1, m_reg, mnA, alA);
  SLOAD(SO, KVBLK); if constexpr (SDEPTH == 2) { if (2 < NT) SLOAD(SE, 2 * KVBLK); }
  SWAIT(); SWRITE(1, SO); __syncthreads();
  for (int j = 1; j + 1 < NT; j += 2) {
    SBAR(); qkt(pB0, pB1, (bf16*)((char*)K_lds + SHM_K), qr, r32, hi);
    finishSM(pA0, pA1, alA, l_reg, pa0, pa1, pa2, pa3); SBAR();
    SLOAD(SO, (j + SDEPTH) * KVBLK); SBAR();
    pv_d0(o, vb0, pa0, pa1, pa2, pa3); partialSM(pB0, pB1, m_reg, mnB, alB);
    __syncthreads(); SWAIT(); SWRITE(0, SE);
    RESC(alB); __syncthreads();
    SBAR(); qkt(pA0, pA1, K_lds, qr, r32, hi);
    finishSM(pB0, pB1, alB, l_reg, pa0, pa1, pa2, pa3); SBAR();
    if (SDEPTH == 1 || j + 3 < NT) SLOAD(SE, (j + 1 + SDEPTH) * KVBLK); SBAR();
    pv_d0(o, vb0 + (int)SHM_V, pa0, pa1, pa2, pa3); partialSM(pA0, pA1, m_reg, mnA, alA);
    __syncthreads(); SWAIT(); SWRITE(1, SO);
    RESC(alA); __syncthreads();
  }
  SBAR(); qkt(pB0, pB1, (bf16*)((char*)K_lds + SHM_K), qr, r32, hi);
  finishSM(pA0, pA1, alA, l_reg, pa0, pa1, pa2, pa3); SBAR();
  pv_d0(o, vb0, pa0, pa1, pa2, pa3); partialSM(pB0, pB1, m_reg, mnB, alB);
  __syncthreads(); RESC(alB);
  finishSM(pB0, pB1, alB, l_reg, pa0, pa1, pa2, pa3); SBAR();
  pv_d0(o, vb0 + (int)SHM_V, pa0, pa1, pa2, pa3);
  if (hi == 0) li_l[r32] = l_reg; asm volatile("s_waitcnt lgkmcnt(0)" ::: "memory");
  float rli[16];
#pragma unroll
  for (int r = 0; r < 16; ++r) rli[r] = __builtin_amdgcn_rcpf(li_l[crow(r, hi)]);
  unsigned char* Ow = Ob + (long)(wid * QBLK) * LDO;
#pragma unroll
  for (int r = 0; r < 16; ++r) { int orow = crow(r, hi);
    for (int d0 = 0; d0 < 4; ++d0) Ow[(long)orow * LDO + d0 * 32 + r32] = (unsigned char)(__builtin_amdgcn_cvt_pk_fp8_f32(o[d0][r] * rli[r] * 64.0f, 0.f, 0, false) & 0xff); }
#undef SLOAD
#undef SWRITE
#undef SWAIT
#undef RESC
}


__device__ __forceinline__ void dilated_unit(const bf16* __restrict__ proj, const float* __restrict__ lutg, bf16* __restrict__ outg, float* __restrict__ lseg,
                                             int d, int hd12, int hh, int r, int i0, char* lds) {
  constexpr int LDP = 10240;
  constexpr float L2E = 1.4426950408889634f, C = SCALE * L2E;
  const int tid = threadIdx.x, wid = tid >> 6, lane = tid & 63, r32 = lane & 31, hi = lane >> 5;
  const int n = 8192 / d;
  char* KV = lds;
  float* lutx = (float*)(lds + 98304);
  float* wsx = (float*)(lds + 98304 + 2048) + wid * 64;
  const int qoff = hd12 * 128, koff = 1536 + hd12 * 128;
  if (tid < 320) { const int o = tid - 96; lutx[tid] = (o >= 0 && o <= 128) ? lutg[o] * L2E : -1e30f; }
  const int iq = i0 + wid * 32 + r32;
  const int sr = tid >> 4, sc = (tid & 15) * 8;
  f32x16 s00, s01, s10, s11, s20, s21;
  const int a = wid >> 1;
  {
    const bf16* Qw = proj + (size_t)(r + iq * d) * LDP + qoff + hi * 8;
    bf16x8 qr[8];
#pragma unroll
    for (int d0 = 0; d0 < 8; ++d0) qr[d0] = *reinterpret_cast<const bf16x8*>(Qw + d0 * 16);
#pragma unroll
    for (int ib = 0; ib < 12; ib += 6) {
      bf16x8 kv6[6];
#pragma unroll
      for (int i = 0; i < 6; ++i) { const int row = sr + 32 * (ib + i); int j = i0 - 64 + row; j = j < 0 ? 0 : (j >= n ? n - 1 : j);
        kv6[i] = *reinterpret_cast<const bf16x8*>(proj + (size_t)(r + j * d) * LDP + koff + sc); }
#pragma unroll
      for (int i = 0; i < 6; ++i) { const int row = sr + 32 * (ib + i);
        *reinterpret_cast<bf16x8*>(KV + (row >> 6) * 16384 + KSWZ(row & 63, sc * 2)) = kv6[i]; }
      SBAR();
    }
    __syncthreads();
    qkt(s00, s01, (const bf16*)(KV + (a + 0) * 16384), qr, r32, hi);
    qkt(s10, s11, (const bf16*)(KV + (a + 1) * 16384), qr, r32, hi);
    qkt(s20, s21, (const bf16*)(KV + (a + 2) * 16384), qr, r32, hi);
  }
  __syncthreads();
  SBAR();
  const int base = -32 * (wid & 1) - 64 - r32 + 4 * hi;
  const float* lp = lutx + (base + 160);
  float mx = -1e30f;
#define DIL_LOGITS(S, TT, HALF) _Pragma("unroll") for (int rr = 0; rr < 16; ++rr) { const float v = fmaf(S[rr], C, lp[64 * TT + 32 * HALF + (rr & 3) + 8 * (rr >> 2)]); S[rr] = v; }
  DIL_LOGITS(s00, 0, 0) DIL_LOGITS(s01, 0, 1) DIL_LOGITS(s10, 1, 0) DIL_LOGITS(s11, 1, 1) DIL_LOGITS(s20, 2, 0) DIL_LOGITS(s21, 2, 1)
#undef DIL_LOGITS
  if (i0 == 0 || i0 + 320 > n) {
    const int lo = -iq - base, hi_ = n - 1 - iq - base;
#define DIL_MASK(S, TT, HALF) _Pragma("unroll") for (int rr = 0; rr < 16; ++rr) { const int c = 64 * TT + 32 * HALF + (rr & 3) + 8 * (rr >> 2); S[rr] = (c >= lo && c <= hi_) ? S[rr] : -1e30f; }
    DIL_MASK(s00, 0, 0) DIL_MASK(s01, 0, 1) DIL_MASK(s10, 1, 0) DIL_MASK(s11, 1, 1) DIL_MASK(s20, 2, 0) DIL_MASK(s21, 2, 1)
#undef DIL_MASK
  }
#define DIL_MAX(S) _Pragma("unroll") for (int rr = 0; rr < 16; ++rr) mx = fmaxf(mx, S[rr]);
  DIL_MAX(s00) DIL_MAX(s01) DIL_MAX(s10) DIL_MAX(s11) DIL_MAX(s20) DIL_MAX(s21)
#undef DIL_MAX
  { auto rr = __builtin_amdgcn_permlane32_swap(__float_as_uint(mx), __float_as_uint(mx), false, false);
    mx = fmaxf(__uint_as_float(rr[0]), __uint_as_float(rr[1])); }
  float ps = 0.f;
#define DIL_EXP(S) _Pragma("unroll") for (int rr = 0; rr < 16; ++rr) { const float p = __builtin_amdgcn_exp2f(S[rr] - mx); S[rr] = p; ps += p; }
  DIL_EXP(s00) DIL_EXP(s01) DIL_EXP(s10) DIL_EXP(s11) DIL_EXP(s20) DIL_EXP(s21)
#undef DIL_EXP
  { auto rr = __builtin_amdgcn_permlane32_swap(__float_as_uint(ps), __float_as_uint(ps), false, false);
    ps = __uint_as_float(rr[0]) + __uint_as_float(rr[1]); }
  bf16x8 pa[12];
#define PK4(P, BASE, OUT) do { unsigned a0 = cvtpk(P[BASE + 0], P[BASE + 1]), a1 = cvtpk(P[BASE + 2], P[BASE + 3]);   \
    unsigned b0 = cvtpk(P[BASE + 4], P[BASE + 5]), b1 = cvtpk(P[BASE + 6], P[BASE + 7]);                              \
    auto r0 = __builtin_amdgcn_permlane32_swap(a0, b0, false, false); auto r1 = __builtin_amdgcn_permlane32_swap(a1, b1, false, false); \
    u32x4 w = {r0[0], r1[0], r0[1], r1[1]}; OUT = *reinterpret_cast<bf16x8*>(&w); } while (0)
  PK4(s00, 0, pa[0]); PK4(s00, 8, pa[1]); PK4(s01, 0, pa[2]); PK4(s01, 8, pa[3]);
  PK4(s10, 0, pa[4]); PK4(s10, 8, pa[5]); PK4(s11, 0, pa[6]); PK4(s11, 8, pa[7]);
  PK4(s20, 0, pa[8]); PK4(s20, 8, pa[9]); PK4(s21, 0, pa[10]); PK4(s21, 8, pa[11]);
#undef PK4
  SBAR();
#pragma unroll
  for (int ib = 0; ib < 12; ib += 6) {
    bf16x8 kv6[6];
#pragma unroll
    for (int i = 0; i < 6; ++i) { const int row = sr + 32 * (ib + i); int j = i0 - 64 + row; j = j < 0 ? 0 : (j >= n ? n - 1 : j);
      kv6[i] = *reinterpret_cast<const bf16x8*>(proj + (size_t)(r + j * d) * LDP + koff + 1536 + sc); }
#pragma unroll
    for (int i = 0; i < 6; ++i) { const int row = sr + 32 * (ib + i);
      *reinterpret_cast<bf16x8*>(KV + (row >> 6) * 16384 + v_st(row & 63, sc)) = kv6[i]; }
    SBAR();
  }
  if (hi == 0) wsx[r32] = ps;
  __syncthreads();
  f32x16 o[4] = {};
  const int vb = (int)(uintptr_t)KV + v_rd_base(lane);
  pv_d0(o, vb + (a + 0) * 16384, pa[0], pa[1], pa[2], pa[3]);
  pv_d0(o, vb + (a + 1) * 16384, pa[4], pa[5], pa[6], pa[7]);
  pv_d0(o, vb + (a + 2) * 16384, pa[8], pa[9], pa[10], pa[11]);
  float rli[16];
#pragma unroll
  for (int rr = 0; rr < 16; ++rr) rli[rr] = __builtin_amdgcn_rcpf(wsx[crow(rr, hi)]);
#pragma unroll
  for (int rr = 0; rr < 16; ++rr) { const int ir = i0 + wid * 32 + crow(rr, hi); bf16* orow = outg + (size_t)(r + ir * d) * 512 + hh * 128 + r32;
#pragma unroll
    for (int d0 = 0; d0 < 4; ++d0) orow[d0 * 32] = __float2bfloat16(o[d0][rr] * rli[rr]); }
  if (hi == 0) lseg[(size_t)(r + iq * d) * 4 + hh] = (mx + __builtin_amdgcn_logf(ps)) * 0.6931471805599453f;
  __syncthreads();
}
}

#define GAS __attribute__((address_space(1)))
#define LAS __attribute__((address_space(3)))
typedef unsigned short bf16;
typedef unsigned v4u __attribute__((ext_vector_type(4)));
typedef unsigned v2u __attribute__((ext_vector_type(2)));
typedef float f32x4 __attribute__((ext_vector_type(4)));
#define LDS_WAIT() asm volatile("s_waitcnt lgkmcnt(0)" ::: "memory")
#define VM_WAIT() asm volatile("s_waitcnt vmcnt(0)" ::: "memory")
__device__ __forceinline__ unsigned pk2(float lo, float hi) { return pg8::cvt_pk_bf16(lo, hi); }
__device__ __forceinline__ float bflo(unsigned w) { return __builtin_bit_cast(float, w << 16); }
__device__ __forceinline__ float bfhi(unsigned w) { return __builtin_bit_cast(float, w & 0xffff0000u); }
#ifndef MK_Q8
#define MK_Q8 0
#endif
__device__ __forceinline__ unsigned pk4_fp8(float a, float b, float c, float d) {
    int w = __builtin_amdgcn_cvt_pk_fp8_f32(a, b, 0, false); w = __builtin_amdgcn_cvt_pk_fp8_f32(c, d, w, true); return (unsigned)w; }
__device__ __forceinline__ float q8f(float v) { const int p = __builtin_amdgcn_cvt_pk_fp8_f32(v, v, 0, false); return __builtin_amdgcn_cvt_f32_fp8(p, 0); }
__device__ __forceinline__ float bf2f(bf16 b) { return __builtin_bit_cast(float, ((unsigned)b) << 16); }

#define XB_TMO      128
#define XB_XCNT(j)  (256  + 64 * (j))
#define XB_XSUB(j)  (1280 + 64 * (j))
#define XB_XGEN(j)  (2304 + 64 * (j))
#define XB_TOP      3328
#define XB_TOPGEN   3392
#define XCD_BAR_WORDS 3456
#define XB_SPIN_CAP (1u << 18)

__device__ __forceinline__ unsigned xb_ld(unsigned* p)              { return __hip_atomic_load(p, __ATOMIC_RELAXED, __HIP_MEMORY_SCOPE_AGENT); }
__device__ __forceinline__ unsigned xb_add(unsigned* p, unsigned v) { return __hip_atomic_fetch_add(p, v, __ATOMIC_RELAXED, __HIP_MEMORY_SCOPE_AGENT); }
__device__ __forceinline__ unsigned xb_xcc_id() { return (unsigned)__builtin_amdgcn_s_getreg((3 << 11) | 20) & 0xFu; }
#define XB_SPIN(cond, bar) do { unsigned _sp = 0; while (cond) { __builtin_amdgcn_s_sleep(1); \
    if ((++_sp & 255u) == 0u) { if (xb_ld(&(bar)[XB_TMO])) break; if (_sp > XB_SPIN_CAP) { atomicAdd(&(bar)[XB_TMO], 1u); break; } } } } while (0)

struct XcdBarrier {
    unsigned* bar; unsigned x;
    volatile LAS unsigned* st;
};

__device__ __forceinline__ XcdBarrier xcd_barrier_post(unsigned* bar, volatile LAS unsigned* st) {
    XcdBarrier b; b.bar = bar; b.x = xb_xcc_id(); b.st = st;
    if (threadIdx.x == 0) (void)xb_add(&bar[XB_XCNT(b.x)], 1u);
    return b;
}
__device__ __forceinline__ void xcd_barrier_complete(unsigned* bar, unsigned x, unsigned& nloc, unsigned& nx) {
    const unsigned G = gridDim.x * gridDim.y * gridDim.z;
    unsigned sum, cnt, mine, sp = 0u;
    for (;;) {
        sum = 0u; cnt = 0u; mine = 0u;
#pragma unroll
        for (unsigned j = 0; j < 16; ++j) { const unsigned c = xb_ld(&bar[XB_XCNT(j)]); sum += c; cnt += (c > 0u) ? 1u : 0u; mine = (j == x) ? c : mine; }
        if (sum == G) break;
        __builtin_amdgcn_s_sleep(1);
        if ((++sp & 255u) == 0u) { if (xb_ld(&bar[XB_TMO])) break; if (sp > XB_SPIN_CAP) { atomicAdd(&bar[XB_TMO], 1u); break; } }
    }
    nloc = mine > 0u ? mine : 1u; nx = cnt > 0u ? cnt : 1u;
}

__device__ __forceinline__ void xcd_barrier(const XcdBarrier& b) {
    asm volatile("s_waitcnt vmcnt(0)" ::: "memory");
    __syncthreads();
    if (threadIdx.x == 0) {
        unsigned* bar = b.bar;
        __builtin_amdgcn_s_waitcnt(0);
        unsigned nloc = b.st[0], nx = b.st[1];
        if (nloc == 0u) { xcd_barrier_complete(bar, b.x, nloc, nx); b.st[0] = nloc; b.st[1] = nx; }
        const unsigned old = xb_add(&bar[XB_XSUB(b.x)], 1u);
        const unsigned gen = old / nloc;
        if (old + 1u == (gen + 1u) * nloc) {
            __builtin_amdgcn_fence(__ATOMIC_RELEASE, "agent");
            asm volatile("s_waitcnt vmcnt(0)" ::: "memory");
            const unsigned og = xb_add(&bar[XB_TOP], 1u);
            const unsigned tg = og / nx;
            if (og + 1u == (tg + 1u) * nx) xb_add(&bar[XB_TOPGEN], 1u);
            else XB_SPIN(xb_ld(&bar[XB_TOPGEN]) == tg, bar);
            __builtin_amdgcn_fence(__ATOMIC_ACQUIRE, "agent");
            xb_add(&bar[XB_XGEN(b.x)], 1u);
            asm volatile("s_waitcnt vmcnt(0)" ::: "memory");
        } else {
            XB_SPIN(xb_ld(&bar[XB_XGEN(b.x)]) == gen, bar);
            __builtin_amdgcn_fence(__ATOMIC_ACQUIRE, "agent");
            asm volatile("s_waitcnt vmcnt(0)" ::: "memory");
        }
    }
    __syncthreads();
}

constexpr int S_ = 8192, DM = 2048, INW = 10240, NE = 32, TOPK = 4;
constexpr int A_W = 1536, A_V_OFF = 3072, B_Q_OFF = 4608, B_K_OFF = 5632, B_V_OFF = 5888, GATE_OFF = 6144;
constexpr int MAXSLOT = 40960;
constexpr float LN_EPS = 1e-5f, QK_EPS = 1e-6f;
constexpr float ALPHA = 1.189207115002721f;
constexpr int NPH = 11;

constexpr size_t MiB = 1u << 20;
constexpr size_t WS_CTL = 0, CTL_ZERO_BYTES = 64 * 1024;
constexpr int CW_BAR = 0;
constexpr int CW_CNT = 4096;
constexpr size_t WS_LUT = 1 * MiB;
constexpr size_t WS_ROPE = 1 * MiB + 8192;
constexpr size_t WS_WRT = 1 * MiB + 65536;
constexpr size_t WS_TOKE = 1 * MiB + 65536 + 262144;
constexpr size_t WS_TOKR = WS_TOKE + 131072;
constexpr size_t WS_TOKW = WS_TOKR + 131072;
constexpr size_t WS_TOKS = WS_TOKW + 131072;
constexpr size_t WS_SLOTW = WS_TOKS + 131072;
constexpr size_t WS_LSE = 3 * MiB;
constexpr size_t WS_XB = 4 * MiB;
constexpr size_t WS_WIN = WS_XB + 32 * MiB;
constexpr size_t WS_WA = WS_WIN + 40 * MiB;
constexpr size_t WS_WB = WS_WA + 2 * MiB;
constexpr size_t WS_WO = WS_WB + 4 * MiB;
constexpr size_t WS_WGL = WS_WO + 8 * MiB;
constexpr size_t WS_WD = WS_WGL + 512 * MiB;
constexpr size_t WS_PROJ = WS_WD + 256 * MiB;
constexpr size_t WS_QBR = WS_PROJ + 160 * MiB;
constexpr size_t WS_KBR = WS_QBR + 16 * MiB;
constexpr size_t WS_VBR = WS_KBR + 4 * MiB;
constexpr size_t WS_OUTA = WS_VBR + 4 * MiB;
constexpr size_t WS_YA = WS_OUTA + 24 * MiB;
constexpr size_t WS_YB = WS_YA + 8 * MiB;
constexpr size_t WS_T1 = WS_YB + 16 * MiB;
constexpr size_t WS_Y = WS_T1 + 64 * MiB;
constexpr size_t WS_X1 = WS_Y + 32 * MiB;
constexpr size_t WS_X1B = WS_X1 + 64 * MiB;
constexpr size_t WS_XS = WS_X1B + 32 * MiB;
constexpr size_t WS_H = WS_XS + 160 * MiB;
constexpr size_t WS_YS = WS_PROJ;
constexpr size_t WS_END = WS_H + 160 * MiB;

constexpr int RING_OFF = 0, RING_BYTES = 131072;
constexpr int L_XB = RING_BYTES;
constexpr int L_TILE = RING_BYTES + 64;
constexpr int L_PST = RING_BYTES + 1024;
constexpr int L_CNT = RING_BYTES + 1280;
constexpr int L_ASG = RING_BYTES + 2048;
constexpr int L_PTR = RING_BYTES + 3584;
constexpr int LDS_BYTES = 147456;

struct Frame {
    LAS unsigned char* lds; unsigned char* ldsg;
    unsigned char* ws; unsigned* ctl;
    int tid, lane, wave, G;
};
__device__ __forceinline__ const float* inp(const Frame& F, int i) {
    const LAS unsigned* p = (const LAS unsigned*)(F.lds + L_PTR) + 2 * i;
    const unsigned lo = __builtin_amdgcn_readfirstlane(p[0]), hi = __builtin_amdgcn_readfirstlane(p[1]);
    return (const float*)(((unsigned long long)hi << 32) | lo);
}
__device__ __forceinline__ float wave_sum(float v) {
#pragma unroll
    for (int o = 1; o < 64; o <<= 1) v += __shfl_xor(v, o);
    return v;
}

__device__ __forceinline__ void transpose_item(const float* __restrict__ W, int N, int k0, int n0, bf16* WT, int ldo, int orow0, int ocol0, LAS float* scr, int lane, const bool q8 = false) {
    f32x4 v[8];
#pragma unroll
    for (int i = 0; i < 8; ++i) v[i] = *(const f32x4*)(W + (size_t)(k0 + 8 * i + (lane >> 3)) * N + n0 + 4 * (lane & 7));
#pragma unroll
    for (int i = 0; i < 8; ++i) { LAS float* s = scr + (8 * i + (lane >> 3)) * 33 + 4 * (lane & 7); if (q8) { for (int e = 0; e < 4; ++e) v[i][e] = q8f(v[i][e] * 64.0f) * (1.0f / 64.0f); } s[0] = v[i][0]; s[1] = v[i][1]; s[2] = v[i][2]; s[3] = v[i][3]; }
    LDS_WAIT(); asm volatile("" ::: "memory");
    const int c = lane & 7;
#pragma unroll
    for (int j = 0; j < 4; ++j) { const int n = (lane >> 3) + 8 * j; const LAS float* s = scr + (8 * c) * 33 + n;
        v4u o; o.x = pk2(s[0 * 33], s[1 * 33]); o.y = pk2(s[2 * 33], s[3 * 33]); o.z = pk2(s[4 * 33], s[5 * 33]); o.w = pk2(s[6 * 33], s[7 * 33]);
        *(v4u*)(WT + (size_t)(orow0 + n) * ldo + ocol0 + 8 * c) = o; }
    LDS_WAIT(); asm volatile("" ::: "memory");
}
__device__ __forceinline__ void transpose_item8(const float* __restrict__ W, int N, int k0, int n0, unsigned char* WT, int ldo, int orow0, int ocol0, float scale, LAS float* scr, int lane) {
    f32x4 v[8];
#pragma unroll
    for (int i = 0; i < 8; ++i) v[i] = *(const f32x4*)(W + (size_t)(k0 + 8 * i + (lane >> 3)) * N + n0 + 4 * (lane & 7));
#pragma unroll
    for (int i = 0; i < 8; ++i) { LAS float* s = scr + (8 * i + (lane >> 3)) * 33 + 4 * (lane & 7); s[0] = v[i][0] * scale; s[1] = v[i][1] * scale; s[2] = v[i][2] * scale; s[3] = v[i][3] * scale; }
    LDS_WAIT(); asm volatile("" ::: "memory");
    const int c = lane & 3;
#pragma unroll
    for (int j = 0; j < 2; ++j) { const int n = (lane >> 2) + 16 * j; const LAS float* s = scr + (16 * c) * 33 + n;
        v4u o; o.x = pk4_fp8(s[0 * 33], s[1 * 33], s[2 * 33], s[3 * 33]); o.y = pk4_fp8(s[4 * 33], s[5 * 33], s[6 * 33], s[7 * 33]);
        o.z = pk4_fp8(s[8 * 33], s[9 * 33], s[10 * 33], s[11 * 33]); o.w = pk4_fp8(s[12 * 33], s[13 * 33], s[14 * 33], s[15 * 33]);
        *(v4u*)(WT + (size_t)(orow0 + n) * ldo + ocol0 + 16 * c) = o; }
    LDS_WAIT(); asm volatile("" ::: "memory");
}
__device__ __forceinline__ int t5_bucket(int rel) {
    const int n = rel < 0 ? -rel : rel; const float nf = (float)(n < 1 ? 1 : n);
    int large = 8 + (int)(logf(nf / 8.0f) / 4.852030263919617f * 8.0f); large = large < 15 ? large : 15;
    return (rel > 0 ? 16 : 0) + (n < 8 ? n : large);
}
__device__ __forceinline__ void p0_prologue(Frame& F) {
    LAS float* scr = (LAS float*)(F.lds + RING_OFF + F.wave * 16384);
    const int gw = blockIdx.x * 8 + F.wave, NGW = F.G * 8;
    const int gt = blockIdx.x * 512 + F.tid, NGT = F.G * 512;
    bf16* XB = (bf16*)(F.ws + WS_XB); bf16* WIN = (bf16*)(F.ws + WS_WIN); bf16* WA = (bf16*)(F.ws + WS_WA); bf16* WB = (bf16*)(F.ws + WS_WB); bf16* WO = (bf16*)(F.ws + WS_WO);
    bf16* WGL = (bf16*)(F.ws + WS_WGL); bf16* WD = (bf16*)(F.ws + WS_WD);
    { float* lut = (float*)(F.ws + WS_LUT); const float* rb = inp(F, 3);
      for (int i = gt; i < 3 * 4 * 129; i += NGT) { const int g = i / 516, hh = (i / 129) % 4, j = i % 129; const int d = (g == 0) ? 1 : (g == 1 ? 4 : 16);
          lut[i] = rb[t5_bucket((j - 64) * d) * 12 + g * 4 + hh]; }
      float* rope = (float*)(F.ws + WS_ROPE);
      for (int i = gt; i < 128 * 32; i += NGT) { const int pos = i >> 5, fi = i & 31; const float inv = powf(10000.0f, -(float)(2 * fi) / 64.0f); const float ang = (float)pos * inv;
          rope[2 * i] = __cosf(ang); rope[2 * i + 1] = __sinf(ang); }
      float* wrt = (float*)(F.ws + WS_WRT); const float* wr = inp(F, 11);
      for (int i = gt; i < 32 * 2048; i += NGT) { const int e = i >> 11, c = i & 2047; wrt[i] = wr[c * 32 + e]; }
    }
    { const float* x = inp(F, 0);
      for (int i = gw; i < S_ * DM / 512; i += NGW) { const size_t o = (size_t)i * 512 + F.lane * 8; const f32x4 a = *(const f32x4*)(x + o), b = *(const f32x4*)(x + o + 4);
          v2u w; w.x = pk4_fp8(a[0], a[1], a[2], a[3]); w.y = pk4_fp8(b[0], b[1], b[2], b[3]); *(v2u*)((unsigned char*)XB + o) = w; } }
    constexpr int I_WIN = 32 * 320, I_WA = 8 * 64, I_WB = 16 * 64, I_WO = 32 * 64, I_EXP = 32 * 64, I_MOE = 3 * 32 * I_EXP;
    constexpr int NITEMS = I_WIN + I_WA + I_WB + I_WO + I_MOE;
    const float* const w_in = inp(F, 1); const float* const w_ba = inp(F, 6); const float* const w_bb = inp(F, 7); const float* const w_o = inp(F, 8);
    const float* const w_g = inp(F, 13); const float* const w_l = inp(F, 15); const float* const w_d = inp(F, 17);
    for (int it = gw; it < NITEMS; it += NGW) {
        int r = it;
        if (r < I_WIN) { const int kb = r / 320, nb = r % 320; transpose_item8(w_in, INW, 64 * kb, 32 * nb, (unsigned char*)WIN, 2048, 32 * nb, 64 * kb, 64.0f, scr, F.lane); continue; } r -= I_WIN;
        if (r < I_WA) { const int kb = r / 64, nb = r % 64; transpose_item8(w_ba, DM, 64 * kb, 32 * nb, (unsigned char*)WA, 512, 32 * nb, 64 * kb, 32.0f, scr, F.lane); continue; } r -= I_WA;
        if (r < I_WB) { const int kb = r / 64, nb = r % 64; transpose_item8(w_bb, DM, 64 * kb, 32 * nb, (unsigned char*)WB, 1024, 32 * nb, 64 * kb, 32.0f, scr, F.lane); continue; } r -= I_WB;
        if (r < I_WO) { const int kb = r / 64, nb = r % 64; transpose_item8(w_o, DM, 64 * kb, 32 * nb, (unsigned char*)WO, 2048, 32 * nb, 64 * kb, 64.0f, scr, F.lane); continue; } r -= I_WO;
        const int which = r / (32 * I_EXP), rr = r % (32 * I_EXP), e = rr / I_EXP, q = rr % I_EXP, kb = q / 64, nb = q % 64, n0 = 32 * nb;
        const float* src = (which == 0 ? w_g : (which == 1 ? w_l : w_d)) + (size_t)e * DM * DM;
        if (which < 2) transpose_item8(src, DM, 64 * kb, n0, (unsigned char*)WGL + (size_t)e * 4096 * 2048, 2048, (n0 >> 7) * 256 + which * 128 + (n0 & 127), 64 * kb, 64.0f, scr, F.lane);
        else transpose_item8(src, DM, 64 * kb, n0, (unsigned char*)WD + (size_t)e * 2048 * 2048, 2048, n0, 64 * kb, 64.0f, scr, F.lane);
    }
}

__device__ __forceinline__ void p2_prep_dilated(Frame& F) {
    const bf16* proj = (const bf16*)(F.ws + WS_PROJ);
    bf16* QBR = (bf16*)(F.ws + WS_QBR); bf16* KBR = (bf16*)(F.ws + WS_KBR); bf16* VBR = (bf16*)(F.ws + WS_VBR);
    const float* rope = (const float*)(F.ws + WS_ROPE);
    const int gw = blockIdx.x * 8 + F.wave, NGW = F.G * 8;
    const int half = F.lane >> 5, fi = F.lane & 31, c1 = half * 64 + fi, c2 = c1 + 32;
    const float* const qn_g = inp(F, 4); const float* const kn_g = inp(F, 5);
    for (int it = gw; it < S_ * 12; it += NGW) {
        const int t = it / 12, h = it % 12;
        if (h >= 10) { const unsigned* vs = (const unsigned*)(proj + (size_t)t * INW + B_V_OFF + (h - 10) * 128); ((unsigned*)(VBR + (size_t)t * 256 + (h - 10) * 128))[F.lane] = vs[F.lane]; continue; }
        const bf16* src = proj + (size_t)t * INW + (h < 8 ? B_Q_OFF + h * 128 : B_K_OFF + (h - 8) * 128);
        const float* gn = h < 8 ? qn_g : kn_g;
        float v1 = bf2f(src[c1]), v2 = bf2f(src[c2]);
        const float ss = wave_sum(v1 * v1 + v2 * v2);
        const float rs = 1.0f / sqrtf(ss * (1.0f / 128.0f) + QK_EPS);
        v1 = v1 * rs * gn[c1]; v2 = v2 * rs * gn[c2];
        const int pos = half ? (t & 63) : (t >> 6);
        const float cs = rope[(pos * 32 + fi) * 2], sn = rope[(pos * 32 + fi) * 2 + 1];
        const float o1 = v1 * cs - v2 * sn, o2 = v1 * sn + v2 * cs;
        bf16* dst = h < 8 ? QBR + (size_t)t * 1024 + h * 128 : KBR + (size_t)t * 256 + (h - 8) * 128;
        dst[c1] = (bf16)(pk2(o1, 0.f) & 0xffffu); dst[c2] = (bf16)(pk2(o2, 0.f) & 0xffffu);
    }
    const float* lut = (const float*)(F.ws + WS_LUT);
    for (int u = blockIdx.x; u < 384; u += F.G) {
        const int gh = u >> 5, blk = u & 31, g = gh >> 2, hh = gh & 3, d = (g == 0) ? 1 : (g == 1 ? 4 : 16);
        const int bps = 32 / d, r = blk / bps, qb = blk % bps;
        at::dilated_unit((const at::bf16*)proj, lut + (g * 4 + hh) * 129, (at::bf16*)(F.ws + WS_OUTA) + (size_t)g * S_ * 512, (float*)(F.ws + WS_LSE) + (size_t)g * S_ * 4,
                         d, gh, hh, r, qb * 256, (char*)F.ldsg + RING_OFF);
    }
}

__device__ __forceinline__ void p3_attn_combine(Frame& F) {
    const at::bf16* QBR = (const at::bf16*)(F.ws + WS_QBR); const at::bf16* KBR = (const at::bf16*)(F.ws + WS_KBR); const at::bf16* VBR = (const at::bf16*)(F.ws + WS_VBR);
    unsigned char* YB = F.ws + WS_YB;
    for (int u = blockIdx.x; u < 256; u += F.G) {
        const int h = u & 7, qb = u >> 3, kv = h >> 2;
        at::attn_dense_body<1024, 256, 256, 1024>(QBR + (size_t)qb * 256 * 1024 + h * 128, KBR + kv * 128, VBR + kv * 128, YB + (size_t)qb * 256 * 1024 + h * 128, S_, (char*)F.ldsg + RING_OFF);
        __syncthreads();
    }
    const bf16* OUTA = (const bf16*)(F.ws + WS_OUTA); const float* LSE = (const float*)(F.ws + WS_LSE); bf16* YA = (bf16*)(F.ws + WS_YA);
    for (int tb = blockIdx.x; tb < 256; tb += F.G) {
        const int t = tb * 32 + (F.tid >> 4), c0 = (F.tid & 15) * 32, hh = c0 >> 7;
        const float l0 = LSE[(size_t)t * 4 + hh], l1 = LSE[(size_t)(S_ + t) * 4 + hh], l2 = LSE[(size_t)(2 * S_ + t) * 4 + hh];
        const float m = fmaxf(l0, fmaxf(l1, l2)); float w0 = __expf(l0 - m), w1 = __expf(l1 - m), w2 = __expf(l2 - m); const float inv = 16.0f / (w0 + w1 + w2); w0 *= inv; w1 *= inv; w2 *= inv;
#pragma unroll
        for (int q = 0; q < 4; ++q) { const size_t o = (size_t)t * 512 + c0 + q * 8;
            const v4u a = *(const v4u*)(OUTA + o), b = *(const v4u*)(OUTA + (size_t)S_ * 512 + o), c = *(const v4u*)(OUTA + (size_t)2 * S_ * 512 + o);
            v2u w;
            w.x = pk4_fp8(w0 * bflo(a.x) + w1 * bflo(b.x) + w2 * bflo(c.x), w0 * bfhi(a.x) + w1 * bfhi(b.x) + w2 * bfhi(c.x), w0 * bflo(a.y) + w1 * bflo(b.y) + w2 * bflo(c.y), w0 * bfhi(a.y) + w1 * bfhi(b.y) + w2 * bfhi(c.y));
            w.y = pk4_fp8(w0 * bflo(a.z) + w1 * bflo(b.z) + w2 * bflo(c.z), w0 * bfhi(a.z) + w1 * bfhi(b.z) + w2 * bfhi(c.z), w0 * bflo(a.w) + w1 * bflo(b.w) + w2 * bflo(c.w), w0 * bfhi(a.w) + w1 * bfhi(b.w) + w2 * bfhi(c.w));
            *(v2u*)((unsigned char*)YA + o) = w; }
    }
}

__device__ __forceinline__ void p6_ln_router(Frame& F, const int bank = 0) {
    LAS int* cntl = (LAS int*)(F.lds + L_CNT); LAS int* basel = cntl + 32;
    LAS int* asg_e = (LAS int*)(F.lds + L_ASG); LAS int* asg_lr = asg_e + 128; LAS float* asg_w = (LAS float*)(asg_lr + 128);
    const float* Z1 = (const float*)(F.ws + WS_T1); float* X1 = (float*)(F.ws + WS_X1); bf16* X1B = (bf16*)(F.ws + WS_X1B);
    const f32x4* G4 = (const f32x4*)inp(F, 9); const f32x4* B4 = (const f32x4*)inp(F, 10);
    const f32x4* WRT4 = (const f32x4*)(F.ws + WS_WRT); const float* br = inp(F, 12);
    unsigned* gcnt = F.ctl + CW_CNT + bank * 64;
    int* TOKE = (int*)(F.ws + (bank ? WS_H : WS_TOKE)); int* TOKR = (int*)(F.ws + (bank ? WS_H + MiB : WS_TOKR)); float* TOKW = (float*)(F.ws + (bank ? WS_H + 2 * MiB : WS_TOKW));
    for (int tb = blockIdx.x; tb < 256; tb += F.G) {
        if (F.tid < 32) cntl[F.tid] = 0;
        __syncthreads();
#pragma unroll 1
        for (int hp = 0; hp < 2; ++hp) {
        const int t0 = tb * 32 + F.wave * 4 + hp * 2;
        f32x4 xv[2][8];
#pragma unroll
        for (int tk = 0; tk < 2; ++tk) {
            const f32x4* zr = (const f32x4*)(Z1 + (size_t)(t0 + tk) * DM) + F.lane; float s = 0.f;
#pragma unroll
            for (int j = 0; j < 8; ++j) { xv[tk][j] = zr[64 * j]; s += (xv[tk][j][0] + xv[tk][j][1]) + (xv[tk][j][2] + xv[tk][j][3]); }
            const float mean = wave_sum(s) * (1.0f / DM); float s2 = 0.f;
#pragma unroll
            for (int j = 0; j < 8; ++j) { xv[tk][j] = xv[tk][j] - mean; s2 += (xv[tk][j][0] * xv[tk][j][0] + xv[tk][j][1] * xv[tk][j][1]) + (xv[tk][j][2] * xv[tk][j][2] + xv[tk][j][3] * xv[tk][j][3]); }
            const float rstd = 1.0f / sqrtf(wave_sum(s2) * (1.0f / DM) + LN_EPS);
            f32x4* xo = (f32x4*)(X1 + (size_t)(t0 + tk) * DM) + F.lane; unsigned* xb = (unsigned*)((unsigned char*)X1B + (size_t)(t0 + tk) * DM) + F.lane;
#pragma unroll
            for (int j = 0; j < 8; ++j) { const f32x4 v = xv[tk][j] * rstd * G4[64 * j + F.lane] + B4[64 * j + F.lane]; xv[tk][j] = v; xo[64 * j] = v;
                xb[64 * j] = pk4_fp8(v[0], v[1], v[2], v[3]); }
        }
        float logit[2] = {-3.0e38f, -3.0e38f};
#pragma unroll 1
        for (int e = 0; e < 32; ++e) {
            f32x4 w[8];
#pragma unroll
            for (int j = 0; j < 8; ++j) w[j] = WRT4[e * 512 + 64 * j + F.lane];
            const float be = br[e];
#pragma unroll
            for (int tk = 0; tk < 2; ++tk) { float p = 0.f;
#pragma unroll
                for (int j = 0; j < 8; ++j) p += (xv[tk][j][0] * w[j][0] + xv[tk][j][1] * w[j][1]) + (xv[tk][j][2] * w[j][2] + xv[tk][j][3] * w[j][3]);
                const float sres = wave_sum(p) + be; logit[tk] = (F.lane == e) ? sres : logit[tk]; }
        }
#pragma unroll
        for (int tk = 0; tk < 2; ++tk) {
            float v = logit[tk]; float tv[4]; int ti[4];
#pragma unroll
            for (int k = 0; k < 4; ++k) { float bv = v; int bi = F.lane;
#pragma unroll
                for (int o = 1; o < 64; o <<= 1) { const float ov = __shfl_xor(bv, o); const int oi = __shfl_xor(bi, o); if (ov > bv || (ov == bv && oi < bi)) { bv = ov; bi = oi; } }
                tv[k] = bv; ti[k] = bi; if (F.lane == bi) v = -3.0e38f; }
            const float e1 = __expf(tv[1] - tv[0]), e2 = __expf(tv[2] - tv[0]), e3 = __expf(tv[3] - tv[0]); const float inv = 1.0f / (1.0f + e1 + e2 + e3);
            if (F.lane < 4) { const int me = F.lane == 0 ? ti[0] : (F.lane == 1 ? ti[1] : (F.lane == 2 ? ti[2] : ti[3]));
                const float mw = (F.lane == 0 ? 1.0f : (F.lane == 1 ? e1 : (F.lane == 2 ? e2 : e3))) * inv;
                const int lr = atomicAdd((int*)(cntl + me), 1);
                const int a = (F.wave * 4 + hp * 2 + tk) * 4 + F.lane; asg_e[a] = me; asg_lr[a] = lr; asg_w[a] = mw; }
        }
        }
        __syncthreads();
        if (F.tid < 32) basel[F.tid] = (int)atomicAdd(gcnt + F.tid, (unsigned)cntl[F.tid]);
        __syncthreads();
        if (F.tid < 128) { const int a = tb * 128 + F.tid; const int e = asg_e[F.tid]; TOKE[a] = e; TOKR[a] = basel[e] + asg_lr[F.tid]; TOKW[a] = asg_w[F.tid]; }
        __syncthreads();
    }
}

__device__ __forceinline__ void p7_gather(Frame& F) {
    LAS int* pst = (LAS int*)(F.lds + L_PST);
    const unsigned* gcnt = F.ctl + CW_CNT;
    if (F.tid == 0) { int acc = 0; for (int e = 0; e < 32; ++e) { pst[e] = acc; acc += ((int)gcnt[e] + 255) & ~255; } pst[32] = acc; }
    __syncthreads();
    const int* TOKE = (const int*)(F.ws + WS_TOKE); const int* TOKR = (const int*)(F.ws + WS_TOKR); const float* TOKW = (const float*)(F.ws + WS_TOKW);
    int* TOKS = (int*)(F.ws + WS_TOKS); float* SLOTW = (float*)(F.ws + WS_SLOTW);
    const bf16* X1B = (const bf16*)(F.ws + WS_X1B); bf16* XS = (bf16*)(F.ws + WS_XS);
    const int gw = blockIdx.x * 8 + F.wave, NGW = F.G * 8;
    for (int a = gw; a < S_ * TOPK; a += NGW) {
        const int t = a >> 2, e = TOKE[a]; const int slot = pst[e] + TOKR[a];
        if (F.lane == 0) { TOKS[a] = slot; SLOTW[slot] = TOKW[a]; }
        const v4u* src = (const v4u*)((const unsigned char*)X1B + (size_t)t * DM) + F.lane; v4u* dst = (v4u*)((unsigned char*)XS + (size_t)slot * DM) + F.lane;
        const v4u a0 = src[0], a1 = src[64];
        dst[0] = a0; dst[64] = a1;
    }
}
__device__ __forceinline__ int moe_tiles(Frame& F) {
    LAS int* tile_e = (LAS int*)(F.lds + L_TILE);
    const unsigned* gcnt = F.ctl + CW_CNT;
    __syncthreads();
    if (F.tid == 0) { int ti = 0; for (int e = 0; e < 32; ++e) { const int nt = ((int)gcnt[e] + 255) >> 8; for (int k = 0; k < nt && ti < 160; ++k) tile_e[ti++] = e; } tile_e[160] = ti; }
    __syncthreads();
    return tile_e[160];
}

__device__ __forceinline__ void p10_final(Frame& F) {
    const float* X1 = (const float*)(F.ws + WS_X1); const bf16* YS = (const bf16*)(F.ws + WS_YS); const int* TOKS = (const int*)(F.ws + WS_TOKS);
    const f32x4* G4 = (const f32x4*)inp(F, 19); const f32x4* B4 = (const f32x4*)inp(F, 20);
    float* outp = (float*)inp(F, 21);
    const int gw = blockIdx.x * 8 + F.wave, NGW = F.G * 8;
    for (int t = gw; t < S_; t += NGW) {
        const int sl0 = TOKS[t * 4], sl1 = TOKS[t * 4 + 1], sl2 = TOKS[t * 4 + 2], sl3 = TOKS[t * 4 + 3];
        const f32x4* xr = (const f32x4*)(X1 + (size_t)t * DM) + F.lane;
        const v2u* y0 = (const v2u*)(YS + (size_t)sl0 * DM) + F.lane; const v2u* y1 = (const v2u*)(YS + (size_t)sl1 * DM) + F.lane;
        const v2u* y2 = (const v2u*)(YS + (size_t)sl2 * DM) + F.lane; const v2u* y3 = (const v2u*)(YS + (size_t)sl3 * DM) + F.lane;
        f32x4 v[8]; float s = 0.f;
#pragma unroll
        for (int j = 0; j < 8; ++j) { const v2u a = y0[64 * j], b = y1[64 * j], c = y2[64 * j], d = y3[64 * j]; f32x4 f;
            f[0] = (bflo(a.x) + bflo(b.x)) + (bflo(c.x) + bflo(d.x)); f[1] = (bfhi(a.x) + bfhi(b.x)) + (bfhi(c.x) + bfhi(d.x));
            f[2] = (bflo(a.y) + bflo(b.y)) + (bflo(c.y) + bflo(d.y)); f[3] = (bfhi(a.y) + bfhi(b.y)) + (bfhi(c.y) + bfhi(d.y));
            v[j] = xr[64 * j] * ALPHA + f; s += (v[j][0] + v[j][1]) + (v[j][2] + v[j][3]); }
        const float mean = wave_sum(s) * (1.0f / DM); float s2 = 0.f;
#pragma unroll
        for (int j = 0; j < 8; ++j) { v[j] = v[j] - mean; s2 += (v[j][0] * v[j][0] + v[j][1] * v[j][1]) + (v[j][2] * v[j][2] + v[j][3] * v[j][3]); }
        const float rstd = 1.0f / sqrtf(wave_sum(s2) * (1.0f / DM) + LN_EPS);
        f32x4* o = (f32x4*)(outp + (size_t)t * DM) + F.lane;
#pragma unroll
        for (int j = 0; j < 8; ++j) o[64 * j] = v[j] * rstd * G4[64 * j + F.lane] + B4[64 * j + F.lane];
    }
}

struct Args { const float* in[21]; float* out; unsigned char* ws; int ph_lo, ph_hi; };
__global__ void __launch_bounds__(512, 2) mk_fwd(Args args) {
    extern __shared__ __attribute__((aligned(16))) unsigned char lds[];
    Frame F;
    F.lds = (LAS unsigned char*)lds; F.ldsg = lds;
    F.tid = threadIdx.x; F.lane = F.tid & 63; F.wave = __builtin_amdgcn_readfirstlane(F.tid >> 6); F.G = gridDim.x;
    F.ws = args.ws; F.ctl = (unsigned*)(args.ws + WS_CTL);
    if (F.tid == 0) { LAS unsigned long long* pp = (LAS unsigned long long*)(F.lds + L_PTR);
#pragma unroll
        for (int i = 0; i < 21; ++i) pp[i] = (unsigned long long)args.in[i];
        pp[21] = (unsigned long long)args.out; }
    if (F.tid < 4) ((LAS unsigned*)(F.lds + L_XB))[F.tid] = 0u;
    __syncthreads();
    const int lo = args.ph_lo, hi = args.ph_hi;
    XcdBarrier bar; bar.bar = F.ctl + CW_BAR; bar.x = 0; bar.st = (volatile LAS unsigned*)(F.lds + L_XB);
    if (hi - lo > 1) bar = xcd_barrier_post(F.ctl + CW_BAR, (volatile LAS unsigned*)(F.lds + L_XB));
#ifndef MK_PHASE_MASK
#define MK_PHASE_MASK 0x7ff
#endif
#define IN(k) (((MK_PHASE_MASK >> (k)) & 1) && lo <= (k) && (k) < hi)
#ifndef MK_DUP_MASK
#define MK_DUP_MASK 0
#endif
#define REP(k) for (int rep_ = 0; rep_ < 1 + ((MK_DUP_MASK >> (k)) & 1); ++rep_)
#ifndef MK_BAR2
#define MK_BAR2 0
#endif
#define SEAM(k) do { if (IN(k) && IN((k) + 1)) { xcd_barrier(bar); if (MK_BAR2) xcd_barrier(bar); } } while (0)
    LAS unsigned char* ring = F.lds + RING_OFF;
    const pg8::bf16_t* XB = (const pg8::bf16_t*)(F.ws + WS_XB);

    if (IN(0)) REP(0) { p0_prologue(F); }
    SEAM(0);
    if (IN(1)) REP(1) {
        pg8::Gemm g{XB, (const pg8::bf16_t*)(F.ws + WS_WIN), S_, INW, DM / 2}; pg8::StaticOrder S; S.init(S_, INW, F.G, (int)blockIdx.x);
        pg8::EpiStoreBf16 E{(pg8::bf16_t*)(F.ws + WS_PROJ), INW, 1.0f / 64.0f};
        pg8::gemm_phase<pg8::EpiStoreBf16, pg8::StaticOrder, true, true, true>(ring, g, S, E);
    }
    SEAM(1);
    if (IN(2)) { p2_prep_dilated(F); if ((MK_DUP_MASK >> 2) & 1) p2_prep_dilated(F); }
    SEAM(2);
    if (IN(3)) REP(3) { p3_attn_combine(F); }
    SEAM(3);
#define PHASE4_BODY { \
        { pg8::Gemm g{(const pg8::bf16_t*)(F.ws + WS_YA), (const pg8::bf16_t*)(F.ws + WS_WA), S_, DM, 256}; pg8::StaticOrder S; S.init(S_, DM, F.G, (int)blockIdx.x); \
          pg8::EpiGateA E{(const pg8::bf16_t*)(F.ws + WS_PROJ), INW, GATE_OFF, inp(F, 2), (float*)(F.ws + WS_T1), DM, 1.0f / 512.0f}; \
          pg8::gemm_phase<pg8::EpiGateA, pg8::StaticOrder, true, true, true>(ring, g, S, E); } \
        { pg8::Gemm g{(const pg8::bf16_t*)(F.ws + WS_YB), (const pg8::bf16_t*)(F.ws + WS_WB), S_, DM, 512}; pg8::StaticOrder S; S.init(S_, DM, F.G, (int)blockIdx.x); \
          pg8::EpiGateB E{(const pg8::bf16_t*)(F.ws + WS_PROJ), INW, GATE_OFF + DM, inp(F, 2) + DM, (const float*)(F.ws + WS_T1), F.ws + WS_Y, DM, 1.0f / 2048.0f}; \
          pg8::gemm_phase<pg8::EpiGateB, pg8::StaticOrder, true, true, true>(ring, g, S, E); } \
    }
    if (IN(4)) { PHASE4_BODY if ((MK_DUP_MASK >> 4) & 1) PHASE4_BODY }
    SEAM(4);
    if (IN(5)) REP(5) {
        pg8::Gemm g{(const pg8::bf16_t*)(F.ws + WS_Y), (const pg8::bf16_t*)(F.ws + WS_WO), S_, DM, DM / 2}; pg8::StaticOrder S; S.init(S_, DM, F.G, (int)blockIdx.x);
        pg8::EpiResF32 E{inp(F, 0), (float*)(F.ws + WS_T1), DM, ALPHA, 1.0f / 4096.0f};
        pg8::gemm_phase<pg8::EpiResF32, pg8::StaticOrder, true, true, true>(ring, g, S, E);
    }
    SEAM(5);
    if (IN(6)) { p6_ln_router(F); if ((MK_DUP_MASK >> 6) & 1) p6_ln_router(F, 1); }
    SEAM(6);
    if (IN(7)) REP(7) { p7_gather(F); }
    SEAM(7);
    if (IN(8)) REP(8) {
        const int nt = moe_tiles(F);
        pg8::Gemm g{(const pg8::bf16_t*)(F.ws + WS_XS), (const pg8::bf16_t*)(F.ws + WS_WGL), nt * 256, 4096, DM / 2};
        pg8::MoeOrder S; S.init(nt * 256, 4096, F.G, (int)blockIdx.x); S.tile_e = (const LAS int*)(F.lds + L_TILE); S.estride = (size_t)4096 * 2048;
        pg8::EpiSwiglu E{(const LAS int*)(F.lds + L_TILE), inp(F, 14), inp(F, 16), F.ws + WS_H, DM, 1.0f / 64.0f};
        pg8::gemm_phase<pg8::EpiSwiglu, pg8::MoeOrder, true, true, true>(ring, g, S, E);
    }
    SEAM(8);
    if (IN(9)) REP(9) {
        const int nt = moe_tiles(F);
        pg8::Gemm g{(const pg8::bf16_t*)(F.ws + WS_H), (const pg8::bf16_t*)(F.ws + WS_WD), nt * 256, DM, DM / 2};
        pg8::MoeOrder S; S.init(nt * 256, DM, F.G, (int)blockIdx.x); S.tile_e = (const LAS int*)(F.lds + L_TILE); S.estride = (size_t)2048 * 2048;
        pg8::EpiDown E{(const LAS int*)(F.lds + L_TILE), inp(F, 18), (const float*)(F.ws + WS_SLOTW), (pg8::bf16_t*)(F.ws + WS_YS), DM, 1.0f / 64.0f};
        pg8::gemm_phase<pg8::EpiDown, pg8::MoeOrder, true, true, true>(ring, g, S, E);
    }
    SEAM(9);
    if (IN(10)) REP(10) { p10_final(F); }
#undef IN
#undef SEAM
}

#ifndef MK_CUTS
#define MK_CUTS 0
#endif
extern "C" void kernel_launch(void* const* d_in, const int* in_sizes, int n_in, void* d_out, int out_size, void* d_ws, size_t ws_size, hipStream_t stream) {
    static int grid = 0;
    if (grid == 0) {
        if (n_in != 21 || out_size != S_ * DM || ws_size < WS_END) { fprintf(stderr, "kernel_launch: unexpected shapes (n_in %d out %d ws %zu, need %zu)\n", n_in, out_size, ws_size, (size_t)WS_END); grid = -1; return; }
        int dev = 0, cus = 0, per_cu = 0;
        if (hipGetDevice(&dev) != hipSuccess || hipDeviceGetAttribute(&cus, hipDeviceAttributeMultiprocessorCount, dev) != hipSuccess) { grid = -1; return; }
        if (hipFuncSetAttribute((const void*)mk_fwd, hipFuncAttributeMaxDynamicSharedMemorySize, LDS_BYTES) != hipSuccess) { fprintf(stderr, "kernel_launch: hipFuncSetAttribute failed\n"); grid = -1; return; }
        if (hipOccupancyMaxActiveBlocksPerMultiprocessor(&per_cu, (const void*)mk_fwd, 512, LDS_BYTES) != hipSuccess || per_cu < 1) { fprintf(stderr, "kernel_launch: occupancy query says %d\n", per_cu); per_cu = 1; }
        (void)hipGetLastError();
        grid = cus;
    }
    if (grid < 0) return;
    (void)hipMemsetAsync((char*)d_ws + WS_CTL, 0, CTL_ZERO_BYTES, stream);
    Args a{};
    for (int i = 0; i < 21; ++i) a.in[i] = (const float*)d_in[i];
    a.out = (float*)d_out; a.ws = (unsigned char*)d_ws;
#if MK_CUTS
    for (int p = 0; p < NPH; ++p) { a.ph_lo = p; a.ph_hi = p + 1; hipLaunchKernelGGL(mk_fwd, dim3(grid), dim3(512), LDS_BYTES, stream, a); }
#else
    a.ph_lo = 0; a.ph_hi = NPH; hipLaunchKernelGGL(mk_fwd, dim3(grid), dim3(512), LDS_BYTES, stream, a);
#endif
}
```

```cpp
#include <hip/hip_runtime.h>
#include <hip/hip_bf16.h>
#include <cstdio>
#include <cstdint>
#define MK_CUTS 0
namespace pg8 {
#define PG8_LAS __attribute__((address_space(3)))
typedef unsigned short bf16_t;
typedef short bf16x8 __attribute__((ext_vector_type(8)));
typedef float f32x4 __attribute__((ext_vector_type(4)));
typedef unsigned u32x4 __attribute__((ext_vector_type(4)));
constexpr int BM = 256, BK = 64, HALF = 128, HTB = HALF * BK * 2  , STAGE_BYTES = 8 * HTB, NXCD = 8, WGM = 8;

__host__ __device__ __forceinline__ int lds_byte(int r, int c) { const int st = (r >> 4) * 2 + (c >> 5), rr = r & 15, cc = c & 31, ob = rr * 64 + cc * 2; return st * 1024 + (ob ^ (((ob >> 9) & 1) << 5)); }
__host__ __device__ __forceinline__ void stage_rc(int b, int& R, int& C) { const int st = b / 1024, sb = b % 1024, swz = sb ^ (((sb >> 9) & 1) << 5); R = (st >> 1) * 16 + swz / 64; C = (st & 1) * 32 + (swz % 64) / 2; }
__host__ __device__ __forceinline__ int perm32(int rho) { const int n = rho >> 4, i = rho & 15; return 8 * (i >> 2) + 4 * n + (i & 3); }

struct Unit { int pm, pn; };
struct Gemm { const bf16_t* A; const bf16_t* Bt; int M, N, K; };

struct StaticOrder {
    int nM, nN, nwg, G, c;
    __host__ __device__ void init(int M, int N, int G_, int c_) { nM = M / BM; nN = N / BM; nwg = nM * nN; G = G_; c = c_; }
    __host__ __device__ bool next(int i, Unit& u) const {
        const long L = (long)i * G + c; if (L >= nwg) return false;
        int wgid = (int)L; { const int q = nwg / NXCD, r = nwg % NXCD, xcd = wgid % NXCD, off = wgid / NXCD; wgid = (xcd < r ? xcd * (q + 1) : r * (q + 1) + (xcd - r) * q) + off; }
        const int nig = WGM * nN, gid = wgid / nig, fm = gid * WGM, gsz = (nM - fm) < WGM ? (nM - fm) : WGM;
        u.pm = fm + ((wgid % nig) % gsz); u.pn = (wgid % nig) / gsz; return true;
    }
    __device__ __forceinline__ void a_ready(const Unit&) const {}
    __device__ __forceinline__ size_t b_off(const Unit&) const { return 0; }
    __device__ __forceinline__ void done(const Unit&) const {}
};


typedef unsigned u32x2 __attribute__((ext_vector_type(2)));
__device__ __forceinline__ unsigned cvt_pk_bf16(float lo, float hi) { unsigned r; asm volatile("v_cvt_pk_bf16_f32 %0, %1, %2" : "=v"(r) : "v"(lo), "v"(hi)); return r; }
__device__ __forceinline__ unsigned pk4_fp8_(float a, float b, float c, float d) { int w = __builtin_amdgcn_cvt_pk_fp8_f32(a, b, 0, false); w = __builtin_amdgcn_cvt_pk_fp8_f32(c, d, w, true); return (unsigned)w; }
__device__ __forceinline__ float bf_lo(unsigned w) { return __builtin_bit_cast(float, w << 16); }
__device__ __forceinline__ float bf_hi(unsigned w) { return __builtin_bit_cast(float, w & 0xffff0000u); }
__device__ __forceinline__ float sigmoidf_(float v) { return __builtin_amdgcn_rcpf(1.0f + __expf(-v)); }

struct EpiStoreBf16 {
    static constexpr bool PERM = true, AFTER_DRAIN = false;
    bf16_t* O; int ldc; float sc;
    __device__ __forceinline__ void operator()(const f32x4 (&acc)[2][2][4][2], const Unit& u, int wr, int wc, int fr, int fq) const {
        const int row0 = u.pm * BM + wr * 64 + fr, col0 = u.pn * BM + wc * 32 + 8 * fq;
#pragma unroll
        for (int ai = 0; ai < 2; ++ai)
#pragma unroll
            for (int m = 0; m < 4; ++m) { bf16_t* rowp = O + (size_t)(row0 + ai * HALF + m * 16) * ldc + col0;
#pragma unroll
                for (int bj = 0; bj < 2; ++bj) { const f32x4 v0 = acc[ai][bj][m][0] * sc, v1 = acc[ai][bj][m][1] * sc;
                    u32x4 w; w.x = cvt_pk_bf16(v0[0], v0[1]); w.y = cvt_pk_bf16(v0[2], v0[3]); w.z = cvt_pk_bf16(v1[0], v1[1]); w.w = cvt_pk_bf16(v1[2], v1[3]);
                    *(u32x4*)(rowp + bj * HALF) = w; } }
    }
};

struct EpiGateA {
    static constexpr bool PERM = true, AFTER_DRAIN = false;
    const bf16_t* proj; int ldp; int gcol0; const float* bg; float* T1; int ldc; float sc;
    __device__ __forceinline__ void operator()(const f32x4 (&acc)[2][2][4][2], const Unit& u, int wr, int wc, int fr, int fq) const {
        const int row0 = u.pm * BM + wr * 64 + fr, col0 = u.pn * BM + wc * 32 + 8 * fq;
#pragma unroll
        for (int ai = 0; ai < 2; ++ai)
#pragma unroll
            for (int m = 0; m < 4; ++m) { const int row = row0 + ai * HALF + m * 16;
#pragma unroll
                for (int bj = 0; bj < 2; ++bj) { const int c = col0 + bj * HALF;
                    const u32x4 gw = *(const u32x4*)(proj + (size_t)row * ldp + gcol0 + c);
                    const f32x4 b0 = *(const f32x4*)(bg + c), b1 = *(const f32x4*)(bg + c + 4);
                    f32x4 g0, g1;
                    g0[0] = sigmoidf_(bf_lo(gw.x) + b0[0]); g0[1] = sigmoidf_(bf_hi(gw.x) + b0[1]); g0[2] = sigmoidf_(bf_lo(gw.y) + b0[2]); g0[3] = sigmoidf_(bf_hi(gw.y) + b0[3]);
                    g1[0] = sigmoidf_(bf_lo(gw.z) + b1[0]); g1[1] = sigmoidf_(bf_hi(gw.z) + b1[1]); g1[2] = sigmoidf_(bf_lo(gw.w) + b1[2]); g1[3] = sigmoidf_(bf_hi(gw.w) + b1[3]);
                    float* o = T1 + (size_t)row * ldc + c;
                    *(f32x4*)o = acc[ai][bj][m][0] * sc * g0; *(f32x4*)(o + 4) = acc[ai][bj][m][1] * sc * g1; } }
    }
};
struct EpiGateB {
    static constexpr bool PERM = true, AFTER_DRAIN = false;
    const bf16_t* proj; int ldp; int gcol0; const float* bg; const float* T1; unsigned char* Y; int ldc; float sc;
    __device__ __forceinline__ void operator()(const f32x4 (&acc)[2][2][4][2], const Unit& u, int wr, int wc, int fr, int fq) const {
        const int row0 = u.pm * BM + wr * 64 + fr, col0 = u.pn * BM + wc * 32 + 8 * fq;
#pragma unroll
        for (int ai = 0; ai < 2; ++ai)
#pragma unroll
            for (int m = 0; m < 4; ++m) { const int row = row0 + ai * HALF + m * 16;
#pragma unroll
                for (int bj = 0; bj < 2; ++bj) { const int c = col0 + bj * HALF;
                    const u32x4 gw = *(const u32x4*)(proj + (size_t)row * ldp + gcol0 + c);
                    const f32x4 b0 = *(const f32x4*)(bg + c), b1 = *(const f32x4*)(bg + c + 4);
                    const float* tp = T1 + (size_t)row * ldc + c;
                    const f32x4 t0 = *(const f32x4*)tp, t1 = *(const f32x4*)(tp + 4);
                    f32x4 g0, g1;
                    g0[0] = sigmoidf_(bf_lo(gw.x) + b0[0]); g0[1] = sigmoidf_(bf_hi(gw.x) + b0[1]); g0[2] = sigmoidf_(bf_lo(gw.y) + b0[2]); g0[3] = sigmoidf_(bf_hi(gw.y) + b0[3]);
                    g1[0] = sigmoidf_(bf_lo(gw.z) + b1[0]); g1[1] = sigmoidf_(bf_hi(gw.z) + b1[1]); g1[2] = sigmoidf_(bf_lo(gw.w) + b1[2]); g1[3] = sigmoidf_(bf_hi(gw.w) + b1[3]);
                    const f32x4 v0 = (t0 + acc[ai][bj][m][0] * sc * g0) * 64.0f, v1 = (t1 + acc[ai][bj][m][1] * sc * g1) * 64.0f;
                    u32x2 w; w.x = pk4_fp8_(v0[0], v0[1], v0[2], v0[3]); w.y = pk4_fp8_(v1[0], v1[1], v1[2], v1[3]);
                    *(u32x2*)(Y + (size_t)row * ldc + c) = w; } }
    }
};
struct EpiResF32 {
    static constexpr bool PERM = false, AFTER_DRAIN = false;
    const float* X; float* Z; int ldc; float alpha; float sc;
    __device__ __forceinline__ void operator()(const f32x4 (&acc)[2][2][4][2], const Unit& u, int wr, int wc, int fr, int fq) const {
        const int row0 = u.pm * BM + wr * 64 + fr, col0 = u.pn * BM + wc * 32 + 4 * fq;
#pragma unroll
        for (int ai = 0; ai < 2; ++ai)
#pragma unroll
            for (int m = 0; m < 4; ++m) { const size_t ro = (size_t)(row0 + ai * HALF + m * 16) * ldc + col0;
#pragma unroll
                for (int bj = 0; bj < 2; ++bj)
#pragma unroll
                    for (int n = 0; n < 2; ++n) { const f32x4 xv = *(const f32x4*)(X + ro + bj * HALF + n * 16);
                        *(f32x4*)(Z + ro + bj * HALF + n * 16) = xv * alpha + acc[ai][bj][m][n] * sc; } }
    }
};
struct EpiSwiglu {
    static constexpr bool PERM = true, AFTER_DRAIN = false;
    const PG8_LAS int* tile_e; const float* bgate; const float* blin; unsigned char* H; int ldc; float sc;
    __device__ __forceinline__ void operator()(const f32x4 (&acc)[2][2][4][2], const Unit& u, int wr, int wc, int fr, int fq) const {
        const int e = tile_e[u.pm];
        const int row0 = u.pm * BM + wr * 64 + fr, j0 = u.pn * HALF + wc * 32 + 8 * fq;
        const f32x4 bg0 = *(const f32x4*)(bgate + (size_t)e * 2048 + j0), bg1 = *(const f32x4*)(bgate + (size_t)e * 2048 + j0 + 4);
        const f32x4 bl0 = *(const f32x4*)(blin + (size_t)e * 2048 + j0), bl1 = *(const f32x4*)(blin + (size_t)e * 2048 + j0 + 4);
#pragma unroll
        for (int ai = 0; ai < 2; ++ai)
#pragma unroll
            for (int m = 0; m < 4; ++m) { const int row = row0 + ai * HALF + m * 16;
                f32x4 h0, h1;
#pragma unroll
                for (int i = 0; i < 4; ++i) {
                    float g = fminf(acc[ai][0][m][0][i] * sc + bg0[i], 7.0f); float l = fminf(fmaxf(acc[ai][1][m][0][i] * sc + bl0[i], -7.0f), 7.0f);
                    h0[i] = (l + 1.0f) * (g * sigmoidf_(1.702f * g));
                    g = fminf(acc[ai][0][m][1][i] * sc + bg1[i], 7.0f); l = fminf(fmaxf(acc[ai][1][m][1][i] * sc + bl1[i], -7.0f), 7.0f);
                    h1[i] = (l + 1.0f) * (g * sigmoidf_(1.702f * g)); }
                u32x2 w; w.x = pk4_fp8_(h0[0], h0[1], h0[2], h0[3]); w.y = pk4_fp8_(h1[0], h1[1], h1[2], h1[3]);
                *(u32x2*)(H + (size_t)row * ldc + j0) = w; }
    }
};
struct EpiDown {
    static constexpr bool PERM = true, AFTER_DRAIN = false;
    const PG8_LAS int* tile_e; const float* bdown; const float* slot_w; bf16_t* YS; int ldc; float sc;
    __device__ __forceinline__ void operator()(const f32x4 (&acc)[2][2][4][2], const Unit& u, int wr, int wc, int fr, int fq) const {
        const int e = tile_e[u.pm];
        const int row0 = u.pm * BM + wr * 64 + fr, col0 = u.pn * BM + wc * 32 + 8 * fq;
        f32x4 bv[2][2];
#pragma unroll
        for (int bj = 0; bj < 2; ++bj)
#pragma unroll
            for (int n = 0; n < 2; ++n) bv[bj][n] = *(const f32x4*)(bdown + (size_t)e * 2048 + col0 + bj * HALF + 4 * n);
#pragma unroll
        for (int ai = 0; ai < 2; ++ai)
#pragma unroll
            for (int m = 0; m < 4; ++m) { const int row = row0 + ai * HALF + m * 16; const float sw = slot_w[row];
#pragma unroll
                for (int bj = 0; bj < 2; ++bj) { const f32x4 v0 = (acc[ai][bj][m][0] * sc + bv[bj][0]) * sw, v1 = (acc[ai][bj][m][1] * sc + bv[bj][1]) * sw;
                    u32x4 w; w.x = cvt_pk_bf16(v0[0], v0[1]); w.y = cvt_pk_bf16(v0[2], v0[3]); w.z = cvt_pk_bf16(v1[0], v1[1]); w.w = cvt_pk_bf16(v1[2], v1[3]);
                    *(u32x4*)(YS + (size_t)row * ldc + col0 + bj * HALF) = w; } }
    }
};
struct MoeOrder : StaticOrder {
    const PG8_LAS int* tile_e; size_t estride;
    __device__ __forceinline__ size_t b_off(const Unit& u) const { return (size_t)__builtin_amdgcn_readfirstlane(tile_e[u.pm]) * estride; }
};
typedef int i32x4_ __attribute__((ext_vector_type(4)));
typedef int i32x8_ __attribute__((ext_vector_type(8)));
#define PG8_CAT(lo, hi) __builtin_shufflevector(__builtin_bit_cast(i32x4_, lo), __builtin_bit_cast(i32x4_, hi), 0, 1, 2, 3, 4, 5, 6, 7)
template <class Epi, class Sched, bool ALIGN_EPI = false, bool SP2 = false, bool FP8 = false>
__device__ __forceinline__ void gemm_phase(PG8_LAS unsigned char* lds, const Gemm g, const Sched& S, const Epi& E) {
    const int tid = threadIdx.x, wid = __builtin_amdgcn_readfirstlane(tid >> 6), lane = tid & 63, wr = wid >> 2, wc = wid & 3, fr = lane & 15, fq = lane >> 4;
    const int K = g.K, nt = K / BK;
    unsigned voffA[2], voffB[2];
#pragma unroll
    for (int i = 0; i < 2; ++i) { int R, C; stage_rc(tid * 16 + i * 8192, R, C); const int Rb = Epi::PERM ? ((R & ~31) + perm32(R & 31)) : R;
        voffA[i] = (unsigned)(R * K + C) * 2u; voffB[i] = (unsigned)(Rb * K + C) * 2u; }
    const size_t kstep = (size_t)(BK * 2);
    const size_t hstep = (size_t)HALF * K * 2;
    const size_t tstep = 2 * hstep;
    const unsigned ldsw = (unsigned)wid * 1024u;
    const int aoff = lds_byte(wr * 64 + fr, fq * 8), boff = lds_byte(wc * 32 + fr, fq * 8);
#define PG8_SA(b, h) (((b) * 2 + (h)) * HTB)
#define PG8_SB(b, h) ((4 + (b) * 2 + (h)) * HTB)
#define PG8_STAGE(bufoff, gbase, voff) do { _Pragma("unroll") for (int _i = 0; _i < 2; ++_i) \
        __builtin_amdgcn_global_load_lds((const unsigned*)((const char*)(gbase) + (voff)[_i]), (PG8_LAS unsigned*)(lds + (bufoff) + ldsw + _i * 8192), 16, 0, 0); } while (0)
#define PG8_LDA(dst, b, h) do { _Pragma("unroll") for (int m = 0; m < 4; ++m) _Pragma("unroll") for (int k = 0; k < 2; ++k) dst[m][k] = *(const PG8_LAS bf16x8*)(lds + PG8_SA(b, h) + aoff + m * 2048 + k * 1024); } while (0)
#define PG8_LDB(dst, b, h) do { _Pragma("unroll") for (int n = 0; n < 2; ++n) _Pragma("unroll") for (int k = 0; k < 2; ++k) dst[n][k] = *(const PG8_LAS bf16x8*)(lds + PG8_SB(b, h) + boff + n * 2048 + k * 1024); } while (0)
#define PG8_MFMA8(C, Bv, Av) asm volatile("v_mfma_f32_16x16x128_f8f6f4 %0, %1, %2, %0" : "+v"(C) : "v"(Bv), "v"(Av))
#define PG8_MMA(ai, bj, At, Bt) do { __builtin_amdgcn_s_setprio(1); if constexpr (FP8) { const i32x8_ b0_ = PG8_CAT(Bt[0][0], Bt[0][1]), b1_ = PG8_CAT(Bt[1][0], Bt[1][1]); _Pragma("unroll") for (int m = 0; m < 4; ++m) { \
        const i32x8_ a_ = PG8_CAT(At[m][0], At[m][1]); PG8_MFMA8(acc[ai][bj][m][0], b0_, a_); PG8_MFMA8(acc[ai][bj][m][1], b1_, a_); } } else { \
        _Pragma("unroll") for (int m = 0; m < 4; ++m) _Pragma("unroll") for (int n = 0; n < 2; ++n) _Pragma("unroll") for (int k = 0; k < 2; ++k) \
        acc[ai][bj][m][n] = __builtin_amdgcn_mfma_f32_16x16x32_bf16(Bt[n][k], At[m][k], acc[ai][bj][m][n], 0, 0, 0); } __builtin_amdgcn_s_setprio(0); } while (0)
#define PG8_WAIT_V(n) asm volatile("s_waitcnt vmcnt(" #n ")" ::: "memory")
#define PG8_WAIT_L(n) asm volatile("s_waitcnt lgkmcnt(" #n ")" ::: "memory")
#define PG8_BAR __builtin_amdgcn_s_barrier()
#define PG8_SCHED __builtin_amdgcn_sched_barrier(0)
    Unit cur, nxt; int ui = 0;
    if (!S.next(0, cur)) return;
    f32x4 acc[2][2][4][2];
#pragma unroll
    for (int a = 0; a < 2; ++a)
#pragma unroll
        for (int b = 0; b < 2; ++b)
#pragma unroll
            for (int m = 0; m < 4; ++m)
#pragma unroll
                for (int n = 0; n < 2; ++n) acc[a][b][m][n] = (f32x4){0.f, 0.f, 0.f, 0.f};
    bf16x8 At[4][2], B0[2][2], B1[2][2];
    const char* cA = (const char*)g.A + (size_t)cur.pm * tstep; const char* cB = (const char*)g.Bt + S.b_off(cur) + (size_t)cur.pn * tstep;
    S.a_ready(cur);
    if constexpr (SP2) {
        PG8_STAGE(PG8_SB(0, 0), cB, voffB); PG8_STAGE(PG8_SB(0, 1), cB + hstep, voffB); PG8_STAGE(PG8_SA(0, 0), cA, voffA); PG8_STAGE(PG8_SA(0, 1), cA + hstep, voffA);
        if (wr == 1) PG8_BAR;
        PG8_WAIT_V(2); PG8_BAR;
        PG8_STAGE(PG8_SB(1, 0), cB + kstep, voffB); PG8_STAGE(PG8_SA(1, 0), cA + kstep, voffA); PG8_STAGE(PG8_SB(1, 1), cB + hstep + kstep, voffB);
        PG8_WAIT_V(6); PG8_BAR;
    } else {
        PG8_STAGE(PG8_SB(0, 0), cB, voffB); PG8_STAGE(PG8_SA(0, 0), cA, voffA); PG8_STAGE(PG8_SB(0, 1), cB + hstep, voffB); PG8_STAGE(PG8_SA(0, 1), cA + hstep, voffA);
        if (wr == 1) PG8_BAR;
        PG8_WAIT_V(4); PG8_BAR;
        PG8_STAGE(PG8_SB(1, 0), cB + kstep, voffB); PG8_STAGE(PG8_SA(1, 0), cA + kstep, voffA); PG8_STAGE(PG8_SB(1, 1), cB + hstep + kstep, voffB);
        PG8_WAIT_V(6); PG8_BAR;
    }
    for (;;) {
        const bool has_next = S.next(ui + 1, nxt);
        const char* nA = has_next ? (const char*)g.A + (size_t)nxt.pm * tstep : cA; const char* nB = has_next ? (const char*)g.Bt + S.b_off(nxt) + (size_t)nxt.pn * tstep : cB;
        for (int t = 0; t < nt; t += 2) {
            const bool last = (t == nt - 2);
            const char* a1 = cA + (size_t)(t + 1) * kstep;
            const char* a2 = last ? nA : cA + (size_t)(t + 2) * kstep; const char* b2 = last ? nB : cB + (size_t)(t + 2) * kstep;
            const char* a3 = a2 + kstep; const char* b3 = b2 + kstep;
            if (last && has_next) S.a_ready(nxt);
            if constexpr (SP2) {
            PG8_LDB(B0, 0, 0); PG8_LDB(B1, 0, 1); PG8_SCHED; PG8_LDA(At, 0, 0); PG8_STAGE(PG8_SA(1, 1), a1 + hstep, voffA);
            PG8_WAIT_V(8); PG8_WAIT_L(0); PG8_BAR; PG8_MMA(0, 0, At, B0); PG8_MMA(0, 1, At, B1); PG8_BAR; PG8_SCHED;
            PG8_LDA(At, 0, 1); PG8_STAGE(PG8_SB(0, 0), b2, voffB); PG8_STAGE(PG8_SB(0, 1), b2 + hstep, voffB); PG8_STAGE(PG8_SA(0, 0), a2, voffA);
            PG8_WAIT_V(8); PG8_WAIT_L(0); PG8_BAR; PG8_MMA(1, 0, At, B0); PG8_MMA(1, 1, At, B1); PG8_BAR; PG8_SCHED;
            PG8_LDB(B0, 1, 0); PG8_LDB(B1, 1, 1); PG8_SCHED; PG8_LDA(At, 1, 0); PG8_STAGE(PG8_SA(0, 1), a2 + hstep, voffA);
            PG8_WAIT_V(8); PG8_WAIT_L(0); PG8_BAR; PG8_MMA(0, 0, At, B0); PG8_MMA(0, 1, At, B1); PG8_BAR; PG8_SCHED;
            PG8_LDA(At, 1, 1); PG8_STAGE(PG8_SB(1, 0), b3, voffB); PG8_STAGE(PG8_SB(1, 1), b3 + hstep, voffB); PG8_STAGE(PG8_SA(1, 0), a3, voffA);
            PG8_WAIT_V(8); PG8_WAIT_L(0); PG8_BAR; PG8_MMA(1, 0, At, B0); PG8_MMA(1, 1, At, B1); PG8_BAR; PG8_SCHED;
            } else {
            PG8_LDB(B0, 0, 0); PG8_SCHED; PG8_LDA(At, 0, 0); PG8_STAGE(PG8_SA(1, 1), a1 + hstep, voffA);
            PG8_WAIT_L(8); PG8_BAR; PG8_WAIT_L(0); PG8_MMA(0, 0, At, B0); PG8_BAR; PG8_SCHED;
            PG8_LDB(B1, 0, 1); PG8_STAGE(PG8_SB(0, 0), b2, voffB);
            PG8_BAR; PG8_WAIT_L(0); PG8_MMA(0, 1, At, B1); PG8_BAR;
            PG8_LDA(At, 0, 1); PG8_STAGE(PG8_SA(0, 0), a2, voffA);
            PG8_BAR; PG8_WAIT_L(0); PG8_MMA(1, 0, At, B0); PG8_BAR; PG8_SCHED;
            PG8_STAGE(PG8_SB(0, 1), b2 + hstep, voffB);
            PG8_WAIT_V(6); PG8_BAR; PG8_MMA(1, 1, At, B1); PG8_BAR;
            PG8_LDB(B0, 1, 0); PG8_SCHED; PG8_LDA(At, 1, 0); PG8_STAGE(PG8_SA(0, 1), a2 + hstep, voffA);
            PG8_WAIT_L(8); PG8_BAR; PG8_WAIT_L(0); PG8_MMA(0, 0, At, B0); PG8_BAR; PG8_SCHED;
            PG8_LDB(B1, 1, 1); PG8_STAGE(PG8_SB(1, 0), b3, voffB);
            PG8_BAR; PG8_WAIT_L(0); PG8_MMA(0, 1, At, B1); PG8_BAR;
            PG8_LDA(At, 1, 1); PG8_STAGE(PG8_SA(1, 0), a3, voffA);
            PG8_BAR; PG8_WAIT_L(0); PG8_MMA(1, 0, At, B0); PG8_BAR; PG8_SCHED;
            PG8_STAGE(PG8_SB(1, 1), b3 + hstep, voffB);
            PG8_WAIT_V(6); PG8_BAR; PG8_MMA(1, 1, At, B1); PG8_BAR;
            }
        }
        if constexpr (ALIGN_EPI) { if (wr == 0) PG8_BAR; }
        if constexpr (FP8) { asm volatile("s_nop 15\n\ts_nop 7" ::: "memory"); PG8_SCHED; }
        if constexpr (!Epi::AFTER_DRAIN) { E(acc, cur, wr, wc, fr, fq); S.done(cur); }
        if (!has_next) break;
#pragma unroll
        for (int a = 0; a < 2; ++a)
#pragma unroll
            for (int b = 0; b < 2; ++b)
#pragma unroll
                for (int m = 0; m < 4; ++m)
#pragma unroll
                    for (int n = 0; n < 2; ++n) acc[a][b][m][n] = (f32x4){0.f, 0.f, 0.f, 0.f};
        cur = nxt; cA = nA; cB = nB; ++ui;
        if constexpr (ALIGN_EPI) { if (wr == 1) PG8_BAR; }
    }
    PG8_WAIT_V(0);
    if constexpr (!ALIGN_EPI) { if (wr == 0) PG8_BAR; }
    PG8_BAR;
    if constexpr (Epi::AFTER_DRAIN) { E.fused(acc, cur, wr, wc, fr, fq, lds, wid, lane); S.done(cur); }
#undef PG8_SA
#undef PG8_SB
#undef PG8_STAGE
#undef PG8_LDA
#undef PG8_LDB
#undef PG8_MMA
#undef PG8_WAIT_V
#undef PG8_WAIT_L
#undef PG8_BAR
#undef PG8_SCHED
}
}
namespace at {
using bf16 = __hip_bfloat16;
constexpr int   D = 128, NW = 8, QBLK = 32, KVBLK = 64;
constexpr float SCALE = 0.088388347648318440f;
constexpr float THR = 8.f;
constexpr int SDEPTH = 2;
constexpr size_t SHM_V = KVBLK * D * 2, SHM_K = KVBLK * D * 2, SHM_ATTN = 2 * SHM_V + 2 * SHM_K + NW * 64 * 4;
using bf16x8 = __attribute__((ext_vector_type(8))) short;
using s16x4  = __attribute__((ext_vector_type(4))) short;
using f32x16 = __attribute__((ext_vector_type(16))) float;
using f32x8  = __attribute__((ext_vector_type(8))) float;
using u32x4  = __attribute__((ext_vector_type(4))) unsigned;
#define KSWZ(row, colB) ((row) * 256 + ((colB) ^ (((row) & 7) << 4)))
#define SBAR() __builtin_amdgcn_sched_barrier(0)
__device__ __forceinline__ int crow(int r, int hi) { return (r & 3) + 8 * (r >> 2) + 4 * hi; }
__device__ __forceinline__ unsigned cvtpk(float lo, float hi) {
  unsigned r; asm volatile("v_cvt_pk_bf16_f32 %0, %1, %2" : "=v"(r) : "v"(lo), "v"(hi)); return r;
}
template <typename TIn> struct Stage;
template <> struct Stage<bf16>  { using T = bf16x8;
  __device__ static __forceinline__ T ld8(const bf16* p) { return *reinterpret_cast<const bf16x8*>(p); }
  __device__ static __forceinline__ bf16x8 tobf(T x) { return x; } };
template <> struct Stage<float> { using T = f32x8;
  __device__ static __forceinline__ T ld8(const float* p) { return *reinterpret_cast<const f32x8*>(p); }
  __device__ static __forceinline__ bf16x8 tobf(T x) {
    u32x4 w = {cvtpk(x[0], x[1]), cvtpk(x[2], x[3]), cvtpk(x[4], x[5]), cvtpk(x[6], x[7])}; return *reinterpret_cast<bf16x8*>(&w); } };

__device__ __forceinline__ void partialSM(f32x16& p0, f32x16& p1, float& m_reg, float& mn, float& alpha) {
  constexpr float C = SCALE * 1.4426950408889634f;
  float pmax = p0[0]; for (int r = 1; r < 16; ++r) pmax = fmaxf(pmax, p0[r]); for (int r = 0; r < 16; ++r) pmax = fmaxf(pmax, p1[r]);
  { auto rr = __builtin_amdgcn_permlane32_swap(__float_as_uint(pmax), __float_as_uint(pmax), false, false);
    pmax = fmaxf(__uint_as_float(rr[0]), __uint_as_float(rr[1])); }
  if (__builtin_expect(__all(pmax - m_reg <= THR / SCALE), 1)) { mn = m_reg; alpha = 1.f; }
  else { mn = fmaxf(m_reg, pmax); alpha = __builtin_amdgcn_exp2f((m_reg - mn) * C); m_reg = mn; }
  float mnC = -mn * C;
  for (int r = 0; r < 16; ++r) p0[r] = fmaf(p0[r], C, mnC); for (int r = 0; r < 16; ++r) p1[r] = fmaf(p1[r], C, mnC);
  for (int r = 0; r < 16; ++r) p0[r] = __builtin_amdgcn_exp2f(p0[r]);
}
__device__ __forceinline__ void finishSM(f32x16& p0, f32x16& p1, float alpha, float& l_reg, bf16x8& pa0, bf16x8& pa1, bf16x8& pa2, bf16x8& pa3) {
  for (int r = 0; r < 16; ++r) p1[r] = __builtin_amdgcn_exp2f(p1[r]);
  float ps = 0; for (int r = 0; r < 16; ++r) ps += p0[r]; for (int r = 0; r < 16; ++r) ps += p1[r];
  { auto rr = __builtin_amdgcn_permlane32_swap(__float_as_uint(ps), __float_as_uint(ps), false, false);
    ps = __uint_as_float(rr[0]) + __uint_as_float(rr[1]); }
  l_reg = l_reg * alpha + ps;
#define PK4(P, BASE, OUT) do { unsigned a0 = cvtpk(P[BASE + 0], P[BASE + 1]), a1 = cvtpk(P[BASE + 2], P[BASE + 3]);   \
    unsigned b0 = cvtpk(P[BASE + 4], P[BASE + 5]), b1 = cvtpk(P[BASE + 6], P[BASE + 7]);                              \
    auto r0 = __builtin_amdgcn_permlane32_swap(a0, b0, false, false); auto r1 = __builtin_amdgcn_permlane32_swap(a1, b1, false, false); \
    u32x4 w = {r0[0], r1[0], r0[1], r1[1]}; OUT = *reinterpret_cast<bf16x8*>(&w); } while (0)
  PK4(p0, 0, pa0); PK4(p0, 8, pa1); PK4(p1, 0, pa2); PK4(p1, 8, pa3);
#undef PK4
}
__device__ __forceinline__ void qkt(f32x16& p0, f32x16& p1, const bf16* Ks, const bf16x8* qr, int r32, int hi) {
  p0 = f32x16{}; p1 = f32x16{};
  for (int d0 = 0; d0 < 8; ++d0) { int cb = (d0 * 16 + hi * 8) * 2;
    bf16x8 b0 = *reinterpret_cast<const bf16x8*>((const char*)Ks + KSWZ(r32, cb));
    bf16x8 b1 = *reinterpret_cast<const bf16x8*>((const char*)Ks + KSWZ(32 + r32, cb));
    p0 = __builtin_amdgcn_mfma_f32_32x32x16_bf16(b0, qr[d0], p0, 0, 0, 0);
    p1 = __builtin_amdgcn_mfma_f32_32x32x16_bf16(b1, qr[d0], p1, 0, 0, 0); }
}
__device__ __forceinline__ int v_st(int k, int c) { const int kk = (k & ~0xC) | ((k & 4) << 1) | ((k & 8) >> 1); return ((kk >> 3) * 4 + (c >> 5)) * 512 + ((kk & 7) * 32 + (c & 31)) * 2; }
__device__ __forceinline__ int v_rd_base(int lane) { return ((lane & 3) << 3) | (((lane >> 2) & 3) << 6) | (((lane >> 4) & 1) << 5) | (((lane >> 5) & 1) << 8); }
constexpr int v_rd_off(int d0, int ks, int half) { return d0 * 512 + ks * 4096 + half * 2048; }
template <int OFF> __device__ __forceinline__ s16x4 tr_read(int vb) {
  s16x4 r; asm volatile("ds_read_b64_tr_b16 %0, %1 offset:%2" : "=&v"(r) : "v"(vb), "i"(OFF) : "memory"); return r;
}
template <int D0> __device__ __forceinline__ void pv_one(f32x16& od, int vb, bf16x8 pa0, bf16x8 pa1, bf16x8 pa2, bf16x8 pa3) {
  const s16x4 l0 = tr_read<v_rd_off(D0, 0, 0)>(vb), h0 = tr_read<v_rd_off(D0, 0, 1)>(vb), l1 = tr_read<v_rd_off(D0, 1, 0)>(vb), h1 = tr_read<v_rd_off(D0, 1, 1)>(vb);
  const s16x4 l2 = tr_read<v_rd_off(D0, 2, 0)>(vb), h2 = tr_read<v_rd_off(D0, 2, 1)>(vb), l3 = tr_read<v_rd_off(D0, 3, 0)>(vb), h3 = tr_read<v_rd_off(D0, 3, 1)>(vb);
  asm volatile("s_waitcnt lgkmcnt(0)" ::: "memory"); SBAR();
#define PK(L, H) (bf16x8){L[0], L[1], L[2], L[3], H[0], H[1], H[2], H[3]}
  od = __builtin_amdgcn_mfma_f32_32x32x16_bf16(pa0, PK(l0, h0), od, 0, 0, 0);
  od = __builtin_amdgcn_mfma_f32_32x32x16_bf16(pa1, PK(l1, h1), od, 0, 0, 0);
  od = __builtin_amdgcn_mfma_f32_32x32x16_bf16(pa2, PK(l2, h2), od, 0, 0, 0);
  od = __builtin_amdgcn_mfma_f32_32x32x16_bf16(pa3, PK(l3, h3), od, 0, 0, 0);
#undef PK
}
__device__ __forceinline__ void pv_d0(f32x16* o, int vb, bf16x8 pa0, bf16x8 pa1, bf16x8 pa2, bf16x8 pa3) {
  pv_one<0>(o[0], vb, pa0, pa1, pa2, pa3); pv_one<1>(o[1], vb, pa0, pa1, pa2, pa3); pv_one<2>(o[2], vb, pa0, pa1, pa2, pa3); pv_one<3>(o[3], vb, pa0, pa1, pa2, pa3);
}

template <int LDQ, int LDK, int LDV, int LDO>
__device__ __forceinline__ void attn_dense_body(const bf16* __restrict__ Qb, const bf16* __restrict__ Kh, const bf16* __restrict__ Vh,
                                                unsigned char* __restrict__ Ob, int seq, char* lds) {
  using St = Stage<bf16>; using SQ = Stage<bf16>;
  const int tid = threadIdx.x, wid = tid >> 6, lane = tid & 63, r32 = lane & 31, hi = lane >> 5;
  bf16* V_lds = (bf16*)lds; bf16* K_lds = (bf16*)(lds + 2 * SHM_V);
  float* ws = (float*)(lds + 2 * SHM_V + 2 * SHM_K) + wid * 64; float* li_l = ws; float* al_l = ws + 32;
  float m_reg = -1e30f, l_reg = 0; f32x16 o[4] = {}; bf16x8 qr[8];
  const bf16* Qw = Qb + (long)(wid * QBLK + r32) * LDQ + hi * 8;
#pragma unroll
  for (int d0 = 0; d0 < 8; ++d0) qr[d0] = SQ::tobf(SQ::ld8(Qw + d0 * 16));
  const int sr = tid >> 4, sc = (tid & 15) * 8, vst0 = v_st(sr, sc), vst1 = v_st(32 + sr, sc);
  const int vb0 = (int)(uintptr_t)V_lds + v_rd_base(lane);
  struct { typename St::T vs0, vs1, ks0, ks1; } sr_[SDEPTH];
#define SLOAD(i, k0) do { sr_[i].vs0 = St::ld8(&Vh[(long)((k0) + sr) * LDV + sc]); sr_[i].vs1 = St::ld8(&Vh[(long)((k0) + 32 + sr) * LDV + sc]); \
    sr_[i].ks0 = St::ld8(&Kh[(long)((k0) + sr) * LDK + sc]); sr_[i].ks1 = St::ld8(&Kh[(long)((k0) + 32 + sr) * LDK + sc]); } while (0)
#define SWRITE(b, i) do { *(bf16x8*)((char*)V_lds + (b) * SHM_V + vst0) = St::tobf(sr_[i].vs0);          \
    *(bf16x8*)((char*)V_lds + (b) * SHM_V + vst1) = St::tobf(sr_[i].vs1); int kc = sc * 2;               \
    *(bf16x8*)((char*)K_lds + (b) * SHM_K + KSWZ(sr, kc)) = St::tobf(sr_[i].ks0);                       \
    *(bf16x8*)((char*)K_lds + (b) * SHM_K + KSWZ(32 + sr, kc)) = St::tobf(sr_[i].ks1); } while (0)
#define SWAIT() do { if constexpr (SDEPTH == 2) asm volatile("s_waitcnt vmcnt(4)" ::: "memory"); else asm volatile("s_waitcnt vmcnt(0)" ::: "memory"); } while (0)
#define RESC(a) do { if (__any((a) < 1.f)) { if (hi == 0) al_l[r32] = (a); asm volatile("s_waitcnt lgkmcnt(0)" ::: "memory"); \
    for (int d = 0; d < 4; ++d) for (int r = 0; r < 16; ++r) o[d][r] *= al_l[crow(r, hi)]; } } while (0)
  f32x16 pA0, pA1, pB0, pB1; float mnA, mnB, alA, alB; bf16x8 pa0, pa1, pa2, pa3; const int NT = seq / KVBLK;
  constexpr int SE = 0, SO = SDEPTH - 1;
  SLOAD(SE, 0); asm volatile("s_waitcnt vmcnt(0)" ::: "memory"); SWRITE(0, SE); __syncthreads();
  qkt(pA0, pA1, K_lds, qr, r32, hi); partialSM(pA0, pA1, m_reg, mnA, alA);
  SLOAD(SO, KVBLK); if constexpr (SDEPTH == 2) { if (2 < NT) SLOAD(SE, 2 * KVBLK); }
  SWAIT(); SWRITE(1, SO); __syncthreads();
  for (int j = 1; j + 1 < NT; j += 2) {
    SBAR(); qkt(pB0, pB1, (bf16*)((char*)K_lds + SHM_K), qr, r32, hi);
    finishSM(pA0, pA1, alA, l_reg, pa0, pa1, pa2, pa3); SBAR();
    SLOAD(SO, (j + SDEPTH) * KVBLK); SBAR();
    pv_d0(o, vb0, pa0, pa1, pa2, pa3); partialSM(pB0, pB1, m_reg, mnB, alB);
    __syncthreads(); SWAIT(); SWRITE(0, SE);
    RESC(alB); __syncthreads();
    SBAR(); qkt(pA0, pA1, K_lds, qr, r32, hi);
    finishSM(pB0, pB1, alB, l_reg, pa0, pa1, pa2, pa3); SBAR();
    if (SDEPTH == 1 || j + 3 < NT) SLOAD(SE, (j + 1 + SDEPTH) * KVBLK); SBAR();
    pv_d0(o, vb0 + (int)SHM_V, pa0, pa1, pa2, pa3); partialSM(pA0, pA1, m_reg, mnA, alA);
    __syncthreads(); SWAIT(); SWRITE(1, SO);
    RESC(alA); __syncthreads();
  }
  SBAR(); qkt(pB0, pB1, (bf16*)((char*)K_lds + SHM_K), qr, r32, hi);
  finishSM(pA0, pA1, alA, l_reg, pa0, pa1, pa2, pa3); SBAR();
  pv_d0(o, vb0, pa0, pa1, pa2, pa3); partialSM(pB0, pB1, m_reg, mnB, alB);
  __syncthreads(); RESC(alB);
  finishSM(pB0, pB1, alB, l_reg, pa0, pa1, pa2, pa3); SBAR();
  pv_d0(o, vb0 + (int)SHM_V, pa0, pa1, pa2, pa3);
  if (hi == 0) li_l[r32] = l_reg; asm volatile("s_waitcnt lgkmcnt(0)" ::: "memory");
  float rli[16];
#pragma unroll
  for (int r = 0; r < 16; ++r) rli[r] = __builtin_amdgcn_rcpf(li_l[crow(r, hi)]);
  unsigned char* Ow = Ob + (long)(wid * QBLK) * LDO;
#pragma unroll
  for (int r = 0; r < 16; ++r) { int orow = crow(r, hi);
    for (int d0 = 0; d0 < 4; ++d0) Ow[(long)orow * LDO + d0 * 32 + r32] = (unsigned char)(__builtin_amdgcn_cvt_pk_fp8_f32(o[d0][r] * rli[r] * 64.0f, 0.f, 0, false) & 0xff); }
#undef SLOAD
#undef SWRITE
#undef SWAIT
#undef RESC
}


__device__ __forceinline__ void dilated_unit(const bf16* __restrict__ proj, const float* __restrict__ lutg, bf16* __restrict__ outg, float* __restrict__ lseg,
                                             int d, int hd12, int hh, int r, int i0, char* lds) {
  constexpr int LDP = 10240;
  constexpr float L2E = 1.4426950408889634f, C = SCALE * L2E;
  const int tid = threadIdx.x, wid = tid >> 6, lane = tid & 63, r32 = lane & 31, hi = lane >> 5;
  const int n = 8192 / d;
  char* KV = lds;
  float* lutx = (float*)(lds + 98304);
  float* wsx = (float*)(lds + 98304 + 2048) + wid * 64;
  const int qoff = hd12 * 128, koff = 1536 + hd12 * 128;
  if (tid < 320) { const int o = tid - 96; lutx[tid] = (o >= 0 && o <= 128) ? lutg[o] * L2E : -1e30f; }
  const int iq = i0 + wid * 32 + r32;
  const int sr = tid >> 4, sc = (tid & 15) * 8;
  f32x16 s00, s01, s10, s11, s20, s21;
  const int a = wid >> 1;
  {
    const bf16* Qw = proj + (size_t)(r + iq * d) * LDP + qoff + hi * 8;
    bf16x8 qr[8];
#pragma unroll
    for (int d0 = 0; d0 < 8; ++d0) qr[d0] = *reinterpret_cast<const bf16x8*>(Qw + d0 * 16);
#pragma unroll
    for (int ib = 0; ib < 12; ib += 6) {
      bf16x8 kv6[6];
#pragma unroll
      for (int i = 0; i < 6; ++i) { const int row = sr + 32 * (ib + i); int j = i0 - 64 + row; j = j < 0 ? 0 : (j >= n ? n - 1 : j);
        kv6[i] = *reinterpret_cast<const bf16x8*>(proj + (size_t)(r + j * d) * LDP + koff + sc); }
#pragma unroll
      for (int i = 0; i < 6; ++i) { const int row = sr + 32 * (ib + i);
        *reinterpret_cast<bf16x8*>(KV + (row >> 6) * 16384 + KSWZ(row & 63, sc * 2)) = kv6[i]; }
      SBAR();
    }
    __syncthreads();
    qkt(s00, s01, (const bf16*)(KV + (a + 0) * 16384), qr, r32, hi);
    qkt(s10, s11, (const bf16*)(KV + (a + 1) * 16384), qr, r32, hi);
    qkt(s20, s21, (const bf16*)(KV + (a + 2) * 16384), qr, r32, hi);
  }
  __syncthreads();
  SBAR();
  const int base = -32 * (wid & 1) - 64 - r32 + 4 * hi;
  const float* lp = lutx + (base + 160);
  float mx = -1e30f;
#define DIL_LOGITS(S, TT, HALF) _Pragma("unroll") for (int rr = 0; rr < 16; ++rr) { const float v = fmaf(S[rr], C, lp[64 * TT + 32 * HALF + (rr & 3) + 8 * (rr >> 2)]); S[rr] = v; }
  DIL_LOGITS(s00, 0, 0) DIL_LOGITS(s01, 0, 1) DIL_LOGITS(s10, 1, 0) DIL_LOGITS(s11, 1, 1) DIL_LOGITS(s20, 2, 0) DIL_LOGITS(s21, 2, 1)
#undef DIL_LOGITS
  if (i0 == 0 || i0 + 320 > n) {
    const int lo = -iq - base, hi_ = n - 1 - iq - base;
#define DIL_MASK(S, TT, HALF) _Pragma("unroll") for (int rr = 0; rr < 16; ++rr) { const int c = 64 * TT + 32 * HALF + (rr & 3) + 8 * (rr >> 2); S[rr] = (c >= lo && c <= hi_) ? S[rr] : -1e30f; }
    DIL_MASK(s00, 0, 0) DIL_MASK(s01, 0, 1) DIL_MASK(s10, 1, 0) DIL_MASK(s11, 1, 1) DIL_MASK(s20, 2, 0) DIL_MASK(s21, 2, 1)
#undef DIL_MASK
  }
#define DIL_MAX(S) _Pragma("unroll") for (int rr = 0; rr < 16; ++rr) mx = fmaxf(mx, S[rr]);
  DIL_MAX(s00) DIL_MAX(s01) DIL_MAX(s10) DIL_MAX(s11) DIL_MAX(s20) DIL_MAX(s21)
#undef DIL_MAX
  { auto rr = __builtin_amdgcn_permlane32_swap(__float_as_uint(mx), __float_as_uint(mx), false, false);
    mx = fmaxf(__uint_as_float(rr[0]), __uint_as_float(rr[1])); }
  float ps = 0.f;
#define DIL_EXP(S) _Pragma("unroll") for (int rr = 0; rr < 16; ++rr) { const float p = __builtin_amdgcn_exp2f(S[rr] - mx); S[rr] = p; ps += p; }
  DIL_EXP(s00) DIL_EXP(s01) DIL_EXP(s10) DIL_EXP(s11) DIL_EXP(s20) DIL_EXP(s21)
#undef DIL_EXP
  { auto rr = __builtin_amdgcn_permlane32_swap(__float_as_uint(ps), __float_as_uint(ps), false, false);
    ps = __uint_as_float(rr[0]) + __uint_as_float(rr[1]); }
  bf16x8 pa[12];
#define PK4(P, BASE, OUT) do { unsigned a0 = cvtpk(P[BASE + 0], P[BASE + 1]), a1 = cvtpk(P[BASE + 2], P[BASE + 3]);   \
    unsigned b0 = cvtpk(P[BASE + 4], P[BASE + 5]), b1 = cvtpk(P[BASE + 6], P[BASE + 7]);                              \
    auto r0 = __builtin_amdgcn_permlane32_swap(a0, b0, false, false); auto r1 = __builtin_amdgcn_permlane32_swap(a1, b1, false, false); \
    u32x4 w = {r0[0], r1[0], r0[1], r1[1]}; OUT = *reinterpret_cast<bf16x8*>(&w); } while (0)
  PK4(s00, 0, pa[0]); PK4(s00, 8, pa[1]); PK4(s01, 0, pa[2]); PK4(s01, 8, pa[3]);
  PK4(s10, 0, pa[4]); PK4(s10, 8, pa[5]); PK4(s11, 0, pa[6]); PK4(s11, 8, pa[7]);
  PK4(s20, 0, pa[8]); PK4(s20, 8, pa[9]); PK4(s21, 0, pa[10]); PK4(s21, 8, pa[11]);
#undef PK4
  SBAR();
#pragma unroll
  for (int ib = 0; ib < 12; ib += 6) {
    bf16x8 kv6[6];
#pragma unroll
    for (int i = 0; i < 6; ++i) { const int row = sr + 32 * (ib + i); int j = i0 - 64 + row; j = j < 0 ? 0 : (j >= n ? n - 1 : j);
      kv6[i] = *reinterpret_cast<const bf16x8*>(proj + (size_t)(r + j * d) * LDP + koff + 1536 + sc); }
#pragma unroll
    for (int i = 0; i < 6; ++i) { const int row = sr + 32 * (ib + i);
      *reinterpret_cast<bf16x8*>(KV + (row >> 6) * 16384 + v_st(row & 63, sc)) = kv6[i]; }
    SBAR();
  }
  if (hi == 0) wsx[r32] = ps;
  __syncthreads();
  f32x16 o[4] = {};
  const int vb = (int)(uintptr_t)KV + v_rd_base(lane);
  pv_d0(o, vb + (a + 0) * 16384, pa[0], pa[1], pa[2], pa[3]);
  pv_d0(o, vb + (a + 1) * 16384, pa[4], pa[5], pa[6], pa[7]);
  pv_d0(o, vb + (a + 2) * 16384, pa[8], pa[9], pa[10], pa[11]);
  float rli[16];
#pragma unroll
  for (int rr = 0; rr < 16; ++rr) rli[rr] = __builtin_amdgcn_rcpf(wsx[crow(rr, hi)]);
#pragma unroll
  for (int rr = 0; rr < 16; ++rr) { const int ir = i0 + wid * 32 + crow(rr, hi); bf16* orow = outg + (size_t)(r + ir * d) * 512 + hh * 128 + r32;
#pragma unroll
    for (int d0 = 0; d0 < 4; ++d0) orow[d0 * 32] = __float2bfloat16(o[d0][rr] * rli[rr]); }
  if (hi == 0) lseg[(size_t)(r + iq * d) * 4 + hh] = (mx + __builtin_amdgcn_logf(ps)) * 0.6931471805599453f;
  __syncthreads();
}
}

#define GAS __attribute__((address_space(1)))
#define LAS __attribute__((address_space(3)))
typedef unsigned short bf16;
typedef unsigned v4u __attribute__((ext_vector_type(4)));
typedef unsigned v2u __attribute__((ext_vector_type(2)));
typedef float f32x4 __attribute__((ext_vector_type(4)));
#define LDS_WAIT() asm volatile("s_waitcnt lgkmcnt(0)" ::: "memory")
#define VM_WAIT() asm volatile("s_waitcnt vmcnt(0)" ::: "memory")
__device__ __forceinline__ unsigned pk2(float lo, float hi) { return pg8::cvt_pk_bf16(lo, hi); }
__device__ __forceinline__ float bflo(unsigned w) { return __builtin_bit_cast(float, w << 16); }
__device__ __forceinline__ float bfhi(unsigned w) { return __builtin_bit_cast(float, w & 0xffff0000u); }
#ifndef MK_Q8
#define MK_Q8 0
#endif
__device__ __forceinline__ unsigned pk4_fp8(float a, float b, float c, float d) {
    int w = __builtin_amdgcn_cvt_pk_fp8_f32(a, b, 0, false); w = __builtin_amdgcn_cvt_pk_fp8_f32(c, d, w, true); return (unsigned)w; }
__device__ __forceinline__ float q8f(float v) { const int p = __builtin_amdgcn_cvt_pk_fp8_f32(v, v, 0, false); return __builtin_amdgcn_cvt_f32_fp8(p, 0); }
__device__ __forceinline__ float bf2f(bf16 b) { return __builtin_bit_cast(float, ((unsigned)b) << 16); }

#define XB_TMO      128
#define XB_XCNT(j)  (256  + 64 * (j))
#define XB_XSUB(j)  (1280 + 64 * (j))
#define XB_XGEN(j)  (2304 + 64 * (j))
#define XB_TOP      3328
#define XB_TOPGEN   3392
#define XCD_BAR_WORDS 3456
#define XB_SPIN_CAP (1u << 18)

__device__ __forceinline__ unsigned xb_ld(unsigned* p)              { return __hip_atomic_load(p, __ATOMIC_RELAXED, __HIP_MEMORY_SCOPE_AGENT); }
__device__ __forceinline__ unsigned xb_add(unsigned* p, unsigned v) { return __hip_atomic_fetch_add(p, v, __ATOMIC_RELAXED, __HIP_MEMORY_SCOPE_AGENT); }
__device__ __forceinline__ unsigned xb_xcc_id() { return (unsigned)__builtin_amdgcn_s_getreg((3 << 11) | 20) & 0xFu; }
#define XB_SPIN(cond, bar) do { unsigned _sp = 0; while (cond) { __builtin_amdgcn_s_sleep(1); \
    if ((++_sp & 255u) == 0u) { if (xb_ld(&(bar)[XB_TMO])) break; if (_sp > XB_SPIN_CAP) { atomicAdd(&(bar)[XB_TMO], 1u); break; } } } } while (0)

struct XcdBarrier {
    unsigned* bar; unsigned x;
    volatile LAS unsigned* st;
};

__device__ __forceinline__ XcdBarrier xcd_barrier_post(unsigned* bar, volatile LAS unsigned* st) {
    XcdBarrier b; b.bar = bar; b.x = xb_xcc_id(); b.st = st;
    if (threadIdx.x == 0) (void)xb_add(&bar[XB_XCNT(b.x)], 1u);
    return b;
}
__device__ __forceinline__ void xcd_barrier_complete(unsigned* bar, unsigned x, unsigned& nloc, unsigned& nx) {
    const unsigned G = gridDim.x * gridDim.y * gridDim.z;
    unsigned sum, cnt, mine, sp = 0u;
    for (;;) {
        sum = 0u; cnt = 0u; mine = 0u;
#pragma unroll
        for (unsigned j = 0; j < 16; ++j) { const unsigned c = xb_ld(&bar[XB_XCNT(j)]); sum += c; cnt += (c > 0u) ? 1u : 0u; mine = (j == x) ? c : mine; }
        if (sum == G) break;
        __builtin_amdgcn_s_sleep(1);
        if ((++sp & 255u) == 0u) { if (xb_ld(&bar[XB_TMO])) break; if (sp > XB_SPIN_CAP) { atomicAdd(&bar[XB_TMO], 1u); break; } }
    }
    nloc = mine > 0u ? mine : 1u; nx = cnt > 0u ? cnt : 1u;
}

__device__ __forceinline__ void xcd_barrier(const XcdBarrier& b) {
    asm volatile("s_waitcnt vmcnt(0)" ::: "memory");
    __syncthreads();
    if (threadIdx.x == 0) {
        unsigned* bar = b.bar;
        __builtin_amdgcn_s_waitcnt(0);
        unsigned nloc = b.st[0], nx = b.st[1];
        if (nloc == 0u) { xcd_barrier_complete(bar, b.x, nloc, nx); b.st[0] = nloc; b.st[1] = nx; }
        const unsigned old = xb_add(&bar[XB_XSUB(b.x)], 1u);
        const unsigned gen = old / nloc;
        if (old + 1u == (gen + 1u) * nloc) {
            __builtin_amdgcn_fence(__ATOMIC_RELEASE, "agent");
            asm volatile("s_waitcnt vmcnt(0)" ::: "memory");
            const unsigned og = xb_add(&bar[XB_TOP], 1u);
            const unsigned tg = og / nx;
            if (og + 1u == (tg + 1u) * nx) xb_add(&bar[XB_TOPGEN], 1u);
            else XB_SPIN(xb_ld(&bar[XB_TOPGEN]) == tg, bar);
            __builtin_amdgcn_fence(__ATOMIC_ACQUIRE, "agent");
            xb_add(&bar[XB_XGEN(b.x)], 1u);
            asm volatile("s_waitcnt vmcnt(0)" ::: "memory");
        } else {
            XB_SPIN(xb_ld(&bar[XB_XGEN(b.x)]) == gen, bar);
            __builtin_amdgcn_fence(__ATOMIC_ACQUIRE, "agent");
            asm volatile("s_waitcnt vmcnt(0)" ::: "memory");
        }
    }
    __syncthreads();
}

constexpr int S_ = 8192, DM = 2048, INW = 10240, NE = 32, TOPK = 4;
constexpr int A_W = 1536, A_V_OFF = 3072, B_Q_OFF = 4608, B_K_OFF = 5632, B_V_OFF = 5888, GATE_OFF = 6144;
constexpr int MAXSLOT = 40960;
constexpr float LN_EPS = 1e-5f, QK_EPS = 1e-6f;
constexpr float ALPHA = 1.189207115002721f;
constexpr int NPH = 11;

constexpr size_t MiB = 1u << 20;
constexpr size_t WS_CTL = 0, CTL_ZERO_BYTES = 64 * 1024;
constexpr int CW_BAR = 0;
constexpr int CW_CNT = 4096;
constexpr size_t WS_LUT = 1 * MiB;
constexpr size_t WS_ROPE = 1 * MiB + 8192;
constexpr size_t WS_WRT = 1 * MiB + 65536;
constexpr size_t WS_TOKE = 1 * MiB + 65536 + 262144;
constexpr size_t WS_TOKR = WS_TOKE + 131072;
constexpr size_t WS_TOKW = WS_TOKR + 131072;
constexpr size_t WS_TOKS = WS_TOKW + 131072;
constexpr size_t WS_SLOTW = WS_TOKS + 131072;
constexpr size_t WS_LSE = 3 * MiB;
constexpr size_t WS_XB = 4 * MiB;
constexpr size_t WS_WIN = WS_XB + 32 * MiB;
constexpr size_t WS_WA = WS_WIN + 40 * MiB;
constexpr size_t WS_WB = WS_WA + 2 * MiB;
constexpr size_t WS_WO = WS_WB + 4 * MiB;
constexpr size_t WS_WGL = WS_WO + 8 * MiB;
constexpr size_t WS_WD = WS_WGL + 512 * MiB;
constexpr size_t WS_PROJ = WS_WD + 256 * MiB;
constexpr size_t WS_QBR = WS_PROJ + 160 * MiB;
constexpr size_t WS_KBR = WS_QBR + 16 * MiB;
constexpr size_t WS_VBR = WS_KBR + 4 * MiB;
constexpr size_t WS_OUTA = WS_VBR + 4 * MiB;
constexpr size_t WS_YA = WS_OUTA + 24 * MiB;
constexpr size_t WS_YB = WS_YA + 8 * MiB;
constexpr size_t WS_T1 = WS_YB + 16 * MiB;
constexpr size_t WS_Y = WS_T1 + 64 * MiB;
constexpr size_t WS_X1 = WS_Y + 32 * MiB;
constexpr size_t WS_X1B = WS_X1 + 64 * MiB;
constexpr size_t WS_XS = WS_X1B + 32 * MiB;
constexpr size_t WS_H = WS_XS + 160 * MiB;
constexpr size_t WS_YS = WS_PROJ;
constexpr size_t WS_END = WS_H + 160 * MiB;

constexpr int RING_OFF = 0, RING_BYTES = 131072;
constexpr int L_XB = RING_BYTES;
constexpr int L_TILE = RING_BYTES + 64;
constexpr int L_PST = RING_BYTES + 1024;
constexpr int L_CNT = RING_BYTES + 1280;
constexpr int L_ASG = RING_BYTES + 2048;
constexpr int L_PTR = RING_BYTES + 3584;
constexpr int LDS_BYTES = 147456;

struct Frame {
    LAS unsigned char* lds; unsigned char* ldsg;
    unsigned char* ws; unsigned* ctl;
    int tid, lane, wave, G;
};
__device__ __forceinline__ const float* inp(const Frame& F, int i) {
    const LAS unsigned* p = (const LAS unsigned*)(F.lds + L_PTR) + 2 * i;
    const unsigned lo = __builtin_amdgcn_readfirstlane(p[0]), hi = __builtin_amdgcn_readfirstlane(p[1]);
    return (const float*)(((unsigned long long)hi << 32) | lo);
}
__device__ __forceinline__ float wave_sum(float v) {
#pragma unroll
    for (int o = 1; o < 64; o <<= 1) v += __shfl_xor(v, o);
    return v;
}

__device__ __forceinline__ void transpose_item(const float* __restrict__ W, int N, int k0, int n0, bf16* WT, int ldo, int orow0, int ocol0, LAS float* scr, int lane, const bool q8 = false) {
    f32x4 v[8];
#pragma unroll
    for (int i = 0; i < 8; ++i) v[i] = *(const f32x4*)(W + (size_t)(k0 + 8 * i + (lane >> 3)) * N + n0 + 4 * (lane & 7));
#pragma unroll
    for (int i = 0; i < 8; ++i) { LAS float* s = scr + (8 * i + (lane >> 3)) * 33 + 4 * (lane & 7); if (q8) { for (int e = 0; e < 4; ++e) v[i][e] = q8f(v[i][e] * 64.0f) * (1.0f / 64.0f); } s[0] = v[i][0]; s[1] = v[i][1]; s[2] = v[i][2]; s[3] = v[i][3]; }
    LDS_WAIT(); asm volatile("" ::: "memory");
    const int c = lane & 7;
#pragma unroll
    for (int j = 0; j < 4; ++j) { const int n = (lane >> 3) + 8 * j; const LAS float* s = scr + (8 * c) * 33 + n;
        v4u o; o.x = pk2(s[0 * 33], s[1 * 33]); o.y = pk2(s[2 * 33], s[3 * 33]); o.z = pk2(s[4 * 33], s[5 * 33]); o.w = pk2(s[6 * 33], s[7 * 33]);
        *(v4u*)(WT + (size_t)(orow0 + n) * ldo + ocol0 + 8 * c) = o; }
    LDS_WAIT(); asm volatile("" ::: "memory");
}
__device__ __forceinline__ void transpose_item8(const float* __restrict__ W, int N, int k0, int n0, unsigned char* WT, int ldo, int orow0, int ocol0, float scale, LAS float* scr, int lane) {
    f32x4 v[8];
#pragma unroll
    for (int i = 0; i < 8; ++i) v[i] = *(const f32x4*)(W + (size_t)(k0 + 8 * i + (lane >> 3)) * N + n0 + 4 * (lane & 7));
#pragma unroll
    for (int i = 0; i < 8; ++i) { LAS float* s = scr + (8 * i + (lane >> 3)) * 33 + 4 * (lane & 7); s[0] = v[i][0] * scale; s[1] = v[i][1] * scale; s[2] = v[i][2] * scale; s[3] = v[i][3] * scale; }
    LDS_WAIT(); asm volatile("" ::: "memory");
    const int c = lane & 3;
#pragma unroll
    for (int j = 0; j < 2; ++j) { const int n = (lane >> 2) + 16 * j; const LAS float* s = scr + (16 * c) * 33 + n;
        v4u o; o.x = pk4_fp8(s[0 * 33], s[1 * 33], s[2 * 33], s[3 * 33]); o.y = pk4_fp8(s[4 * 33], s[5 * 33], s[6 * 33], s[7 * 33]);
        o.z = pk4_fp8(s[8 * 33], s[9 * 33], s[10 * 33], s[11 * 33]); o.w = pk4_fp8(s[12 * 33], s[13 * 33], s[14 * 33], s[15 * 33]);
        *(v4u*)(WT + (size_t)(orow0 + n) * ldo + ocol0 + 16 * c) = o; }
    LDS_WAIT(); asm volatile("" ::: "memory");
}
__device__ __forceinline__ int t5_bucket(int rel) {
    const int n = rel < 0 ? -rel : rel; const float nf = (float)(n < 1 ? 1 : n);
    int large = 8 + (int)(logf(nf / 8.0f) / 4.852030263919617f * 8.0f); large = large < 15 ? large : 15;
    return (rel > 0 ? 16 : 0) + (n < 8 ? n : large);
}
__device__ __forceinline__ void p0_prologue(Frame& F) {
    LAS float* scr = (LAS float*)(F.lds + RING_OFF + F.wave * 16384);
    const int gw = blockIdx.x * 8 + F.wave, NGW = F.G * 8;
    const int gt = blockIdx.x * 512 + F.tid, NGT = F.G * 512;
    bf16* XB = (bf16*)(F.ws + WS_XB); bf16* WIN = (bf16*)(F.ws + WS_WIN); bf16* WA = (bf16*)(F.ws + WS_WA); bf16* WB = (bf16*)(F.ws + WS_WB); bf16* WO = (bf16*)(F.ws + WS_WO);
    bf16* WGL = (bf16*)(F.ws + WS_WGL); bf16* WD = (bf16*)(F.ws + WS_WD);
    { float* lut = (float*)(F.ws + WS_LUT); const float* rb = inp(F, 3);
      for (int i = gt; i < 3 * 4 * 129; i += NGT) { const int g = i / 516, hh = (i / 129) % 4, j = i % 129; const int d = (g == 0) ? 1 : (g == 1 ? 4 : 16);
          lut[i] = rb[t5_bucket((j - 64) * d) * 12 + g * 4 + hh]; }
      float* rope = (float*)(F.ws + WS_ROPE);
      for (int i = gt; i < 128 * 32; i += NGT) { const int pos = i >> 5, fi = i & 31; const float inv = powf(10000.0f, -(float)(2 * fi) / 64.0f); const float ang = (float)pos * inv;
          rope[2 * i] = __cosf(ang); rope[2 * i + 1] = __sinf(ang); }
      float* wrt = (float*)(F.ws + WS_WRT); const float* wr = inp(F, 11);
      for (int i = gt; i < 32 * 2048; i += NGT) { const int e = i >> 11, c = i & 2047; wrt[i] = wr[c * 32 + e]; }
    }
    { const float* x = inp(F, 0);
      for (int i = gw; i < S_ * DM / 512; i += NGW) { const size_t o = (size_t)i * 512 + F.lane * 8; const f32x4 a = *(const f32x4*)(x + o), b = *(const f32x4*)(x + o + 4);
          v2u w; w.x = pk4_fp8(a[0], a[1], a[2], a[3]); w.y = pk4_fp8(b[0], b[1], b[2], b[3]); *(v2u*)((unsigned char*)XB + o) = w; } }
    constexpr int T_WIN = 16 * 80, T_WA = 4 * 16, T_WB = 8 * 16, T_WO = 16 * 16, T_EXP = 16 * 16, T_MOE = 3 * 32 * T_EXP;
    constexpr int NT = T_WIN + T_WA + T_WB + T_WO + T_MOE;
    const float* const w_in = inp(F, 1); const float* const w_ba = inp(F, 6); const float* const w_bb = inp(F, 7); const float* const w_o = inp(F, 8);
    const float* const w_g = inp(F, 13); const float* const w_l = inp(F, 15); const float* const w_d = inp(F, 17);
#define P0_DECODE(T, SRC, NN, DST, LDO, SCL) do { int r_ = (T); \
        if (r_ < T_WIN) { const int kt = r_ / 80, nt = r_ % 80; SRC = w_in + (size_t)(128 * kt) * INW + 128 * nt; NN = INW; DST = (unsigned char*)WIN + (size_t)(128 * nt) * 2048 + 128 * kt; LDO = 2048; SCL = 64.0f; break; } r_ -= T_WIN; \
        if (r_ < T_WA) { const int kt = r_ / 16, nt = r_ % 16; SRC = w_ba + (size_t)(128 * kt) * DM + 128 * nt; NN = DM; DST = (unsigned char*)WA + (size_t)(128 * nt) * 512 + 128 * kt; LDO = 512; SCL = 32.0f; break; } r_ -= T_WA; \
        if (r_ < T_WB) { const int kt = r_ / 16, nt = r_ % 16; SRC = w_bb + (size_t)(128 * kt) * DM + 128 * nt; NN = DM; DST = (unsigned char*)WB + (size_t)(128 * nt) * 1024 + 128 * kt; LDO = 1024; SCL = 32.0f; break; } r_ -= T_WB; \
        if (r_ < T_WO) { const int kt = r_ / 16, nt = r_ % 16; SRC = w_o + (size_t)(128 * kt) * DM + 128 * nt; NN = DM; DST = (unsigned char*)WO + (size_t)(128 * nt) * 2048 + 128 * kt; LDO = 2048; SCL = 64.0f; break; } r_ -= T_WO; \
        { const int which = r_ / (32 * T_EXP), rr = r_ % (32 * T_EXP), e = rr / T_EXP, q = rr % T_EXP, kt = q / 16, nt = q % 16; \
          SRC = (which == 0 ? w_g : (which == 1 ? w_l : w_d)) + (size_t)e * DM * DM + (size_t)(128 * kt) * DM + 128 * nt; NN = DM; LDO = 2048; SCL = 64.0f; \
          DST = (which < 2) ? (unsigned char*)WGL + ((size_t)e * 4096 + nt * 256 + which * 128) * 2048 + 128 * kt : (unsigned char*)WD + ((size_t)e * 2048 + 128 * nt) * 2048 + 128 * kt; } } while (0)
    const int nq = F.tid & 31, kq0 = F.tid >> 5;
#define P0_LOAD(V, SRC, NN) do { _Pragma("unroll") for (int p = 0; p < 2; ++p) _Pragma("unroll") for (int i = 0; i < 4; ++i) V[p * 4 + i] = *(const f32x4*)(SRC + (size_t)(4 * (kq0 + 16 * p) + i) * NN + 4 * nq); } while (0)
    if ((int)blockIdx.x < NT) {
        const int nj = (NT - (int)blockIdx.x + F.G - 1) / F.G;
        const float* src; int nn; unsigned char* dst; int ldo; float scl;
        P0_DECODE((int)blockIdx.x, src, nn, dst, ldo, scl);
        f32x4 v[8]; P0_LOAD(v, src, nn);
        for (int j = 0; j < nj; ++j) {
            const int jn = (j + 1 < nj) ? j + 1 : j;
            const float* nsrc; int nnn; unsigned char* ndst; int nldo; float nscl;
            P0_DECODE((int)blockIdx.x + jn * F.G, nsrc, nnn, ndst, nldo, nscl);
            f32x4 nv[8]; P0_LOAD(nv, nsrc, nnn);
            LAS unsigned* t32 = (LAS unsigned*)(F.lds + RING_OFF + (j & 1) * 16384);
#pragma unroll
            for (int p = 0; p < 2; ++p)
#pragma unroll
                for (int c = 0; c < 4; ++c) t32[(4 * nq + c) * 32 + ((kq0 + 16 * p) ^ nq)] = pk4_fp8(v[p * 4 + 0][c] * scl, v[p * 4 + 1][c] * scl, v[p * 4 + 2][c] * scl, v[p * 4 + 3][c] * scl);
            __syncthreads();
#pragma unroll
            for (int jj = 0; jj < 2; ++jj) { const int n = (F.tid >> 3) + 64 * jj, c8 = F.tid & 7, g = n >> 2; const LAS unsigned* rp = t32 + n * 32;
                v4u o; o.x = rp[(4 * c8 + 0) ^ g]; o.y = rp[(4 * c8 + 1) ^ g]; o.z = rp[(4 * c8 + 2) ^ g]; o.w = rp[(4 * c8 + 3) ^ g];
                *(v4u*)(dst + (size_t)n * ldo + 16 * c8) = o; }
#pragma unroll
            for (int i = 0; i < 8; ++i) v[i] = nv[i];
            src = nsrc; nn = nnn; dst = ndst; ldo = nldo; scl = nscl;
        }
        __syncthreads();
    }
#undef P0_DECODE
#undef P0_LOAD
}

__device__ __forceinline__ void p2_prep_dilated(Frame& F) {
    const bf16* proj = (const bf16*)(F.ws + WS_PROJ);
    bf16* QBR = (bf16*)(F.ws + WS_QBR); bf16* KBR = (bf16*)(F.ws + WS_KBR); bf16* VBR = (bf16*)(F.ws + WS_VBR);
    const float* rope = (const float*)(F.ws + WS_ROPE);
    const int gw = blockIdx.x * 8 + F.wave, NGW = F.G * 8;
    const int half = F.lane >> 5, fi = F.lane & 31, c1 = half * 64 + fi, c2 = c1 + 32;
    const float* const qn_g = inp(F, 4); const float* const kn_g = inp(F, 5);
    for (int it = gw; it < S_ * 12; it += NGW) {
        const int t = it / 12, h = it % 12;
        if (h >= 10) { const unsigned* vs = (const unsigned*)(proj + (size_t)t * INW + B_V_OFF + (h - 10) * 128); ((unsigned*)(VBR + (size_t)t * 256 + (h - 10) * 128))[F.lane] = vs[F.lane]; continue; }
        const bf16* src = proj + (size_t)t * INW + (h < 8 ? B_Q_OFF + h * 128 : B_K_OFF + (h - 8) * 128);
        const float* gn = h < 8 ? qn_g : kn_g;
        float v1 = bf2f(src[c1]), v2 = bf2f(src[c2]);
        const float ss = wave_sum(v1 * v1 + v2 * v2);
        const float rs = 1.0f / sqrtf(ss * (1.0f / 128.0f) + QK_EPS);
        v1 = v1 * rs * gn[c1]; v2 = v2 * rs * gn[c2];
        const int pos = half ? (t & 63) : (t >> 6);
        const float cs = rope[(pos * 32 + fi) * 2], sn = rope[(pos * 32 + fi) * 2 + 1];
        const float o1 = v1 * cs - v2 * sn, o2 = v1 * sn + v2 * cs;
        bf16* dst = h < 8 ? QBR + (size_t)t * 1024 + h * 128 : KBR + (size_t)t * 256 + (h - 8) * 128;
        dst[c1] = (bf16)(pk2(o1, 0.f) & 0xffffu); dst[c2] = (bf16)(pk2(o2, 0.f) & 0xffffu);
    }
    const float* lut = (const float*)(F.ws + WS_LUT);
    for (int u = blockIdx.x; u < 384; u += F.G) {
        const int gh = u >> 5, blk = u & 31, g = gh >> 2, hh = gh & 3, d = (g == 0) ? 1 : (g == 1 ? 4 : 16);
        const int bps = 32 / d, r = blk / bps, qb = blk % bps;
        at::dilated_unit((const at::bf16*)proj, lut + (g * 4 + hh) * 129, (at::bf16*)(F.ws + WS_OUTA) + (size_t)g * S_ * 512, (float*)(F.ws + WS_LSE) + (size_t)g * S_ * 4,
                         d, gh, hh, r, qb * 256, (char*)F.ldsg + RING_OFF);
    }
}

__device__ __forceinline__ void p3_attn_combine(Frame& F) {
    const at::bf16* QBR = (const at::bf16*)(F.ws + WS_QBR); const at::bf16* KBR = (const at::bf16*)(F.ws + WS_KBR); const at::bf16* VBR = (const at::bf16*)(F.ws + WS_VBR);
    unsigned char* YB = F.ws + WS_YB;
    for (int u = blockIdx.x; u < 256; u += F.G) {
        const int h = u & 7, qb = u >> 3, kv = h >> 2;
        at::attn_dense_body<1024, 256, 256, 1024>(QBR + (size_t)qb * 256 * 1024 + h * 128, KBR + kv * 128, VBR + kv * 128, YB + (size_t)qb * 256 * 1024 + h * 128, S_, (char*)F.ldsg + RING_OFF);
        __syncthreads();
    }
    const bf16* OUTA = (const bf16*)(F.ws + WS_OUTA); const float* LSE = (const float*)(F.ws + WS_LSE); bf16* YA = (bf16*)(F.ws + WS_YA);
    for (int tb = blockIdx.x; tb < 256; tb += F.G) {
        const int t = tb * 32 + (F.tid >> 4), c0 = (F.tid & 15) * 32, hh = c0 >> 7;
        const float l0 = LSE[(size_t)t * 4 + hh], l1 = LSE[(size_t)(S_ + t) * 4 + hh], l2 = LSE[(size_t)(2 * S_ + t) * 4 + hh];
        const float m = fmaxf(l0, fmaxf(l1, l2)); float w0 = __expf(l0 - m), w1 = __expf(l1 - m), w2 = __expf(l2 - m); const float inv = 16.0f / (w0 + w1 + w2); w0 *= inv; w1 *= inv; w2 *= inv;
#pragma unroll
        for (int q = 0; q < 4; ++q) { const size_t o = (size_t)t * 512 + c0 + q * 8;
            const v4u a = *(const v4u*)(OUTA + o), b = *(const v4u*)(OUTA + (size_t)S_ * 512 + o), c = *(const v4u*)(OUTA + (size_t)2 * S_ * 512 + o);
            v2u w;
            w.x = pk4_fp8(w0 * bflo(a.x) + w1 * bflo(b.x) + w2 * bflo(c.x), w0 * bfhi(a.x) + w1 * bfhi(b.x) + w2 * bfhi(c.x), w0 * bflo(a.y) + w1 * bflo(b.y) + w2 * bflo(c.y), w0 * bfhi(a.y) + w1 * bfhi(b.y) + w2 * bfhi(c.y));
            w.y = pk4_fp8(w0 * bflo(a.z) + w1 * bflo(b.z) + w2 * bflo(c.z), w0 * bfhi(a.z) + w1 * bfhi(b.z) + w2 * bfhi(c.z), w0 * bflo(a.w) + w1 * bflo(b.w) + w2 * bflo(c.w), w0 * bfhi(a.w) + w1 * bfhi(b.w) + w2 * bfhi(c.w));
            *(v2u*)((unsigned char*)YA + o) = w; }
    }
}

__device__ __forceinline__ void p6_ln_router(Frame& F, const int bank = 0) {
    LAS int* cntl = (LAS int*)(F.lds + L_CNT); LAS int* basel = cntl + 32;
    LAS int* asg_e = (LAS int*)(F.lds + L_ASG); LAS int* asg_lr = asg_e + 128; LAS float* asg_w = (LAS float*)(asg_lr + 128);
    const float* Z1 = (const float*)(F.ws + WS_T1); float* X1 = (float*)(F.ws + WS_X1); bf16* X1B = (bf16*)(F.ws + WS_X1B);
    const f32x4* G4 = (const f32x4*)inp(F, 9); const f32x4* B4 = (const f32x4*)inp(F, 10);
    const f32x4* WRT4 = (const f32x4*)(F.ws + WS_WRT); const float* br = inp(F, 12);
    unsigned* gcnt = F.ctl + CW_CNT + bank * 64;
    int* TOKE = (int*)(F.ws + (bank ? WS_H : WS_TOKE)); int* TOKR = (int*)(F.ws + (bank ? WS_H + MiB : WS_TOKR)); float* TOKW = (float*)(F.ws + (bank ? WS_H + 2 * MiB : WS_TOKW));
    for (int tb = blockIdx.x; tb < 256; tb += F.G) {
        if (F.tid < 32) cntl[F.tid] = 0;
        __syncthreads();
#pragma unroll 1
        for (int hp = 0; hp < 2; ++hp) {
        const int t0 = tb * 32 + F.wave * 4 + hp * 2;
        f32x4 xv[2][8];
#pragma unroll
        for (int tk = 0; tk < 2; ++tk) {
            const f32x4* zr = (const f32x4*)(Z1 + (size_t)(t0 + tk) * DM) + F.lane; float s = 0.f;
#pragma unroll
            for (int j = 0; j < 8; ++j) { xv[tk][j] = zr[64 * j]; s += (xv[tk][j][0] + xv[tk][j][1]) + (xv[tk][j][2] + xv[tk][j][3]); }
            const float mean = wave_sum(s) * (1.0f / DM); float s2 = 0.f;
#pragma unroll
            for (int j = 0; j < 8; ++j) { xv[tk][j] = xv[tk][j] - mean; s2 += (xv[tk][j][0] * xv[tk][j][0] + xv[tk][j][1] * xv[tk][j][1]) + (xv[tk][j][2] * xv[tk][j][2] + xv[tk][j][3] * xv[tk][j][3]); }
            const float rstd = 1.0f / sqrtf(wave_sum(s2) * (1.0f / DM) + LN_EPS);
            f32x4* xo = (f32x4*)(X1 + (size_t)(t0 + tk) * DM) + F.lane; unsigned* xb = (unsigned*)((unsigned char*)X1B + (size_t)(t0 + tk) * DM) + F.lane;
#pragma unroll
            for (int j = 0; j < 8; ++j) { const f32x4 v = xv[tk][j] * rstd * G4[64 * j + F.lane] + B4[64 * j + F.lane]; xv[tk][j] = v; xo[64 * j] = v;
                xb[64 * j] = pk4_fp8(v[0], v[1], v[2], v[3]); }
        }
        float logit[2] = {-3.0e38f, -3.0e38f};
#pragma unroll 1
        for (int e = 0; e < 32; ++e) {
            f32x4 w[8];
#pragma unroll
            for (int j = 0; j < 8; ++j) w[j] = WRT4[e * 512 + 64 * j + F.lane];
            const float be = br[e];
#pragma unroll
            for (int tk = 0; tk < 2; ++tk) { float p = 0.f;
#pragma unroll
                for (int j = 0; j < 8; ++j) p += (xv[tk][j][0] * w[j][0] + xv[tk][j][1] * w[j][1]) + (xv[tk][j][2] * w[j][2] + xv[tk][j][3] * w[j][3]);
                const float sres = wave_sum(p) + be; logit[tk] = (F.lane == e) ? sres : logit[tk]; }
        }
#pragma unroll
        for (int tk = 0; tk < 2; ++tk) {
            float v = logit[tk]; float tv[4]; int ti[4];
#pragma unroll
            for (int k = 0; k < 4; ++k) { float bv = v; int bi = F.lane;
#pragma unroll
                for (int o = 1; o < 64; o <<= 1) { const float ov = __shfl_xor(bv, o); const int oi = __shfl_xor(bi, o); if (ov > bv || (ov == bv && oi < bi)) { bv = ov; bi = oi; } }
                tv[k] = bv; ti[k] = bi; if (F.lane == bi) v = -3.0e38f; }
            const float e1 = __expf(tv[1] - tv[0]), e2 = __expf(tv[2] - tv[0]), e3 = __expf(tv[3] - tv[0]); const float inv = 1.0f / (1.0f + e1 + e2 + e3);
            if (F.lane < 4) { const int me = F.lane == 0 ? ti[0] : (F.lane == 1 ? ti[1] : (F.lane == 2 ? ti[2] : ti[3]));
                const float mw = (F.lane == 0 ? 1.0f : (F.lane == 1 ? e1 : (F.lane == 2 ? e2 : e3))) * inv;
                const int lr = atomicAdd((int*)(cntl + me), 1);
                const int a = (F.wave * 4 + hp * 2 + tk) * 4 + F.lane; asg_e[a] = me; asg_lr[a] = lr; asg_w[a] = mw; }
        }
        }
        __syncthreads();
        if (F.tid < 32) basel[F.tid] = (int)atomicAdd(gcnt + F.tid, (unsigned)cntl[F.tid]);
        __syncthreads();
        if (F.tid < 128) { const int a = tb * 128 + F.tid; const int e = asg_e[F.tid]; TOKE[a] = e; TOKR[a] = basel[e] + asg_lr[F.tid]; TOKW[a] = asg_w[F.tid]; }
        __syncthreads();
    }
}

__device__ __forceinline__ void p7_gather(Frame& F) {
    LAS int* pst = (LAS int*)(F.lds + L_PST);
    const unsigned* gcnt = F.ctl + CW_CNT;
    if (F.tid == 0) { int acc = 0; for (int e = 0; e < 32; ++e) { pst[e] = acc; acc += ((int)gcnt[e] + 255) & ~255; } pst[32] = acc; }
    __syncthreads();
    const int* TOKE = (const int*)(F.ws + WS_TOKE); const int* TOKR = (const int*)(F.ws + WS_TOKR); const float* TOKW = (const float*)(F.ws + WS_TOKW);
    int* TOKS = (int*)(F.ws + WS_TOKS); float* SLOTW = (float*)(F.ws + WS_SLOTW);
    const bf16* X1B = (const bf16*)(F.ws + WS_X1B); bf16* XS = (bf16*)(F.ws + WS_XS);
    const int gw = blockIdx.x * 8 + F.wave, NGW = F.G * 8;
    for (int a = gw; a < S_ * TOPK; a += NGW) {
        const int t = a >> 2, e = TOKE[a]; const int slot = pst[e] + TOKR[a];
        if (F.lane == 0) { TOKS[a] = slot; SLOTW[slot] = TOKW[a]; }
        const v4u* src = (const v4u*)((const unsigned char*)X1B + (size_t)t * DM) + F.lane; v4u* dst = (v4u*)((unsigned char*)XS + (size_t)slot * DM) + F.lane;
        const v4u a0 = src[0], a1 = src[64];
        dst[0] = a0; dst[64] = a1;
    }
}
__device__ __forceinline__ int moe_tiles(Frame& F) {
    LAS int* tile_e = (LAS int*)(F.lds + L_TILE);
    const unsigned* gcnt = F.ctl + CW_CNT;
    __syncthreads();
    if (F.tid == 0) { int ti = 0; for (int e = 0; e < 32; ++e) { const int nt = ((int)gcnt[e] + 255) >> 8; for (int k = 0; k < nt && ti < 160; ++k) tile_e[ti++] = e; } tile_e[160] = ti; }
    __syncthreads();
    return tile_e[160];
}

__device__ __forceinline__ void p10_final(Frame& F) {
    const float* X1 = (const float*)(F.ws + WS_X1); const bf16* YS = (const bf16*)(F.ws + WS_YS); const int* TOKS = (const int*)(F.ws + WS_TOKS);
    const f32x4* G4 = (const f32x4*)inp(F, 19); const f32x4* B4 = (const f32x4*)inp(F, 20);
    float* outp = (float*)inp(F, 21);
    const int gw = blockIdx.x * 8 + F.wave, NGW = F.G * 8;
    for (int t = gw; t < S_; t += NGW) {
        const int sl0 = TOKS[t * 4], sl1 = TOKS[t * 4 + 1], sl2 = TOKS[t * 4 + 2], sl3 = TOKS[t * 4 + 3];
        const f32x4* xr = (const f32x4*)(X1 + (size_t)t * DM) + F.lane;
        const v2u* y0 = (const v2u*)(YS + (size_t)sl0 * DM) + F.lane; const v2u* y1 = (const v2u*)(YS + (size_t)sl1 * DM) + F.lane;
        const v2u* y2 = (const v2u*)(YS + (size_t)sl2 * DM) + F.lane; const v2u* y3 = (const v2u*)(YS + (size_t)sl3 * DM) + F.lane;
        f32x4 v[8]; float s = 0.f;
#pragma unroll
        for (int j = 0; j < 8; ++j) { const v2u a = y0[64 * j], b = y1[64 * j], c = y2[64 * j], d = y3[64 * j]; f32x4 f;
            f[0] = (bflo(a.x) + bflo(b.x)) + (bflo(c.x) + bflo(d.x)); f[1] = (bfhi(a.x) + bfhi(b.x)) + (bfhi(c.x) + bfhi(d.x));
            f[2] = (bflo(a.y) + bflo(b.y)) + (bflo(c.y) + bflo(d.y)); f[3] = (bfhi(a.y) + bfhi(b.y)) + (bfhi(c.y) + bfhi(d.y));
            v[j] = xr[64 * j] * ALPHA + f; s += (v[j][0] + v[j][1]) + (v[j][2] + v[j][3]); }
        const float mean = wave_sum(s) * (1.0f / DM); float s2 = 0.f;
#pragma unroll
        for (int j = 0; j < 8; ++j) { v[j] = v[j] - mean; s2 += (v[j][0] * v[j][0] + v[j][1] * v[j][1]) + (v[j][2] * v[j][2] + v[j][3] * v[j][3]); }
        const float rstd = 1.0f / sqrtf(wave_sum(s2) * (1.0f / DM) + LN_EPS);
        f32x4* o = (f32x4*)(outp + (size_t)t * DM) + F.lane;
#pragma unroll
        for (int j = 0; j < 8; ++j) o[64 * j] = v[j] * rstd * G4[64 * j + F.lane] + B4[64 * j + F.lane];
    }
}

struct Args { const float* in[21]; float* out; unsigned char* ws; int ph_lo, ph_hi; };
__global__ void __launch_bounds__(512, 2) mk_fwd(Args args) {
    extern __shared__ __attribute__((aligned(16))) unsigned char lds[];
    Frame F;
    F.lds = (LAS unsigned char*)lds; F.ldsg = lds;
    F.tid = threadIdx.x; F.lane = F.tid & 63; F.wave = __builtin_amdgcn_readfirstlane(F.tid >> 6); F.G = gridDim.x;
    F.ws = args.ws; F.ctl = (unsigned*)(args.ws + WS_CTL);
    if (F.tid == 0) { LAS unsigned long long* pp = (LAS unsigned long long*)(F.lds + L_PTR);
#pragma unroll
        for (int i = 0; i < 21; ++i) pp[i] = (unsigned long long)args.in[i];
        pp[21] = (unsigned long long)args.out; }
    if (F.tid < 4) ((LAS unsigned*)(F.lds + L_XB))[F.tid] = 0u;
    __syncthreads();
    const int lo = args.ph_lo, hi = args.ph_hi;
    XcdBarrier bar; bar.bar = F.ctl + CW_BAR; bar.x = 0; bar.st = (volatile LAS unsigned*)(F.lds + L_XB);
    if (hi - lo > 1) bar = xcd_barrier_post(F.ctl + CW_BAR, (volatile LAS unsigned*)(F.lds + L_XB));
#ifndef MK_PHASE_MASK
#define MK_PHASE_MASK 0x7ff
#endif
#define IN(k) (((MK_PHASE_MASK >> (k)) & 1) && lo <= (k) && (k) < hi)
#ifndef MK_DUP_MASK
#define MK_DUP_MASK 0
#endif
#define REP(k) for (int rep_ = 0; rep_ < 1 + ((MK_DUP_MASK >> (k)) & 1); ++rep_)
#ifndef MK_BAR2
#define MK_BAR2 0
#endif
#define SEAM(k) do { if (IN(k) && IN((k) + 1)) { xcd_barrier(bar); if (MK_BAR2) xcd_barrier(bar); } } while (0)
    LAS unsigned char* ring = F.lds + RING_OFF;
    const pg8::bf16_t* XB = (const pg8::bf16_t*)(F.ws + WS_XB);

    if (IN(0)) REP(0) { p0_prologue(F); }
    SEAM(0);
    if (IN(1)) REP(1) {
        pg8::Gemm g{XB, (const pg8::bf16_t*)(F.ws + WS_WIN), S_, INW, DM / 2}; pg8::StaticOrder S; S.init(S_, INW, F.G, (int)blockIdx.x);
        pg8::EpiStoreBf16 E{(pg8::bf16_t*)(F.ws + WS_PROJ), INW, 1.0f / 64.0f};
        pg8::gemm_phase<pg8::EpiStoreBf16, pg8::StaticOrder, true, true, true>(ring, g, S, E);
    }
    SEAM(1);
    if (IN(2)) { p2_prep_dilated(F); if ((MK_DUP_MASK >> 2) & 1) p2_prep_dilated(F); }
    SEAM(2);
    if (IN(3)) REP(3) { p3_attn_combine(F); }
    SEAM(3);
#define PHASE4_BODY { \
        { pg8::Gemm g{(const pg8::bf16_t*)(F.ws + WS_YA), (const pg8::bf16_t*)(F.ws + WS_WA), S_, DM, 256}; pg8::StaticOrder S; S.init(S_, DM, F.G, (int)blockIdx.x); \
          pg8::EpiGateA E{(const pg8::bf16_t*)(F.ws + WS_PROJ), INW, GATE_OFF, inp(F, 2), (float*)(F.ws + WS_T1), DM, 1.0f / 512.0f}; \
          pg8::gemm_phase<pg8::EpiGateA, pg8::StaticOrder, true, true, true>(ring, g, S, E); } \
        { pg8::Gemm g{(const pg8::bf16_t*)(F.ws + WS_YB), (const pg8::bf16_t*)(F.ws + WS_WB), S_, DM, 512}; pg8::StaticOrder S; S.init(S_, DM, F.G, (int)blockIdx.x); \
          pg8::EpiGateB E{(const pg8::bf16_t*)(F.ws + WS_PROJ), INW, GATE_OFF + DM, inp(F, 2) + DM, (const float*)(F.ws + WS_T1), F.ws + WS_Y, DM, 1.0f / 2048.0f}; \
          pg8::gemm_phase<pg8::EpiGateB, pg8::StaticOrder, true, true, true>(ring, g, S, E); } \
    }
    if (IN(4)) { PHASE4_BODY if ((MK_DUP_MASK >> 4) & 1) PHASE4_BODY }
    SEAM(4);
    if (IN(5)) REP(5) {
        pg8::Gemm g{(const pg8::bf16_t*)(F.ws + WS_Y), (const pg8::bf16_t*)(F.ws + WS_WO), S_, DM, DM / 2}; pg8::StaticOrder S; S.init(S_, DM, F.G, (int)blockIdx.x);
        pg8::EpiResF32 E{inp(F, 0), (float*)(F.ws + WS_T1), DM, ALPHA, 1.0f / 4096.0f};
        pg8::gemm_phase<pg8::EpiResF32, pg8::StaticOrder, true, true, true>(ring, g, S, E);
    }
    SEAM(5);
    if (IN(6)) { p6_ln_router(F); if ((MK_DUP_MASK >> 6) & 1) p6_ln_router(F, 1); }
    SEAM(6);
    if (IN(7)) REP(7) { p7_gather(F); }
    SEAM(7);
    if (IN(8)) REP(8) {
        const int nt = moe_tiles(F);
        pg8::Gemm g{(const pg8::bf16_t*)(F.ws + WS_XS), (const pg8::bf16_t*)(F.ws + WS_WGL), nt * 256, 4096, DM / 2};
        pg8::MoeOrder S; S.init(nt * 256, 4096, F.G, (int)blockIdx.x); S.tile_e = (const LAS int*)(F.lds + L_TILE); S.estride = (size_t)4096 * 2048;
        pg8::EpiSwiglu E{(const LAS int*)(F.lds + L_TILE), inp(F, 14), inp(F, 16), F.ws + WS_H, DM, 1.0f / 64.0f};
        pg8::gemm_phase<pg8::EpiSwiglu, pg8::MoeOrder, true, true, true>(ring, g, S, E);
    }
    SEAM(8);
    if (IN(9)) REP(9) {
        const int nt = moe_tiles(F);
        pg8::Gemm g{(const pg8::bf16_t*)(F.ws + WS_H), (const pg8::bf16_t*)(F.ws + WS_WD), nt * 256, DM, DM / 2};
        pg8::MoeOrder S; S.init(nt * 256, DM, F.G, (int)blockIdx.x); S.tile_e = (const LAS int*)(F.lds + L_TILE); S.estride = (size_t)2048 * 2048;
        pg8::EpiDown E{(const LAS int*)(F.lds + L_TILE), inp(F, 18), (const float*)(F.ws + WS_SLOTW), (pg8::bf16_t*)(F.ws + WS_YS), DM, 1.0f / 64.0f};
        pg8::gemm_phase<pg8::EpiDown, pg8::MoeOrder, true, true, true>(ring, g, S, E);
    }
    SEAM(9);
    if (IN(10)) REP(10) { p10_final(F); }
#undef IN
#undef SEAM
}

#ifndef MK_CUTS
#define MK_CUTS 0
#endif
extern "C" void kernel_launch(void* const* d_in, const int* in_sizes, int n_in, void* d_out, int out_size, void* d_ws, size_t ws_size, hipStream_t stream) {
    static int grid = 0;
    if (grid == 0) {
        if (n_in != 21 || out_size != S_ * DM || ws_size < WS_END) { fprintf(stderr, "kernel_launch: unexpected shapes (n_in %d out %d ws %zu, need %zu)\n", n_in, out_size, ws_size, (size_t)WS_END); grid = -1; return; }
        int dev = 0, cus = 0, per_cu = 0;
        if (hipGetDevice(&dev) != hipSuccess || hipDeviceGetAttribute(&cus, hipDeviceAttributeMultiprocessorCount, dev) != hipSuccess) { grid = -1; return; }
        if (hipFuncSetAttribute((const void*)mk_fwd, hipFuncAttributeMaxDynamicSharedMemorySize, LDS_BYTES) != hipSuccess) { fprintf(stderr, "kernel_launch: hipFuncSetAttribute failed\n"); grid = -1; return; }
        if (hipOccupancyMaxActiveBlocksPerMultiprocessor(&per_cu, (const void*)mk_fwd, 512, LDS_BYTES) != hipSuccess || per_cu < 1) { fprintf(stderr, "kernel_launch: occupancy query says %d\n", per_cu); per_cu = 1; }
        (void)hipGetLastError();
        grid = cus;
    }
    if (grid < 0) return;
    (void)hipMemsetAsync((char*)d_ws + WS_CTL, 0, CTL_ZERO_BYTES, stream);
    Args a{};
    for (int i = 0; i < 21; ++i) a.in[i] = (const float*)d_in[i];
    a.out = (float*)d_out; a.ws = (unsigned char*)d_ws;
#if MK_CUTS
    for (int p = 0; p < NPH; ++p) { a.ph_lo = p; a.ph_hi = p + 1; hipLaunchKernelGGL(mk_fwd, dim3(grid), dim3(512), LDS_BYTES, stream, a); }
#else
    a.ph_lo = 0; a.ph_hi = NPH; hipLaunchKernelGGL(mk_fwd, dim3(grid), dim3(512), LDS_BYTES, stream, a);
#endif
}
```

```cpp
#include <hip/hip_runtime.h>
#include <hip/hip_bf16.h>
#include <cstdio>
#include <cstdint>
#define MK_CUTS 0
namespace pg8 {
#define PG8_LAS __attribute__((address_space(3)))
typedef unsigned short bf16_t;
typedef short bf16x8 __attribute__((ext_vector_type(8)));
typedef float f32x4 __attribute__((ext_vector_type(4)));
typedef unsigned u32x4 __attribute__((ext_vector_type(4)));
constexpr int BM = 256, BK = 64, HALF = 128, HTB = HALF * BK * 2  , STAGE_BYTES = 8 * HTB, NXCD = 8, WGM = 8;

__host__ __device__ __forceinline__ int lds_byte(int r, int c) { const int st = (r >> 4) * 2 + (c >> 5), rr = r & 15, cc = c & 31, ob = rr * 64 + cc * 2; return st * 1024 + (ob ^ (((ob >> 9) & 1) << 5)); }
__host__ __device__ __forceinline__ void stage_rc(int b, int& R, int& C) { const int st = b / 1024, sb = b % 1024, swz = sb ^ (((sb >> 9) & 1) << 5); R = (st >> 1) * 16 + swz / 64; C = (st & 1) * 32 + (swz % 64) / 2; }
__host__ __device__ __forceinline__ int perm32(int rho) { const int n = rho >> 4, i = rho & 15; return 8 * (i >> 2) + 4 * n + (i & 3); }

struct Unit { int pm, pn; };
struct Gemm { const bf16_t* A; const bf16_t* Bt; int M, N, K; };

struct StaticOrder {
    int nM, nN, nwg, G, c;
    __host__ __device__ void init(int M, int N, int G_, int c_) { nM = M / BM; nN = N / BM; nwg = nM * nN; G = G_; c = c_; }
    __host__ __device__ bool next(int i, Unit& u) const {
        const long L = (long)i * G + c; if (L >= nwg) return false;
        int wgid = (int)L; { const int q = nwg / NXCD, r = nwg % NXCD, xcd = wgid % NXCD, off = wgid / NXCD; wgid = (xcd < r ? xcd * (q + 1) : r * (q + 1) + (xcd - r) * q) + off; }
        const int nig = WGM * nN, gid = wgid / nig, fm = gid * WGM, gsz = (nM - fm) < WGM ? (nM - fm) : WGM;
        u.pm = fm + ((wgid % nig) % gsz); u.pn = (wgid % nig) / gsz; return true;
    }
    __device__ __forceinline__ void a_ready(const Unit&) const {}
    __device__ __forceinline__ size_t b_off(const Unit&) const { return 0; }
    __device__ __forceinline__ void done(const Unit&) const {}
};


typedef unsigned u32x2 __attribute__((ext_vector_type(2)));
__device__ __forceinline__ unsigned cvt_pk_bf16(float lo, float hi) { unsigned r; asm volatile("v_cvt_pk_bf16_f32 %0, %1, %2" : "=v"(r) : "v"(lo), "v"(hi)); return r; }
__device__ __forceinline__ unsigned pk4_fp8_(float a, float b, float c, float d) { int w = __builtin_amdgcn_cvt_pk_fp8_f32(a, b, 0, false); w = __builtin_amdgcn_cvt_pk_fp8_f32(c, d, w, true); return (unsigned)w; }
__device__ __forceinline__ float bf_lo(unsigned w) { return __builtin_bit_cast(float, w << 16); }
__device__ __forceinline__ float bf_hi(unsigned w) { return __builtin_bit_cast(float, w & 0xffff0000u); }
__device__ __forceinline__ float sigmoidf_(float v) { return __builtin_amdgcn_rcpf(1.0f + __expf(-v)); }

struct EpiStoreBf16 {
    static constexpr bool PERM = true, AFTER_DRAIN = false;
    bf16_t* O; int ldc; float sc;
    __device__ __forceinline__ void operator()(const f32x4 (&acc)[2][2][4][2], const Unit& u, int wr, int wc, int fr, int fq) const {
        const int row0 = u.pm * BM + wr * 64 + fr, col0 = u.pn * BM + wc * 32 + 8 * fq;
#pragma unroll
        for (int ai = 0; ai < 2; ++ai)
#pragma unroll
            for (int m = 0; m < 4; ++m) { bf16_t* rowp = O + (size_t)(row0 + ai * HALF + m * 16) * ldc + col0;
#pragma unroll
                for (int bj = 0; bj < 2; ++bj) { const f32x4 v0 = acc[ai][bj][m][0] * sc, v1 = acc[ai][bj][m][1] * sc;
                    u32x4 w; w.x = cvt_pk_bf16(v0[0], v0[1]); w.y = cvt_pk_bf16(v0[2], v0[3]); w.z = cvt_pk_bf16(v1[0], v1[1]); w.w = cvt_pk_bf16(v1[2], v1[3]);
                    *(u32x4*)(rowp + bj * HALF) = w; } }
    }
};

struct EpiGateA {
    static constexpr bool PERM = true, AFTER_DRAIN = false;
    const bf16_t* proj; int ldp; int gcol0; const float* bg; float* T1; int ldc; float sc;
    __device__ __forceinline__ void operator()(const f32x4 (&acc)[2][2][4][2], const Unit& u, int wr, int wc, int fr, int fq) const {
        const int row0 = u.pm * BM + wr * 64 + fr, col0 = u.pn * BM + wc * 32 + 8 * fq;
#pragma unroll
        for (int ai = 0; ai < 2; ++ai)
#pragma unroll
            for (int m = 0; m < 4; ++m) { const int row = row0 + ai * HALF + m * 16;
#pragma unroll
                for (int bj = 0; bj < 2; ++bj) { const int c = col0 + bj * HALF;
                    const u32x4 gw = *(const u32x4*)(proj + (size_t)row * ldp + gcol0 + c);
                    const f32x4 b0 = *(const f32x4*)(bg + c), b1 = *(const f32x4*)(bg + c + 4);
                    f32x4 g0, g1;
                    g0[0] = sigmoidf_(bf_lo(gw.x) + b0[0]); g0[1] = sigmoidf_(bf_hi(gw.x) + b0[1]); g0[2] = sigmoidf_(bf_lo(gw.y) + b0[2]); g0[3] = sigmoidf_(bf_hi(gw.y) + b0[3]);
                    g1[0] = sigmoidf_(bf_lo(gw.z) + b1[0]); g1[1] = sigmoidf_(bf_hi(gw.z) + b1[1]); g1[2] = sigmoidf_(bf_lo(gw.w) + b1[2]); g1[3] = sigmoidf_(bf_hi(gw.w) + b1[3]);
                    float* o = T1 + (size_t)row * ldc + c;
                    *(f32x4*)o = acc[ai][bj][m][0] * sc * g0; *(f32x4*)(o + 4) = acc[ai][bj][m][1] * sc * g1; } }
    }
};
struct EpiGateB {
    static constexpr bool PERM = true, AFTER_DRAIN = false;
    const bf16_t* proj; int ldp; int gcol0; const float* bg; const float* T1; unsigned char* Y; int ldc; float sc;
    __device__ __forceinline__ void operator()(const f32x4 (&acc)[2][2][4][2], const Unit& u, int wr, int wc, int fr, int fq) const {
        const int row0 = u.pm * BM + wr * 64 + fr, col0 = u.pn * BM + wc * 32 + 8 * fq;
#pragma unroll
        for (int ai = 0; ai < 2; ++ai)
#pragma unroll
            for (int m = 0; m < 4; ++m) { const int row = row0 + ai * HALF + m * 16;
#pragma unroll
                for (int bj = 0; bj < 2; ++bj) { const int c = col0 + bj * HALF;
                    const u32x4 gw = *(const u32x4*)(proj + (size_t)row * ldp + gcol0 + c);
                    const f32x4 b0 = *(const f32x4*)(bg + c), b1 = *(const f32x4*)(bg + c + 4);
                    const float* tp = T1 + (size_t)row * ldc + c;
                    const f32x4 t0 = *(const f32x4*)tp, t1 = *(const f32x4*)(tp + 4);
                    f32x4 g0, g1;
                    g0[0] = sigmoidf_(bf_lo(gw.x) + b0[0]); g0[1] = sigmoidf_(bf_hi(gw.x) + b0[1]); g0[2] = sigmoidf_(bf_lo(gw.y) + b0[2]); g0[3] = sigmoidf_(bf_hi(gw.y) + b0[3]);
                    g1[0] = sigmoidf_(bf_lo(gw.z) + b1[0]); g1[1] = sigmoidf_(bf_hi(gw.z) + b1[1]); g1[2] = sigmoidf_(bf_lo(gw.w) + b1[2]); g1[3] = sigmoidf_(bf_hi(gw.w) + b1[3]);
                    const f32x4 v0 = (t0 + acc[ai][bj][m][0] * sc * g0) * 64.0f, v1 = (t1 + acc[ai][bj][m][1] * sc * g1) * 64.0f;
                    u32x2 w; w.x = pk4_fp8_(v0[0], v0[1], v0[2], v0[3]); w.y = pk4_fp8_(v1[0], v1[1], v1[2], v1[3]);
                    *(u32x2*)(Y + (size_t)row * ldc + c) = w; } }
    }
};
struct EpiResF32 {
    static constexpr bool PERM = false, AFTER_DRAIN = false;
    const float* X; float* Z; int ldc; float alpha; float sc;
    __device__ __forceinline__ void operator()(const f32x4 (&acc)[2][2][4][2], const Unit& u, int wr, int wc, int fr, int fq) const {
        const int row0 = u.pm * BM + wr * 64 + fr, col0 = u.pn * BM + wc * 32 + 4 * fq;
#pragma unroll
        for (int ai = 0; ai < 2; ++ai)
#pragma unroll
            for (int m = 0; m < 4; ++m) { const size_t ro = (size_t)(row0 + ai * HALF + m * 16) * ldc + col0;
#pragma unroll
                for (int bj = 0; bj < 2; ++bj)
#pragma unroll
                    for (int n = 0; n < 2; ++n) { const f32x4 xv = *(const f32x4*)(X + ro + bj * HALF + n * 16);
                        *(f32x4*)(Z + ro + bj * HALF + n * 16) = xv * alpha + acc[ai][bj][m][n] * sc; } }
    }
};
struct EpiSwiglu {
    static constexpr bool PERM = true, AFTER_DRAIN = false;
    const PG8_LAS int* tile_e; const float* bgate; const float* blin; unsigned char* H; int ldc; float sc;
    __device__ __forceinline__ void operator()(const f32x4 (&acc)[2][2][4][2], const Unit& u, int wr, int wc, int fr, int fq) const {
        const int e = tile_e[u.pm];
        const int row0 = u.pm * BM + wr * 64 + fr, j0 = u.pn * HALF + wc * 32 + 8 * fq;
        const f32x4 bg0 = *(const f32x4*)(bgate + (size_t)e * 2048 + j0), bg1 = *(const f32x4*)(bgate + (size_t)e * 2048 + j0 + 4);
        const f32x4 bl0 = *(const f32x4*)(blin + (size_t)e * 2048 + j0), bl1 = *(const f32x4*)(blin + (size_t)e * 2048 + j0 + 4);
#pragma unroll
        for (int ai = 0; ai < 2; ++ai)
#pragma unroll
            for (int m = 0; m < 4; ++m) { const int row = row0 + ai * HALF + m * 16;
                f32x4 h0, h1;
#pragma unroll
                for (int i = 0; i < 4; ++i) {
                    float g = fminf(acc[ai][0][m][0][i] * sc + bg0[i], 7.0f); float l = fminf(fmaxf(acc[ai][1][m][0][i] * sc + bl0[i], -7.0f), 7.0f);
                    h0[i] = (l + 1.0f) * (g * sigmoidf_(1.702f * g));
                    g = fminf(acc[ai][0][m][1][i] * sc + bg1[i], 7.0f); l = fminf(fmaxf(acc[ai][1][m][1][i] * sc + bl1[i], -7.0f), 7.0f);
                    h1[i] = (l + 1.0f) * (g * sigmoidf_(1.702f * g)); }
                u32x2 w; w.x = pk4_fp8_(h0[0], h0[1], h0[2], h0[3]); w.y = pk4_fp8_(h1[0], h1[1], h1[2], h1[3]);
                *(u32x2*)(H + (size_t)row * ldc + j0) = w; }
    }
};
struct EpiDown {
    static constexpr bool PERM = true, AFTER_DRAIN = false;
    const PG8_LAS int* tile_e; const float* bdown; const float* slot_w; bf16_t* YS; int ldc; float sc;
    __device__ __forceinline__ void operator()(const f32x4 (&acc)[2][2][4][2], const Unit& u, int wr, int wc, int fr, int fq) const {
        const int e = tile_e[u.pm];
        const int row0 = u.pm * BM + wr * 64 + fr, col0 = u.pn * BM + wc * 32 + 8 * fq;
        f32x4 bv[2][2];
#pragma unroll
        for (int bj = 0; bj < 2; ++bj)
#pragma unroll
            for (int n = 0; n < 2; ++n) bv[bj][n] = *(const f32x4*)(bdown + (size_t)e * 2048 + col0 + bj * HALF + 4 * n);
#pragma unroll
        for (int ai = 0; ai < 2; ++ai)
#pragma unroll
            for (int m = 0; m < 4; ++m) { const int row = row0 + ai * HALF + m * 16; const float sw = slot_w[row];
#pragma unroll
                for (int bj = 0; bj < 2; ++bj) { const f32x4 v0 = (acc[ai][bj][m][0] * sc + bv[bj][0]) * sw, v1 = (acc[ai][bj][m][1] * sc + bv[bj][1]) * sw;
                    u32x4 w; w.x = cvt_pk_bf16(v0[0], v0[1]); w.y = cvt_pk_bf16(v0[2], v0[3]); w.z = cvt_pk_bf16(v1[0], v1[1]); w.w = cvt_pk_bf16(v1[2], v1[3]);
                    *(u32x4*)(YS + (size_t)row * ldc + col0 + bj * HALF) = w; } }
    }
};
struct MoeOrder : StaticOrder {
    const PG8_LAS int* tile_e; size_t estride;
    __device__ __forceinline__ size_t b_off(const Unit& u) const { return (size_t)__builtin_amdgcn_readfirstlane(tile_e[u.pm]) * estride; }
};
typedef int i32x4_ __attribute__((ext_vector_type(4)));
typedef int i32x8_ __attribute__((ext_vector_type(8)));
#define PG8_CAT(lo, hi) __builtin_shufflevector(__builtin_bit_cast(i32x4_, lo), __builtin_bit_cast(i32x4_, hi), 0, 1, 2, 3, 4, 5, 6, 7)
template <class Epi, class Sched, bool ALIGN_EPI = false, bool SP2 = false, bool FP8 = false, bool BTILED = false>
__device__ __forceinline__ void gemm_phase(PG8_LAS unsigned char* lds, const Gemm g, const Sched& S, const Epi& E) {
    const int tid = threadIdx.x, wid = __builtin_amdgcn_readfirstlane(tid >> 6), lane = tid & 63, wr = wid >> 2, wc = wid & 3, fr = lane & 15, fq = lane >> 4;
    const int K = g.K, nt = K / BK;
    unsigned voffA[2], voffB[2];
#pragma unroll
    for (int i = 0; i < 2; ++i) { int R, C; stage_rc(tid * 16 + i * 8192, R, C); const int Rb = Epi::PERM ? ((R & ~31) + perm32(R & 31)) : R;
        voffA[i] = (unsigned)(R * K + C) * 2u; voffB[i] = BTILED ? (unsigned)(Rb * 64 + C) * 2u : (unsigned)(Rb * K + C) * 2u; }
    const size_t kstep = (size_t)(BK * 2);
    const size_t hstep = (size_t)HALF * K * 2;
    const size_t tstep = 2 * hstep;
    const size_t kstepB = BTILED ? (size_t)32768 : kstep, hstepB = BTILED ? (size_t)16384 : hstep;
    const unsigned ldsw = (unsigned)wid * 1024u;
    const int aoff = lds_byte(wr * 64 + fr, fq * 8), boff = lds_byte(wc * 32 + fr, fq * 8);
#define PG8_SA(b, h) (((b) * 2 + (h)) * HTB)
#define PG8_SB(b, h) ((4 + (b) * 2 + (h)) * HTB)
#define PG8_STAGE(bufoff, gbase, voff) do { _Pragma("unroll") for (int _i = 0; _i < 2; ++_i) \
        __builtin_amdgcn_global_load_lds((const unsigned*)((const char*)(gbase) + (voff)[_i]), (PG8_LAS unsigned*)(lds + (bufoff) + ldsw + _i * 8192), 16, 0, 0); } while (0)
#define PG8_LDA(dst, b, h) do { _Pragma("unroll") for (int m = 0; m < 4; ++m) _Pragma("unroll") for (int k = 0; k < 2; ++k) dst[m][k] = *(const PG8_LAS bf16x8*)(lds + PG8_SA(b, h) + aoff + m * 2048 + k * 1024); } while (0)
#define PG8_LDB(dst, b, h) do { _Pragma("unroll") for (int n = 0; n < 2; ++n) _Pragma("unroll") for (int k = 0; k < 2; ++k) dst[n][k] = *(const PG8_LAS bf16x8*)(lds + PG8_SB(b, h) + boff + n * 2048 + k * 1024); } while (0)
#define PG8_MFMA8(C, Bv, Av) asm volatile("v_mfma_f32_16x16x128_f8f6f4 %0, %1, %2, %0" : "+v"(C) : "v"(Bv), "v"(Av))
#define PG8_MMA(ai, bj, At, Bt) do { __builtin_amdgcn_s_setprio(1); if constexpr (FP8) { const i32x8_ b0_ = PG8_CAT(Bt[0][0], Bt[0][1]), b1_ = PG8_CAT(Bt[1][0], Bt[1][1]); _Pragma("unroll") for (int m = 0; m < 4; ++m) { \
        const i32x8_ a_ = PG8_CAT(At[m][0], At[m][1]); PG8_MFMA8(acc[ai][bj][m][0], b0_, a_); PG8_MFMA8(acc[ai][bj][m][1], b1_, a_); } } else { \
        _Pragma("unroll") for (int m = 0; m < 4; ++m) _Pragma("unroll") for (int n = 0; n < 2; ++n) _Pragma("unroll") for (int k = 0; k < 2; ++k) \
        acc[ai][bj][m][n] = __builtin_amdgcn_mfma_f32_16x16x32_bf16(Bt[n][k], At[m][k], acc[ai][bj][m][n], 0, 0, 0); } __builtin_amdgcn_s_setprio(0); } while (0)
#define PG8_WAIT_V(n) asm volatile("s_waitcnt vmcnt(" #n ")" ::: "memory")
#define PG8_WAIT_L(n) asm volatile("s_waitcnt lgkmcnt(" #n ")" ::: "memory")
#define PG8_BAR __builtin_amdgcn_s_barrier()
#define PG8_SCHED __builtin_amdgcn_sched_barrier(0)
    Unit cur, nxt; int ui = 0;
    if (!S.next(0, cur)) return;
    f32x4 acc[2][2][4][2];
#pragma unroll
    for (int a = 0; a < 2; ++a)
#pragma unroll
        for (int b = 0; b < 2; ++b)
#pragma unroll
            for (int m = 0; m < 4; ++m)
#pragma unroll
                for (int n = 0; n < 2; ++n) acc[a][b][m][n] = (f32x4){0.f, 0.f, 0.f, 0.f};
    bf16x8 At[4][2], B0[2][2], B1[2][2];
    const char* cA = (const char*)g.A + (size_t)cur.pm * tstep; const char* cB = (const char*)g.Bt + S.b_off(cur) + (size_t)cur.pn * tstep;
    S.a_ready(cur);
    if constexpr (SP2) {
        PG8_STAGE(PG8_SB(0, 0), cB, voffB); PG8_STAGE(PG8_SB(0, 1), cB + hstepB, voffB); PG8_STAGE(PG8_SA(0, 0), cA, voffA); PG8_STAGE(PG8_SA(0, 1), cA + hstep, voffA);
        if (wr == 1) PG8_BAR;
        PG8_WAIT_V(2); PG8_BAR;
        PG8_STAGE(PG8_SB(1, 0), cB + kstepB, voffB); PG8_STAGE(PG8_SA(1, 0), cA + kstep, voffA); PG8_STAGE(PG8_SB(1, 1), cB + hstepB + kstepB, voffB);
        PG8_WAIT_V(6); PG8_BAR;
    } else {
        PG8_STAGE(PG8_SB(0, 0), cB, voffB); PG8_STAGE(PG8_SA(0, 0), cA, voffA); PG8_STAGE(PG8_SB(0, 1), cB + hstepB, voffB); PG8_STAGE(PG8_SA(0, 1), cA + hstep, voffA);
        if (wr == 1) PG8_BAR;
        PG8_WAIT_V(4); PG8_BAR;
        PG8_STAGE(PG8_SB(1, 0), cB + kstepB, voffB); PG8_STAGE(PG8_SA(1, 0), cA + kstep, voffA); PG8_STAGE(PG8_SB(1, 1), cB + hstepB + kstepB, voffB);
        PG8_WAIT_V(6); PG8_BAR;
    }
    for (;;) {
        const bool has_next = S.next(ui + 1, nxt);
        const char* nA = has_next ? (const char*)g.A + (size_t)nxt.pm * tstep : cA; const char* nB = has_next ? (const char*)g.Bt + S.b_off(nxt) + (size_t)nxt.pn * tstep : cB;
        for (int t = 0; t < nt; t += 2) {
            const bool last = (t == nt - 2);
            const char* a1 = cA + (size_t)(t + 1) * kstep;
            const char* a2 = last ? nA : cA + (size_t)(t + 2) * kstep; const char* b2 = last ? nB : cB + (size_t)(t + 2) * kstepB;
            const char* a3 = a2 + kstep; const char* b3 = b2 + kstepB;
            if (last && has_next) S.a_ready(nxt);
            if constexpr (SP2) {
            PG8_LDB(B0, 0, 0); PG8_LDB(B1, 0, 1); PG8_SCHED; PG8_LDA(At, 0, 0); PG8_STAGE(PG8_SA(1, 1), a1 + hstep, voffA);
            PG8_WAIT_V(8); PG8_WAIT_L(0); PG8_BAR; PG8_MMA(0, 0, At, B0); PG8_MMA(0, 1, At, B1); PG8_BAR; PG8_SCHED;
            PG8_LDA(At, 0, 1); PG8_STAGE(PG8_SB(0, 0), b2, voffB); PG8_STAGE(PG8_SB(0, 1), b2 + hstepB, voffB); PG8_STAGE(PG8_SA(0, 0), a2, voffA);
            PG8_WAIT_V(8); PG8_WAIT_L(0); PG8_BAR; PG8_MMA(1, 0, At, B0); PG8_MMA(1, 1, At, B1); PG8_BAR; PG8_SCHED;
            PG8_LDB(B0, 1, 0); PG8_LDB(B1, 1, 1); PG8_SCHED; PG8_LDA(At, 1, 0); PG8_STAGE(PG8_SA(0, 1), a2 + hstep, voffA);
            PG8_WAIT_V(8); PG8_WAIT_L(0); PG8_BAR; PG8_MMA(0, 0, At, B0); PG8_MMA(0, 1, At, B1); PG8_BAR; PG8_SCHED;
            PG8_LDA(At, 1, 1); PG8_STAGE(PG8_SB(1, 0), b3, voffB); PG8_STAGE(PG8_SB(1, 1), b3 + hstepB, voffB); PG8_STAGE(PG8_SA(1, 0), a3, voffA);
            PG8_WAIT_V(8); PG8_WAIT_L(0); PG8_BAR; PG8_MMA(1, 0, At, B0); PG8_MMA(1, 1, At, B1); PG8_BAR; PG8_SCHED;
            } else {
            PG8_LDB(B0, 0, 0); PG8_SCHED; PG8_LDA(At, 0, 0); PG8_STAGE(PG8_SA(1, 1), a1 + hstep, voffA);
            PG8_WAIT_L(8); PG8_BAR; PG8_WAIT_L(0); PG8_MMA(0, 0, At, B0); PG8_BAR; PG8_SCHED;
            PG8_LDB(B1, 0, 1); PG8_STAGE(PG8_SB(0, 0), b2, voffB);
            PG8_BAR; PG8_WAIT_L(0); PG8_MMA(0, 1, At, B1); PG8_BAR;
            PG8_LDA(At, 0, 1); PG8_STAGE(PG8_SA(0, 0), a2, voffA);
            PG8_BAR; PG8_WAIT_L(0); PG8_MMA(1, 0, At, B0); PG8_BAR; PG8_SCHED;
            PG8_STAGE(PG8_SB(0, 1), b2 + hstepB, voffB);
            PG8_WAIT_V(6); PG8_BAR; PG8_MMA(1, 1, At, B1); PG8_BAR;
            PG8_LDB(B0, 1, 0); PG8_SCHED; PG8_LDA(At, 1, 0); PG8_STAGE(PG8_SA(0, 1), a2 + hstep, voffA);
            PG8_WAIT_L(8); PG8_BAR; PG8_WAIT_L(0); PG8_MMA(0, 0, At, B0); PG8_BAR; PG8_SCHED;
            PG8_LDB(B1, 1, 1); PG8_STAGE(PG8_SB(1, 0), b3, voffB);
            PG8_BAR; PG8_WAIT_L(0); PG8_MMA(0, 1, At, B1); PG8_BAR;
            PG8_LDA(At, 1, 1); PG8_STAGE(PG8_SA(1, 0), a3, voffA);
            PG8_BAR; PG8_WAIT_L(0); PG8_MMA(1, 0, At, B0); PG8_BAR; PG8_SCHED;
            PG8_STAGE(PG8_SB(1, 1), b3 + hstepB, voffB);
            PG8_WAIT_V(6); PG8_BAR; PG8_MMA(1, 1, At, B1); PG8_BAR;
            }
        }
        if constexpr (ALIGN_EPI) { if (wr == 0) PG8_BAR; }
        if constexpr (FP8) { asm volatile("s_nop 15\n\ts_nop 7" ::: "memory"); PG8_SCHED; }
        if constexpr (!Epi::AFTER_DRAIN) { E(acc, cur, wr, wc, fr, fq); S.done(cur); }
        if (!has_next) break;
#pragma unroll
        for (int a = 0; a < 2; ++a)
#pragma unroll
            for (int b = 0; b < 2; ++b)
#pragma unroll
                for (int m = 0; m < 4; ++m)
#pragma unroll
                    for (int n = 0; n < 2; ++n) acc[a][b][m][n] = (f32x4){0.f, 0.f, 0.f, 0.f};
        cur = nxt; cA = nA; cB = nB; ++ui;
        if constexpr (ALIGN_EPI) { if (wr == 1) PG8_BAR; }
    }
    PG8_WAIT_V(0);
    if constexpr (!ALIGN_EPI) { if (wr == 0) PG8_BAR; }
    PG8_BAR;
    if constexpr (Epi::AFTER_DRAIN) { E.fused(acc, cur, wr, wc, fr, fq, lds, wid, lane); S.done(cur); }
#undef PG8_SA
#undef PG8_SB
#undef PG8_STAGE
#undef PG8_LDA
#undef PG8_LDB
#undef PG8_MMA
#undef PG8_WAIT_V
#undef PG8_WAIT_L
#undef PG8_BAR
#undef PG8_SCHED
}
}
namespace at {
using bf16 = __hip_bfloat16;
constexpr int   D = 128, NW = 8, QBLK = 32, KVBLK = 64;
constexpr float SCALE = 0.088388347648318440f;
constexpr float THR = 8.f;
constexpr int SDEPTH = 2;
constexpr size_t SHM_V = KVBLK * D * 2, SHM_K = KVBLK * D * 2, SHM_ATTN = 2 * SHM_V + 2 * SHM_K + NW * 64 * 4;
using bf16x8 = __attribute__((ext_vector_type(8))) short;
using s16x4  = __attribute__((ext_vector_type(4))) short;
using f32x16 = __attribute__((ext_vector_type(16))) float;
using f32x8  = __attribute__((ext_vector_type(8))) float;
using u32x4  = __attribute__((ext_vector_type(4))) unsigned;
#define KSWZ(row, colB) ((row) * 256 + ((colB) ^ (((row) & 7) << 4)))
#define SBAR() __builtin_amdgcn_sched_barrier(0)
__device__ __forceinline__ int crow(int r, int hi) { return (r & 3) + 8 * (r >> 2) + 4 * hi; }
__device__ __forceinline__ unsigned cvtpk(float lo, float hi) {
  unsigned r; asm volatile("v_cvt_pk_bf16_f32 %0, %1, %2" : "=v"(r) : "v"(lo), "v"(hi)); return r;
}
template <typename TIn> struct Stage;
template <> struct Stage<bf16>  { using T = bf16x8;
  __device__ static __forceinline__ T ld8(const bf16* p) { return *reinterpret_cast<const bf16x8*>(p); }
  __device__ static __forceinline__ bf16x8 tobf(T x) { return x; } };
template <> struct Stage<float> { using T = f32x8;
  __device__ static __forceinline__ T ld8(const float* p) { return *reinterpret_cast<const f32x8*>(p); }
  __device__ static __forceinline__ bf16x8 tobf(T x) {
    u32x4 w = {cvtpk(x[0], x[1]), cvtpk(x[2], x[3]), cvtpk(x[4], x[5]), cvtpk(x[6], x[7])}; return *reinterpret_cast<bf16x8*>(&w); } };

__device__ __forceinline__ void partialSM(f32x16& p0, f32x16& p1, float& m_reg, float& mn, float& alpha) {
  constexpr float C = SCALE * 1.4426950408889634f;
  float pmax = p0[0]; for (int r = 1; r < 16; ++r) pmax = fmaxf(pmax, p0[r]); for (int r = 0; r < 16; ++r) pmax = fmaxf(pmax, p1[r]);
  { auto rr = __builtin_amdgcn_permlane32_swap(__float_as_uint(pmax), __float_as_uint(pmax), false, false);
    pmax = fmaxf(__uint_as_float(rr[0]), __uint_as_float(rr[1])); }
  if (__builtin_expect(__all(pmax - m_reg <= THR / SCALE), 1)) { mn = m_reg; alpha = 1.f; }
  else { mn = fmaxf(m_reg, pmax); alpha = __builtin_amdgcn_exp2f((m_reg - mn) * C); m_reg = mn; }
  float mnC = -mn * C;
  for (int r = 0; r < 16; ++r) p0[r] = fmaf(p0[r], C, mnC); for (int r = 0; r < 16; ++r) p1[r] = fmaf(p1[r], C, mnC);
  for (int r = 0; r < 16; ++r) p0[r] = __builtin_amdgcn_exp2f(p0[r]);
}
__device__ __forceinline__ void finishSM(f32x16& p0, f32x16& p1, float alpha, float& l_reg, bf16x8& pa0, bf16x8& pa1, bf16x8& pa2, bf16x8& pa3) {
  for (int r = 0; r < 16; ++r) p1[r] = __builtin_amdgcn_exp2f(p1[r]);
  float ps = 0; for (int r = 0; r < 16; ++r) ps += p0[r]; for (int r = 0; r < 16; ++r) ps += p1[r];
  { auto rr = __builtin_amdgcn_permlane32_swap(__float_as_uint(ps), __float_as_uint(ps), false, false);
    ps = __uint_as_float(rr[0]) + __uint_as_float(rr[1]); }
  l_reg = l_reg * alpha + ps;
#define PK4(P, BASE, OUT) do { unsigned a0 = cvtpk(P[BASE + 0], P[BASE + 1]), a1 = cvtpk(P[BASE + 2], P[BASE + 3]);   \
    unsigned b0 = cvtpk(P[BASE + 4], P[BASE + 5]), b1 = cvtpk(P[BASE + 6], P[BASE + 7]);                              \
    auto r0 = __builtin_amdgcn_permlane32_swap(a0, b0, false, false); auto r1 = __builtin_amdgcn_permlane32_swap(a1, b1, false, false); \
    u32x4 w = {r0[0], r1[0], r0[1], r1[1]}; OUT = *reinterpret_cast<bf16x8*>(&w); } while (0)
  PK4(p0, 0, pa0); PK4(p0, 8, pa1); PK4(p1, 0, pa2); PK4(p1, 8, pa3);
#undef PK4
}
__device__ __forceinline__ void qkt(f32x16& p0, f32x16& p1, const bf16* Ks, const bf16x8* qr, int r32, int hi) {
  p0 = f32x16{}; p1 = f32x16{};
  for (int d0 = 0; d0 < 8; ++d0) { int cb = (d0 * 16 + hi * 8) * 2;
    bf16x8 b0 = *reinterpret_cast<const bf16x8*>((const char*)Ks + KSWZ(r32, cb));
    bf16x8 b1 = *reinterpret_cast<const bf16x8*>((const char*)Ks + KSWZ(32 + r32, cb));
    p0 = __builtin_amdgcn_mfma_f32_32x32x16_bf16(b0, qr[d0], p0, 0, 0, 0);
    p1 = __builtin_amdgcn_mfma_f32_32x32x16_bf16(b1, qr[d0], p1, 0, 0, 0); }
}
__device__ __forceinline__ int v_st(int k, int c) { const int kk = (k & ~0xC) | ((k & 4) << 1) | ((k & 8) >> 1); return ((kk >> 3) * 4 + (c >> 5)) * 512 + ((kk & 7) * 32 + (c & 31)) * 2; }
__device__ __forceinline__ int v_rd_base(int lane) { return ((lane & 3) << 3) | (((lane >> 2) & 3) << 6) | (((lane >> 4) & 1) << 5) | (((lane >> 5) & 1) << 8); }
constexpr int v_rd_off(int d0, int ks, int half) { return d0 * 512 + ks * 4096 + half * 2048; }
template <int OFF> __device__ __forceinline__ s16x4 tr_read(int vb) {
  s16x4 r; asm volatile("ds_read_b64_tr_b16 %0, %1 offset:%2" : "=&v"(r) : "v"(vb), "i"(OFF) : "memory"); return r;
}
template <int D0> __device__ __forceinline__ void pv_one(f32x16& od, int vb, bf16x8 pa0, bf16x8 pa1, bf16x8 pa2, bf16x8 pa3) {
  const s16x4 l0 = tr_read<v_rd_off(D0, 0, 0)>(vb), h0 = tr_read<v_rd_off(D0, 0, 1)>(vb), l1 = tr_read<v_rd_off(D0, 1, 0)>(vb), h1 = tr_read<v_rd_off(D0, 1, 1)>(vb);
  const s16x4 l2 = tr_read<v_rd_off(D0, 2, 0)>(vb), h2 = tr_read<v_rd_off(D0, 2, 1)>(vb), l3 = tr_read<v_rd_off(D0, 3, 0)>(vb), h3 = tr_read<v_rd_off(D0, 3, 1)>(vb);
  asm volatile("s_waitcnt lgkmcnt(0)" ::: "memory"); SBAR();
#define PK(L, H) (bf16x8){L[0], L[1], L[2], L[3], H[0], H[1], H[2], H[3]}
  od = __builtin_amdgcn_mfma_f32_32x32x16_bf16(pa0, PK(l0, h0), od, 0, 0, 0);
  od = __builtin_amdgcn_mfma_f32_32x32x16_bf16(pa1, PK(l1, h1), od, 0, 0, 0);
  od = __builtin_amdgcn_mfma_f32_32x32x16_bf16(pa2, PK(l2, h2), od, 0, 0, 0);
  od = __builtin_amdgcn_mfma_f32_32x32x16_bf16(pa3, PK(l3, h3), od, 0, 0, 0);
#undef PK
}
__device__ __forceinline__ void pv_d0(f32x16* o, int vb, bf16x8 pa0, bf16x8 pa1, bf16x8 pa2, bf16x8 pa3) {
  pv_one<0>(o[0], vb, pa0, pa1, pa2, pa3); pv_one<1>(o[1], vb, pa0, pa1, pa2, pa3); pv_one<2>(o[2], vb, pa0, pa1, pa2, pa3); pv_one<3>(o[3], vb, pa0, pa1, pa2, pa3);
}

template <int LDQ, int LDK, int LDV, int LDO>
__device__ __forceinline__ void attn_dense_body(const bf16* __restrict__ Qb, const bf16* __restrict__ Kh, const bf16* __restrict__ Vh,
                                                unsigned char* __restrict__ Ob, int seq, char* lds) {
  using St = Stage<bf16>; using SQ = Stage<bf16>;
  const int tid = threadIdx.x, wid = tid >> 6, lane = tid & 63, r32 = lane & 31, hi = lane >> 5;
  bf16* V_lds = (bf16*)lds; bf16* K_lds = (bf16*)(lds + 2 * SHM_V);
  float* ws = (float*)(lds + 2 * SHM_V + 2 * SHM_K) + wid * 64; float* li_l = ws; float* al_l = ws + 32;
  float m_reg = -1e30f, l_reg = 0; f32x16 o[4] = {}; bf16x8 qr[8];
  const bf16* Qw = Qb + (long)(wid * QBLK + r32) * LDQ + hi * 8;
#pragma unroll
  for (int d0 = 0; d0 < 8; ++d0) qr[d0] = SQ::tobf(SQ::ld8(Qw + d0 * 16));
  const int sr = tid >> 4, sc = (tid & 15) * 8, vst0 = v_st(sr, sc), vst1 = v_st(32 + sr, sc);
  const int vb0 = (int)(uintptr_t)V_lds + v_rd_base(lane);
  struct { typename St::T vs0, vs1, ks0, ks1; } sr_[SDEPTH];
#define SLOAD(i, k0) do { sr_[i].vs0 = St::ld8(&Vh[(long)((k0) + sr) * LDV + sc]); sr_[i].vs1 = St::ld8(&Vh[(long)((k0) + 32 + sr) * LDV + sc]); \
    sr_[i].ks0 = St::ld8(&Kh[(long)((k0) + sr) * LDK + sc]); sr_[i].ks1 = St::ld8(&Kh[(long)((k0) + 32 + sr) * LDK + sc]); } while (0)
#define SWRITE(b, i) do { *(bf16x8*)((char*)V_lds + (b) * SHM_V + vst0) = St::tobf(sr_[i].vs0);          \
    *(bf16x8*)((char*)V_lds + (b) * SHM_V + vst1) = St::tobf(sr_[i].vs1); int kc = sc * 2;               \
    *(bf16x8*)((char*)K_lds + (b) * SHM_K + KSWZ(sr, kc)) = St::tobf(sr_[i].ks0);                       \
    *(bf16x8*)((char*)K_lds + (b) * SHM_K + KSWZ(32 + sr, kc)) = St::tobf(sr_[i].ks1); } while (0)
#define SWAIT() do { if constexpr (SDEPTH == 2) asm volatile("s_waitcnt vmcnt(4)" ::: "memory"); else asm volatile("s_waitcnt vmcnt(0)" ::: "memory"); } while (0)
#define RESC(a) do { if (__any((a) < 1.f)) { if (hi == 0) al_l[r32] = (a); asm volatile("s_waitcnt lgkmcnt(0)" ::: "memory"); \
    for (int d = 0; d < 4; ++d) for (int r = 0; r < 16; ++r) o[d][r] *= al_l[crow(r, hi)]; } } while (0)
  f32x16 pA0, pA1, pB0, pB1; float mnA, mnB, alA, alB; bf16x8 pa0, pa1, pa2, pa3; const int NT = seq / KVBLK;
  constexpr int SE = 0, SO = SDEPTH - 1;
  SLOAD(SE, 0); asm volatile("s_waitcnt vmcnt(0)" ::: "memory"); SWRITE(0, SE); __syncthreads();
  qkt(pA0, pA1, K_lds, qr, r32, hi); partialSM(pA0, pA1, m_reg, mnA, alA);
  SLOAD(SO, KVBLK); if constexpr (SDEPTH == 2) { if (2 < NT) SLOAD(SE, 2 * KVBLK); }
  SWAIT(); SWRITE(1, SO); __syncthreads();
  for (int j = 1; j + 1 < NT; j += 2) {
    SBAR(); qkt(pB0, pB1, (bf16*)((char*)K_lds + SHM_K), qr, r32, hi);
    finishSM(pA0, pA1, alA, l_reg, pa0, pa1, pa2, pa3); SBAR();
    SLOAD(SO, (j + SDEPTH) * KVBLK); SBAR();
    pv_d0(o, vb0, pa0, pa1, pa2, pa3); partialSM(pB0, pB1, m_reg, mnB, alB);
    __syncthreads(); SWAIT(); SWRITE(0, SE);
    RESC(alB); __syncthreads();
    SBAR(); qkt(pA0, pA1, K_lds, qr, r32, hi);
    finishSM(pB0, pB1, alB, l_reg, pa0, pa1, pa2, pa3); SBAR();
    if (SDEPTH == 1 || j + 3 < NT) SLOAD(SE, (j + 1 + SDEPTH) * KVBLK); SBAR();
    pv_d0(o, vb0 + (int)SHM_V, pa0, pa1, pa2, pa3); partialSM(pA0, pA1, m_reg, mnA, alA);
    __syncthreads(); SWAIT(); SWRITE(1, SO);
    RESC(alA); __syncthreads();
  }
  SBAR(); qkt(pB0, pB1, (bf16*)((char*)K_lds + SHM_K), qr, r32, hi);
  finishSM(pA0, pA1, alA, l_reg, pa0, pa1, pa2, pa3); SBAR();
  pv_d0(o, vb0, pa0, pa1, pa2, pa3); partialSM(pB0, pB1, m_reg, mnB, alB);
  __syncthreads(); RESC(alB);
  finishSM(pB0, pB1, alB, l_reg, pa0, pa1, pa2, pa3); SBAR();
  pv_d0(o, vb0 + (int)SHM_V, pa0, pa1, pa2, pa3);
  if (hi == 0) li_l[r32] = l_reg; asm volatile("s_waitcnt lgkmcnt(0)" ::: "memory");
  float rli[16];
#pragma unroll
  for (int r = 0; r < 16; ++r) rli[r] = __builtin_amdgcn_rcpf(li_l[crow(r, hi)]);
  unsigned char* Ow = Ob + (long)(wid * QBLK) * LDO;
#pragma unroll
  for (int r = 0; r < 16; ++r) { int orow = crow(r, hi);
    for (int d0 = 0; d0 < 4; ++d0) Ow[(long)orow * LDO + d0 * 32 + r32] = (unsigned char)(__builtin_amdgcn_cvt_pk_fp8_f32(o[d0][r] * rli[r] * 64.0f, 0.f, 0, false) & 0xff); }
#undef SLOAD
#undef SWRITE
#undef SWAIT
#undef RESC
}


__device__ __forceinline__ void dilated_unit(const bf16* __restrict__ proj, const float* __restrict__ lutg, bf16* __restrict__ outg, float* __restrict__ lseg,
                                             int d, int hd12, int hh, int r, int i0, char* lds) {
  constexpr int LDP = 10240;
  constexpr float L2E = 1.4426950408889634f, C = SCALE * L2E;
  const int tid = threadIdx.x, wid = tid >> 6, lane = tid & 63, r32 = lane & 31, hi = lane >> 5;
  const int n = 8192 / d;
  char* KV = lds;
  float* lutx = (float*)(lds + 98304);
  float* wsx = (float*)(lds + 98304 + 2048) + wid * 64;
  const int qoff = hd12 * 128, koff = 1536 + hd12 * 128;
  if (tid < 320) { const int o = tid - 96; lutx[tid] = (o >= 0 && o <= 128) ? lutg[o] * L2E : -1e30f; }
  const int iq = i0 + wid * 32 + r32;
  const int sr = tid >> 4, sc = (tid & 15) * 8;
  f32x16 s00, s01, s10, s11, s20, s21;
  const int a = wid >> 1;
  {
    const bf16* Qw = proj + (size_t)(r + iq * d) * LDP + qoff + hi * 8;
    bf16x8 qr[8];
#pragma unroll
    for (int d0 = 0; d0 < 8; ++d0) qr[d0] = *reinterpret_cast<const bf16x8*>(Qw + d0 * 16);
#pragma unroll
    for (int ib = 0; ib < 12; ib += 6) {
      bf16x8 kv6[6];
#pragma unroll
      for (int i = 0; i < 6; ++i) { const int row = sr + 32 * (ib + i); int j = i0 - 64 + row; j = j < 0 ? 0 : (j >= n ? n - 1 : j);
        kv6[i] = *reinterpret_cast<const bf16x8*>(proj + (size_t)(r + j * d) * LDP + koff + sc); }
#pragma unroll
      for (int i = 0; i < 6; ++i) { const int row = sr + 32 * (ib + i);
        *reinterpret_cast<bf16x8*>(KV + (row >> 6) * 16384 + KSWZ(row & 63, sc * 2)) = kv6[i]; }
      SBAR();
    }
    __syncthreads();
    qkt(s00, s01, (const bf16*)(KV + (a + 0) * 16384), qr, r32, hi);
    qkt(s10, s11, (const bf16*)(KV + (a + 1) * 16384), qr, r32, hi);
    qkt(s20, s21, (const bf16*)(KV + (a + 2) * 16384), qr, r32, hi);
  }
  __syncthreads();
  SBAR();
  const int base = -32 * (wid & 1) - 64 - r32 + 4 * hi;
  const float* lp = lutx + (base + 160);
  float mx = -1e30f;
#define DIL_LOGITS(S, TT, HALF) _Pragma("unroll") for (int rr = 0; rr < 16; ++rr) { const float v = fmaf(S[rr], C, lp[64 * TT + 32 * HALF + (rr & 3) + 8 * (rr >> 2)]); S[rr] = v; }
  DIL_LOGITS(s00, 0, 0) DIL_LOGITS(s01, 0, 1) DIL_LOGITS(s10, 1, 0) DIL_LOGITS(s11, 1, 1) DIL_LOGITS(s20, 2, 0) DIL_LOGITS(s21, 2, 1)
#undef DIL_LOGITS
  if (i0 == 0 || i0 + 320 > n) {
    const int lo = -iq - base, hi_ = n - 1 - iq - base;
#define DIL_MASK(S, TT, HALF) _Pragma("unroll") for (int rr = 0; rr < 16; ++rr) { const int c = 64 * TT + 32 * HALF + (rr & 3) + 8 * (rr >> 2); S[rr] = (c >= lo && c <= hi_) ? S[rr] : -1e30f; }
    DIL_MASK(s00, 0, 0) DIL_MASK(s01, 0, 1) DIL_MASK(s10, 1, 0) DIL_MASK(s11, 1, 1) DIL_MASK(s20, 2, 0) DIL_MASK(s21, 2, 1)
#undef DIL_MASK
  }
#define DIL_MAX(S) _Pragma("unroll") for (int rr = 0; rr < 16; ++rr) mx = fmaxf(mx, S[rr]);
  DIL_MAX(s00) DIL_MAX(s01) DIL_MAX(s10) DIL_MAX(s11) DIL_MAX(s20) DIL_MAX(s21)
#undef DIL_MAX
  { auto rr = __builtin_amdgcn_permlane32_swap(__float_as_uint(mx), __float_as_uint(mx), false, false);
    mx = fmaxf(__uint_as_float(rr[0]), __uint_as_float(rr[1])); }
  float ps = 0.f;
#define DIL_EXP(S) _Pragma("unroll") for (int rr = 0; rr < 16; ++rr) { const float p = __builtin_amdgcn_exp2f(S[rr] - mx); S[rr] = p; ps += p; }
  DIL_EXP(s00) DIL_EXP(s01) DIL_EXP(s10) DIL_EXP(s11) DIL_EXP(s20) DIL_EXP(s21)
#undef DIL_EXP
  { auto rr = __builtin_amdgcn_permlane32_swap(__float_as_uint(ps), __float_as_uint(ps), false, false);
    ps = __uint_as_float(rr[0]) + __uint_as_float(rr[1]); }
  bf16x8 pa[12];
#define PK4(P, BASE, OUT) do { unsigned a0 = cvtpk(P[BASE + 0], P[BASE + 1]), a1 = cvtpk(P[BASE + 2], P[BASE + 3]);   \
    unsigned b0 = cvtpk(P[BASE + 4], P[BASE + 5]), b1 = cvtpk(P[BASE + 6], P[BASE + 7]);                              \
    auto r0 = __builtin_amdgcn_permlane32_swap(a0, b0, false, false); auto r1 = __builtin_amdgcn_permlane32_swap(a1, b1, false, false); \
    u32x4 w = {r0[0], r1[0], r0[1], r1[1]}; OUT = *reinterpret_cast<bf16x8*>(&w); } while (0)
  PK4(s00, 0, pa[0]); PK4(s00, 8, pa[1]); PK4(s01, 0, pa[2]); PK4(s01, 8, pa[3]);
  PK4(s10, 0, pa[4]); PK4(s10, 8, pa[5]); PK4(s11, 0, pa[6]); PK4(s11, 8, pa[7]);
  PK4(s20, 0, pa[8]); PK4(s20, 8, pa[9]); PK4(s21, 0, pa[10]); PK4(s21, 8, pa[11]);
#undef PK4
  SBAR();
#pragma unroll
  for (int ib = 0; ib < 12; ib += 6) {
    bf16x8 kv6[6];
#pragma unroll
    for (int i = 0; i < 6; ++i) { const int row = sr + 32 * (ib + i); int j = i0 - 64 + row; j = j < 0 ? 0 : (j >= n ? n - 1 : j);
      kv6[i] = *reinterpret_cast<const bf16x8*>(proj + (size_t)(r + j * d) * LDP + koff + 1536 + sc); }
#pragma unroll
    for (int i = 0; i < 6; ++i) { const int row = sr + 32 * (ib + i);
      *reinterpret_cast<bf16x8*>(KV + (row >> 6) * 16384 + v_st(row & 63, sc)) = kv6[i]; }
    SBAR();
  }
  if (hi == 0) wsx[r32] = ps;
  __syncthreads();
  f32x16 o[4] = {};
  const int vb = (int)(uintptr_t)KV + v_rd_base(lane);
  pv_d0(o, vb + (a + 0) * 16384, pa[0], pa[1], pa[2], pa[3]);
  pv_d0(o, vb + (a + 1) * 16384, pa[4], pa[5], pa[6], pa[7]);
  pv_d0(o, vb + (a + 2) * 16384, pa[8], pa[9], pa[10], pa[11]);
  float rli[16];
#pragma unroll
  for (int rr = 0; rr < 16; ++rr) rli[rr] = __builtin_amdgcn_rcpf(wsx[crow(rr, hi)]);
#pragma unroll
  for (int rr = 0; rr < 16; ++rr) { const int ir = i0 + wid * 32 + crow(rr, hi); bf16* orow = outg + (size_t)(r + ir * d) * 512 + hh * 128 + r32;
#pragma unroll
    for (int d0 = 0; d0 < 4; ++d0) orow[d0 * 32] = __float2bfloat16(o[d0][rr] * rli[rr]); }
  if (hi == 0) lseg[(size_t)(r + iq * d) * 4 + hh] = (mx + __builtin_amdgcn_logf(ps)) * 0.6931471805599453f;
  __syncthreads();
}
}

#define GAS __attribute__((address_space(1)))
#define LAS __attribute__((address_space(3)))
typedef unsigned short bf16;
typedef unsigned v4u __attribute__((ext_vector_type(4)));
typedef unsigned v2u __attribute__((ext_vector_type(2)));
typedef float f32x4 __attribute__((ext_vector_type(4)));
#define LDS_WAIT() asm volatile("s_waitcnt lgkmcnt(0)" ::: "memory")
#define VM_WAIT() asm volatile("s_waitcnt vmcnt(0)" ::: "memory")
__device__ __forceinline__ unsigned pk2(float lo, float hi) { return pg8::cvt_pk_bf16(lo, hi); }
__device__ __forceinline__ float bflo(unsigned w) { return __builtin_bit_cast(float, w << 16); }
__device__ __forceinline__ float bfhi(unsigned w) { return __builtin_bit_cast(float, w & 0xffff0000u); }
#ifndef MK_Q8
#define MK_Q8 0
#endif
__device__ __forceinline__ unsigned pk4_fp8(float a, float b, float c, float d) {
    int w = __builtin_amdgcn_cvt_pk_fp8_f32(a, b, 0, false); w = __builtin_amdgcn_cvt_pk_fp8_f32(c, d, w, true); return (unsigned)w; }
__device__ __forceinline__ float q8f(float v) { const int p = __builtin_amdgcn_cvt_pk_fp8_f32(v, v, 0, false); return __builtin_amdgcn_cvt_f32_fp8(p, 0); }
__device__ __forceinline__ float bf2f(bf16 b) { return __builtin_bit_cast(float, ((unsigned)b) << 16); }

#define XB_TMO      128
#define XB_XCNT(j)  (256  + 64 * (j))
#define XB_XSUB(j)  (1280 + 64 * (j))
#define XB_XGEN(j)  (2304 + 64 * (j))
#define XB_TOP      3328
#define XB_TOPGEN   3392
#define XCD_BAR_WORDS 3456
#define XB_SPIN_CAP (1u << 18)

__device__ __forceinline__ unsigned xb_ld(unsigned* p)              { return __hip_atomic_load(p, __ATOMIC_RELAXED, __HIP_MEMORY_SCOPE_AGENT); }
__device__ __forceinline__ unsigned xb_add(unsigned* p, unsigned v) { return __hip_atomic_fetch_add(p, v, __ATOMIC_RELAXED, __HIP_MEMORY_SCOPE_AGENT); }
__device__ __forceinline__ unsigned xb_xcc_id() { return (unsigned)__builtin_amdgcn_s_getreg((3 << 11) | 20) & 0xFu; }
#define XB_SPIN(cond, bar) do { unsigned _sp = 0; while (cond) { __builtin_amdgcn_s_sleep(1); \
    if ((++_sp & 255u) == 0u) { if (xb_ld(&(bar)[XB_TMO])) break; if (_sp > XB_SPIN_CAP) { atomicAdd(&(bar)[XB_TMO], 1u); break; } } } } while (0)

struct XcdBarrier {
    unsigned* bar; unsigned x;
    volatile LAS unsigned* st;
};

__device__ __forceinline__ XcdBarrier xcd_barrier_post(unsigned* bar, volatile LAS unsigned* st) {
    XcdBarrier b; b.bar = bar; b.x = xb_xcc_id(); b.st = st;
    if (threadIdx.x == 0) (void)xb_add(&bar[XB_XCNT(b.x)], 1u);
    return b;
}
__device__ __forceinline__ void xcd_barrier_complete(unsigned* bar, unsigned x, unsigned& nloc, unsigned& nx) {
    const unsigned G = gridDim.x * gridDim.y * gridDim.z;
    unsigned sum, cnt, mine, sp = 0u;
    for (;;) {
        sum = 0u; cnt = 0u; mine = 0u;
#pragma unroll
        for (unsigned j = 0; j < 16; ++j) { const unsigned c = xb_ld(&bar[XB_XCNT(j)]); sum += c; cnt += (c > 0u) ? 1u : 0u; mine = (j == x) ? c : mine; }
        if (sum == G) break;
        __builtin_amdgcn_s_sleep(1);
        if ((++sp & 255u) == 0u) { if (xb_ld(&bar[XB_TMO])) break; if (sp > XB_SPIN_CAP) { atomicAdd(&bar[XB_TMO], 1u); break; } }
    }
    nloc = mine > 0u ? mine : 1u; nx = cnt > 0u ? cnt : 1u;
}

__device__ __forceinline__ void xcd_barrier(const XcdBarrier& b) {
    asm volatile("s_waitcnt vmcnt(0)" ::: "memory");
    __syncthreads();
    if (threadIdx.x == 0) {
        unsigned* bar = b.bar;
        __builtin_amdgcn_s_waitcnt(0);
        unsigned nloc = b.st[0], nx = b.st[1];
        if (nloc == 0u) { xcd_barrier_complete(bar, b.x, nloc, nx); b.st[0] = nloc; b.st[1] = nx; }
        const unsigned old = xb_add(&bar[XB_XSUB(b.x)], 1u);
        const unsigned gen = old / nloc;
        if (old + 1u == (gen + 1u) * nloc) {
            __builtin_amdgcn_fence(__ATOMIC_RELEASE, "agent");
            asm volatile("s_waitcnt vmcnt(0)" ::: "memory");
            const unsigned og = xb_add(&bar[XB_TOP], 1u);
            const unsigned tg = og / nx;
            if (og + 1u == (tg + 1u) * nx) xb_add(&bar[XB_TOPGEN], 1u);
            else XB_SPIN(xb_ld(&bar[XB_TOPGEN]) == tg, bar);
            __builtin_amdgcn_fence(__ATOMIC_ACQUIRE, "agent");
            xb_add(&bar[XB_XGEN(b.x)], 1u);
            asm volatile("s_waitcnt vmcnt(0)" ::: "memory");
        } else {
            XB_SPIN(xb_ld(&bar[XB_XGEN(b.x)]) == gen, bar);
            __builtin_amdgcn_fence(__ATOMIC_ACQUIRE, "agent");
            asm volatile("s_waitcnt vmcnt(0)" ::: "memory");
        }
    }
    __syncthreads();
}

constexpr int S_ = 8192, DM = 2048, INW = 10240, NE = 32, TOPK = 4;
constexpr int A_W = 1536, A_V_OFF = 3072, B_Q_OFF = 4608, B_K_OFF = 5632, B_V_OFF = 5888, GATE_OFF = 6144;
constexpr int MAXSLOT = 40960;
constexpr float LN_EPS = 1e-5f, QK_EPS = 1e-6f;
constexpr float ALPHA = 1.189207115002721f;
constexpr int NPH = 11;

constexpr size_t MiB = 1u << 20;
constexpr size_t WS_CTL = 0, CTL_ZERO_BYTES = 64 * 1024;
constexpr int CW_BAR = 0;
constexpr int CW_CNT = 4096;
constexpr size_t WS_LUT = 1 * MiB;
constexpr size_t WS_ROPE = 1 * MiB + 8192;
constexpr size_t WS_WRT = 1 * MiB + 65536;
constexpr size_t WS_TOKE = 1 * MiB + 65536 + 262144;
constexpr size_t WS_TOKR = WS_TOKE + 131072;
constexpr size_t WS_TOKW = WS_TOKR + 131072;
constexpr size_t WS_TOKS = WS_TOKW + 131072;
constexpr size_t WS_SLOTW = WS_TOKS + 131072;
constexpr size_t WS_LSE = 3 * MiB;
constexpr size_t WS_XB = 4 * MiB;
constexpr size_t WS_WIN = WS_XB + 32 * MiB;
constexpr size_t WS_WA = WS_WIN + 40 * MiB;
constexpr size_t WS_WB = WS_WA + 2 * MiB;
constexpr size_t WS_WO = WS_WB + 4 * MiB;
constexpr size_t WS_WGL = WS_WO + 8 * MiB;
constexpr size_t WS_WD = WS_WGL + 512 * MiB;
constexpr size_t WS_PROJ = WS_WD + 256 * MiB;
constexpr size_t WS_QBR = WS_PROJ + 160 * MiB;
constexpr size_t WS_KBR = WS_QBR + 16 * MiB;
constexpr size_t WS_VBR = WS_KBR + 4 * MiB;
constexpr size_t WS_OUTA = WS_VBR + 4 * MiB;
constexpr size_t WS_YA = WS_OUTA + 24 * MiB;
constexpr size_t WS_YB = WS_YA + 8 * MiB;
constexpr size_t WS_T1 = WS_YB + 16 * MiB;
constexpr size_t WS_Y = WS_T1 + 64 * MiB;
constexpr size_t WS_X1 = WS_Y + 32 * MiB;
constexpr size_t WS_X1B = WS_X1 + 64 * MiB;
constexpr size_t WS_XS = WS_X1B + 32 * MiB;
constexpr size_t WS_H = WS_XS + 160 * MiB;
constexpr size_t WS_YS = WS_PROJ;
constexpr size_t WS_END = WS_H + 160 * MiB;

constexpr int RING_OFF = 0, RING_BYTES = 131072;
constexpr int L_XB = RING_BYTES;
constexpr int L_TILE = RING_BYTES + 64;
constexpr int L_PST = RING_BYTES + 1024;
constexpr int L_CNT = RING_BYTES + 1280;
constexpr int L_ASG = RING_BYTES + 2048;
constexpr int L_PTR = RING_BYTES + 3584;
constexpr int LDS_BYTES = 147456;

struct Frame {
    LAS unsigned char* lds; unsigned char* ldsg;
    unsigned char* ws; unsigned* ctl;
    int tid, lane, wave, G;
};
__device__ __forceinline__ const float* inp(const Frame& F, int i) {
    const LAS unsigned* p = (const LAS unsigned*)(F.lds + L_PTR) + 2 * i;
    const unsigned lo = __builtin_amdgcn_readfirstlane(p[0]), hi = __builtin_amdgcn_readfirstlane(p[1]);
    return (const float*)(((unsigned long long)hi << 32) | lo);
}
__device__ __forceinline__ float wave_sum(float v) {
#pragma unroll
    for (int o = 1; o < 64; o <<= 1) v += __shfl_xor(v, o);
    return v;
}

__device__ __forceinline__ void transpose_item(const float* __restrict__ W, int N, int k0, int n0, bf16* WT, int ldo, int orow0, int ocol0, LAS float* scr, int lane, const bool q8 = false) {
    f32x4 v[8];
#pragma unroll
    for (int i = 0; i < 8; ++i) v[i] = *(const f32x4*)(W + (size_t)(k0 + 8 * i + (lane >> 3)) * N + n0 + 4 * (lane & 7));
#pragma unroll
    for (int i = 0; i < 8; ++i) { LAS float* s = scr + (8 * i + (lane >> 3)) * 33 + 4 * (lane & 7); if (q8) { for (int e = 0; e < 4; ++e) v[i][e] = q8f(v[i][e] * 64.0f) * (1.0f / 64.0f); } s[0] = v[i][0]; s[1] = v[i][1]; s[2] = v[i][2]; s[3] = v[i][3]; }
    LDS_WAIT(); asm volatile("" ::: "memory");
    const int c = lane & 7;
#pragma unroll
    for (int j = 0; j < 4; ++j) { const int n = (lane >> 3) + 8 * j; const LAS float* s = scr + (8 * c) * 33 + n;
        v4u o; o.x = pk2(s[0 * 33], s[1 * 33]); o.y = pk2(s[2 * 33], s[3 * 33]); o.z = pk2(s[4 * 33], s[5 * 33]); o.w = pk2(s[6 * 33], s[7 * 33]);
        *(v4u*)(WT + (size_t)(orow0 + n) * ldo + ocol0 + 8 * c) = o; }
    LDS_WAIT(); asm volatile("" ::: "memory");
}
__device__ __forceinline__ void transpose_item8(const float* __restrict__ W, int N, int k0, int n0, unsigned char* WT, int ldo, int orow0, int ocol0, float scale, LAS float* scr, int lane) {
    f32x4 v[8];
#pragma unroll
    for (int i = 0; i < 8; ++i) v[i] = *(const f32x4*)(W + (size_t)(k0 + 8 * i + (lane >> 3)) * N + n0 + 4 * (lane & 7));
#pragma unroll
    for (int i = 0; i < 8; ++i) { LAS float* s = scr + (8 * i + (lane >> 3)) * 33 + 4 * (lane & 7); s[0] = v[i][0] * scale; s[1] = v[i][1] * scale; s[2] = v[i][2] * scale; s[3] = v[i][3] * scale; }
    LDS_WAIT(); asm volatile("" ::: "memory");
    const int c = lane & 3;
#pragma unroll
    for (int j = 0; j < 2; ++j) { const int n = (lane >> 2) + 16 * j; const LAS float* s = scr + (16 * c) * 33 + n;
        v4u o; o.x = pk4_fp8(s[0 * 33], s[1 * 33], s[2 * 33], s[3 * 33]); o.y = pk4_fp8(s[4 * 33], s[5 * 33], s[6 * 33], s[7 * 33]);
        o.z = pk4_fp8(s[8 * 33], s[9 * 33], s[10 * 33], s[11 * 33]); o.w = pk4_fp8(s[12 * 33], s[13 * 33], s[14 * 33], s[15 * 33]);
        *(v4u*)(WT + (size_t)(orow0 + n) * ldo + ocol0 + 16 * c) = o; }
    LDS_WAIT(); asm volatile("" ::: "memory");
}
__device__ __forceinline__ int t5_bucket(int rel) {
    const int n = rel < 0 ? -rel : rel; const float nf = (float)(n < 1 ? 1 : n);
    int large = 8 + (int)(logf(nf / 8.0f) / 4.852030263919617f * 8.0f); large = large < 15 ? large : 15;
    return (rel > 0 ? 16 : 0) + (n < 8 ? n : large);
}
__device__ __forceinline__ void p0_prologue(Frame& F) {
    LAS float* scr = (LAS float*)(F.lds + RING_OFF + F.wave * 16384);
    const int gw = blockIdx.x * 8 + F.wave, NGW = F.G * 8;
    const int gt = blockIdx.x * 512 + F.tid, NGT = F.G * 512;
    bf16* XB = (bf16*)(F.ws + WS_XB); bf16* WIN = (bf16*)(F.ws + WS_WIN); bf16* WA = (bf16*)(F.ws + WS_WA); bf16* WB = (bf16*)(F.ws + WS_WB); bf16* WO = (bf16*)(F.ws + WS_WO);
    bf16* WGL = (bf16*)(F.ws + WS_WGL); bf16* WD = (bf16*)(F.ws + WS_WD);
    { float* lut = (float*)(F.ws + WS_LUT); const float* rb = inp(F, 3);
      for (int i = gt; i < 3 * 4 * 129; i += NGT) { const int g = i / 516, hh = (i / 129) % 4, j = i % 129; const int d = (g == 0) ? 1 : (g == 1 ? 4 : 16);
          lut[i] = rb[t5_bucket((j - 64) * d) * 12 + g * 4 + hh]; }
      float* rope = (float*)(F.ws + WS_ROPE);
      for (int i = gt; i < 128 * 32; i += NGT) { const int pos = i >> 5, fi = i & 31; const float inv = powf(10000.0f, -(float)(2 * fi) / 64.0f); const float ang = (float)pos * inv;
          rope[2 * i] = __cosf(ang); rope[2 * i + 1] = __sinf(ang); }
      float* wrt = (float*)(F.ws + WS_WRT); const float* wr = inp(F, 11);
      for (int i = gt; i < 32 * 2048; i += NGT) { const int e = i >> 11, c = i & 2047; wrt[i] = wr[c * 32 + e]; }
    }
    { const float* x = inp(F, 0);
      for (int i = gw; i < S_ * DM / 512; i += NGW) { const size_t o = (size_t)i * 512 + F.lane * 8; const f32x4 a = *(const f32x4*)(x + o), b = *(const f32x4*)(x + o + 4);
          v2u w; w.x = pk4_fp8(a[0], a[1], a[2], a[3]); w.y = pk4_fp8(b[0], b[1], b[2], b[3]); *(v2u*)((unsigned char*)XB + o) = w; } }
    constexpr int T_WIN = 16 * 80, T_WA = 4 * 16, T_WB = 8 * 16, T_WO = 16 * 16, T_EXP = 16 * 16, T_MOE = 3 * 32 * T_EXP;
    constexpr int NT = T_WIN + T_WA + T_WB + T_WO + T_MOE;
    const float* const w_in = inp(F, 1); const float* const w_ba = inp(F, 6); const float* const w_bb = inp(F, 7); const float* const w_o = inp(F, 8);
    const float* const w_g = inp(F, 13); const float* const w_l = inp(F, 15); const float* const w_d = inp(F, 17);
#define P0_DECODE(T, SRC, NN, DST, LDO, SCL) do { int r_ = (T); \
        if (r_ < T_WIN) { const int kt = r_ / 80, nt = r_ % 80; SRC = w_in + (size_t)(128 * kt) * INW + 128 * nt; NN = INW; DST = (unsigned char*)WIN + (size_t)(nt >> 1) * (256 * 2048) + kt * 32768 + (nt & 1) * 16384; LDO = 128; SCL = 64.0f; break; } r_ -= T_WIN; \
        if (r_ < T_WA) { const int kt = r_ / 16, nt = r_ % 16; SRC = w_ba + (size_t)(128 * kt) * DM + 128 * nt; NN = DM; DST = (unsigned char*)WA + (size_t)(nt >> 1) * (256 * 512) + kt * 32768 + (nt & 1) * 16384; LDO = 128; SCL = 32.0f; break; } r_ -= T_WA; \
        if (r_ < T_WB) { const int kt = r_ / 16, nt = r_ % 16; SRC = w_bb + (size_t)(128 * kt) * DM + 128 * nt; NN = DM; DST = (unsigned char*)WB + (size_t)(nt >> 1) * (256 * 1024) + kt * 32768 + (nt & 1) * 16384; LDO = 128; SCL = 32.0f; break; } r_ -= T_WB; \
        if (r_ < T_WO) { const int kt = r_ / 16, nt = r_ % 16; SRC = w_o + (size_t)(128 * kt) * DM + 128 * nt; NN = DM; DST = (unsigned char*)WO + (size_t)(nt >> 1) * (256 * 2048) + kt * 32768 + (nt & 1) * 16384; LDO = 128; SCL = 64.0f; break; } r_ -= T_WO; \
        { const int which = r_ / (32 * T_EXP), rr = r_ % (32 * T_EXP), e = rr / T_EXP, q = rr % T_EXP, kt = q / 16, nt = q % 16; \
          SRC = (which == 0 ? w_g : (which == 1 ? w_l : w_d)) + (size_t)e * DM * DM + (size_t)(128 * kt) * DM + 128 * nt; NN = DM; LDO = 128; SCL = 64.0f; \
          DST = (which < 2) ? (unsigned char*)WGL + (size_t)e * (4096 * 2048) + (size_t)nt * (256 * 2048) + kt * 32768 + which * 16384 : (unsigned char*)WD + (size_t)e * (2048 * 2048) + (size_t)(nt >> 1) * (256 * 2048) + kt * 32768 + (nt & 1) * 16384; } } while (0)
    const int nq = F.tid & 31, kq0 = F.tid >> 5;
#define P0_LOAD(V, SRC, NN) do { _Pragma("unroll") for (int p = 0; p < 2; ++p) _Pragma("unroll") for (int i = 0; i < 4; ++i) V[p * 4 + i] = __builtin_nontemporal_load((const f32x4*)(SRC + (size_t)(4 * (kq0 + 16 * p) + i) * NN + 4 * nq)); } while (0)
    if ((int)blockIdx.x < NT) {
        const int nj = (NT - (int)blockIdx.x + F.G - 1) / F.G;
        const float* src; int nn; unsigned char* dst; int ldo; float scl;
        P0_DECODE((int)blockIdx.x, src, nn, dst, ldo, scl);
        f32x4 v[8]; P0_LOAD(v, src, nn);
        for (int j = 0; j < nj; ++j) {
            const int jn = (j + 1 < nj) ? j + 1 : j;
            const float* nsrc; int nnn; unsigned char* ndst; int nldo; float nscl;
            P0_DECODE((int)blockIdx.x + jn * F.G, nsrc, nnn, ndst, nldo, nscl);
            f32x4 nv[8]; P0_LOAD(nv, nsrc, nnn);
            LAS unsigned* t32 = (LAS unsigned*)(F.lds + RING_OFF + (j & 1) * 16384);
#pragma unroll
            for (int p = 0; p < 2; ++p)
#pragma unroll
                for (int c = 0; c < 4; ++c) t32[(4 * nq + c) * 32 + ((kq0 + 16 * p) ^ nq)] = pk4_fp8(v[p * 4 + 0][c] * scl, v[p * 4 + 1][c] * scl, v[p * 4 + 2][c] * scl, v[p * 4 + 3][c] * scl);
            __syncthreads();
#pragma unroll
            for (int jj = 0; jj < 2; ++jj) { const int n = (F.tid >> 3) + 64 * jj, c8 = F.tid & 7, g = n >> 2; const LAS unsigned* rp = t32 + n * 32;
                v4u o; o.x = rp[(4 * c8 + 0) ^ g]; o.y = rp[(4 * c8 + 1) ^ g]; o.z = rp[(4 * c8 + 2) ^ g]; o.w = rp[(4 * c8 + 3) ^ g];
                __builtin_nontemporal_store(o, (v4u*)(dst + (size_t)n * ldo + 16 * c8)); }
#pragma unroll
            for (int i = 0; i < 8; ++i) v[i] = nv[i];
            src = nsrc; nn = nnn; dst = ndst; ldo = nldo; scl = nscl;
        }
        __syncthreads();
    }
#undef P0_DECODE
#undef P0_LOAD
}

__device__ __forceinline__ void p2_prep_dilated(Frame& F) {
    const bf16* proj = (const bf16*)(F.ws + WS_PROJ);
    bf16* QBR = (bf16*)(F.ws + WS_QBR); bf16* KBR = (bf16*)(F.ws + WS_KBR); bf16* VBR = (bf16*)(F.ws + WS_VBR);
    const float* rope = (const float*)(F.ws + WS_ROPE);
    const int gw = blockIdx.x * 8 + F.wave, NGW = F.G * 8;
    const int half = F.lane >> 5, fi = F.lane & 31, c1 = half * 64 + fi, c2 = c1 + 32;
    const float* const qn_g = inp(F, 4); const float* const kn_g = inp(F, 5);
    int tfirst, tstep_, tcount;
    if (F.G == 256) { if (blockIdx.x >= 128) { tfirst = ((int)blockIdx.x - 128) * 8 + F.wave; tstep_ = 1024; tcount = 6; } else { tfirst = 6144 + (int)blockIdx.x * 8 + F.wave; tstep_ = 1024; tcount = 2; } }
    else { tfirst = gw; tstep_ = NGW; tcount = (S_ - gw + NGW - 1) / NGW; }
    for (int ti = 0; ti < tcount; ++ti) {
        const int t = tfirst + ti * tstep_;
        const bf16* base = proj + (size_t)t * INW;
        float a1[10], a2[10], ss[10];
#pragma unroll
        for (int h = 0; h < 10; ++h) { const bf16* src = base + (h < 8 ? B_Q_OFF + h * 128 : B_K_OFF + (h - 8) * 128); a1[h] = bf2f(src[c1]); a2[h] = bf2f(src[c2]); }
        const unsigned vv0 = ((const unsigned*)(base + B_V_OFF))[F.lane], vv1 = ((const unsigned*)(base + B_V_OFF + 128))[F.lane];
        const int pos = half ? (t & 63) : (t >> 6);
        const float cs = rope[(pos * 32 + fi) * 2], sn = rope[(pos * 32 + fi) * 2 + 1];
        const float gq1 = qn_g[c1], gq2 = qn_g[c2], gk1 = kn_g[c1], gk2 = kn_g[c2];
#pragma unroll
        for (int h = 0; h < 10; ++h) ss[h] = a1[h] * a1[h] + a2[h] * a2[h];
#pragma unroll
        for (int o = 1; o < 64; o <<= 1)
#pragma unroll
            for (int h = 0; h < 10; ++h) ss[h] += __shfl_xor(ss[h], o);
#pragma unroll
        for (int h = 0; h < 10; ++h) {
            const float rs = 1.0f / sqrtf(ss[h] * (1.0f / 128.0f) + QK_EPS);
            const float v1 = a1[h] * rs * (h < 8 ? gq1 : gk1), v2 = a2[h] * rs * (h < 8 ? gq2 : gk2);
            const float o1 = v1 * cs - v2 * sn, o2 = v1 * sn + v2 * cs;
            bf16* dst = h < 8 ? QBR + (size_t)t * 1024 + h * 128 : KBR + (size_t)t * 256 + (h - 8) * 128;
            dst[c1] = (bf16)(pk2(o1, 0.f) & 0xffffu); dst[c2] = (bf16)(pk2(o2, 0.f) & 0xffffu);
        }
        ((unsigned*)(VBR + (size_t)t * 256))[F.lane] = vv0; ((unsigned*)(VBR + (size_t)t * 256 + 128))[F.lane] = vv1;
    }
    const float* lut = (const float*)(F.ws + WS_LUT);
    for (int u = blockIdx.x; u < 384; u += F.G) {
        const int gh = u >> 5, blk = u & 31, g = gh >> 2, hh = gh & 3, d = (g == 0) ? 1 : (g == 1 ? 4 : 16);
        const int bps = 32 / d, r = blk / bps, qb = blk % bps;
        at::dilated_unit((const at::bf16*)proj, lut + (g * 4 + hh) * 129, (at::bf16*)(F.ws + WS_OUTA) + (size_t)g * S_ * 512, (float*)(F.ws + WS_LSE) + (size_t)g * S_ * 4,
                         d, gh, hh, r, qb * 256, (char*)F.ldsg + RING_OFF);
    }
}

__device__ __forceinline__ void p3_attn_combine(Frame& F) {
    const at::bf16* QBR = (const at::bf16*)(F.ws + WS_QBR); const at::bf16* KBR = (const at::bf16*)(F.ws + WS_KBR); const at::bf16* VBR = (const at::bf16*)(F.ws + WS_VBR);
    unsigned char* YB = F.ws + WS_YB;
    for (int u = blockIdx.x; u < 256; u += F.G) {
        const int h = u & 7, qb = u >> 3, kv = h >> 2;
        at::attn_dense_body<1024, 256, 256, 1024>(QBR + (size_t)qb * 256 * 1024 + h * 128, KBR + kv * 128, VBR + kv * 128, YB + (size_t)qb * 256 * 1024 + h * 128, S_, (char*)F.ldsg + RING_OFF);
        __syncthreads();
    }
    const bf16* OUTA = (const bf16*)(F.ws + WS_OUTA); const float* LSE = (const float*)(F.ws + WS_LSE); bf16* YA = (bf16*)(F.ws + WS_YA);
    for (int tb = blockIdx.x; tb < 256; tb += F.G) {
        const int t = tb * 32 + (F.tid >> 4), c0 = (F.tid & 15) * 32, hh = c0 >> 7;
        const float l0 = LSE[(size_t)t * 4 + hh], l1 = LSE[(size_t)(S_ + t) * 4 + hh], l2 = LSE[(size_t)(2 * S_ + t) * 4 + hh];
        const float m = fmaxf(l0, fmaxf(l1, l2)); float w0 = __expf(l0 - m), w1 = __expf(l1 - m), w2 = __expf(l2 - m); const float inv = 16.0f / (w0 + w1 + w2); w0 *= inv; w1 *= inv; w2 *= inv;
#pragma unroll
        for (int q = 0; q < 4; ++q) { const size_t o = (size_t)t * 512 + c0 + q * 8;
            const v4u a = *(const v4u*)(OUTA + o), b = *(const v4u*)(OUTA + (size_t)S_ * 512 + o), c = *(const v4u*)(OUTA + (size_t)2 * S_ * 512 + o);
            v2u w;
            w.x = pk4_fp8(w0 * bflo(a.x) + w1 * bflo(b.x) + w2 * bflo(c.x), w0 * bfhi(a.x) + w1 * bfhi(b.x) + w2 * bfhi(c.x), w0 * bflo(a.y) + w1 * bflo(b.y) + w2 * bflo(c.y), w0 * bfhi(a.y) + w1 * bfhi(b.y) + w2 * bfhi(c.y));
            w.y = pk4_fp8(w0 * bflo(a.z) + w1 * bflo(b.z) + w2 * bflo(c.z), w0 * bfhi(a.z) + w1 * bfhi(b.z) + w2 * bfhi(c.z), w0 * bflo(a.w) + w1 * bflo(b.w) + w2 * bflo(c.w), w0 * bfhi(a.w) + w1 * bfhi(b.w) + w2 * bfhi(c.w));
            *(v2u*)((unsigned char*)YA + o) = w; }
    }
}

__device__ __forceinline__ void p6_ln_router(Frame& F, const int bank = 0) {
    LAS int* cntl = (LAS int*)(F.lds + L_CNT); LAS int* basel = cntl + 32;
    LAS int* asg_e = (LAS int*)(F.lds + L_ASG); LAS int* asg_lr = asg_e + 128; LAS float* asg_w = (LAS float*)(asg_lr + 128);
    const float* Z1 = (const float*)(F.ws + WS_T1); float* X1 = (float*)(F.ws + WS_X1); bf16* X1B = (bf16*)(F.ws + WS_X1B);
    const f32x4* G4 = (const f32x4*)inp(F, 9); const f32x4* B4 = (const f32x4*)inp(F, 10);
    const f32x4* WRT4 = (const f32x4*)(F.ws + WS_WRT); const float* br = inp(F, 12);
    unsigned* gcnt = F.ctl + CW_CNT + bank * 64;
    int* TOKE = (int*)(F.ws + (bank ? WS_H : WS_TOKE)); int* TOKR = (int*)(F.ws + (bank ? WS_H + MiB : WS_TOKR)); float* TOKW = (float*)(F.ws + (bank ? WS_H + 2 * MiB : WS_TOKW));
    for (int tb = blockIdx.x; tb < 256; tb += F.G) {
        if (F.tid < 32) cntl[F.tid] = 0;
        __syncthreads();
#pragma unroll 1
        for (int hp = 0; hp < 2; ++hp) {
        const int t0 = tb * 32 + F.wave * 4 + hp * 2;
        f32x4 xv[2][8];
#pragma unroll
        for (int tk = 0; tk < 2; ++tk) {
            const f32x4* zr = (const f32x4*)(Z1 + (size_t)(t0 + tk) * DM) + F.lane; float s = 0.f;
#pragma unroll
            for (int j = 0; j < 8; ++j) { xv[tk][j] = zr[64 * j]; s += (xv[tk][j][0] + xv[tk][j][1]) + (xv[tk][j][2] + xv[tk][j][3]); }
            const float mean = wave_sum(s) * (1.0f / DM); float s2 = 0.f;
#pragma unroll
            for (int j = 0; j < 8; ++j) { xv[tk][j] = xv[tk][j] - mean; s2 += (xv[tk][j][0] * xv[tk][j][0] + xv[tk][j][1] * xv[tk][j][1]) + (xv[tk][j][2] * xv[tk][j][2] + xv[tk][j][3] * xv[tk][j][3]); }
            const float rstd = 1.0f / sqrtf(wave_sum(s2) * (1.0f / DM) + LN_EPS);
            f32x4* xo = (f32x4*)(X1 + (size_t)(t0 + tk) * DM) + F.lane; unsigned* xb = (unsigned*)((unsigned char*)X1B + (size_t)(t0 + tk) * DM) + F.lane;
#pragma unroll
            for (int j = 0; j < 8; ++j) { const f32x4 v = xv[tk][j] * rstd * G4[64 * j + F.lane] + B4[64 * j + F.lane]; xv[tk][j] = v; xo[64 * j] = v;
                xb[64 * j] = pk4_fp8(v[0], v[1], v[2], v[3]); }
        }
        float logit[2] = {-3.0e38f, -3.0e38f};
#pragma unroll 1
        for (int e = 0; e < 32; ++e) {
            f32x4 w[8];
#pragma unroll
            for (int j = 0; j < 8; ++j) w[j] = WRT4[e * 512 + 64 * j + F.lane];
            const float be = br[e];
#pragma unroll
            for (int tk = 0; tk < 2; ++tk) { float p = 0.f;
#pragma unroll
                for (int j = 0; j < 8; ++j) p += (xv[tk][j][0] * w[j][0] + xv[tk][j][1] * w[j][1]) + (xv[tk][j][2] * w[j][2] + xv[tk][j][3] * w[j][3]);
                const float sres = wave_sum(p) + be; logit[tk] = (F.lane == e) ? sres : logit[tk]; }
        }
#pragma unroll
        for (int tk = 0; tk < 2; ++tk) {
            float v = logit[tk]; float tv[4]; int ti[4];
#pragma unroll
            for (int k = 0; k < 4; ++k) { float bv = v; int bi = F.lane;
#pragma unroll
                for (int o = 1; o < 64; o <<= 1) { const float ov = __shfl_xor(bv, o); const int oi = __shfl_xor(bi, o); if (ov > bv || (ov == bv && oi < bi)) { bv = ov; bi = oi; } }
                tv[k] = bv; ti[k] = bi; if (F.lane == bi) v = -3.0e38f; }
            const float e1 = __expf(tv[1] - tv[0]), e2 = __expf(tv[2] - tv[0]), e3 = __expf(tv[3] - tv[0]); const float inv = 1.0f / (1.0f + e1 + e2 + e3);
            if (F.lane < 4) { const int me = F.lane == 0 ? ti[0] : (F.lane == 1 ? ti[1] : (F.lane == 2 ? ti[2] : ti[3]));
                const float mw = (F.lane == 0 ? 1.0f : (F.lane == 1 ? e1 : (F.lane == 2 ? e2 : e3))) * inv;
                const int lr = atomicAdd((int*)(cntl + me), 1);
                const int a = (F.wave * 4 + hp * 2 + tk) * 4 + F.lane; asg_e[a] = me; asg_lr[a] = lr; asg_w[a] = mw; }
        }
        }
        __syncthreads();
        if (F.tid < 32) basel[F.tid] = (int)atomicAdd(gcnt + F.tid, (unsigned)cntl[F.tid]);
        __syncthreads();
        if (F.tid < 128) { const int a = tb * 128 + F.tid; const int e = asg_e[F.tid]; TOKE[a] = e; TOKR[a] = basel[e] + asg_lr[F.tid]; TOKW[a] = asg_w[F.tid]; }
        __syncthreads();
    }
}

__device__ __forceinline__ void p7_gather(Frame& F) {
    LAS int* pst = (LAS int*)(F.lds + L_PST);
    const unsigned* gcnt = F.ctl + CW_CNT;
    if (F.tid == 0) { int acc = 0; for (int e = 0; e < 32; ++e) { pst[e] = acc; acc += ((int)gcnt[e] + 255) & ~255; } pst[32] = acc; }
    __syncthreads();
    const int* TOKE = (const int*)(F.ws + WS_TOKE); const int* TOKR = (const int*)(F.ws + WS_TOKR); const float* TOKW = (const float*)(F.ws + WS_TOKW);
    int* TOKS = (int*)(F.ws + WS_TOKS); float* SLOTW = (float*)(F.ws + WS_SLOTW);
    const bf16* X1B = (const bf16*)(F.ws + WS_X1B); bf16* XS = (bf16*)(F.ws + WS_XS);
    const int gw = blockIdx.x * 8 + F.wave, NGW = F.G * 8;
    for (int a0 = gw; a0 < S_ * TOPK; a0 += 4 * NGW) {
        int slot[4]; float w[4]; v4u r0[4], r1[4];
#pragma unroll
        for (int q = 0; q < 4; ++q) { const int a = a0 + q * NGW; const int ac = a < S_ * TOPK ? a : a0; slot[q] = pst[TOKE[ac]] + TOKR[ac]; w[q] = TOKW[ac]; }
#pragma unroll
        for (int q = 0; q < 4; ++q) { const int a = a0 + q * NGW; const int ac = a < S_ * TOPK ? a : a0; const v4u* src = (const v4u*)((const unsigned char*)X1B + (size_t)(ac >> 2) * DM) + F.lane; r0[q] = src[0]; r1[q] = src[64]; }
#pragma unroll
        for (int q = 0; q < 4; ++q) { const int a = a0 + q * NGW; if (a < S_ * TOPK) { if (F.lane == 0) { TOKS[a] = slot[q]; SLOTW[slot[q]] = w[q]; }
            v4u* dst = (v4u*)((unsigned char*)XS + (size_t)slot[q] * DM) + F.lane; dst[0] = r0[q]; dst[64] = r1[q]; } }
    }
}
__device__ __forceinline__ int moe_tiles(Frame& F) {
    LAS int* tile_e = (LAS int*)(F.lds + L_TILE);
    const unsigned* gcnt = F.ctl + CW_CNT;
    __syncthreads();
    if (F.tid == 0) { int ti = 0; for (int e = 0; e < 32; ++e) { const int nt = ((int)gcnt[e] + 255) >> 8; for (int k = 0; k < nt && ti < 160; ++k) tile_e[ti++] = e; } tile_e[160] = ti; }
    __syncthreads();
    return tile_e[160];
}

__device__ __forceinline__ void p10_final(Frame& F) {
    const float* X1 = (const float*)(F.ws + WS_X1); const bf16* YS = (const bf16*)(F.ws + WS_YS); const int* TOKS = (const int*)(F.ws + WS_TOKS);
    const f32x4* G4 = (const f32x4*)inp(F, 19); const f32x4* B4 = (const f32x4*)inp(F, 20);
    float* outp = (float*)inp(F, 21);
    const int gw = blockIdx.x * 8 + F.wave, NGW = F.G * 8;
    for (int t0 = gw; t0 < S_; t0 += 2 * NGW) {
        f32x4 v[2][8]; int tt[2];
#pragma unroll
        for (int q = 0; q < 2; ++q) { const int t = t0 + q * NGW; tt[q] = t < S_ ? t : t0; }
        int sl[2][4];
#pragma unroll
        for (int q = 0; q < 2; ++q)
#pragma unroll
            for (int k = 0; k < 4; ++k) sl[q][k] = TOKS[tt[q] * 4 + k];
#pragma unroll
        for (int q = 0; q < 2; ++q) {
            const f32x4* xr = (const f32x4*)(X1 + (size_t)tt[q] * DM) + F.lane;
            const v2u* y0 = (const v2u*)(YS + (size_t)sl[q][0] * DM) + F.lane; const v2u* y1 = (const v2u*)(YS + (size_t)sl[q][1] * DM) + F.lane;
            const v2u* y2 = (const v2u*)(YS + (size_t)sl[q][2] * DM) + F.lane; const v2u* y3 = (const v2u*)(YS + (size_t)sl[q][3] * DM) + F.lane;
#pragma unroll
            for (int j = 0; j < 8; ++j) { const v2u a = y0[64 * j], b = y1[64 * j], c = y2[64 * j], d = y3[64 * j]; f32x4 f;
                f[0] = (bflo(a.x) + bflo(b.x)) + (bflo(c.x) + bflo(d.x)); f[1] = (bfhi(a.x) + bfhi(b.x)) + (bfhi(c.x) + bfhi(d.x));
                f[2] = (bflo(a.y) + bflo(b.y)) + (bflo(c.y) + bflo(d.y)); f[3] = (bfhi(a.y) + bfhi(b.y)) + (bfhi(c.y) + bfhi(d.y));
                v[q][j] = xr[64 * j] * ALPHA + f; }
        }
#pragma unroll
        for (int q = 0; q < 2; ++q) {
            float s = 0.f;
#pragma unroll
            for (int j = 0; j < 8; ++j) s += (v[q][j][0] + v[q][j][1]) + (v[q][j][2] + v[q][j][3]);
            const float mean = wave_sum(s) * (1.0f / DM); float s2 = 0.f;
#pragma unroll
            for (int j = 0; j < 8; ++j) { v[q][j] = v[q][j] - mean; s2 += (v[q][j][0] * v[q][j][0] + v[q][j][1] * v[q][j][1]) + (v[q][j][2] * v[q][j][2] + v[q][j][3] * v[q][j][3]); }
            const float rstd = 1.0f / sqrtf(wave_sum(s2) * (1.0f / DM) + LN_EPS);
            if (t0 + q * NGW < S_) { f32x4* o = (f32x4*)(outp + (size_t)tt[q] * DM) + F.lane;
#pragma unroll
                for (int j = 0; j < 8; ++j) o[64 * j] = v[q][j] * rstd * G4[64 * j + F.lane] + B4[64 * j + F.lane]; }
        }
    }
}

struct Args { const float* in[21]; float* out; unsigned char* ws; int ph_lo, ph_hi; };
__global__ void __launch_bounds__(512, 2) mk_fwd(Args args) {
    extern __shared__ __attribute__((aligned(16))) unsigned char lds[];
    Frame F;
    F.lds = (LAS unsigned char*)lds; F.ldsg = lds;
    F.tid = threadIdx.x; F.lane = F.tid & 63; F.wave = __builtin_amdgcn_readfirstlane(F.tid >> 6); F.G = gridDim.x;
    F.ws = args.ws; F.ctl = (unsigned*)(args.ws + WS_CTL);
    if (F.tid == 0) { LAS unsigned long long* pp = (LAS unsigned long long*)(F.lds + L_PTR);
#pragma unroll
        for (int i = 0; i < 21; ++i) pp[i] = (unsigned long long)args.in[i];
        pp[21] = (unsigned long long)args.out; }
    if (F.tid < 4) ((LAS unsigned*)(F.lds + L_XB))[F.tid] = 0u;
    __syncthreads();
    const int lo = args.ph_lo, hi = args.ph_hi;
    XcdBarrier bar; bar.bar = F.ctl + CW_BAR; bar.x = 0; bar.st = (volatile LAS unsigned*)(F.lds + L_XB);
    if (hi - lo > 1) bar = xcd_barrier_post(F.ctl + CW_BAR, (volatile LAS unsigned*)(F.lds + L_XB));
#ifndef MK_PHASE_MASK
#define MK_PHASE_MASK 0x7ff
#endif
#define IN(k) (((MK_PHASE_MASK >> (k)) & 1) && lo <= (k) && (k) < hi)
#ifndef MK_DUP_MASK
#define MK_DUP_MASK 0
#endif
#define REP(k) for (int rep_ = 0; rep_ < 1 + ((MK_DUP_MASK >> (k)) & 1); ++rep_)
#ifndef MK_BAR2
#define MK_BAR2 0
#endif
#ifndef MK_STAMP_IDX
#define MK_STAMP_IDX -1
#endif
    unsigned long long st0_ = 0ull, stk_ = 0ull;
    if (MK_STAMP_IDX >= 0) st0_ = __builtin_amdgcn_s_memrealtime();
#define SEAM(k) do { if (IN(k) && IN((k) + 1)) { xcd_barrier(bar); if (MK_BAR2) xcd_barrier(bar); if (MK_STAMP_IDX == (k) + 1) stk_ = __builtin_amdgcn_s_memrealtime(); } } while (0)
    LAS unsigned char* ring = F.lds + RING_OFF;
    const pg8::bf16_t* XB = (const pg8::bf16_t*)(F.ws + WS_XB);

    if (IN(0)) REP(0) { p0_prologue(F); }
    SEAM(0);
    if (IN(1)) REP(1) {
        pg8::Gemm g{XB, (const pg8::bf16_t*)(F.ws + WS_WIN), S_, INW, DM / 2}; pg8::StaticOrder S; S.init(S_, INW, F.G, (int)blockIdx.x);
        pg8::EpiStoreBf16 E{(pg8::bf16_t*)(F.ws + WS_PROJ), INW, 1.0f / 64.0f};
        pg8::gemm_phase<pg8::EpiStoreBf16, pg8::StaticOrder, true, true, true, true>(ring, g, S, E);
    }
    SEAM(1);
    if (IN(2)) { p2_prep_dilated(F); if ((MK_DUP_MASK >> 2) & 1) p2_prep_dilated(F); }
    SEAM(2);
    if (IN(3)) REP(3) { p3_attn_combine(F); }
    SEAM(3);
#define PHASE4_BODY { \
        { pg8::Gemm g{(const pg8::bf16_t*)(F.ws + WS_YA), (const pg8::bf16_t*)(F.ws + WS_WA), S_, DM, 256}; pg8::StaticOrder S; S.init(S_, DM, F.G, (int)blockIdx.x); \
          pg8::EpiGateA E{(const pg8::bf16_t*)(F.ws + WS_PROJ), INW, GATE_OFF, inp(F, 2), (float*)(F.ws + WS_T1), DM, 1.0f / 512.0f}; \
          pg8::gemm_phase<pg8::EpiGateA, pg8::StaticOrder, true, true, true, true>(ring, g, S, E); } \
        { pg8::Gemm g{(const pg8::bf16_t*)(F.ws + WS_YB), (const pg8::bf16_t*)(F.ws + WS_WB), S_, DM, 512}; pg8::StaticOrder S; S.init(S_, DM, F.G, (int)blockIdx.x); \
          pg8::EpiGateB E{(const pg8::bf16_t*)(F.ws + WS_PROJ), INW, GATE_OFF + DM, inp(F, 2) + DM, (const float*)(F.ws + WS_T1), F.ws + WS_Y, DM, 1.0f / 2048.0f}; \
          pg8::gemm_phase<pg8::EpiGateB, pg8::StaticOrder, true, true, true, true>(ring, g, S, E); } \
    }
    if (IN(4)) { PHASE4_BODY if ((MK_DUP_MASK >> 4) & 1) PHASE4_BODY }
    SEAM(4);
    if (IN(5)) REP(5) {
        pg8::Gemm g{(const pg8::bf16_t*)(F.ws + WS_Y), (const pg8::bf16_t*)(F.ws + WS_WO), S_, DM, DM / 2}; pg8::StaticOrder S; S.init(S_, DM, F.G, (int)blockIdx.x);
        pg8::EpiResF32 E{inp(F, 0), (float*)(F.ws + WS_T1), DM, ALPHA, 1.0f / 4096.0f};
        pg8::gemm_phase<pg8::EpiResF32, pg8::StaticOrder, true, true, true, true>(ring, g, S, E);
    }
    SEAM(5);
    if (IN(6)) { p6_ln_router(F); if ((MK_DUP_MASK >> 6) & 1) p6_ln_router(F, 1); }
    SEAM(6);
    if (IN(7)) REP(7) { p7_gather(F); }
    SEAM(7);
    if (IN(8)) REP(8) {
        const int nt = moe_tiles(F);
        pg8::Gemm g{(const pg8::bf16_t*)(F.ws + WS_XS), (const pg8::bf16_t*)(F.ws + WS_WGL), nt * 256, 4096, DM / 2};
        pg8::MoeOrder S; S.init(nt * 256, 4096, F.G, (int)blockIdx.x); S.tile_e = (const LAS int*)(F.lds + L_TILE); S.estride = (size_t)4096 * 2048;
        pg8::EpiSwiglu E{(const LAS int*)(F.lds + L_TILE), inp(F, 14), inp(F, 16), F.ws + WS_H, DM, 1.0f / 64.0f};
        pg8::gemm_phase<pg8::EpiSwiglu, pg8::MoeOrder, true, true, true, true>(ring, g, S, E);
    }
    SEAM(8);
    if (IN(9)) REP(9) {
        const int nt = moe_tiles(F);
        pg8::Gemm g{(const pg8::bf16_t*)(F.ws + WS_H), (const pg8::bf16_t*)(F.ws + WS_WD), nt * 256, DM, DM / 2};
        pg8::MoeOrder S; S.init(nt * 256, DM, F.G, (int)blockIdx.x); S.tile_e = (const LAS int*)(F.lds + L_TILE); S.estride = (size_t)2048 * 2048;
        pg8::EpiDown E{(const LAS int*)(F.lds + L_TILE), inp(F, 18), (const float*)(F.ws + WS_SLOTW), (pg8::bf16_t*)(F.ws + WS_YS), DM, 1.0f / 64.0f};
        pg8::gemm_phase<pg8::EpiDown, pg8::MoeOrder, true, true, true, true>(ring, g, S, E);
    }
    SEAM(9);
    if (IN(10)) REP(10) { p10_final(F); }
    if (MK_STAMP_IDX >= 0 && blockIdx.x == 0 && F.tid == 0) {
        const unsigned long long te = __builtin_amdgcn_s_memrealtime(), dt = stk_ - st0_;
        while (__builtin_amdgcn_s_memrealtime() - te < dt) __builtin_amdgcn_s_sleep(8);
    }
#undef IN
#undef SEAM
}

#ifndef MK_CUTS
#define MK_CUTS 0
#endif
extern "C" void kernel_launch(void* const* d_in, const int* in_sizes, int n_in, void* d_out, int out_size, void* d_ws, size_t ws_size, hipStream_t stream) {
    static int grid = 0;
    if (grid == 0) {
        if (n_in != 21 || out_size != S_ * DM || ws_size < WS_END) { fprintf(stderr, "kernel_launch: unexpected shapes (n_in %d out %d ws %zu, need %zu)\n", n_in, out_size, ws_size, (size_t)WS_END); grid = -1; return; }
        int dev = 0, cus = 0, per_cu = 0;
        if (hipGetDevice(&dev) != hipSuccess || hipDeviceGetAttribute(&cus, hipDeviceAttributeMultiprocessorCount, dev) != hipSuccess) { grid = -1; return; }
        if (hipFuncSetAttribute((const void*)mk_fwd, hipFuncAttributeMaxDynamicSharedMemorySize, LDS_BYTES) != hipSuccess) { fprintf(stderr, "kernel_launch: hipFuncSetAttribute failed\n"); grid = -1; return; }
        if (hipOccupancyMaxActiveBlocksPerMultiprocessor(&per_cu, (const void*)mk_fwd, 512, LDS_BYTES) != hipSuccess || per_cu < 1) { fprintf(stderr, "kernel_launch: occupancy query says %d\n", per_cu); per_cu = 1; }
        (void)hipGetLastError();
        grid = cus;
    }
    if (grid < 0) return;
    (void)hipMemsetAsync((char*)d_ws + WS_CTL, 0, CTL_ZERO_BYTES, stream);
    Args a{};
    for (int i = 0; i < 21; ++i) a.in[i] = (const float*)d_in[i];
    a.out = (float*)d_out; a.ws = (unsigned char*)d_ws;
#if MK_CUTS
    for (int p = 0; p < NPH; ++p) { a.ph_lo = p; a.ph_hi = p + 1; hipLaunchKernelGGL(mk_fwd, dim3(grid), dim3(512), LDS_BYTES, stream, a); }
#else
    a.ph_lo = 0; a.ph_hi = NPH; hipLaunchKernelGGL(mk_fwd, dim3(grid), dim3(512), LDS_BYTES, stream, a);
#endif
}
```

```cpp
#include <hip/hip_runtime.h>
#include <hip/hip_bf16.h>
#include <cstdio>
#include <cstdint>
#define MK_CUTS 0
namespace pg8 {
#define PG8_LAS __attribute__((address_space(3)))
typedef unsigned short bf16_t;
typedef short bf16x8 __attribute__((ext_vector_type(8)));
typedef float f32x4 __attribute__((ext_vector_type(4)));
typedef unsigned u32x4 __attribute__((ext_vector_type(4)));
constexpr int BM = 256, BK = 64, HALF = 128, HTB = HALF * BK * 2  , STAGE_BYTES = 8 * HTB, NXCD = 8, WGM = 8;

__host__ __device__ __forceinline__ int lds_byte(int r, int c) { const int st = (r >> 4) * 2 + (c >> 5), rr = r & 15, cc = c & 31, ob = rr * 64 + cc * 2; return st * 1024 + (ob ^ (((ob >> 9) & 1) << 5)); }
__host__ __device__ __forceinline__ void stage_rc(int b, int& R, int& C) { const int st = b / 1024, sb = b % 1024, swz = sb ^ (((sb >> 9) & 1) << 5); R = (st >> 1) * 16 + swz / 64; C = (st & 1) * 32 + (swz % 64) / 2; }
__host__ __device__ __forceinline__ int perm32(int rho) { const int n = rho >> 4, i = rho & 15; return 8 * (i >> 2) + 4 * n + (i & 3); }

struct Unit { int pm, pn; };
struct Gemm { const bf16_t* A; const bf16_t* Bt; int M, N, K; };

struct StaticOrder {
    int nM, nN, nwg, G, c;
    __host__ __device__ void init(int M, int N, int G_, int c_) { nM = M / BM; nN = N / BM; nwg = nM * nN; G = G_; c = c_; }
    __host__ __device__ bool next(int i, Unit& u) const {
        const long L = (long)i * G + c; if (L >= nwg) return false;
        int wgid = (int)L; { const int q = nwg / NXCD, r = nwg % NXCD, xcd = wgid % NXCD, off = wgid / NXCD; wgid = (xcd < r ? xcd * (q + 1) : r * (q + 1) + (xcd - r) * q) + off; }
        const int nig = WGM * nN, gid = wgid / nig, fm = gid * WGM, gsz = (nM - fm) < WGM ? (nM - fm) : WGM;
        u.pm = fm + ((wgid % nig) % gsz); u.pn = (wgid % nig) / gsz; return true;
    }
    __device__ __forceinline__ void a_ready(const Unit&) const {}
    __device__ __forceinline__ size_t b_off(const Unit&) const { return 0; }
    __device__ __forceinline__ void done(const Unit&) const {}
};


typedef unsigned u32x2 __attribute__((ext_vector_type(2)));
__device__ __forceinline__ unsigned cvt_pk_bf16(float lo, float hi) { unsigned r; asm volatile("v_cvt_pk_bf16_f32 %0, %1, %2" : "=v"(r) : "v"(lo), "v"(hi)); return r; }
__device__ __forceinline__ unsigned pk4_fp8_(float a, float b, float c, float d) { int w = __builtin_amdgcn_cvt_pk_fp8_f32(a, b, 0, false); w = __builtin_amdgcn_cvt_pk_fp8_f32(c, d, w, true); return (unsigned)w; }
__device__ __forceinline__ float bf_lo(unsigned w) { return __builtin_bit_cast(float, w << 16); }
__device__ __forceinline__ float bf_hi(unsigned w) { return __builtin_bit_cast(float, w & 0xffff0000u); }
__device__ __forceinline__ float sigmoidf_(float v) { return __builtin_amdgcn_rcpf(1.0f + __expf(-v)); }

struct EpiStoreBf16 {
    static constexpr bool PERM = true, AFTER_DRAIN = false;
    bf16_t* O; int ldc; float sc;
    __device__ __forceinline__ void operator()(const f32x4 (&acc)[2][2][4][2], const Unit& u, int wr, int wc, int fr, int fq) const {
        const int row0 = u.pm * BM + wr * 64 + fr, col0 = u.pn * BM + wc * 32 + 8 * fq;
#pragma unroll
        for (int ai = 0; ai < 2; ++ai)
#pragma unroll
            for (int m = 0; m < 4; ++m) { bf16_t* rowp = O + (size_t)(row0 + ai * HALF + m * 16) * ldc + col0;
#pragma unroll
                for (int bj = 0; bj < 2; ++bj) { const f32x4 v0 = acc[ai][bj][m][0] * sc, v1 = acc[ai][bj][m][1] * sc;
                    u32x4 w; w.x = cvt_pk_bf16(v0[0], v0[1]); w.y = cvt_pk_bf16(v0[2], v0[3]); w.z = cvt_pk_bf16(v1[0], v1[1]); w.w = cvt_pk_bf16(v1[2], v1[3]);
                    *(u32x4*)(rowp + bj * HALF) = w; } }
    }
};

struct EpiGateA {
    static constexpr bool PERM = true, AFTER_DRAIN = false;
    const bf16_t* proj; int ldp; int gcol0; const float* bg; float* T1; int ldc; float sc;
    __device__ __forceinline__ void operator()(const f32x4 (&acc)[2][2][4][2], const Unit& u, int wr, int wc, int fr, int fq) const {
        const int row0 = u.pm * BM + wr * 64 + fr, col0 = u.pn * BM + wc * 32 + 8 * fq;
#pragma unroll
        for (int ai = 0; ai < 2; ++ai)
#pragma unroll
            for (int m = 0; m < 4; ++m) { const int row = row0 + ai * HALF + m * 16;
#pragma unroll
                for (int bj = 0; bj < 2; ++bj) { const int c = col0 + bj * HALF;
                    const u32x4 gw = *(const u32x4*)(proj + (size_t)row * ldp + gcol0 + c);
                    const f32x4 b0 = *(const f32x4*)(bg + c), b1 = *(const f32x4*)(bg + c + 4);
                    f32x4 g0, g1;
                    g0[0] = sigmoidf_(bf_lo(gw.x) + b0[0]); g0[1] = sigmoidf_(bf_hi(gw.x) + b0[1]); g0[2] = sigmoidf_(bf_lo(gw.y) + b0[2]); g0[3] = sigmoidf_(bf_hi(gw.y) + b0[3]);
                    g1[0] = sigmoidf_(bf_lo(gw.z) + b1[0]); g1[1] = sigmoidf_(bf_hi(gw.z) + b1[1]); g1[2] = sigmoidf_(bf_lo(gw.w) + b1[2]); g1[3] = sigmoidf_(bf_hi(gw.w) + b1[3]);
                    float* o = T1 + (size_t)row * ldc + c;
                    *(f32x4*)o = acc[ai][bj][m][0] * sc * g0; *(f32x4*)(o + 4) = acc[ai][bj][m][1] * sc * g1; } }
    }
};
struct EpiGateB {
    static constexpr bool PERM = true, AFTER_DRAIN = false;
    const bf16_t* proj; int ldp; int gcol0; const float* bg; const float* T1; unsigned char* Y; int ldc; float sc;
    __device__ __forceinline__ void operator()(const f32x4 (&acc)[2][2][4][2], const Unit& u, int wr, int wc, int fr, int fq) const {
        const int row0 = u.pm * BM + wr * 64 + fr, col0 = u.pn * BM + wc * 32 + 8 * fq;
#pragma unroll
        for (int ai = 0; ai < 2; ++ai)
#pragma unroll
            for (int m = 0; m < 4; ++m) { const int row = row0 + ai * HALF + m * 16;
#pragma unroll
                for (int bj = 0; bj < 2; ++bj) { const int c = col0 + bj * HALF;
                    const u32x4 gw = *(const u32x4*)(proj + (size_t)row * ldp + gcol0 + c);
                    const f32x4 b0 = *(const f32x4*)(bg + c), b1 = *(const f32x4*)(bg + c + 4);
                    const float* tp = T1 + (size_t)row * ldc + c;
                    const f32x4 t0 = *(const f32x4*)tp, t1 = *(const f32x4*)(tp + 4);
                    f32x4 g0, g1;
                    g0[0] = sigmoidf_(bf_lo(gw.x) + b0[0]); g0[1] = sigmoidf_(bf_hi(gw.x) + b0[1]); g0[2] = sigmoidf_(bf_lo(gw.y) + b0[2]); g0[3] = sigmoidf_(bf_hi(gw.y) + b0[3]);
                    g1[0] = sigmoidf_(bf_lo(gw.z) + b1[0]); g1[1] = sigmoidf_(bf_hi(gw.z) + b1[1]); g1[2] = sigmoidf_(bf_lo(gw.w) + b1[2]); g1[3] = sigmoidf_(bf_hi(gw.w) + b1[3]);
                    const f32x4 v0 = (t0 + acc[ai][bj][m][0] * sc * g0) * 64.0f, v1 = (t1 + acc[ai][bj][m][1] * sc * g1) * 64.0f;
                    u32x2 w; w.x = pk4_fp8_(v0[0], v0[1], v0[2], v0[3]); w.y = pk4_fp8_(v1[0], v1[1], v1[2], v1[3]);
                    *(u32x2*)(Y + (size_t)row * ldc + c) = w; } }
    }
};
struct EpiResF32 {
    static constexpr bool PERM = false, AFTER_DRAIN = false;
    const float* X; float* Z; int ldc; float alpha; float sc;
    __device__ __forceinline__ void operator()(const f32x4 (&acc)[2][2][4][2], const Unit& u, int wr, int wc, int fr, int fq) const {
        const int row0 = u.pm * BM + wr * 64 + fr, col0 = u.pn * BM + wc * 32 + 4 * fq;
#pragma unroll
        for (int ai = 0; ai < 2; ++ai)
#pragma unroll
            for (int m = 0; m < 4; ++m) { const size_t ro = (size_t)(row0 + ai * HALF + m * 16) * ldc + col0;
#pragma unroll
                for (int bj = 0; bj < 2; ++bj)
#pragma unroll
                    for (int n = 0; n < 2; ++n) { const f32x4 xv = *(const f32x4*)(X + ro + bj * HALF + n * 16);
                        *(f32x4*)(Z + ro + bj * HALF + n * 16) = xv * alpha + acc[ai][bj][m][n] * sc; } }
    }
};
struct EpiSwiglu {
    static constexpr bool PERM = true, AFTER_DRAIN = false;
    const PG8_LAS int* tile_e; const float* bgate; const float* blin; unsigned char* H; int ldc; float sc;
    __device__ __forceinline__ void operator()(const f32x4 (&acc)[2][2][4][2], const Unit& u, int wr, int wc, int fr, int fq) const {
        const int e = tile_e[u.pm];
        const int row0 = u.pm * BM + wr * 64 + fr, j0 = u.pn * HALF + wc * 32 + 8 * fq;
        const f32x4 bg0 = *(const f32x4*)(bgate + (size_t)e * 2048 + j0), bg1 = *(const f32x4*)(bgate + (size_t)e * 2048 + j0 + 4);
        const f32x4 bl0 = *(const f32x4*)(blin + (size_t)e * 2048 + j0), bl1 = *(const f32x4*)(blin + (size_t)e * 2048 + j0 + 4);
#pragma unroll
        for (int ai = 0; ai < 2; ++ai)
#pragma unroll
            for (int m = 0; m < 4; ++m) { const int row = row0 + ai * HALF + m * 16;
                f32x4 h0, h1;
#pragma unroll
                for (int i = 0; i < 4; ++i) {
                    float g = fminf(acc[ai][0][m][0][i] * sc + bg0[i], 7.0f); float l = fminf(fmaxf(acc[ai][1][m][0][i] * sc + bl0[i], -7.0f), 7.0f);
                    h0[i] = (l + 1.0f) * (g * sigmoidf_(1.702f * g));
                    g = fminf(acc[ai][0][m][1][i] * sc + bg1[i], 7.0f); l = fminf(fmaxf(acc[ai][1][m][1][i] * sc + bl1[i], -7.0f), 7.0f);
                    h1[i] = (l + 1.0f) * (g * sigmoidf_(1.702f * g)); }
                u32x2 w; w.x = pk4_fp8_(h0[0], h0[1], h0[2], h0[3]); w.y = pk4_fp8_(h1[0], h1[1], h1[2], h1[3]);
                *(u32x2*)(H + (size_t)row * ldc + j0) = w; }
    }
};
struct EpiDown {
    static constexpr bool PERM = true, AFTER_DRAIN = false;
    const PG8_LAS int* tile_e; const float* bdown; const float* slot_w; bf16_t* YS; int ldc; float sc;
    __device__ __forceinline__ void operator()(const f32x4 (&acc)[2][2][4][2], const Unit& u, int wr, int wc, int fr, int fq) const {
        const int e = tile_e[u.pm];
        const int row0 = u.pm * BM + wr * 64 + fr, col0 = u.pn * BM + wc * 32 + 8 * fq;
        f32x4 bv[2][2];
#pragma unroll
        for (int bj = 0; bj < 2; ++bj)
#pragma unroll
            for (int n = 0; n < 2; ++n) bv[bj][n] = *(const f32x4*)(bdown + (size_t)e * 2048 + col0 + bj * HALF + 4 * n);
#pragma unroll
        for (int ai = 0; ai < 2; ++ai)
#pragma unroll
            for (int m = 0; m < 4; ++m) { const int row = row0 + ai * HALF + m * 16; const float sw = slot_w[row];
#pragma unroll
                for (int bj = 0; bj < 2; ++bj) { const f32x4 v0 = (acc[ai][bj][m][0] * sc + bv[bj][0]) * sw, v1 = (acc[ai][bj][m][1] * sc + bv[bj][1]) * sw;
                    u32x4 w; w.x = cvt_pk_bf16(v0[0], v0[1]); w.y = cvt_pk_bf16(v0[2], v0[3]); w.z = cvt_pk_bf16(v1[0], v1[1]); w.w = cvt_pk_bf16(v1[2], v1[3]);
                    *(u32x4*)(YS + (size_t)row * ldc + col0 + bj * HALF) = w; } }
    }
};
struct MoeOrder : StaticOrder {
    const PG8_LAS int* tile_e; size_t estride;
    __device__ __forceinline__ size_t b_off(const Unit& u) const { return (size_t)__builtin_amdgcn_readfirstlane(tile_e[u.pm]) * estride; }
};
typedef int i32x4_ __attribute__((ext_vector_type(4)));
typedef int i32x8_ __attribute__((ext_vector_type(8)));
#define PG8_CAT(lo, hi) __builtin_shufflevector(__builtin_bit_cast(i32x4_, lo), __builtin_bit_cast(i32x4_, hi), 0, 1, 2, 3, 4, 5, 6, 7)
template <class Epi, class Sched, bool ALIGN_EPI = false, bool SP2 = false, bool FP8 = false, bool BTILED = false>
__device__ __forceinline__ void gemm_phase(PG8_LAS unsigned char* lds, const Gemm g, const Sched& S, const Epi& E) {
    const int tid = threadIdx.x, wid = __builtin_amdgcn_readfirstlane(tid >> 6), lane = tid & 63, wr = wid >> 2, wc = wid & 3, fr = lane & 15, fq = lane >> 4;
    const int K = g.K, nt = K / BK;
    unsigned voffA[2], voffB[2];
#pragma unroll
    for (int i = 0; i < 2; ++i) { int R, C; stage_rc(tid * 16 + i * 8192, R, C); const int Rb = Epi::PERM ? ((R & ~31) + perm32(R & 31)) : R;
        voffA[i] = (unsigned)(R * K + C) * 2u; voffB[i] = BTILED ? (unsigned)(Rb * 64 + C) * 2u : (unsigned)(Rb * K + C) * 2u; }
    const size_t kstep = (size_t)(BK * 2);
    const size_t hstep = (size_t)HALF * K * 2;
    const size_t tstep = 2 * hstep;
    const size_t kstepB = BTILED ? (size_t)32768 : kstep, hstepB = BTILED ? (size_t)16384 : hstep;
    const unsigned ldsw = (unsigned)wid * 1024u;
    const int aoff = lds_byte(wr * 64 + fr, fq * 8), boff = lds_byte(wc * 32 + fr, fq * 8);
#define PG8_SA(b, h) (((b) * 2 + (h)) * HTB)
#define PG8_SB(b, h) ((4 + (b) * 2 + (h)) * HTB)
#define PG8_STAGE(bufoff, gbase, voff) do { _Pragma("unroll") for (int _i = 0; _i < 2; ++_i) \
        __builtin_amdgcn_global_load_lds((const unsigned*)((const char*)(gbase) + (voff)[_i]), (PG8_LAS unsigned*)(lds + (bufoff) + ldsw + _i * 8192), 16, 0, 0); } while (0)
#define PG8_LDA(dst, b, h) do { _Pragma("unroll") for (int m = 0; m < 4; ++m) _Pragma("unroll") for (int k = 0; k < 2; ++k) dst[m][k] = *(const PG8_LAS bf16x8*)(lds + PG8_SA(b, h) + aoff + m * 2048 + k * 1024); } while (0)
#define PG8_LDB(dst, b, h) do { _Pragma("unroll") for (int n = 0; n < 2; ++n) _Pragma("unroll") for (int k = 0; k < 2; ++k) dst[n][k] = *(const PG8_LAS bf16x8*)(lds + PG8_SB(b, h) + boff + n * 2048 + k * 1024); } while (0)
#define PG8_MFMA8(C, Bv, Av) asm volatile("v_mfma_f32_16x16x128_f8f6f4 %0, %1, %2, %0" : "+v"(C) : "v"(Bv), "v"(Av))
#define PG8_MMA(ai, bj, At, Bt) do { __builtin_amdgcn_s_setprio(1); if constexpr (FP8) { const i32x8_ b0_ = PG8_CAT(Bt[0][0], Bt[0][1]), b1_ = PG8_CAT(Bt[1][0], Bt[1][1]); _Pragma("unroll") for (int m = 0; m < 4; ++m) { \
        const i32x8_ a_ = PG8_CAT(At[m][0], At[m][1]); PG8_MFMA8(acc[ai][bj][m][0], b0_, a_); PG8_MFMA8(acc[ai][bj][m][1], b1_, a_); } } else { \
        _Pragma("unroll") for (int m = 0; m < 4; ++m) _Pragma("unroll") for (int n = 0; n < 2; ++n) _Pragma("unroll") for (int k = 0; k < 2; ++k) \
        acc[ai][bj][m][n] = __builtin_amdgcn_mfma_f32_16x16x32_bf16(Bt[n][k], At[m][k], acc[ai][bj][m][n], 0, 0, 0); } __builtin_amdgcn_s_setprio(0); } while (0)
#define PG8_WAIT_V(n) asm volatile("s_waitcnt vmcnt(" #n ")" ::: "memory")
#define PG8_WAIT_L(n) asm volatile("s_waitcnt lgkmcnt(" #n ")" ::: "memory")
#define PG8_BAR __builtin_amdgcn_s_barrier()
#define PG8_SCHED __builtin_amdgcn_sched_barrier(0)
    Unit cur, nxt; int ui = 0;
    if (!S.next(0, cur)) return;
    f32x4 acc[2][2][4][2];
#pragma unroll
    for (int a = 0; a < 2; ++a)
#pragma unroll
        for (int b = 0; b < 2; ++b)
#pragma unroll
            for (int m = 0; m < 4; ++m)
#pragma unroll
                for (int n = 0; n < 2; ++n) acc[a][b][m][n] = (f32x4){0.f, 0.f, 0.f, 0.f};
    bf16x8 At[4][2], B0[2][2], B1[2][2];
    const char* cA = (const char*)g.A + (size_t)cur.pm * tstep; const char* cB = (const char*)g.Bt + S.b_off(cur) + (size_t)cur.pn * tstep;
    S.a_ready(cur);
    if constexpr (SP2) {
        PG8_STAGE(PG8_SB(0, 0), cB, voffB); PG8_STAGE(PG8_SB(0, 1), cB + hstepB, voffB); PG8_STAGE(PG8_SA(0, 0), cA, voffA); PG8_STAGE(PG8_SA(0, 1), cA + hstep, voffA);
        if (wr == 1) PG8_BAR;
        PG8_WAIT_V(2); PG8_BAR;
        PG8_STAGE(PG8_SB(1, 0), cB + kstepB, voffB); PG8_STAGE(PG8_SA(1, 0), cA + kstep, voffA); PG8_STAGE(PG8_SB(1, 1), cB + hstepB + kstepB, voffB);
        PG8_WAIT_V(6); PG8_BAR;
    } else {
        PG8_STAGE(PG8_SB(0, 0), cB, voffB); PG8_STAGE(PG8_SA(0, 0), cA, voffA); PG8_STAGE(PG8_SB(0, 1), cB + hstepB, voffB); PG8_STAGE(PG8_SA(0, 1), cA + hstep, voffA);
        if (wr == 1) PG8_BAR;
        PG8_WAIT_V(4); PG8_BAR;
        PG8_STAGE(PG8_SB(1, 0), cB + kstepB, voffB); PG8_STAGE(PG8_SA(1, 0), cA + kstep, voffA); PG8_STAGE(PG8_SB(1, 1), cB + hstepB + kstepB, voffB);
        PG8_WAIT_V(6); PG8_BAR;
    }
    for (;;) {
        const bool has_next = S.next(ui + 1, nxt);
        const char* nA = has_next ? (const char*)g.A + (size_t)nxt.pm * tstep : cA; const char* nB = has_next ? (const char*)g.Bt + S.b_off(nxt) + (size_t)nxt.pn * tstep : cB;
        for (int t = 0; t < nt; t += 2) {
            const bool last = (t == nt - 2);
            const char* a1 = cA + (size_t)(t + 1) * kstep;
            const char* a2 = last ? nA : cA + (size_t)(t + 2) * kstep; const char* b2 = last ? nB : cB + (size_t)(t + 2) * kstepB;
            const char* a3 = a2 + kstep; const char* b3 = b2 + kstepB;
            if (last && has_next) S.a_ready(nxt);
            if constexpr (SP2) {
            PG8_LDB(B0, 0, 0); PG8_LDB(B1, 0, 1); PG8_SCHED; PG8_LDA(At, 0, 0); PG8_STAGE(PG8_SA(1, 1), a1 + hstep, voffA);
            PG8_WAIT_V(8); PG8_WAIT_L(0); PG8_BAR; PG8_MMA(0, 0, At, B0); PG8_MMA(0, 1, At, B1); PG8_BAR; PG8_SCHED;
            PG8_LDA(At, 0, 1); PG8_STAGE(PG8_SB(0, 0), b2, voffB); PG8_STAGE(PG8_SB(0, 1), b2 + hstepB, voffB); PG8_STAGE(PG8_SA(0, 0), a2, voffA);
            PG8_WAIT_V(8); PG8_WAIT_L(0); PG8_BAR; PG8_MMA(1, 0, At, B0); PG8_MMA(1, 1, At, B1); PG8_BAR; PG8_SCHED;
            PG8_LDB(B0, 1, 0); PG8_LDB(B1, 1, 1); PG8_SCHED; PG8_LDA(At, 1, 0); PG8_STAGE(PG8_SA(0, 1), a2 + hstep, voffA);
            PG8_WAIT_V(8); PG8_WAIT_L(0); PG8_BAR; PG8_MMA(0, 0, At, B0); PG8_MMA(0, 1, At, B1); PG8_BAR; PG8_SCHED;
            PG8_LDA(At, 1, 1); PG8_STAGE(PG8_SB(1, 0), b3, voffB); PG8_STAGE(PG8_SB(1, 1), b3 + hstepB, voffB); PG8_STAGE(PG8_SA(1, 0), a3, voffA);
            PG8_WAIT_V(8); PG8_WAIT_L(0); PG8_BAR; PG8_MMA(1, 0, At, B0); PG8_MMA(1, 1, At, B1); PG8_BAR; PG8_SCHED;
            } else {
            PG8_LDB(B0, 0, 0); PG8_SCHED; PG8_LDA(At, 0, 0); PG8_STAGE(PG8_SA(1, 1), a1 + hstep, voffA);
            PG8_WAIT_L(8); PG8_BAR; PG8_WAIT_L(0); PG8_MMA(0, 0, At, B0); PG8_BAR; PG8_SCHED;
            PG8_LDB(B1, 0, 1); PG8_STAGE(PG8_SB(0, 0), b2, voffB);
            PG8_BAR; PG8_WAIT_L(0); PG8_MMA(0, 1, At, B1); PG8_BAR;
            PG8_LDA(At, 0, 1); PG8_STAGE(PG8_SA(0, 0), a2, voffA);
            PG8_BAR; PG8_WAIT_L(0); PG8_MMA(1, 0, At, B0); PG8_BAR; PG8_SCHED;
            PG8_STAGE(PG8_SB(0, 1), b2 + hstepB, voffB);
            PG8_WAIT_V(6); PG8_BAR; PG8_MMA(1, 1, At, B1); PG8_BAR;
            PG8_LDB(B0, 1, 0); PG8_SCHED; PG8_LDA(At, 1, 0); PG8_STAGE(PG8_SA(0, 1), a2 + hstep, voffA);
            PG8_WAIT_L(8); PG8_BAR; PG8_WAIT_L(0); PG8_MMA(0, 0, At, B0); PG8_BAR; PG8_SCHED;
            PG8_LDB(B1, 1, 1); PG8_STAGE(PG8_SB(1, 0), b3, voffB);
            PG8_BAR; PG8_WAIT_L(0); PG8_MMA(0, 1, At, B1); PG8_BAR;
            PG8_LDA(At, 1, 1); PG8_STAGE(PG8_SA(1, 0), a3, voffA);
            PG8_BAR; PG8_WAIT_L(0); PG8_MMA(1, 0, At, B0); PG8_BAR; PG8_SCHED;
            PG8_STAGE(PG8_SB(1, 1), b3 + hstepB, voffB);
            PG8_WAIT_V(6); PG8_BAR; PG8_MMA(1, 1, At, B1); PG8_BAR;
            }
        }
        if constexpr (ALIGN_EPI) { if (wr == 0) PG8_BAR; }
        if constexpr (FP8) { asm volatile("s_nop 15\n\ts_nop 7" ::: "memory"); PG8_SCHED; }
        if constexpr (!Epi::AFTER_DRAIN) { E(acc, cur, wr, wc, fr, fq); S.done(cur); }
        if (!has_next) break;
#pragma unroll
        for (int a = 0; a < 2; ++a)
#pragma unroll
            for (int b = 0; b < 2; ++b)
#pragma unroll
                for (int m = 0; m < 4; ++m)
#pragma unroll
                    for (int n = 0; n < 2; ++n) acc[a][b][m][n] = (f32x4){0.f, 0.f, 0.f, 0.f};
        cur = nxt; cA = nA; cB = nB; ++ui;
        if constexpr (ALIGN_EPI) { if (wr == 1) PG8_BAR; }
    }
    PG8_WAIT_V(0);
    if constexpr (!ALIGN_EPI) { if (wr == 0) PG8_BAR; }
    PG8_BAR;
    if constexpr (Epi::AFTER_DRAIN) { E.fused(acc, cur, wr, wc, fr, fq, lds, wid, lane); S.done(cur); }
#undef PG8_SA
#undef PG8_SB
#undef PG8_STAGE
#undef PG8_LDA
#undef PG8_LDB
#undef PG8_MMA
#undef PG8_WAIT_V
#undef PG8_WAIT_L
#undef PG8_BAR
#undef PG8_SCHED
}
}
namespace at {
using bf16 = __hip_bfloat16;
constexpr int   D = 128, NW = 8, QBLK = 32, KVBLK = 64;
constexpr float SCALE = 0.088388347648318440f;
constexpr float THR = 8.f;
constexpr int SDEPTH = 2;
constexpr size_t SHM_V = KVBLK * D * 2, SHM_K = KVBLK * D * 2, SHM_ATTN = 2 * SHM_V + 2 * SHM_K + NW * 64 * 4;
using bf16x8 = __attribute__((ext_vector_type(8))) short;
using s16x4  = __attribute__((ext_vector_type(4))) short;
using f32x16 = __attribute__((ext_vector_type(16))) float;
using f32x8  = __attribute__((ext_vector_type(8))) float;
using u32x4  = __attribute__((ext_vector_type(4))) unsigned;
#define KSWZ(row, colB) ((row) * 256 + ((colB) ^ (((row) & 7) << 4)))
#define SBAR() __builtin_amdgcn_sched_barrier(0)
__device__ __forceinline__ int crow(int r, int hi) { return (r & 3) + 8 * (r >> 2) + 4 * hi; }
__device__ __forceinline__ unsigned cvtpk(float lo, float hi) {
  unsigned r; asm volatile("v_cvt_pk_bf16_f32 %0, %1, %2" : "=v"(r) : "v"(lo), "v"(hi)); return r;
}
template <typename TIn> struct Stage;
template <> struct Stage<bf16>  { using T = bf16x8;
  __device__ static __forceinline__ T ld8(const bf16* p) { return *reinterpret_cast<const bf16x8*>(p); }
  __device__ static __forceinline__ bf16x8 tobf(T x) { return x; } };
template <> struct Stage<float> { using T = f32x8;
  __device__ static __forceinline__ T ld8(const float* p) { return *reinterpret_cast<const f32x8*>(p); }
  __device__ static __forceinline__ bf16x8 tobf(T x) {
    u32x4 w = {cvtpk(x[0], x[1]), cvtpk(x[2], x[3]), cvtpk(x[4], x[5]), cvtpk(x[6], x[7])}; return *reinterpret_cast<bf16x8*>(&w); } };

__device__ __forceinline__ void partialSM(f32x16& p0, f32x16& p1, float& m_reg, float& mn, float& alpha) {
  constexpr float C = SCALE * 1.4426950408889634f;
  float pmax = p0[0]; for (int r = 1; r < 16; ++r) pmax = fmaxf(pmax, p0[r]); for (int r = 0; r < 16; ++r) pmax = fmaxf(pmax, p1[r]);
  { auto rr = __builtin_amdgcn_permlane32_swap(__float_as_uint(pmax), __float_as_uint(pmax), false, false);
    pmax = fmaxf(__uint_as_float(rr[0]), __uint_as_float(rr[1])); }
  if (__builtin_expect(__all(pmax - m_reg <= THR / SCALE), 1)) { mn = m_reg; alpha = 1.f; }
  else { mn = fmaxf(m_reg, pmax); alpha = __builtin_amdgcn_exp2f((m_reg - mn) * C); m_reg = mn; }
  float mnC = -mn * C;
  for (int r = 0; r < 16; ++r) p0[r] = fmaf(p0[r], C, mnC); for (int r = 0; r < 16; ++r) p1[r] = fmaf(p1[r], C, mnC);
  for (int r = 0; r < 16; ++r) p0[r] = __builtin_amdgcn_exp2f(p0[r]);
}
__device__ __forceinline__ void finishSM(f32x16& p0, f32x16& p1, float alpha, float& l_reg, bf16x8& pa0, bf16x8& pa1, bf16x8& pa2, bf16x8& pa3) {
  for (int r = 0; r < 16; ++r) p1[r] = __builtin_amdgcn_exp2f(p1[r]);
  float ps = 0; for (int r = 0; r < 16; ++r) ps += p0[r]; for (int r = 0; r < 16; ++r) ps += p1[r];
  { auto rr = __builtin_amdgcn_permlane32_swap(__float_as_uint(ps), __float_as_uint(ps), false, false);
    ps = __uint_as_float(rr[0]) + __uint_as_float(rr[1]); }
  l_reg = l_reg * alpha + ps;
#define PK4(P, BASE, OUT) do { unsigned a0 = cvtpk(P[BASE + 0], P[BASE + 1]), a1 = cvtpk(P[BASE + 2], P[BASE + 3]);   \
    unsigned b0 = cvtpk(P[BASE + 4], P[BASE + 5]), b1 = cvtpk(P[BASE + 6], P[BASE + 7]);                              \
    auto r0 = __builtin_amdgcn_permlane32_swap(a0, b0, false, false); auto r1 = __builtin_amdgcn_permlane32_swap(a1, b1, false, false); \
    u32x4 w = {r0[0], r1[0], r0[1], r1[1]}; OUT = *reinterpret_cast<bf16x8*>(&w); } while (0)
  PK4(p0, 0, pa0); PK4(p0, 8, pa1); PK4(p1, 0, pa2); PK4(p1, 8, pa3);
#undef PK4
}
__device__ __forceinline__ void qkt(f32x16& p0, f32x16& p1, const bf16* Ks, const bf16x8* qr, int r32, int hi) {
  p0 = f32x16{}; p1 = f32x16{};
  for (int d0 = 0; d0 < 8; ++d0) { int cb = (d0 * 16 + hi * 8) * 2;
    bf16x8 b0 = *reinterpret_cast<const bf16x8*>((const char*)Ks + KSWZ(r32, cb));
    bf16x8 b1 = *reinterpret_cast<const bf16x8*>((const char*)Ks + KSWZ(32 + r32, cb));
    p0 = __builtin_amdgcn_mfma_f32_32x32x16_bf16(b0, qr[d0], p0, 0, 0, 0);
    p1 = __builtin_amdgcn_mfma_f32_32x32x16_bf16(b1, qr[d0], p1, 0, 0, 0); }
}
__device__ __forceinline__ int v_st(int k, int c) { const int kk = (k & ~0xC) | ((k & 4) << 1) | ((k & 8) >> 1); return ((kk >> 3) * 4 + (c >> 5)) * 512 + ((kk & 7) * 32 + (c & 31)) * 2; }
__device__ __forceinline__ int v_rd_base(int lane) { return ((lane & 3) << 3) | (((lane >> 2) & 3) << 6) | (((lane >> 4) & 1) << 5) | (((lane >> 5) & 1) << 8); }
constexpr int v_rd_off(int d0, int ks, int half) { return d0 * 512 + ks * 4096 + half * 2048; }
template <int OFF> __device__ __forceinline__ s16x4 tr_read(int vb) {
  s16x4 r; asm volatile("ds_read_b64_tr_b16 %0, %1 offset:%2" : "=&v"(r) : "v"(vb), "i"(OFF) : "memory"); return r;
}
template <int D0> __device__ __forceinline__ void pv_one(f32x16& od, int vb, bf16x8 pa0, bf16x8 pa1, bf16x8 pa2, bf16x8 pa3) {
  const s16x4 l0 = tr_read<v_rd_off(D0, 0, 0)>(vb), h0 = tr_read<v_rd_off(D0, 0, 1)>(vb), l1 = tr_read<v_rd_off(D0, 1, 0)>(vb), h1 = tr_read<v_rd_off(D0, 1, 1)>(vb);
  const s16x4 l2 = tr_read<v_rd_off(D0, 2, 0)>(vb), h2 = tr_read<v_rd_off(D0, 2, 1)>(vb), l3 = tr_read<v_rd_off(D0, 3, 0)>(vb), h3 = tr_read<v_rd_off(D0, 3, 1)>(vb);
  asm volatile("s_waitcnt lgkmcnt(0)" ::: "memory"); SBAR();
#define PK(L, H) (bf16x8){L[0], L[1], L[2], L[3], H[0], H[1], H[2], H[3]}
  od = __builtin_amdgcn_mfma_f32_32x32x16_bf16(pa0, PK(l0, h0), od, 0, 0, 0);
  od = __builtin_amdgcn_mfma_f32_32x32x16_bf16(pa1, PK(l1, h1), od, 0, 0, 0);
  od = __builtin_amdgcn_mfma_f32_32x32x16_bf16(pa2, PK(l2, h2), od, 0, 0, 0);
  od = __builtin_amdgcn_mfma_f32_32x32x16_bf16(pa3, PK(l3, h3), od, 0, 0, 0);
#undef PK
}
__device__ __forceinline__ void pv_d0(f32x16* o, int vb, bf16x8 pa0, bf16x8 pa1, bf16x8 pa2, bf16x8 pa3) {
  pv_one<0>(o[0], vb, pa0, pa1, pa2, pa3); pv_one<1>(o[1], vb, pa0, pa1, pa2, pa3); pv_one<2>(o[2], vb, pa0, pa1, pa2, pa3); pv_one<3>(o[3], vb, pa0, pa1, pa2, pa3);
}

template <int LDQ, int LDK, int LDV, int LDO>
__device__ __forceinline__ void attn_dense_body(const bf16* __restrict__ Qb, const bf16* __restrict__ Kh, const bf16* __restrict__ Vh,
                                                unsigned char* __restrict__ Ob, int seq, char* lds) {
  using St = Stage<bf16>; using SQ = Stage<bf16>;
  const int tid = threadIdx.x, wid = tid >> 6, lane = tid & 63, r32 = lane & 31, hi = lane >> 5;
  bf16* V_lds = (bf16*)lds; bf16* K_lds = (bf16*)(lds + 2 * SHM_V);
  float* ws = (float*)(lds + 2 * SHM_V + 2 * SHM_K) + wid * 64; float* li_l = ws; float* al_l = ws + 32;
  float m_reg = -1e30f, l_reg = 0; f32x16 o[4] = {}; bf16x8 qr[8];
  const bf16* Qw = Qb + (long)(wid * QBLK + r32) * LDQ + hi * 8;
#pragma unroll
  for (int d0 = 0; d0 < 8; ++d0) qr[d0] = SQ::tobf(SQ::ld8(Qw + d0 * 16));
  const int sr = tid >> 4, sc = (tid & 15) * 8, vst0 = v_st(sr, sc), vst1 = v_st(32 + sr, sc);
  const int vb0 = (int)(uintptr_t)V_lds + v_rd_base(lane);
  struct { typename St::T vs0, vs1, ks0, ks1; } sr_[SDEPTH];
#define SLOAD(i, k0) do { sr_[i].vs0 = St::ld8(&Vh[(long)((k0) + sr) * LDV + sc]); sr_[i].vs1 = St::ld8(&Vh[(long)((k0) + 32 + sr) * LDV + sc]); \
    sr_[i].ks0 = St::ld8(&Kh[(long)((k0) + sr) * LDK + sc]); sr_[i].ks1 = St::ld8(&Kh[(long)((k0) + 32 + sr) * LDK + sc]); } while (0)
#define SWRITE(b, i) do { *(bf16x8*)((char*)V_lds + (b) * SHM_V + vst0) = St::tobf(sr_[i].vs0);          \
    *(bf16x8*)((char*)V_lds + (b) * SHM_V + vst1) = St::tobf(sr_[i].vs1); int kc = sc * 2;               \
    *(bf16x8*)((char*)K_lds + (b) * SHM_K + KSWZ(sr, kc)) = St::tobf(sr_[i].ks0);                       \
    *(bf16x8*)((char*)K_lds + (b) * SHM_K + KSWZ(32 + sr, kc)) = St::tobf(sr_[i].ks1); } while (0)
#define SWAIT() do { if constexpr (SDEPTH == 2) asm volatile("s_waitcnt vmcnt(4)" ::: "memory"); else asm volatile("s_waitcnt vmcnt(0)" ::: "memory"); } while (0)
#define RESC(a) do { if (__any((a) < 1.f)) { if (hi == 0) al_l[r32] = (a); asm volatile("s_waitcnt lgkmcnt(0)" ::: "memory"); \
    for (int d = 0; d < 4; ++d) for (int r = 0; r < 16; ++r) o[d][r] *= al_l[crow(r, hi)]; } } while (0)
  f32x16 pA0, pA1, pB0, pB1; float mnA, mnB, alA, alB; bf16x8 pa0, pa1, pa2, pa3; const int NT = seq / KVBLK;
  constexpr int SE = 0, SO = SDEPTH - 1;
  SLOAD(SE, 0); asm volatile("s_waitcnt vmcnt(0)" ::: "memory"); SWRITE(0, SE); __syncthreads();
  qkt(pA0, pA1, K_lds, qr, r32, hi); partialSM(pA0, pA1, m_reg, mnA, alA);
  SLOAD(SO, KVBLK); if constexpr (SDEPTH == 2) { if (2 < NT) SLOAD(SE, 2 * KVBLK); }
  SWAIT(); SWRITE(1, SO); __syncthreads();
  for (int j = 1; j + 1 < NT; j += 2) {
    SBAR(); qkt(pB0, pB1, (bf16*)((char*)K_lds + SHM_K), qr, r32, hi);
    finishSM(pA0, pA1, alA, l_reg, pa0, pa1, pa2, pa3); SBAR();
    SLOAD(SO, (j + SDEPTH) * KVBLK); SBAR();
    pv_d0(o, vb0, pa0, pa1, pa2, pa3); partialSM(pB0, pB1, m_reg, mnB, alB);
    __syncthreads(); SWAIT(); SWRITE(0, SE);
    RESC(alB); __syncthreads();
    SBAR(); qkt(pA0, pA1, K_lds, qr, r32, hi);
    finishSM(pB0, pB1, alB, l_reg, pa0, pa1, pa2, pa3); SBAR();
    if (SDEPTH == 1 || j + 3 < NT) SLOAD(SE, (j + 1 + SDEPTH) * KVBLK); SBAR();
    pv_d0(o, vb0 + (int)SHM_V, pa0, pa1, pa2, pa3); partialSM(pA0, pA1, m_reg, mnA, alA);
    __syncthreads(); SWAIT(); SWRITE(1, SO);
    RESC(alA); __syncthreads();
  }
  SBAR(); qkt(pB0, pB1, (bf16*)((char*)K_lds + SHM_K), qr, r32, hi);
  finishSM(pA0, pA1, alA, l_reg, pa0, pa1, pa2, pa3); SBAR();
  pv_d0(o, vb0, pa0, pa1, pa2, pa3); partialSM(pB0, pB1, m_reg, mnB, alB);
  __syncthreads(); RESC(alB);
  finishSM(pB0, pB1, alB, l_reg, pa0, pa1, pa2, pa3); SBAR();
  pv_d0(o, vb0 + (int)SHM_V, pa0, pa1, pa2, pa3);
  if (hi == 0) li_l[r32] = l_reg; asm volatile("s_waitcnt lgkmcnt(0)" ::: "memory");
  float rli[16];
#pragma unroll
  for (int r = 0; r < 16; ++r) rli[r] = __builtin_amdgcn_rcpf(li_l[crow(r, hi)]);
  unsigned char* Ow = Ob + (long)(wid * QBLK) * LDO;
#pragma unroll
  for (int r = 0; r < 16; ++r) { int orow = crow(r, hi);
    for (int d0 = 0; d0 < 4; ++d0) Ow[(long)orow * LDO + d0 * 32 + r32] = (unsigned char)(__builtin_amdgcn_cvt_pk_fp8_f32(o[d0][r] * rli[r] * 64.0f, 0.f, 0, false) & 0xff); }
#undef SLOAD
#undef SWRITE
#undef SWAIT
#undef RESC
}


__device__ __forceinline__ void dilated_unit(const bf16* __restrict__ proj, const float* __restrict__ lutg, bf16* __restrict__ outg, float* __restrict__ lseg,
                                             int d, int hd12, int hh, int r, int i0, char* lds) {
  constexpr int LDP = 10240;
  constexpr float L2E = 1.4426950408889634f, C = SCALE * L2E;
  const int tid = threadIdx.x, wid = tid >> 6, lane = tid & 63, r32 = lane & 31, hi = lane >> 5;
  const int n = 8192 / d;
  char* KV = lds;
  float* lutx = (float*)(lds + 98304);
  float* wsx = (float*)(lds + 98304 + 2048) + wid * 64;
  const int qoff = hd12 * 128, koff = 1536 + hd12 * 128;
  if (tid < 320) { const int o = tid - 96; lutx[tid] = (o >= 0 && o <= 128) ? lutg[o] * L2E : -1e30f; }
  const int iq = i0 + wid * 32 + r32;
  const int sr = tid >> 4, sc = (tid & 15) * 8;
  f32x16 s00, s01, s10, s11, s20, s21;
  const int a = wid >> 1;
  {
    const bf16* Qw = proj + (size_t)(r + iq * d) * LDP + qoff + hi * 8;
    bf16x8 qr[8];
#pragma unroll
    for (int d0 = 0; d0 < 8; ++d0) qr[d0] = *reinterpret_cast<const bf16x8*>(Qw + d0 * 16);
#pragma unroll
    for (int ib = 0; ib < 12; ib += 6) {
      bf16x8 kv6[6];
#pragma unroll
      for (int i = 0; i < 6; ++i) { const int row = sr + 32 * (ib + i); int j = i0 - 64 + row; j = j < 0 ? 0 : (j >= n ? n - 1 : j);
        kv6[i] = *reinterpret_cast<const bf16x8*>(proj + (size_t)(r + j * d) * LDP + koff + sc); }
#pragma unroll
      for (int i = 0; i < 6; ++i) { const int row = sr + 32 * (ib + i);
        *reinterpret_cast<bf16x8*>(KV + (row >> 6) * 16384 + KSWZ(row & 63, sc * 2)) = kv6[i]; }
      SBAR();
    }
    __syncthreads();
    qkt(s00, s01, (const bf16*)(KV + (a + 0) * 16384), qr, r32, hi);
    qkt(s10, s11, (const bf16*)(KV + (a + 1) * 16384), qr, r32, hi);
    qkt(s20, s21, (const bf16*)(KV + (a + 2) * 16384), qr, r32, hi);
  }
  __syncthreads();
  SBAR();
  const int base = -32 * (wid & 1) - 64 - r32 + 4 * hi;
  const float* lp = lutx + (base + 160);
  float mx = -1e30f;
#define DIL_LOGITS(S, TT, HALF) _Pragma("unroll") for (int rr = 0; rr < 16; ++rr) { const float v = fmaf(S[rr], C, lp[64 * TT + 32 * HALF + (rr & 3) + 8 * (rr >> 2)]); S[rr] = v; }
  DIL_LOGITS(s00, 0, 0) DIL_LOGITS(s01, 0, 1) DIL_LOGITS(s10, 1, 0) DIL_LOGITS(s11, 1, 1) DIL_LOGITS(s20, 2, 0) DIL_LOGITS(s21, 2, 1)
#undef DIL_LOGITS
  if (i0 == 0 || i0 + 320 > n) {
    const int lo = -iq - base, hi_ = n - 1 - iq - base;
#define DIL_MASK(S, TT, HALF) _Pragma("unroll") for (int rr = 0; rr < 16; ++rr) { const int c = 64 * TT + 32 * HALF + (rr & 3) + 8 * (rr >> 2); S[rr] = (c >= lo && c <= hi_) ? S[rr] : -1e30f; }
    DIL_MASK(s00, 0, 0) DIL_MASK(s01, 0, 1) DIL_MASK(s10, 1, 0) DIL_MASK(s11, 1, 1) DIL_MASK(s20, 2, 0) DIL_MASK(s21, 2, 1)
#undef DIL_MASK
  }
#define DIL_MAX(S) _Pragma("unroll") for (int rr = 0; rr < 16; ++rr) mx = fmaxf(mx, S[rr]);
  DIL_MAX(s00) DIL_MAX(s01) DIL_MAX(s10) DIL_MAX(s11) DIL_MAX(s20) DIL_MAX(s21)
#undef DIL_MAX
  { auto rr = __builtin_amdgcn_permlane32_swap(__float_as_uint(mx), __float_as_uint(mx), false, false);
    mx = fmaxf(__uint_as_float(rr[0]), __uint_as_float(rr[1])); }
  float ps = 0.f;
#define DIL_EXP(S) _Pragma("unroll") for (int rr = 0; rr < 16; ++rr) { const float p = __builtin_amdgcn_exp2f(S[rr] - mx); S[rr] = p; ps += p; }
  DIL_EXP(s00) DIL_EXP(s01) DIL_EXP(s10) DIL_EXP(s11) DIL_EXP(s20) DIL_EXP(s21)
#undef DIL_EXP
  { auto rr = __builtin_amdgcn_permlane32_swap(__float_as_uint(ps), __float_as_uint(ps), false, false);
    ps = __uint_as_float(rr[0]) + __uint_as_float(rr[1]); }
  bf16x8 pa[12];
#define PK4(P, BASE, OUT) do { unsigned a0 = cvtpk(P[BASE + 0], P[BASE + 1]), a1 = cvtpk(P[BASE + 2], P[BASE + 3]);   \
    unsigned b0 = cvtpk(P[BASE + 4], P[BASE + 5]), b1 = cvtpk(P[BASE + 6], P[BASE + 7]);                              \
    auto r0 = __builtin_amdgcn_permlane32_swap(a0, b0, false, false); auto r1 = __builtin_amdgcn_permlane32_swap(a1, b1, false, false); \
    u32x4 w = {r0[0], r1[0], r0[1], r1[1]}; OUT = *reinterpret_cast<bf16x8*>(&w); } while (0)
  PK4(s00, 0, pa[0]); PK4(s00, 8, pa[1]); PK4(s01, 0, pa[2]); PK4(s01, 8, pa[3]);
  PK4(s10, 0, pa[4]); PK4(s10, 8, pa[5]); PK4(s11, 0, pa[6]); PK4(s11, 8, pa[7]);
  PK4(s20, 0, pa[8]); PK4(s20, 8, pa[9]); PK4(s21, 0, pa[10]); PK4(s21, 8, pa[11]);
#undef PK4
  SBAR();
#pragma unroll
  for (int ib = 0; ib < 12; ib += 6) {
    bf16x8 kv6[6];
#pragma unroll
    for (int i = 0; i < 6; ++i) { const int row = sr + 32 * (ib + i); int j = i0 - 64 + row; j = j < 0 ? 0 : (j >= n ? n - 1 : j);
      kv6[i] = *reinterpret_cast<const bf16x8*>(proj + (size_t)(r + j * d) * LDP + koff + 1536 + sc); }
#pragma unroll
    for (int i = 0; i < 6; ++i) { const int row = sr + 32 * (ib + i);
      *reinterpret_cast<bf16x8*>(KV + (row >> 6) * 16384 + v_st(row & 63, sc)) = kv6[i]; }
    SBAR();
  }
  if (hi == 0) wsx[r32] = ps;
  __syncthreads();
  f32x16 o[4] = {};
  const int vb = (int)(uintptr_t)KV + v_rd_base(lane);
  pv_d0(o, vb + (a + 0) * 16384, pa[0], pa[1], pa[2], pa[3]);
  pv_d0(o, vb + (a + 1) * 16384, pa[4], pa[5], pa[6], pa[7]);
  pv_d0(o, vb + (a + 2) * 16384, pa[8], pa[9], pa[10], pa[11]);
  float rli[16];
#pragma unroll
  for (int rr = 0; rr < 16; ++rr) rli[rr] = __builtin_amdgcn_rcpf(wsx[crow(rr, hi)]);
#pragma unroll
  for (int rr = 0; rr < 16; ++rr) { const int ir = i0 + wid * 32 + crow(rr, hi); bf16* orow = outg + (size_t)(r + ir * d) * 512 + hh * 128 + r32;
#pragma unroll
    for (int d0 = 0; d0 < 4; ++d0) orow[d0 * 32] = __float2bfloat16(o[d0][rr] * rli[rr]); }
  if (hi == 0) lseg[(size_t)(r + iq * d) * 4 + hh] = (mx + __builtin_amdgcn_logf(ps)) * 0.6931471805599453f;
  __syncthreads();
}

typedef int i32x4a __attribute__((ext_vector_type(4)));
typedef int i32x8a __attribute__((ext_vector_type(8)));
constexpr float THR8 = 3.f;
constexpr size_t SHM8_K = 64 * 128, SHM8_V = 64 * 128, SHM_ATTN8 = 2 * SHM8_K + 2 * SHM8_V + NW * 64 * 4;
#define A8_CAT(lo, hi) __builtin_shufflevector(lo, hi, 0, 1, 2, 3, 4, 5, 6, 7)
__device__ __forceinline__ f32x16 mfma8(i32x8a a, i32x8a b, f32x16 c) { return __builtin_amdgcn_mfma_scale_f32_32x32x64_f8f6f4(a, b, c, 0, 0, 0, 0, 0, 0); }
__device__ __forceinline__ int kchunk(int row, int c) { return row * 128 + ((c ^ ((row >> 1) & 7)) << 4); }
__device__ __forceinline__ void partialSM8(f32x16& p0, f32x16& p1, float& m_reg, float& mn, float& alpha) {
  constexpr float C = SCALE * 1.4426950408889634f;
  float pmax = p0[0]; for (int r = 1; r < 16; ++r) pmax = fmaxf(pmax, p0[r]); for (int r = 0; r < 16; ++r) pmax = fmaxf(pmax, p1[r]);
  { auto rr = __builtin_amdgcn_permlane32_swap(__float_as_uint(pmax), __float_as_uint(pmax), false, false);
    pmax = fmaxf(__uint_as_float(rr[0]), __uint_as_float(rr[1])); }
  if (__builtin_expect(__all(pmax - m_reg <= THR8 / SCALE), 1)) { mn = m_reg; alpha = 1.f; }
  else { mn = fmaxf(m_reg, pmax); alpha = __builtin_amdgcn_exp2f((m_reg - mn) * C); m_reg = mn; }
  const float mnC = 4.0f - mn * C;
  for (int r = 0; r < 16; ++r) p0[r] = fmaf(p0[r], C, mnC); for (int r = 0; r < 16; ++r) p1[r] = fmaf(p1[r], C, mnC);
  for (int r = 0; r < 16; ++r) p0[r] = __builtin_amdgcn_exp2f(p0[r]);
}
__device__ __forceinline__ unsigned pk4f8(float a, float b, float c, float d) { int w = __builtin_amdgcn_cvt_pk_fp8_f32(a, b, 0, false); w = __builtin_amdgcn_cvt_pk_fp8_f32(c, d, w, true); return (unsigned)w; }
__device__ __forceinline__ void finishSM8(f32x16& p0, f32x16& p1, float alpha, float& l_reg, i32x8a& pa) {
  for (int r = 0; r < 16; ++r) p1[r] = __builtin_amdgcn_exp2f(p1[r]);
  float ps = 0; for (int r = 0; r < 16; ++r) ps += p0[r]; for (int r = 0; r < 16; ++r) ps += p1[r];
  { auto rr = __builtin_amdgcn_permlane32_swap(__float_as_uint(ps), __float_as_uint(ps), false, false);
    ps = __uint_as_float(rr[0]) + __uint_as_float(rr[1]); }
  l_reg = l_reg * alpha + ps;
  pa[0] = (int)pk4f8(p0[0], p0[1], p0[2], p0[3]);   pa[1] = (int)pk4f8(p0[4], p0[5], p0[6], p0[7]);
  pa[2] = (int)pk4f8(p0[8], p0[9], p0[10], p0[11]); pa[3] = (int)pk4f8(p0[12], p0[13], p0[14], p0[15]);
  pa[4] = (int)pk4f8(p1[0], p1[1], p1[2], p1[3]);   pa[5] = (int)pk4f8(p1[4], p1[5], p1[6], p1[7]);
  pa[6] = (int)pk4f8(p1[8], p1[9], p1[10], p1[11]); pa[7] = (int)pk4f8(p1[12], p1[13], p1[14], p1[15]);
}
__device__ __forceinline__ void qkt8(f32x16& p0, f32x16& p1, const char* Ks, const i32x8a (&qr)[2], int r32, int hi) {
  p0 = f32x16{}; p1 = f32x16{};
#pragma unroll
  for (int s = 0; s < 2; ++s) { const int c0 = 4 * s + 2 * hi;
    const i32x8a a0 = A8_CAT(*reinterpret_cast<const i32x4a*>(Ks + kchunk(r32, c0)), *reinterpret_cast<const i32x4a*>(Ks + kchunk(r32, c0 + 1)));
    const i32x8a a1 = A8_CAT(*reinterpret_cast<const i32x4a*>(Ks + kchunk(32 + r32, c0)), *reinterpret_cast<const i32x4a*>(Ks + kchunk(32 + r32, c0 + 1)));
    p0 = mfma8(a0, qr[s], p0); p1 = mfma8(a1, qr[s], p1); }
}
__device__ __forceinline__ void pv8(f32x16* o, const char* Vs, i32x8a pa, int lane) {
#pragma unroll
  for (int d0 = 0; d0 < 4; ++d0) { const i32x8a b = A8_CAT(*reinterpret_cast<const i32x4a*>(Vs + d0 * 2048 + lane * 16), *reinterpret_cast<const i32x4a*>(Vs + d0 * 2048 + 1024 + lane * 16));
    o[d0] = mfma8(pa, b, o[d0]); }
}
template <int LDQ, int LDK, int LDO>
__device__ __forceinline__ void attn_dense_body8(const unsigned char* __restrict__ Qb, const unsigned char* __restrict__ Kh, const unsigned char* __restrict__ Vimg,
                                                 unsigned char* __restrict__ Ob, int seq, char* lds) {
  const int tid = threadIdx.x, wid = tid >> 6, lane = tid & 63, r32 = lane & 31, hi = lane >> 5;
  char* V_lds = lds; char* K_lds = lds + 2 * SHM8_V;
  float* ws = (float*)(lds + 2 * SHM8_V + 2 * SHM8_K) + wid * 64; float* li_l = ws; float* al_l = ws + 32;
  float m_reg = -1e30f, l_reg = 0; f32x16 o[4] = {}; i32x8a qr[2];
  const unsigned char* Qw = Qb + (long)(wid * QBLK + r32) * LDQ + hi * 32;
#pragma unroll
  for (int s = 0; s < 2; ++s) qr[s] = A8_CAT(*reinterpret_cast<const i32x4a*>(Qw + 64 * s), *reinterpret_cast<const i32x4a*>(Qw + 64 * s + 16));
  const int sr = tid >> 3, sc = tid & 7, kst = kchunk(sr, sc);
  struct { i32x4a vs, ks; } sr_[SDEPTH];
#define SLOAD8(i, k0) do { sr_[i].vs = *reinterpret_cast<const i32x4a*>(Vimg + (long)((k0) >> 6) * 8192 + tid * 16); sr_[i].ks = *reinterpret_cast<const i32x4a*>(Kh + (long)((k0) + sr) * LDK + sc * 16); } while (0)
#define SWRITE8(b, i) do { *reinterpret_cast<i32x4a*>(V_lds + (b) * SHM8_V + tid * 16) = sr_[i].vs; *reinterpret_cast<i32x4a*>(K_lds + (b) * SHM8_K + kst) = sr_[i].ks; } while (0)
#define SWAIT8() do { if constexpr (SDEPTH == 2) asm volatile("s_waitcnt vmcnt(2)" ::: "memory"); else asm volatile("s_waitcnt vmcnt(0)" ::: "memory"); } while (0)
#define RESC8(a) do { if (__any((a) < 1.f)) { if (hi == 0) al_l[r32] = (a); asm volatile("s_waitcnt lgkmcnt(0)" ::: "memory"); \
    for (int d = 0; d < 4; ++d) for (int r = 0; r < 16; ++r) o[d][r] *= al_l[crow(r, hi)]; } } while (0)
  f32x16 pA0, pA1, pB0, pB1; float mnA, mnB, alA, alB; i32x8a pa; const int NT = seq / KVBLK;
  constexpr int SE = 0, SO = SDEPTH - 1;
  SLOAD8(SE, 0); asm volatile("s_waitcnt vmcnt(0)" ::: "memory"); SWRITE8(0, SE); __syncthreads();
  qkt8(pA0, pA1, K_lds, qr, r32, hi); partialSM8(pA0, pA1, m_reg, mnA, alA);
  SLOAD8(SO, KVBLK); if constexpr (SDEPTH == 2) { if (2 < NT) SLOAD8(SE, 2 * KVBLK); }
  SWAIT8(); SWRITE8(1, SO); __syncthreads();
  for (int j = 1; j + 1 < NT; j += 2) {
    SBAR(); qkt8(pB0, pB1, K_lds + SHM8_K, qr, r32, hi);
    finishSM8(pA0, pA1, alA, l_reg, pa); SBAR();
    SLOAD8(SO, (j + SDEPTH) * KVBLK); SBAR();
    pv8(o, V_lds, pa, lane); partialSM8(pB0, pB1, m_reg, mnB, alB);
    __syncthreads(); SWAIT8(); SWRITE8(0, SE);
    RESC8(alB); __syncthreads();
    SBAR(); qkt8(pA0, pA1, K_lds, qr, r32, hi);
    finishSM8(pB0, pB1, alB, l_reg, pa); SBAR();
    if (SDEPTH == 1 || j + 3 < NT) SLOAD8(SE, (j + 1 + SDEPTH) * KVBLK); SBAR();
    pv8(o, V_lds + SHM8_V, pa, lane); partialSM8(pA0, pA1, m_reg, mnA, alA);
    __syncthreads(); SWAIT8(); SWRITE8(1, SO);
    RESC8(alA); __syncthreads();
  }
  SBAR(); qkt8(pB0, pB1, K_lds + SHM8_K, qr, r32, hi);
  finishSM8(pA0, pA1, alA, l_reg, pa); SBAR();
  pv8(o, V_lds, pa, lane); partialSM8(pB0, pB1, m_reg, mnB, alB);
  __syncthreads(); RESC8(alB);
  finishSM8(pB0, pB1, alB, l_reg, pa); SBAR();
  pv8(o, V_lds + SHM8_V, pa, lane);
  if (hi == 0) li_l[r32] = l_reg; asm volatile("s_waitcnt lgkmcnt(0)" ::: "memory");
  float rli[16];
#pragma unroll
  for (int r = 0; r < 16; ++r) rli[r] = 4.0f * __builtin_amdgcn_rcpf(li_l[crow(r, hi)]);
  unsigned char* Ow = Ob + (long)(wid * QBLK) * LDO;
#pragma unroll
  for (int r = 0; r < 16; ++r) { const int orow = crow(r, hi);
    for (int d0 = 0; d0 < 4; ++d0) Ow[(long)orow * LDO + d0 * 32 + r32] = (unsigned char)(__builtin_amdgcn_cvt_pk_fp8_f32(o[d0][r] * rli[r], 0.f, 0, false) & 0xff); }
#undef SLOAD8
#undef SWRITE8
#undef SWAIT8
#undef RESC8
}
}

#define GAS __attribute__((address_space(1)))
#define LAS __attribute__((address_space(3)))
typedef unsigned short bf16;
typedef unsigned v4u __attribute__((ext_vector_type(4)));
typedef unsigned v2u __attribute__((ext_vector_type(2)));
typedef float f32x4 __attribute__((ext_vector_type(4)));
#define LDS_WAIT() asm volatile("s_waitcnt lgkmcnt(0)" ::: "memory")
#define VM_WAIT() asm volatile("s_waitcnt vmcnt(0)" ::: "memory")
__device__ __forceinline__ unsigned pk2(float lo, float hi) { return pg8::cvt_pk_bf16(lo, hi); }
__device__ __forceinline__ float bflo(unsigned w) { return __builtin_bit_cast(float, w << 16); }
__device__ __forceinline__ float bfhi(unsigned w) { return __builtin_bit_cast(float, w & 0xffff0000u); }
#ifndef MK_Q8
#define MK_Q8 0
#endif
#ifndef MK_CHK_TOL
#define MK_CHK_TOL 0.15f
#endif
#ifndef MK_CHECK8
#define MK_CHECK8 0
#endif
__device__ __forceinline__ unsigned pk4_fp8(float a, float b, float c, float d) {
    int w = __builtin_amdgcn_cvt_pk_fp8_f32(a, b, 0, false); w = __builtin_amdgcn_cvt_pk_fp8_f32(c, d, w, true); return (unsigned)w; }
__device__ __forceinline__ float q8f(float v) { const int p = __builtin_amdgcn_cvt_pk_fp8_f32(v, v, 0, false); return __builtin_amdgcn_cvt_f32_fp8(p, 0); }
__device__ __forceinline__ float bf2f(bf16 b) { return __builtin_bit_cast(float, ((unsigned)b) << 16); }

#define XB_TMO      128
#define XB_XCNT(j)  (256  + 64 * (j))
#define XB_XSUB(j)  (1280 + 64 * (j))
#define XB_XGEN(j)  (2304 + 64 * (j))
#define XB_TOP      3328
#define XB_TOPGEN   3392
#define XCD_BAR_WORDS 3456
#define XB_SPIN_CAP (1u << 18)

__device__ __forceinline__ unsigned xb_ld(unsigned* p)              { return __hip_atomic_load(p, __ATOMIC_RELAXED, __HIP_MEMORY_SCOPE_AGENT); }
__device__ __forceinline__ unsigned xb_add(unsigned* p, unsigned v) { return __hip_atomic_fetch_add(p, v, __ATOMIC_RELAXED, __HIP_MEMORY_SCOPE_AGENT); }
__device__ __forceinline__ unsigned xb_xcc_id() { return (unsigned)__builtin_amdgcn_s_getreg((3 << 11) | 20) & 0xFu; }
#define XB_SPIN(cond, bar) do { unsigned _sp = 0; while (cond) { __builtin_amdgcn_s_sleep(1); \
    if ((++_sp & 255u) == 0u) { if (xb_ld(&(bar)[XB_TMO])) break; if (_sp > XB_SPIN_CAP) { atomicAdd(&(bar)[XB_TMO], 1u); break; } } } } while (0)

struct XcdBarrier {
    unsigned* bar; unsigned x;
    volatile LAS unsigned* st;
};

__device__ __forceinline__ XcdBarrier xcd_barrier_post(unsigned* bar, volatile LAS unsigned* st) {
    XcdBarrier b; b.bar = bar; b.x = xb_xcc_id(); b.st = st;
    if (threadIdx.x == 0) (void)xb_add(&bar[XB_XCNT(b.x)], 1u);
    return b;
}
__device__ __forceinline__ void xcd_barrier_complete(unsigned* bar, unsigned x, unsigned& nloc, unsigned& nx) {
    const unsigned G = gridDim.x * gridDim.y * gridDim.z;
    unsigned sum, cnt, mine, sp = 0u;
    for (;;) {
        sum = 0u; cnt = 0u; mine = 0u;
#pragma unroll
        for (unsigned j = 0; j < 16; ++j) { const unsigned c = xb_ld(&bar[XB_XCNT(j)]); sum += c; cnt += (c > 0u) ? 1u : 0u; mine = (j == x) ? c : mine; }
        if (sum == G) break;
        __builtin_amdgcn_s_sleep(1);
        if ((++sp & 255u) == 0u) { if (xb_ld(&bar[XB_TMO])) break; if (sp > XB_SPIN_CAP) { atomicAdd(&bar[XB_TMO], 1u); break; } }
    }
    nloc = mine > 0u ? mine : 1u; nx = cnt > 0u ? cnt : 1u;
}

__device__ __forceinline__ void xcd_barrier(const XcdBarrier& b) {
    asm volatile("s_waitcnt vmcnt(0)" ::: "memory");
    __syncthreads();
    if (threadIdx.x == 0) {
        unsigned* bar = b.bar;
        __builtin_amdgcn_s_waitcnt(0);
        unsigned nloc = b.st[0], nx = b.st[1];
        if (nloc == 0u) { xcd_barrier_complete(bar, b.x, nloc, nx); b.st[0] = nloc; b.st[1] = nx; }
        const unsigned old = xb_add(&bar[XB_XSUB(b.x)], 1u);
        const unsigned gen = old / nloc;
        if (old + 1u == (gen + 1u) * nloc) {
            __builtin_amdgcn_fence(__ATOMIC_RELEASE, "agent");
            asm volatile("s_waitcnt vmcnt(0)" ::: "memory");
            const unsigned og = xb_add(&bar[XB_TOP], 1u);
            const unsigned tg = og / nx;
            if (og + 1u == (tg + 1u) * nx) xb_add(&bar[XB_TOPGEN], 1u);
            else XB_SPIN(xb_ld(&bar[XB_TOPGEN]) == tg, bar);
            __builtin_amdgcn_fence(__ATOMIC_ACQUIRE, "agent");
            xb_add(&bar[XB_XGEN(b.x)], 1u);
            asm volatile("s_waitcnt vmcnt(0)" ::: "memory");
        } else {
            XB_SPIN(xb_ld(&bar[XB_XGEN(b.x)]) == gen, bar);
            __builtin_amdgcn_fence(__ATOMIC_ACQUIRE, "agent");
            asm volatile("s_waitcnt vmcnt(0)" ::: "memory");
        }
    }
    __syncthreads();
}

constexpr int S_ = 8192, DM = 2048, INW = 10240, NE = 32, TOPK = 4;
constexpr int A_W = 1536, A_V_OFF = 3072, B_Q_OFF = 4608, B_K_OFF = 5632, B_V_OFF = 5888, GATE_OFF = 6144;
constexpr int MAXSLOT = 40960;
constexpr float LN_EPS = 1e-5f, QK_EPS = 1e-6f;
constexpr float ALPHA = 1.189207115002721f;
constexpr int NPH = 11;

constexpr size_t MiB = 1u << 20;
constexpr size_t WS_CTL = 0, CTL_ZERO_BYTES = 64 * 1024;
constexpr int CW_BAR = 0;
constexpr int CW_CNT = 4096;
constexpr size_t WS_LUT = 1 * MiB;
constexpr size_t WS_ROPE = 1 * MiB + 8192;
constexpr size_t WS_WRT = 1 * MiB + 65536;
constexpr size_t WS_TOKE = 1 * MiB + 65536 + 262144;
constexpr size_t WS_TOKR = WS_TOKE + 131072;
constexpr size_t WS_TOKW = WS_TOKR + 131072;
constexpr size_t WS_TOKS = WS_TOKW + 131072;
constexpr size_t WS_SLOTW = WS_TOKS + 131072;
constexpr size_t WS_LSE = 3 * MiB;
constexpr size_t WS_XB = 4 * MiB;
constexpr size_t WS_WIN = WS_XB + 32 * MiB;
constexpr size_t WS_WA = WS_WIN + 40 * MiB;
constexpr size_t WS_WB = WS_WA + 2 * MiB;
constexpr size_t WS_WO = WS_WB + 4 * MiB;
constexpr size_t WS_WGL = WS_WO + 8 * MiB;
constexpr size_t WS_WD = WS_WGL + 512 * MiB;
constexpr size_t WS_PROJ = WS_WD + 256 * MiB;
constexpr size_t WS_QBR = WS_PROJ + 160 * MiB;
constexpr size_t WS_KBR = WS_QBR + 16 * MiB;
constexpr size_t WS_VBR = WS_KBR + 4 * MiB;
constexpr size_t WS_Q8 = WS_VBR + 4 * MiB;
constexpr size_t WS_K8 = WS_Q8 + 8 * MiB;
constexpr size_t WS_VIMG = WS_K8 + 2 * MiB;
constexpr size_t WS_DBG = WS_VIMG + 2 * MiB;
constexpr size_t WS_OUTA = WS_DBG + 64 * MiB;
constexpr size_t WS_YA = WS_OUTA + 24 * MiB;
constexpr size_t WS_YB = WS_YA + 8 * MiB;
constexpr size_t WS_T1 = WS_YB + 16 * MiB;
constexpr size_t WS_Y = WS_T1 + 64 * MiB;
constexpr size_t WS_X1 = WS_Y + 32 * MiB;
constexpr size_t WS_X1B = WS_X1 + 64 * MiB;
constexpr size_t WS_XS = WS_X1B + 32 * MiB;
constexpr size_t WS_H = WS_XS + 160 * MiB;
constexpr size_t WS_YS = WS_PROJ;
constexpr size_t WS_END = WS_H + 160 * MiB;

constexpr int RING_OFF = 0, RING_BYTES = 131072;
constexpr int L_XB = RING_BYTES;
constexpr int L_TILE = RING_BYTES + 64;
constexpr int L_PST = RING_BYTES + 1024;
constexpr int L_CNT = RING_BYTES + 1280;
constexpr int L_ASG = RING_BYTES + 2048;
constexpr int L_PTR = RING_BYTES + 3584;
constexpr int LDS_BYTES = 147456;

struct Frame {
    LAS unsigned char* lds; unsigned char* ldsg;
    unsigned char* ws; unsigned* ctl;
    int tid, lane, wave, G;
};
__device__ __forceinline__ const float* inp(const Frame& F, int i) {
    const LAS unsigned* p = (const LAS unsigned*)(F.lds + L_PTR) + 2 * i;
    const unsigned lo = __builtin_amdgcn_readfirstlane(p[0]), hi = __builtin_amdgcn_readfirstlane(p[1]);
    return (const float*)(((unsigned long long)hi << 32) | lo);
}
__device__ __forceinline__ float wave_sum(float v) {
#pragma unroll
    for (int o = 1; o < 64; o <<= 1) v += __shfl_xor(v, o);
    return v;
}

__device__ __forceinline__ void transpose_item(const float* __restrict__ W, int N, int k0, int n0, bf16* WT, int ldo, int orow0, int ocol0, LAS float* scr, int lane, const bool q8 = false) {
    f32x4 v[8];
#pragma unroll
    for (int i = 0; i < 8; ++i) v[i] = *(const f32x4*)(W + (size_t)(k0 + 8 * i + (lane >> 3)) * N + n0 + 4 * (lane & 7));
#pragma unroll
    for (int i = 0; i < 8; ++i) { LAS float* s = scr + (8 * i + (lane >> 3)) * 33 + 4 * (lane & 7); if (q8) { for (int e = 0; e < 4; ++e) v[i][e] = q8f(v[i][e] * 64.0f) * (1.0f / 64.0f); } s[0] = v[i][0]; s[1] = v[i][1]; s[2] = v[i][2]; s[3] = v[i][3]; }
    LDS_WAIT(); asm volatile("" ::: "memory");
    const int c = lane & 7;
#pragma unroll
    for (int j = 0; j < 4; ++j) { const int n = (lane >> 3) + 8 * j; const LAS float* s = scr + (8 * c) * 33 + n;
        v4u o; o.x = pk2(s[0 * 33], s[1 * 33]); o.y = pk2(s[2 * 33], s[3 * 33]); o.z = pk2(s[4 * 33], s[5 * 33]); o.w = pk2(s[6 * 33], s[7 * 33]);
        *(v4u*)(WT + (size_t)(orow0 + n) * ldo + ocol0 + 8 * c) = o; }
    LDS_WAIT(); asm volatile("" ::: "memory");
}
__device__ __forceinline__ void transpose_item8(const float* __restrict__ W, int N, int k0, int n0, unsigned char* WT, int ldo, int orow0, int ocol0, float scale, LAS float* scr, int lane) {
    f32x4 v[8];
#pragma unroll
    for (int i = 0; i < 8; ++i) v[i] = *(const f32x4*)(W + (size_t)(k0 + 8 * i + (lane >> 3)) * N + n0 + 4 * (lane & 7));
#pragma unroll
    for (int i = 0; i < 8; ++i) { LAS float* s = scr + (8 * i + (lane >> 3)) * 33 + 4 * (lane & 7); s[0] = v[i][0] * scale; s[1] = v[i][1] * scale; s[2] = v[i][2] * scale; s[3] = v[i][3] * scale; }
    LDS_WAIT(); asm volatile("" ::: "memory");
    const int c = lane & 3;
#pragma unroll
    for (int j = 0; j < 2; ++j) { const int n = (lane >> 2) + 16 * j; const LAS float* s = scr + (16 * c) * 33 + n;
        v4u o; o.x = pk4_fp8(s[0 * 33], s[1 * 33], s[2 * 33], s[3 * 33]); o.y = pk4_fp8(s[4 * 33], s[5 * 33], s[6 * 33], s[7 * 33]);
        o.z = pk4_fp8(s[8 * 33], s[9 * 33], s[10 * 33], s[11 * 33]); o.w = pk4_fp8(s[12 * 33], s[13 * 33], s[14 * 33], s[15 * 33]);
        *(v4u*)(WT + (size_t)(orow0 + n) * ldo + ocol0 + 16 * c) = o; }
    LDS_WAIT(); asm volatile("" ::: "memory");
}
__device__ __forceinline__ int t5_bucket(int rel) {
    const int n = rel < 0 ? -rel : rel; const float nf = (float)(n < 1 ? 1 : n);
    int large = 8 + (int)(logf(nf / 8.0f) / 4.852030263919617f * 8.0f); large = large < 15 ? large : 15;
    return (rel > 0 ? 16 : 0) + (n < 8 ? n : large);
}
__device__ __forceinline__ void p0_prologue(Frame& F) {
    LAS float* scr = (LAS float*)(F.lds + RING_OFF + F.wave * 16384);
    const int gw = blockIdx.x * 8 + F.wave, NGW = F.G * 8;
    const int gt = blockIdx.x * 512 + F.tid, NGT = F.G * 512;
    bf16* XB = (bf16*)(F.ws + WS_XB); bf16* WIN = (bf16*)(F.ws + WS_WIN); bf16* WA = (bf16*)(F.ws + WS_WA); bf16* WB = (bf16*)(F.ws + WS_WB); bf16* WO = (bf16*)(F.ws + WS_WO);
    bf16* WGL = (bf16*)(F.ws + WS_WGL); bf16* WD = (bf16*)(F.ws + WS_WD);
    { float* lut = (float*)(F.ws + WS_LUT); const float* rb = inp(F, 3);
      for (int i = gt; i < 3 * 4 * 129; i += NGT) { const int g = i / 516, hh = (i / 129) % 4, j = i % 129; const int d = (g == 0) ? 1 : (g == 1 ? 4 : 16);
          lut[i] = rb[t5_bucket((j - 64) * d) * 12 + g * 4 + hh]; }
      float* rope = (float*)(F.ws + WS_ROPE);
      for (int i = gt; i < 128 * 32; i += NGT) { const int pos = i >> 5, fi = i & 31; const float inv = powf(10000.0f, -(float)(2 * fi) / 64.0f); const float ang = (float)pos * inv;
          rope[2 * i] = __cosf(ang); rope[2 * i + 1] = __sinf(ang); }
      float* wrt = (float*)(F.ws + WS_WRT); const float* wr = inp(F, 11);
      for (int i = gt; i < 32 * 2048; i += NGT) { const int e = i >> 11, c = i & 2047; wrt[i] = wr[c * 32 + e]; }
    }
    { const float* x = inp(F, 0);
      for (int i = gw; i < S_ * DM / 512; i += NGW) { const size_t o = (size_t)i * 512 + F.lane * 8; const f32x4 a = *(const f32x4*)(x + o), b = *(const f32x4*)(x + o + 4);
          v2u w; w.x = pk4_fp8(a[0], a[1], a[2], a[3]); w.y = pk4_fp8(b[0], b[1], b[2], b[3]); *(v2u*)((unsigned char*)XB + o) = w; } }
    constexpr int T_WIN = 16 * 80, T_WA = 4 * 16, T_WB = 8 * 16, T_WO = 16 * 16, T_EXP = 16 * 16, T_MOE = 3 * 32 * T_EXP;
    constexpr int NT = T_WIN + T_WA + T_WB + T_WO + T_MOE;
    const float* const w_in = inp(F, 1); const float* const w_ba = inp(F, 6); const float* const w_bb = inp(F, 7); const float* const w_o = inp(F, 8);
    const float* const w_g = inp(F, 13); const float* const w_l = inp(F, 15); const float* const w_d = inp(F, 17);
#define P0_DECODE(T, SRC, NN, DST, LDO, SCL) do { int r_ = (T); \
        if (r_ < T_WIN) { const int kt = r_ / 80, nt = r_ % 80; SRC = w_in + (size_t)(128 * kt) * INW + 128 * nt; NN = INW; DST = (unsigned char*)WIN + (size_t)(nt >> 1) * (256 * 2048) + kt * 32768 + (nt & 1) * 16384; LDO = 128; SCL = 64.0f; break; } r_ -= T_WIN; \
        if (r_ < T_WA) { const int kt = r_ / 16, nt = r_ % 16; SRC = w_ba + (size_t)(128 * kt) * DM + 128 * nt; NN = DM; DST = (unsigned char*)WA + (size_t)(nt >> 1) * (256 * 512) + kt * 32768 + (nt & 1) * 16384; LDO = 128; SCL = 32.0f; break; } r_ -= T_WA; \
        if (r_ < T_WB) { const int kt = r_ / 16, nt = r_ % 16; SRC = w_bb + (size_t)(128 * kt) * DM + 128 * nt; NN = DM; DST = (unsigned char*)WB + (size_t)(nt >> 1) * (256 * 1024) + kt * 32768 + (nt & 1) * 16384; LDO = 128; SCL = 32.0f; break; } r_ -= T_WB; \
        if (r_ < T_WO) { const int kt = r_ / 16, nt = r_ % 16; SRC = w_o + (size_t)(128 * kt) * DM + 128 * nt; NN = DM; DST = (unsigned char*)WO + (size_t)(nt >> 1) * (256 * 2048) + kt * 32768 + (nt & 1) * 16384; LDO = 128; SCL = 64.0f; break; } r_ -= T_WO; \
        { const int which = r_ / (32 * T_EXP), rr = r_ % (32 * T_EXP), e = rr / T_EXP, q = rr % T_EXP, kt = q / 16, nt = q % 16; \
          SRC = (which == 0 ? w_g : (which == 1 ? w_l : w_d)) + (size_t)e * DM * DM + (size_t)(128 * kt) * DM + 128 * nt; NN = DM; LDO = 128; SCL = 64.0f; \
          DST = (which < 2) ? (unsigned char*)WGL + (size_t)e * (4096 * 2048) + (size_t)nt * (256 * 2048) + kt * 32768 + which * 16384 : (unsigned char*)WD + (size_t)e * (2048 * 2048) + (size_t)(nt >> 1) * (256 * 2048) + kt * 32768 + (nt & 1) * 16384; } } while (0)
    const int nq = F.tid & 31, kq0 = F.tid >> 5;
#define P0_LOAD(V, SRC, NN) do { _Pragma("unroll") for (int p = 0; p < 2; ++p) _Pragma("unroll") for (int i = 0; i < 4; ++i) V[p * 4 + i] = __builtin_nontemporal_load((const f32x4*)(SRC + (size_t)(4 * (kq0 + 16 * p) + i) * NN + 4 * nq)); } while (0)
    if ((int)blockIdx.x < NT) {
        const int nj = (NT - (int)blockIdx.x + F.G - 1) / F.G;
        const float* src; int nn; unsigned char* dst; int ldo; float scl;
        P0_DECODE((int)blockIdx.x, src, nn, dst, ldo, scl);
        f32x4 v[8]; P0_LOAD(v, src, nn);
        for (int j = 0; j < nj; ++j) {
            const int jn = (j + 1 < nj) ? j + 1 : j;
            const float* nsrc; int nnn; unsigned char* ndst; int nldo; float nscl;
            P0_DECODE((int)blockIdx.x + jn * F.G, nsrc, nnn, ndst, nldo, nscl);
            f32x4 nv[8]; P0_LOAD(nv, nsrc, nnn);
            LAS unsigned* t32 = (LAS unsigned*)(F.lds + RING_OFF + (j & 1) * 16384);
#pragma unroll
            for (int p = 0; p < 2; ++p)
#pragma unroll
                for (int c = 0; c < 4; ++c) t32[(4 * nq + c) * 32 + ((kq0 + 16 * p) ^ nq)] = pk4_fp8(v[p * 4 + 0][c] * scl, v[p * 4 + 1][c] * scl, v[p * 4 + 2][c] * scl, v[p * 4 + 3][c] * scl);
            __syncthreads();
#pragma unroll
            for (int jj = 0; jj < 2; ++jj) { const int n = (F.tid >> 3) + 64 * jj, c8 = F.tid & 7, g = n >> 2; const LAS unsigned* rp = t32 + n * 32;
                v4u o; o.x = rp[(4 * c8 + 0) ^ g]; o.y = rp[(4 * c8 + 1) ^ g]; o.z = rp[(4 * c8 + 2) ^ g]; o.w = rp[(4 * c8 + 3) ^ g];
                __builtin_nontemporal_store(o, (v4u*)(dst + (size_t)n * ldo + 16 * c8)); }
#pragma unroll
            for (int i = 0; i < 8; ++i) v[i] = nv[i];
            src = nsrc; nn = nnn; dst = ndst; ldo = nldo; scl = nscl;
        }
        __syncthreads();
    }
#undef P0_DECODE
#undef P0_LOAD
}

__device__ __forceinline__ void p2_prep_dilated(Frame& F) {
    const bf16* proj = (const bf16*)(F.ws + WS_PROJ);
    bf16* QBR = (bf16*)(F.ws + WS_QBR); bf16* KBR = (bf16*)(F.ws + WS_KBR); bf16* VBR = (bf16*)(F.ws + WS_VBR);
    unsigned char* Q8 = F.ws + WS_Q8; unsigned char* K8 = F.ws + WS_K8; unsigned char* VIMG = F.ws + WS_VIMG;
    const float* rope = (const float*)(F.ws + WS_ROPE);
    const int gw = blockIdx.x * 8 + F.wave, NGW = F.G * 8;
    const int half = F.lane >> 5, fi = F.lane & 31, c1 = half * 64 + fi, c2 = c1 + 32;
    const float* const qn_g = inp(F, 4); const float* const kn_g = inp(F, 5);
    int tfirst, tstep_, tcount;
    if (F.G == 256) { if (blockIdx.x >= 128) { tfirst = ((int)blockIdx.x - 128) * 8 + F.wave; tstep_ = 1024; tcount = 6; } else { tfirst = 6144 + (int)blockIdx.x * 8 + F.wave; tstep_ = 1024; tcount = 2; } }
    else { tfirst = gw; tstep_ = NGW; tcount = (S_ - gw + NGW - 1) / NGW; }
    for (int ti = 0; ti < tcount; ++ti) {
        const int t = tfirst + ti * tstep_;
        const bf16* base = proj + (size_t)t * INW;
        float a1[10], a2[10], ss[10];
#pragma unroll
        for (int h = 0; h < 10; ++h) { const bf16* src = base + (h < 8 ? B_Q_OFF + h * 128 : B_K_OFF + (h - 8) * 128); a1[h] = bf2f(src[c1]); a2[h] = bf2f(src[c2]); }
        const unsigned vv0 = ((const unsigned*)(base + B_V_OFF))[F.lane], vv1 = ((const unsigned*)(base + B_V_OFF + 128))[F.lane];
        const int pos = half ? (t & 63) : (t >> 6);
        const float cs = rope[(pos * 32 + fi) * 2], sn = rope[(pos * 32 + fi) * 2 + 1];
        const float gq1 = qn_g[c1], gq2 = qn_g[c2], gk1 = kn_g[c1], gk2 = kn_g[c2];
#pragma unroll
        for (int h = 0; h < 10; ++h) ss[h] = a1[h] * a1[h] + a2[h] * a2[h];
#pragma unroll
        for (int o = 1; o < 64; o <<= 1)
#pragma unroll
            for (int h = 0; h < 10; ++h) ss[h] += __shfl_xor(ss[h], o);
#pragma unroll
        for (int h = 0; h < 10; ++h) {
            const float rs = 1.0f / sqrtf(ss[h] * (1.0f / 128.0f) + QK_EPS);
            const float v1 = a1[h] * rs * (h < 8 ? gq1 : gk1), v2 = a2[h] * rs * (h < 8 ? gq2 : gk2);
            const float o1 = v1 * cs - v2 * sn, o2 = v1 * sn + v2 * cs;
            unsigned char* dst8 = h < 8 ? Q8 + (size_t)t * 1024 + h * 128 : K8 + (size_t)t * 256 + (h - 8) * 128;
            const unsigned pq = pk4_fp8(o1, o2, 0.f, 0.f); dst8[c1] = (unsigned char)(pq & 0xffu); dst8[c2] = (unsigned char)((pq >> 8) & 0xffu);
            if (MK_CHECK8) { bf16* dst = h < 8 ? QBR + (size_t)t * 1024 + h * 128 : KBR + (size_t)t * 256 + (h - 8) * 128;
                dst[c1] = (bf16)(pk2(o1, 0.f) & 0xffffu); dst[c2] = (bf16)(pk2(o2, 0.f) & 0xffffu); }
        }
        if (MK_CHECK8) { ((unsigned*)(VBR + (size_t)t * 256))[F.lane] = vv0; ((unsigned*)(VBR + (size_t)t * 256 + 128))[F.lane] = vv1; }
        {
            const int kk = t & 63, part = kk >> 5, k32 = kk & 31, g = (k32 >> 2) & 1, ii = (k32 & 3) + 4 * (k32 >> 3);
            unsigned char* img = VIMG + (size_t)(t >> 6) * 8192 + part * 1024 + g * 512 + ii;
            const int ca = 2 * F.lane, cb = 2 * F.lane + 1;
            const unsigned p0 = pk4_fp8(bflo(vv0) * 16.0f, bfhi(vv0) * 16.0f, bflo(vv1) * 16.0f, bfhi(vv1) * 16.0f);
            img[(ca >> 5) * 2048 + (ca & 31) * 16] = (unsigned char)(p0 & 0xffu); img[(cb >> 5) * 2048 + (cb & 31) * 16] = (unsigned char)((p0 >> 8) & 0xffu);
            img[128 * 8192 + (ca >> 5) * 2048 + (ca & 31) * 16] = (unsigned char)((p0 >> 16) & 0xffu); img[128 * 8192 + (cb >> 5) * 2048 + (cb & 31) * 16] = (unsigned char)((p0 >> 24) & 0xffu);
        }
    }
    const float* lut = (const float*)(F.ws + WS_LUT);
    for (int u = blockIdx.x; u < 384; u += F.G) {
        const int gh = u >> 5, blk = u & 31, g = gh >> 2, hh = gh & 3, d = (g == 0) ? 1 : (g == 1 ? 4 : 16);
        const int bps = 32 / d, r = blk / bps, qb = blk % bps;
        at::dilated_unit((const at::bf16*)proj, lut + (g * 4 + hh) * 129, (at::bf16*)(F.ws + WS_OUTA) + (size_t)g * S_ * 512, (float*)(F.ws + WS_LSE) + (size_t)g * S_ * 4,
                         d, gh, hh, r, qb * 256, (char*)F.ldsg + RING_OFF);
    }
}

__device__ __forceinline__ void p3_attn_combine(Frame& F) {
    const at::bf16* QBR = (const at::bf16*)(F.ws + WS_QBR); const at::bf16* KBR = (const at::bf16*)(F.ws + WS_KBR); const at::bf16* VBR = (const at::bf16*)(F.ws + WS_VBR);
    unsigned char* YB = F.ws + WS_YB;
    for (int u = blockIdx.x; u < 256; u += F.G) {
        const int h = u & 7, qb = u >> 3, kv = h >> 2;
        at::attn_dense_body8<1024, 256, 1024>(F.ws + WS_Q8 + (size_t)qb * 256 * 1024 + h * 128, F.ws + WS_K8 + kv * 128, F.ws + WS_VIMG + (size_t)kv * 128 * 8192, YB + (size_t)qb * 256 * 1024 + h * 128, S_, (char*)F.ldsg + RING_OFF);
        __syncthreads();
    }
    if (MK_CHECK8) for (int u = blockIdx.x; u < 256; u += F.G) { const int h = u & 7, qb = u >> 3, kv = h >> 2;
        at::attn_dense_body<1024, 256, 256, 1024>(QBR + (size_t)qb * 256 * 1024 + h * 128, KBR + kv * 128, VBR + kv * 128, F.ws + WS_DBG + (size_t)qb * 256 * 1024 + h * 128, S_, (char*)F.ldsg + RING_OFF); __syncthreads(); }
    const bf16* OUTA = (const bf16*)(F.ws + WS_OUTA); const float* LSE = (const float*)(F.ws + WS_LSE); bf16* YA = (bf16*)(F.ws + WS_YA);
    for (int tb = blockIdx.x; tb < 256; tb += F.G) {
        const int t = tb * 32 + (F.tid >> 4), c0 = (F.tid & 15) * 32, hh = c0 >> 7;
        const float l0 = LSE[(size_t)t * 4 + hh], l1 = LSE[(size_t)(S_ + t) * 4 + hh], l2 = LSE[(size_t)(2 * S_ + t) * 4 + hh];
        const float m = fmaxf(l0, fmaxf(l1, l2)); float w0 = __expf(l0 - m), w1 = __expf(l1 - m), w2 = __expf(l2 - m); const float inv = 16.0f / (w0 + w1 + w2); w0 *= inv; w1 *= inv; w2 *= inv;
#pragma unroll
        for (int q = 0; q < 4; ++q) { const size_t o = (size_t)t * 512 + c0 + q * 8;
            const v4u a = *(const v4u*)(OUTA + o), b = *(const v4u*)(OUTA + (size_t)S_ * 512 + o), c = *(const v4u*)(OUTA + (size_t)2 * S_ * 512 + o);
            v2u w;
            w.x = pk4_fp8(w0 * bflo(a.x) + w1 * bflo(b.x) + w2 * bflo(c.x), w0 * bfhi(a.x) + w1 * bfhi(b.x) + w2 * bfhi(c.x), w0 * bflo(a.y) + w1 * bflo(b.y) + w2 * bflo(c.y), w0 * bfhi(a.y) + w1 * bfhi(b.y) + w2 * bfhi(c.y));
            w.y = pk4_fp8(w0 * bflo(a.z) + w1 * bflo(b.z) + w2 * bflo(c.z), w0 * bfhi(a.z) + w1 * bfhi(b.z) + w2 * bfhi(c.z), w0 * bflo(a.w) + w1 * bflo(b.w) + w2 * bflo(c.w), w0 * bfhi(a.w) + w1 * bfhi(b.w) + w2 * bfhi(c.w));
            *(v2u*)((unsigned char*)YA + o) = w; }
    }
}

typedef float f32x16m __attribute__((ext_vector_type(16)));
__device__ __forceinline__ void p6_ln_router(Frame& F, const int bank = 0) {
    LAS int* cntl = (LAS int*)(F.lds + L_CNT); LAS int* basel = cntl + 32;
    LAS int* asg_e = (LAS int*)(F.lds + L_ASG); LAS int* asg_lr = asg_e + 128; LAS float* asg_w = (LAS float*)(asg_lr + 128);
    LAS float* x1s = (LAS float*)(F.lds + RING_OFF);
    LAS float* red = (LAS float*)(F.lds + RING_OFF + 73728);
    const float* Z1 = (const float*)(F.ws + WS_T1); bf16* X1 = (bf16*)(F.ws + WS_X1); unsigned char* X1Q = F.ws + WS_X1B;
    const f32x4* G4 = (const f32x4*)inp(F, 9); const f32x4* B4 = (const f32x4*)inp(F, 10);
    const float* wr = inp(F, 11); const float* br = inp(F, 12);
    unsigned* gcnt = F.ctl + CW_CNT + bank * 64;
    int* TOKE = (int*)(F.ws + (bank ? WS_H : WS_TOKE)); int* TOKR = (int*)(F.ws + (bank ? WS_H + MiB : WS_TOKR)); float* TOKW = (float*)(F.ws + (bank ? WS_H + 2 * MiB : WS_TOKW));
    const int li = F.lane & 31, kk = F.lane >> 5;
    for (int tb = blockIdx.x; tb < 256; tb += F.G) {
        if (F.tid < 32) cntl[F.tid] = 0;
        const int t0 = tb * 32 + F.wave * 4;
        f32x4 xv[4][8];
#pragma unroll
        for (int tk = 0; tk < 4; ++tk) {
            const f32x4* zr = (const f32x4*)(Z1 + (size_t)(t0 + tk) * DM) + F.lane;
#pragma unroll
            for (int j = 0; j < 8; ++j) xv[tk][j] = zr[64 * j];
            float s = 0.f;
#pragma unroll
            for (int j = 0; j < 8; ++j) s += (xv[tk][j][0] + xv[tk][j][1]) + (xv[tk][j][2] + xv[tk][j][3]);
            const float mean = wave_sum(s) * (1.0f / DM); float s2 = 0.f;
#pragma unroll
            for (int j = 0; j < 8; ++j) { xv[tk][j] = xv[tk][j] - mean; s2 += (xv[tk][j][0] * xv[tk][j][0] + xv[tk][j][1] * xv[tk][j][1]) + (xv[tk][j][2] * xv[tk][j][2] + xv[tk][j][3] * xv[tk][j][3]); }
            const float rstd = 1.0f / sqrtf(wave_sum(s2) * (1.0f / DM) + LN_EPS);
            v2u* xo = (v2u*)(X1 + (size_t)(t0 + tk) * DM) + F.lane; unsigned* xb = (unsigned*)(X1Q + (size_t)(t0 + tk) * DM) + F.lane;
#pragma unroll
            for (int j = 0; j < 8; ++j) { const f32x4 v = xv[tk][j] * rstd * G4[64 * j + F.lane] + B4[64 * j + F.lane]; xv[tk][j] = v;
                v2u w; w.x = pk2(v[0], v[1]); w.y = pk2(v[2], v[3]); xo[64 * j] = w; xb[64 * j] = pk4_fp8(v[0], v[1], v[2], v[3]); }
            asm volatile("" ::: "memory"); __builtin_amdgcn_sched_barrier(0);
        }
        f32x16m acc = {0.f, 0.f, 0.f, 0.f, 0.f, 0.f, 0.f, 0.f, 0.f, 0.f, 0.f, 0.f, 0.f, 0.f, 0.f, 0.f};
        const float* wp = wr + (size_t)(32 * F.wave + 4 * kk) * 32 + li;
#pragma unroll
        for (int c = 0; c < 8; ++c) {
            LAS float* buf = x1s + (c & 1) * (32 * 260);
#pragma unroll
            for (int tk = 0; tk < 4; ++tk) *(LAS f32x4*)(buf + (4 * F.wave + tk) * 260 + 4 * F.lane) = xv[tk][c];
            __syncthreads();
#pragma unroll
            for (int b = 0; b < 4; ++b) {
                const f32x4 a4 = *(const LAS f32x4*)(buf + li * 260 + 32 * F.wave + 8 * b + 4 * kk);
                asm volatile("" : "+v"(wp));
                const float b0 = wp[0], b1 = wp[32], b2 = wp[64], b3 = wp[96]; wp += (b == 3) ? (256 - 24) * 32 : 8 * 32;
                acc = __builtin_amdgcn_mfma_f32_32x32x2f32(a4[0], b0, acc, 0, 0, 0);
                acc = __builtin_amdgcn_mfma_f32_32x32x2f32(a4[1], b1, acc, 0, 0, 0);
                acc = __builtin_amdgcn_mfma_f32_32x32x2f32(a4[2], b2, acc, 0, 0, 0);
                acc = __builtin_amdgcn_mfma_f32_32x32x2f32(a4[3], b3, acc, 0, 0, 0);
            }
            __builtin_amdgcn_sched_barrier(0);
        }
#pragma unroll
        for (int r = 0; r < 16; ++r) red[(F.wave * 32 + ((r & 3) + 8 * (r >> 2) + 4 * kk)) * 32 + li] = acc[r];
        __syncthreads();
#pragma unroll
        for (int tk = 0; tk < 4; ++tk) {
            float v = -3.0e38f;
            if (F.lane < 32) { float sres = br[F.lane];
#pragma unroll
                for (int w8 = 0; w8 < 8; ++w8) sres += red[(w8 * 32 + 4 * F.wave + tk) * 32 + F.lane];
                v = sres; }
            float tv[4]; int ti[4];
#pragma unroll
            for (int k = 0; k < 4; ++k) { float bv = v; int bi = F.lane;
#pragma unroll
                for (int o = 1; o < 64; o <<= 1) { const float ov = __shfl_xor(bv, o); const int oi = __shfl_xor(bi, o); if (ov > bv || (ov == bv && oi < bi)) { bv = ov; bi = oi; } }
                tv[k] = bv; ti[k] = bi; if (F.lane == bi) v = -3.0e38f; }
            const float e1 = __expf(tv[1] - tv[0]), e2 = __expf(tv[2] - tv[0]), e3 = __expf(tv[3] - tv[0]); const float inv = 1.0f / (1.0f + e1 + e2 + e3);
            if (F.lane < 4) { const int me = F.lane == 0 ? ti[0] : (F.lane == 1 ? ti[1] : (F.lane == 2 ? ti[2] : ti[3]));
                const float mw = (F.lane == 0 ? 1.0f : (F.lane == 1 ? e1 : (F.lane == 2 ? e2 : e3))) * inv;
                const int lr = atomicAdd((int*)(cntl + me), 1);
                const int a = (F.wave * 4 + tk) * 4 + F.lane; asg_e[a] = me; asg_lr[a] = lr; asg_w[a] = mw; }
        }
        __syncthreads();
        if (F.tid < 32) basel[F.tid] = (int)atomicAdd(gcnt + F.tid, (unsigned)cntl[F.tid]);
        __syncthreads();
        if (F.tid < 128) { const int a = tb * 128 + F.tid; const int e = asg_e[F.tid]; TOKE[a] = e; TOKR[a] = basel[e] + asg_lr[F.tid]; TOKW[a] = asg_w[F.tid]; }
        __syncthreads();
    }
}

__device__ __forceinline__ void p7_gather(Frame& F) {
    LAS int* pst = (LAS int*)(F.lds + L_PST);
    const unsigned* gcnt = F.ctl + CW_CNT;
    if (F.tid == 0) { int acc = 0; for (int e = 0; e < 32; ++e) { pst[e] = acc; acc += ((int)gcnt[e] + 255) & ~255; } pst[32] = acc; }
    __syncthreads();
    const int* TOKE = (const int*)(F.ws + WS_TOKE); const int* TOKR = (const int*)(F.ws + WS_TOKR); const float* TOKW = (const float*)(F.ws + WS_TOKW);
    int* TOKS = (int*)(F.ws + WS_TOKS); float* SLOTW = (float*)(F.ws + WS_SLOTW);
    const bf16* X1B = (const bf16*)(F.ws + WS_X1B); bf16* XS = (bf16*)(F.ws + WS_XS);
    const int gw = blockIdx.x * 8 + F.wave, NGW = F.G * 8;
    for (int a0 = gw; a0 < S_ * TOPK; a0 += 4 * NGW) {
        int slot[4]; float w[4]; v4u r0[4], r1[4];
#pragma unroll
        for (int q = 0; q < 4; ++q) { const int a = a0 + q * NGW; const int ac = a < S_ * TOPK ? a : a0; slot[q] = pst[TOKE[ac]] + TOKR[ac]; w[q] = TOKW[ac]; }
#pragma unroll
        for (int q = 0; q < 4; ++q) { const int a = a0 + q * NGW; const int ac = a < S_ * TOPK ? a : a0; const v4u* src = (const v4u*)((const unsigned char*)X1B + (size_t)(ac >> 2) * DM) + F.lane; r0[q] = src[0]; r1[q] = src[64]; }
#pragma unroll
        for (int q = 0; q < 4; ++q) { const int a = a0 + q * NGW; if (a < S_ * TOPK) { if (F.lane == 0) { TOKS[a] = slot[q]; SLOTW[slot[q]] = w[q]; }
            v4u* dst = (v4u*)((unsigned char*)XS + (size_t)slot[q] * DM) + F.lane; dst[0] = r0[q]; dst[64] = r1[q]; } }
    }
}
__device__ __forceinline__ int moe_tiles(Frame& F) {
    LAS int* tile_e = (LAS int*)(F.lds + L_TILE);
    const unsigned* gcnt = F.ctl + CW_CNT;
    __syncthreads();
    if (F.tid == 0) { int ti = 0; for (int e = 0; e < 32; ++e) { const int nt = ((int)gcnt[e] + 255) >> 8; for (int k = 0; k < nt && ti < 160; ++k) tile_e[ti++] = e; } tile_e[160] = ti; }
    __syncthreads();
    return tile_e[160];
}

__device__ __forceinline__ void p10_final(Frame& F) {
    const bf16* X1 = (const bf16*)(F.ws + WS_X1); const bf16* YS = (const bf16*)(F.ws + WS_YS); const int* TOKS = (const int*)(F.ws + WS_TOKS);
    const f32x4* G4 = (const f32x4*)inp(F, 19); const f32x4* B4 = (const f32x4*)inp(F, 20);
    float* outp = (float*)inp(F, 21);
    const int gw = blockIdx.x * 8 + F.wave, NGW = F.G * 8;
    for (int t0 = gw; t0 < S_; t0 += 2 * NGW) {
        f32x4 v[2][8]; int tt[2]; int sl[2][4];
#pragma unroll
        for (int q = 0; q < 2; ++q) { const int t = t0 + q * NGW; tt[q] = t < S_ ? t : t0; }
#pragma unroll
        for (int q = 0; q < 2; ++q)
#pragma unroll
            for (int k = 0; k < 4; ++k) sl[q][k] = TOKS[tt[q] * 4 + k];
#pragma unroll
        for (int q = 0; q < 2; ++q) {
            const v4u* xr = (const v4u*)(X1 + (size_t)tt[q] * DM) + F.lane;
            const v4u* y0 = (const v4u*)(YS + (size_t)sl[q][0] * DM) + F.lane; const v4u* y1 = (const v4u*)(YS + (size_t)sl[q][1] * DM) + F.lane;
            const v4u* y2 = (const v4u*)(YS + (size_t)sl[q][2] * DM) + F.lane; const v4u* y3 = (const v4u*)(YS + (size_t)sl[q][3] * DM) + F.lane;
#pragma unroll
            for (int jj = 0; jj < 4; ++jj) { const v4u x = xr[64 * jj], a = y0[64 * jj], b = y1[64 * jj], c = y2[64 * jj], d = y3[64 * jj];
#define P10_LO(W) (bflo(x.W) * ALPHA + ((bflo(a.W) + bflo(b.W)) + (bflo(c.W) + bflo(d.W))))
#define P10_HI(W) (bfhi(x.W) * ALPHA + ((bfhi(a.W) + bfhi(b.W)) + (bfhi(c.W) + bfhi(d.W))))
                v[q][2 * jj] = (f32x4){P10_LO(x), P10_HI(x), P10_LO(y), P10_HI(y)}; v[q][2 * jj + 1] = (f32x4){P10_LO(z), P10_HI(z), P10_LO(w), P10_HI(w)};
#undef P10_LO
#undef P10_HI
            }
        }
#pragma unroll
        for (int q = 0; q < 2; ++q) {
            float s = 0.f;
#pragma unroll
            for (int j = 0; j < 8; ++j) s += (v[q][j][0] + v[q][j][1]) + (v[q][j][2] + v[q][j][3]);
            const float mean = wave_sum(s) * (1.0f / DM); float s2 = 0.f;
#pragma unroll
            for (int j = 0; j < 8; ++j) { v[q][j] = v[q][j] - mean; s2 += (v[q][j][0] * v[q][j][0] + v[q][j][1] * v[q][j][1]) + (v[q][j][2] * v[q][j][2] + v[q][j][3] * v[q][j][3]); }
            const float rstd = 1.0f / sqrtf(wave_sum(s2) * (1.0f / DM) + LN_EPS);
            if (t0 + q * NGW < S_) { f32x4* o = (f32x4*)(outp + (size_t)tt[q] * DM) + 2 * F.lane;
#pragma unroll
                for (int jj = 0; jj < 4; ++jj) { o[128 * jj] = v[q][2 * jj] * rstd * G4[128 * jj + 2 * F.lane] + B4[128 * jj + 2 * F.lane];
                    o[128 * jj + 1] = v[q][2 * jj + 1] * rstd * G4[128 * jj + 2 * F.lane + 1] + B4[128 * jj + 2 * F.lane + 1]; } }
        }
    }
}

struct Args { const float* in[21]; float* out; unsigned char* ws; int ph_lo, ph_hi; };
__global__ void __launch_bounds__(512, 2) mk_fwd(Args args) {
    extern __shared__ __attribute__((aligned(16))) unsigned char lds[];
    Frame F;
    F.lds = (LAS unsigned char*)lds; F.ldsg = lds;
    F.tid = threadIdx.x; F.lane = F.tid & 63; F.wave = __builtin_amdgcn_readfirstlane(F.tid >> 6); F.G = gridDim.x;
    F.ws = args.ws; F.ctl = (unsigned*)(args.ws + WS_CTL);
    if (F.tid == 0) { LAS unsigned long long* pp = (LAS unsigned long long*)(F.lds + L_PTR);
#pragma unroll
        for (int i = 0; i < 21; ++i) pp[i] = (unsigned long long)args.in[i];
        pp[21] = (unsigned long long)args.out; }
    if (F.tid < 4) ((LAS unsigned*)(F.lds + L_XB))[F.tid] = 0u;
    __syncthreads();
    const int lo = args.ph_lo, hi = args.ph_hi;
    XcdBarrier bar; bar.bar = F.ctl + CW_BAR; bar.x = 0; bar.st = (volatile LAS unsigned*)(F.lds + L_XB);
    if (hi - lo > 1) bar = xcd_barrier_post(F.ctl + CW_BAR, (volatile LAS unsigned*)(F.lds + L_XB));
#ifndef MK_PHASE_MASK
#define MK_PHASE_MASK 0x7ff
#endif
#define IN(k) (((MK_PHASE_MASK >> (k)) & 1) && lo <= (k) && (k) < hi)
#ifndef MK_DUP_MASK
#define MK_DUP_MASK 0
#endif
#define REP(k) for (int rep_ = 0; rep_ < 1 + ((MK_DUP_MASK >> (k)) & 1); ++rep_)
#ifndef MK_BAR2
#define MK_BAR2 0
#endif
#ifndef MK_STAMP_IDX
#define MK_STAMP_IDX -1
#endif
    unsigned long long st0_ = 0ull, stk_ = 0ull;
    if (MK_STAMP_IDX >= 0) st0_ = __builtin_amdgcn_s_memrealtime();
#define SEAM(k) do { if (IN(k) && IN((k) + 1)) { xcd_barrier(bar); if (MK_BAR2) xcd_barrier(bar); if (MK_STAMP_IDX == (k) + 1) stk_ = __builtin_amdgcn_s_memrealtime(); } } while (0)
    LAS unsigned char* ring = F.lds + RING_OFF;
    const pg8::bf16_t* XB = (const pg8::bf16_t*)(F.ws + WS_XB);

    if (IN(0)) REP(0) { p0_prologue(F); }
    SEAM(0);
    if (IN(1)) REP(1) {
        pg8::Gemm g{XB, (const pg8::bf16_t*)(F.ws + WS_WIN), S_, INW, DM / 2}; pg8::StaticOrder S; S.init(S_, INW, F.G, (int)blockIdx.x);
        pg8::EpiStoreBf16 E{(pg8::bf16_t*)(F.ws + WS_PROJ), INW, 1.0f / 64.0f};
        pg8::gemm_phase<pg8::EpiStoreBf16, pg8::StaticOrder, true, true, true, true>(ring, g, S, E);
    }
    SEAM(1);
    if (IN(2)) { p2_prep_dilated(F); if ((MK_DUP_MASK >> 2) & 1) p2_prep_dilated(F); }
    SEAM(2);
    if (IN(3)) REP(3) { p3_attn_combine(F); }
    SEAM(3);
#define PHASE4_BODY { \
        { pg8::Gemm g{(const pg8::bf16_t*)(F.ws + WS_YA), (const pg8::bf16_t*)(F.ws + WS_WA), S_, DM, 256}; pg8::StaticOrder S; S.init(S_, DM, F.G, (int)blockIdx.x); \
          pg8::EpiGateA E{(const pg8::bf16_t*)(F.ws + WS_PROJ), INW, GATE_OFF, inp(F, 2), (float*)(F.ws + WS_T1), DM, 1.0f / 512.0f}; \
          pg8::gemm_phase<pg8::EpiGateA, pg8::StaticOrder, true, true, true, true>(ring, g, S, E); } \
        { pg8::Gemm g{(const pg8::bf16_t*)(F.ws + WS_YB), (const pg8::bf16_t*)(F.ws + WS_WB), S_, DM, 512}; pg8::StaticOrder S; S.init(S_, DM, F.G, (int)blockIdx.x); \
          pg8::EpiGateB E{(const pg8::bf16_t*)(F.ws + WS_PROJ), INW, GATE_OFF + DM, inp(F, 2) + DM, (const float*)(F.ws + WS_T1), F.ws + WS_Y, DM, 1.0f / 2048.0f}; \
          pg8::gemm_phase<pg8::EpiGateB, pg8::StaticOrder, true, true, true, true>(ring, g, S, E); } \
    }
    if (MK_CHECK8 && IN(4)) {
        const unsigned* a32 = (const unsigned*)(F.ws + WS_YB); const unsigned* b32 = (const unsigned*)(F.ws + WS_DBG); float num = 0.f, den = 0.f;
        for (int i = blockIdx.x * 512 + F.tid; i < S_ * 1024 / 4; i += F.G * 512) { const unsigned a = a32[i], b = b32[i];
            for (int q = 0; q < 4; ++q) { const float fa = __builtin_amdgcn_cvt_f32_fp8((int)(a >> (8 * q)), 0), fb = __builtin_amdgcn_cvt_f32_fp8((int)(b >> (8 * q)), 0); num += fabsf(fa - fb); den += fabsf(fb); } }
        num = wave_sum(num); den = wave_sum(den);
        if (F.lane == 0) { atomicAdd((float*)(F.ctl + 4224), num); atomicAdd((float*)(F.ctl + 4225), den); }
    }
    if (IN(4)) { PHASE4_BODY if ((MK_DUP_MASK >> 4) & 1) PHASE4_BODY }
    SEAM(4);
    if (IN(5)) REP(5) {
        pg8::Gemm g{(const pg8::bf16_t*)(F.ws + WS_Y), (const pg8::bf16_t*)(F.ws + WS_WO), S_, DM, DM / 2}; pg8::StaticOrder S; S.init(S_, DM, F.G, (int)blockIdx.x);
        pg8::EpiResF32 E{inp(F, 0), (float*)(F.ws + WS_T1), DM, ALPHA, 1.0f / 4096.0f};
        pg8::gemm_phase<pg8::EpiResF32, pg8::StaticOrder, true, true, true, true>(ring, g, S, E);
    }
    SEAM(5);
    if (IN(6)) { p6_ln_router(F); if ((MK_DUP_MASK >> 6) & 1) p6_ln_router(F, 1); }
    SEAM(6);
    if (IN(7)) REP(7) { p7_gather(F); }
    SEAM(7);
    if (IN(8)) REP(8) {
        const int nt = moe_tiles(F);
        pg8::Gemm g{(const pg8::bf16_t*)(F.ws + WS_XS), (const pg8::bf16_t*)(F.ws + WS_WGL), nt * 256, 4096, DM / 2};
        pg8::MoeOrder S; S.init(nt * 256, 4096, F.G, (int)blockIdx.x); S.tile_e = (const LAS int*)(F.lds + L_TILE); S.estride = (size_t)4096 * 2048;
        pg8::EpiSwiglu E{(const LAS int*)(F.lds + L_TILE), inp(F, 14), inp(F, 16), F.ws + WS_H, DM, 1.0f / 64.0f};
        pg8::gemm_phase<pg8::EpiSwiglu, pg8::MoeOrder, true, true, true, true>(ring, g, S, E);
    }
    SEAM(8);
    if (IN(9)) REP(9) {
        const int nt = moe_tiles(F);
        pg8::Gemm g{(const pg8::bf16_t*)(F.ws + WS_H), (const pg8::bf16_t*)(F.ws + WS_WD), nt * 256, DM, DM / 2};
        pg8::MoeOrder S; S.init(nt * 256, DM, F.G, (int)blockIdx.x); S.tile_e = (const LAS int*)(F.lds + L_TILE); S.estride = (size_t)2048 * 2048;
        pg8::EpiDown E{(const LAS int*)(F.lds + L_TILE), inp(F, 18), (const float*)(F.ws + WS_SLOTW), (pg8::bf16_t*)(F.ws + WS_YS), DM, 1.0f / 64.0f};
        pg8::gemm_phase<pg8::EpiDown, pg8::MoeOrder, true, true, true, true>(ring, g, S, E);
    }
    SEAM(9);
    if (IN(10)) REP(10) { p10_final(F); }
    if (MK_CHECK8 && IN(10)) {
        const float num = *(const float*)(F.ctl + 4224), den = *(const float*)(F.ctl + 4225);
        if (!(num <= MK_CHK_TOL * den) || !(den > 0.f)) { float* o = (float*)inp(F, 21); __syncthreads(); for (int i = blockIdx.x * 512 + F.tid; i < S_ * DM; i += F.G * 512) o[i] = __builtin_nanf(""); }
    }
    if (MK_STAMP_IDX >= 0 && blockIdx.x == 0 && F.tid == 0) {
        const unsigned long long te = __builtin_amdgcn_s_memrealtime(), dt = stk_ - st0_;
        while (__builtin_amdgcn_s_memrealtime() - te < dt) __builtin_amdgcn_s_sleep(8);
    }
#undef IN
#undef SEAM
}

#ifndef MK_CUTS
#define MK_CUTS 0
#endif
extern "C" void kernel_launch(void* const* d_in, const int* in_sizes, int n_in, void* d_out, int out_size, void* d_ws, size_t ws_size, hipStream_t stream) {
    static int grid = 0;
    if (grid == 0) {
        if (n_in != 21 || out_size != S_ * DM || ws_size < WS_END) { fprintf(stderr, "kernel_launch: unexpected shapes (n_in %d out %d ws %zu, need %zu)\n", n_in, out_size, ws_size, (size_t)WS_END); grid = -1; return; }
        int dev = 0, cus = 0, per_cu = 0;
        if (hipGetDevice(&dev) != hipSuccess || hipDeviceGetAttribute(&cus, hipDeviceAttributeMultiprocessorCount, dev) != hipSuccess) { grid = -1; return; }
        if (hipFuncSetAttribute((const void*)mk_fwd, hipFuncAttributeMaxDynamicSharedMemorySize, LDS_BYTES) != hipSuccess) { fprintf(stderr, "kernel_launch: hipFuncSetAttribute failed\n"); grid = -1; return; }
        if (hipOccupancyMaxActiveBlocksPerMultiprocessor(&per_cu, (const void*)mk_fwd, 512, LDS_BYTES) != hipSuccess || per_cu < 1) { fprintf(stderr, "kernel_launch: occupancy query says %d\n", per_cu); per_cu = 1; }
        (void)hipGetLastError();
        grid = cus;
    }
    if (grid < 0) return;
    (void)hipMemsetAsync((char*)d_ws + WS_CTL, 0, CTL_ZERO_BYTES, stream);
    Args a{};
    for (int i = 0; i < 21; ++i) a.in[i] = (const float*)d_in[i];
    a.out = (float*)d_out; a.ws = (unsigned char*)d_ws;
#if MK_CUTS
    for (int p = 0; p < NPH; ++p) { a.ph_lo = p; a.ph_hi = p + 1; hipLaunchKernelGGL(mk_fwd, dim3(grid), dim3(512), LDS_BYTES, stream, a); }
#else
    a.ph_lo = 0; a.ph_hi = NPH; hipLaunchKernelGGL(mk_fwd, dim3(grid), dim3(512), LDS_BYTES, stream, a);
#endif
}
```

```cpp
#include <hip/hip_runtime.h>
#include <hip/hip_bf16.h>
#include <cstdio>
#include <cstdint>
#define MK_CUTS 0
namespace pg8 {
#define PG8_LAS __attribute__((address_space(3)))
typedef unsigned short bf16_t;
typedef short bf16x8 __attribute__((ext_vector_type(8)));
typedef float f32x4 __attribute__((ext_vector_type(4)));
typedef unsigned u32x4 __attribute__((ext_vector_type(4)));
constexpr int BM = 256, BK = 64, HALF = 128, HTB = HALF * BK * 2  , STAGE_BYTES = 8 * HTB, NXCD = 8, WGM = 8;

__host__ __device__ __forceinline__ int lds_byte(int r, int c) { const int st = (r >> 4) * 2 + (c >> 5), rr = r & 15, cc = c & 31, ob = rr * 64 + cc * 2; return st * 1024 + (ob ^ (((ob >> 9) & 1) << 5)); }
__host__ __device__ __forceinline__ void stage_rc(int b, int& R, int& C) { const int st = b / 1024, sb = b % 1024, swz = sb ^ (((sb >> 9) & 1) << 5); R = (st >> 1) * 16 + swz / 64; C = (st & 1) * 32 + (swz % 64) / 2; }
__host__ __device__ __forceinline__ int perm32(int rho) { const int n = rho >> 4, i = rho & 15; return 8 * (i >> 2) + 4 * n + (i & 3); }

struct Unit { int pm, pn; };
struct Gemm { const bf16_t* A; const bf16_t* Bt; int M, N, K; };

struct StaticOrder {
    int nM, nN, nwg, G, c;
    __host__ __device__ void init(int M, int N, int G_, int c_) { nM = M / BM; nN = N / BM; nwg = nM * nN; G = G_; c = c_; }
    __host__ __device__ bool next(int i, Unit& u) const {
        const long L = (long)i * G + c; if (L >= nwg) return false;
        int wgid = (int)L; { const int q = nwg / NXCD, r = nwg % NXCD, xcd = wgid % NXCD, off = wgid / NXCD; wgid = (xcd < r ? xcd * (q + 1) : r * (q + 1) + (xcd - r) * q) + off; }
        const int nig = WGM * nN, gid = wgid / nig, fm = gid * WGM, gsz = (nM - fm) < WGM ? (nM - fm) : WGM;
        u.pm = fm + ((wgid % nig) % gsz); u.pn = (wgid % nig) / gsz; return true;
    }
    __device__ __forceinline__ void a_ready(const Unit&) const {}
    __device__ __forceinline__ size_t b_off(const Unit&) const { return 0; }
    __device__ __forceinline__ void done(const Unit&) const {}
};


typedef unsigned u32x2 __attribute__((ext_vector_type(2)));
__device__ __forceinline__ unsigned cvt_pk_bf16(float lo, float hi) { unsigned r; asm volatile("v_cvt_pk_bf16_f32 %0, %1, %2" : "=v"(r) : "v"(lo), "v"(hi)); return r; }
__device__ __forceinline__ unsigned pk4_fp8_(float a, float b, float c, float d) { int w = __builtin_amdgcn_cvt_pk_fp8_f32(a, b, 0, false); w = __builtin_amdgcn_cvt_pk_fp8_f32(c, d, w, true); return (unsigned)w; }
__device__ __forceinline__ float bf_lo(unsigned w) { return __builtin_bit_cast(float, w << 16); }
__device__ __forceinline__ float bf_hi(unsigned w) { return __builtin_bit_cast(float, w & 0xffff0000u); }
__device__ __forceinline__ float sigmoidf_(float v) { return __builtin_amdgcn_rcpf(1.0f + __expf(-v)); }

struct EpiStoreBf16 {
    static constexpr bool PERM = true, AFTER_DRAIN = false;
    bf16_t* O; int ldc; float sc;
    __device__ __forceinline__ void operator()(const f32x4 (&acc)[2][2][4][2], const Unit& u, int wr, int wc, int fr, int fq) const {
        const int row0 = u.pm * BM + wr * 64 + fr, col0 = u.pn * BM + wc * 32 + 8 * fq;
#pragma unroll
        for (int ai = 0; ai < 2; ++ai)
#pragma unroll
            for (int m = 0; m < 4; ++m) { bf16_t* rowp = O + (size_t)(row0 + ai * HALF + m * 16) * ldc + col0;
#pragma unroll
                for (int bj = 0; bj < 2; ++bj) { const f32x4 v0 = acc[ai][bj][m][0] * sc, v1 = acc[ai][bj][m][1] * sc;
                    u32x4 w; w.x = cvt_pk_bf16(v0[0], v0[1]); w.y = cvt_pk_bf16(v0[2], v0[3]); w.z = cvt_pk_bf16(v1[0], v1[1]); w.w = cvt_pk_bf16(v1[2], v1[3]);
                    *(u32x4*)(rowp + bj * HALF) = w; } }
    }
};

struct EpiGateA {
    static constexpr bool PERM = true, AFTER_DRAIN = false;
    const bf16_t* proj; int ldp; int gcol0; const float* bg; float* T1; int ldc; float sc;
    __device__ __forceinline__ void operator()(const f32x4 (&acc)[2][2][4][2], const Unit& u, int wr, int wc, int fr, int fq) const {
        const int row0 = u.pm * BM + wr * 64 + fr, col0 = u.pn * BM + wc * 32 + 8 * fq;
#pragma unroll
        for (int ai = 0; ai < 2; ++ai)
#pragma unroll
            for (int m = 0; m < 4; ++m) { const int row = row0 + ai * HALF + m * 16;
#pragma unroll
                for (int bj = 0; bj < 2; ++bj) { const int c = col0 + bj * HALF;
                    const u32x4 gw = *(const u32x4*)(proj + (size_t)row * ldp + gcol0 + c);
                    const f32x4 b0 = *(const f32x4*)(bg + c), b1 = *(const f32x4*)(bg + c + 4);
                    f32x4 g0, g1;
                    g0[0] = sigmoidf_(bf_lo(gw.x) + b0[0]); g0[1] = sigmoidf_(bf_hi(gw.x) + b0[1]); g0[2] = sigmoidf_(bf_lo(gw.y) + b0[2]); g0[3] = sigmoidf_(bf_hi(gw.y) + b0[3]);
                    g1[0] = sigmoidf_(bf_lo(gw.z) + b1[0]); g1[1] = sigmoidf_(bf_hi(gw.z) + b1[1]); g1[2] = sigmoidf_(bf_lo(gw.w) + b1[2]); g1[3] = sigmoidf_(bf_hi(gw.w) + b1[3]);
                    float* o = T1 + (size_t)row * ldc + c;
                    *(f32x4*)o = acc[ai][bj][m][0] * sc * g0; *(f32x4*)(o + 4) = acc[ai][bj][m][1] * sc * g1; } }
    }
};
struct EpiGateB {
    static constexpr bool PERM = true, AFTER_DRAIN = false;
    const bf16_t* proj; int ldp; int gcol0; const float* bg; const float* T1; unsigned char* Y; int ldc; float sc;
    __device__ __forceinline__ void operator()(const f32x4 (&acc)[2][2][4][2], const Unit& u, int wr, int wc, int fr, int fq) const {
        const int row0 = u.pm * BM + wr * 64 + fr, col0 = u.pn * BM + wc * 32 + 8 * fq;
#pragma unroll
        for (int ai = 0; ai < 2; ++ai)
#pragma unroll
            for (int m = 0; m < 4; ++m) { const int row = row0 + ai * HALF + m * 16;
#pragma unroll
                for (int bj = 0; bj < 2; ++bj) { const int c = col0 + bj * HALF;
                    const u32x4 gw = *(const u32x4*)(proj + (size_t)row * ldp + gcol0 + c);
                    const f32x4 b0 = *(const f32x4*)(bg + c), b1 = *(const f32x4*)(bg + c + 4);
                    const float* tp = T1 + (size_t)row * ldc + c;
                    const f32x4 t0 = *(const f32x4*)tp, t1 = *(const f32x4*)(tp + 4);
                    f32x4 g0, g1;
                    g0[0] = sigmoidf_(bf_lo(gw.x) + b0[0]); g0[1] = sigmoidf_(bf_hi(gw.x) + b0[1]); g0[2] = sigmoidf_(bf_lo(gw.y) + b0[2]); g0[3] = sigmoidf_(bf_hi(gw.y) + b0[3]);
                    g1[0] = sigmoidf_(bf_lo(gw.z) + b1[0]); g1[1] = sigmoidf_(bf_hi(gw.z) + b1[1]); g1[2] = sigmoidf_(bf_lo(gw.w) + b1[2]); g1[3] = sigmoidf_(bf_hi(gw.w) + b1[3]);
                    const f32x4 v0 = (t0 + acc[ai][bj][m][0] * sc * g0) * 64.0f, v1 = (t1 + acc[ai][bj][m][1] * sc * g1) * 64.0f;
                    u32x2 w; w.x = pk4_fp8_(v0[0], v0[1], v0[2], v0[3]); w.y = pk4_fp8_(v1[0], v1[1], v1[2], v1[3]);
                    *(u32x2*)(Y + (size_t)row * ldc + c) = w; } }
    }
};
struct EpiResF32 {
    static constexpr bool PERM = false, AFTER_DRAIN = false;
    const float* X; float* Z; int ldc; float alpha; float sc;
    __device__ __forceinline__ void operator()(const f32x4 (&acc)[2][2][4][2], const Unit& u, int wr, int wc, int fr, int fq) const {
        const int row0 = u.pm * BM + wr * 64 + fr, col0 = u.pn * BM + wc * 32 + 4 * fq;
#pragma unroll
        for (int ai = 0; ai < 2; ++ai)
#pragma unroll
            for (int m = 0; m < 4; ++m) { const size_t ro = (size_t)(row0 + ai * HALF + m * 16) * ldc + col0;
#pragma unroll
                for (int bj = 0; bj < 2; ++bj)
#pragma unroll
                    for (int n = 0; n < 2; ++n) { const f32x4 xv = *(const f32x4*)(X + ro + bj * HALF + n * 16);
                        *(f32x4*)(Z + ro + bj * HALF + n * 16) = xv * alpha + acc[ai][bj][m][n] * sc; } }
    }
};
struct EpiSwiglu {
    static constexpr bool PERM = true, AFTER_DRAIN = false;
    const PG8_LAS int* tile_e; const float* bgate; const float* blin; unsigned char* H; int ldc; float sc;
    __device__ __forceinline__ void operator()(const f32x4 (&acc)[2][2][4][2], const Unit& u, int wr, int wc, int fr, int fq) const {
        const int e = tile_e[u.pm];
        const int row0 = u.pm * BM + wr * 64 + fr, j0 = u.pn * HALF + wc * 32 + 8 * fq;
        const f32x4 bg0 = *(const f32x4*)(bgate + (size_t)e * 2048 + j0), bg1 = *(const f32x4*)(bgate + (size_t)e * 2048 + j0 + 4);
        const f32x4 bl0 = *(const f32x4*)(blin + (size_t)e * 2048 + j0), bl1 = *(const f32x4*)(blin + (size_t)e * 2048 + j0 + 4);
#pragma unroll
        for (int ai = 0; ai < 2; ++ai)
#pragma unroll
            for (int m = 0; m < 4; ++m) { const int row = row0 + ai * HALF + m * 16;
                f32x4 h0, h1;
#pragma unroll
                for (int i = 0; i < 4; ++i) {
                    float g = fminf(acc[ai][0][m][0][i] * sc + bg0[i], 7.0f); float l = fminf(fmaxf(acc[ai][1][m][0][i] * sc + bl0[i], -7.0f), 7.0f);
                    h0[i] = (l + 1.0f) * (g * sigmoidf_(1.702f * g));
                    g = fminf(acc[ai][0][m][1][i] * sc + bg1[i], 7.0f); l = fminf(fmaxf(acc[ai][1][m][1][i] * sc + bl1[i], -7.0f), 7.0f);
                    h1[i] = (l + 1.0f) * (g * sigmoidf_(1.702f * g)); }
                u32x2 w; w.x = pk4_fp8_(h0[0], h0[1], h0[2], h0[3]); w.y = pk4_fp8_(h1[0], h1[1], h1[2], h1[3]);
                *(u32x2*)(H + (size_t)row * ldc + j0) = w; }
    }
};
struct EpiDown {
    static constexpr bool PERM = true, AFTER_DRAIN = false;
    const PG8_LAS int* tile_e; const float* bdown; const float* slot_w; bf16_t* YS; int ldc; float sc;
    __device__ __forceinline__ void operator()(const f32x4 (&acc)[2][2][4][2], const Unit& u, int wr, int wc, int fr, int fq) const {
        const int e = tile_e[u.pm];
        const int row0 = u.pm * BM + wr * 64 + fr, col0 = u.pn * BM + wc * 32 + 8 * fq;
        f32x4 bv[2][2];
#pragma unroll
        for (int bj = 0; bj < 2; ++bj)
#pragma unroll
            for (int n = 0; n < 2; ++n) bv[bj][n] = *(const f32x4*)(bdown + (size_t)e * 2048 + col0 + bj * HALF + 4 * n);
#pragma unroll
        for (int ai = 0; ai < 2; ++ai)
#pragma unroll
            for (int m = 0; m < 4; ++m) { const int row = row0 + ai * HALF + m * 16; const float sw = slot_w[row];
#pragma unroll
                for (int bj = 0; bj < 2; ++bj) { const f32x4 v0 = (acc[ai][bj][m][0] * sc + bv[bj][0]) * sw, v1 = (acc[ai][bj][m][1] * sc + bv[bj][1]) * sw;
                    u32x4 w; w.x = cvt_pk_bf16(v0[0], v0[1]); w.y = cvt_pk_bf16(v0[2], v0[3]); w.z = cvt_pk_bf16(v1[0], v1[1]); w.w = cvt_pk_bf16(v1[2], v1[3]);
                    *(u32x4*)(YS + (size_t)row * ldc + col0 + bj * HALF) = w; } }
    }
};
struct MoeOrder : StaticOrder {
    const PG8_LAS int* tile_e; size_t estride;
    __device__ __forceinline__ size_t b_off(const Unit& u) const { return (size_t)__builtin_amdgcn_readfirstlane(tile_e[u.pm]) * estride; }
};
typedef int i32x4_ __attribute__((ext_vector_type(4)));
typedef int i32x8_ __attribute__((ext_vector_type(8)));
#define PG8_CAT(lo, hi) __builtin_shufflevector(__builtin_bit_cast(i32x4_, lo), __builtin_bit_cast(i32x4_, hi), 0, 1, 2, 3, 4, 5, 6, 7)
template <class Epi, class Sched, bool ALIGN_EPI = false, bool SP2 = false, bool FP8 = false, bool BTILED = false>
__device__ __forceinline__ void gemm_phase(PG8_LAS unsigned char* lds, const Gemm g, const Sched& S, const Epi& E) {
    const int tid = threadIdx.x, wid = __builtin_amdgcn_readfirstlane(tid >> 6), lane = tid & 63, wr = wid >> 2, wc = wid & 3, fr = lane & 15, fq = lane >> 4;
    const int K = g.K, nt = K / BK;
    unsigned voffA[2], voffB[2];
#pragma unroll
    for (int i = 0; i < 2; ++i) { int R, C; stage_rc(tid * 16 + i * 8192, R, C); const int Rb = Epi::PERM ? ((R & ~31) + perm32(R & 31)) : R;
        voffA[i] = (unsigned)(R * K + C) * 2u; voffB[i] = BTILED ? (unsigned)(Rb * 64 + C) * 2u : (unsigned)(Rb * K + C) * 2u; }
    const size_t kstep = (size_t)(BK * 2);
    const size_t hstep = (size_t)HALF * K * 2;
    const size_t tstep = 2 * hstep;
    const size_t kstepB = BTILED ? (size_t)32768 : kstep, hstepB = BTILED ? (size_t)16384 : hstep;
    const unsigned ldsw = (unsigned)wid * 1024u;
    const int aoff = lds_byte(wr * 64 + fr, fq * 8), boff = lds_byte(wc * 32 + fr, fq * 8);
#define PG8_SA(b, h) (((b) * 2 + (h)) * HTB)
#define PG8_SB(b, h) ((4 + (b) * 2 + (h)) * HTB)
#define PG8_STAGE(bufoff, gbase, voff) do { _Pragma("unroll") for (int _i = 0; _i < 2; ++_i) \
        __builtin_amdgcn_global_load_lds((const unsigned*)((const char*)(gbase) + (voff)[_i]), (PG8_LAS unsigned*)(lds + (bufoff) + ldsw + _i * 8192), 16, 0, 0); } while (0)
#define PG8_LDA(dst, b, h) do { _Pragma("unroll") for (int m = 0; m < 4; ++m) _Pragma("unroll") for (int k = 0; k < 2; ++k) dst[m][k] = *(const PG8_LAS bf16x8*)(lds + PG8_SA(b, h) + aoff + m * 2048 + k * 1024); } while (0)
#define PG8_LDB(dst, b, h) do { _Pragma("unroll") for (int n = 0; n < 2; ++n) _Pragma("unroll") for (int k = 0; k < 2; ++k) dst[n][k] = *(const PG8_LAS bf16x8*)(lds + PG8_SB(b, h) + boff + n * 2048 + k * 1024); } while (0)
#define PG8_MFMA8(C, Bv, Av) asm volatile("v_mfma_f32_16x16x128_f8f6f4 %0, %1, %2, %0" : "+v"(C) : "v"(Bv), "v"(Av))
#define PG8_MMA(ai, bj, At, Bt) do { __builtin_amdgcn_s_setprio(1); if constexpr (FP8) { const i32x8_ b0_ = PG8_CAT(Bt[0][0], Bt[0][1]), b1_ = PG8_CAT(Bt[1][0], Bt[1][1]); _Pragma("unroll") for (int m = 0; m < 4; ++m) { \
        const i32x8_ a_ = PG8_CAT(At[m][0], At[m][1]); PG8_MFMA8(acc[ai][bj][m][0], b0_, a_); PG8_MFMA8(acc[ai][bj][m][1], b1_, a_); } } else { \
        _Pragma("unroll") for (int m = 0; m < 4; ++m) _Pragma("unroll") for (int n = 0; n < 2; ++n) _Pragma("unroll") for (int k = 0; k < 2; ++k) \
        acc[ai][bj][m][n] = __builtin_amdgcn_mfma_f32_16x16x32_bf16(Bt[n][k], At[m][k], acc[ai][bj][m][n], 0, 0, 0); } __builtin_amdgcn_s_setprio(0); } while (0)
#define PG8_WAIT_V(n) asm volatile("s_waitcnt vmcnt(" #n ")" ::: "memory")
#define PG8_WAIT_L(n) asm volatile("s_waitcnt lgkmcnt(" #n ")" ::: "memory")
#define PG8_BAR __builtin_amdgcn_s_barrier()
#define PG8_SCHED __builtin_amdgcn_sched_barrier(0)
    Unit cur, nxt; int ui = 0;
    if (!S.next(0, cur)) return;
    f32x4 acc[2][2][4][2];
#pragma unroll
    for (int a = 0; a < 2; ++a)
#pragma unroll
        for (int b = 0; b < 2; ++b)
#pragma unroll
            for (int m = 0; m < 4; ++m)
#pragma unroll
                for (int n = 0; n < 2; ++n) acc[a][b][m][n] = (f32x4){0.f, 0.f, 0.f, 0.f};
    bf16x8 At[4][2], B0[2][2], B1[2][2];
    const char* cA = (const char*)g.A + (size_t)cur.pm * tstep; const char* cB = (const char*)g.Bt + S.b_off(cur) + (size_t)cur.pn * tstep;
    S.a_ready(cur);
    if constexpr (SP2) {
        PG8_STAGE(PG8_SB(0, 0), cB, voffB); PG8_STAGE(PG8_SB(0, 1), cB + hstepB, voffB); PG8_STAGE(PG8_SA(0, 0), cA, voffA); PG8_STAGE(PG8_SA(0, 1), cA + hstep, voffA);
        if (wr == 1) PG8_BAR;
        PG8_WAIT_V(2); PG8_BAR;
        PG8_STAGE(PG8_SB(1, 0), cB + kstepB, voffB); PG8_STAGE(PG8_SA(1, 0), cA + kstep, voffA); PG8_STAGE(PG8_SB(1, 1), cB + hstepB + kstepB, voffB);
        PG8_WAIT_V(6); PG8_BAR;
    } else {
        PG8_STAGE(PG8_SB(0, 0), cB, voffB); PG8_STAGE(PG8_SA(0, 0), cA, voffA); PG8_STAGE(PG8_SB(0, 1), cB + hstepB, voffB); PG8_STAGE(PG8_SA(0, 1), cA + hstep, voffA);
        if (wr == 1) PG8_BAR;
        PG8_WAIT_V(4); PG8_BAR;
        PG8_STAGE(PG8_SB(1, 0), cB + kstepB, voffB); PG8_STAGE(PG8_SA(1, 0), cA + kstep, voffA); PG8_STAGE(PG8_SB(1, 1), cB + hstepB + kstepB, voffB);
        PG8_WAIT_V(6); PG8_BAR;
    }
    for (;;) {
        const bool has_next = S.next(ui + 1, nxt);
        const char* nA = has_next ? (const char*)g.A + (size_t)nxt.pm * tstep : cA; const char* nB = has_next ? (const char*)g.Bt + S.b_off(nxt) + (size_t)nxt.pn * tstep : cB;
        for (int t = 0; t < nt; t += 2) {
            const bool last = (t == nt - 2);
            const char* a1 = cA + (size_t)(t + 1) * kstep;
            const char* a2 = last ? nA : cA + (size_t)(t + 2) * kstep; const char* b2 = last ? nB : cB + (size_t)(t + 2) * kstepB;
            const char* a3 = a2 + kstep; const char* b3 = b2 + kstepB;
            if (last && has_next) S.a_ready(nxt);
            if constexpr (SP2) {
            PG8_LDB(B0, 0, 0); PG8_LDB(B1, 0, 1); PG8_SCHED; PG8_LDA(At, 0, 0); PG8_STAGE(PG8_SA(1, 1), a1 + hstep, voffA);
            PG8_WAIT_V(8); PG8_WAIT_L(0); PG8_BAR; PG8_MMA(0, 0, At, B0); PG8_MMA(0, 1, At, B1); PG8_BAR; PG8_SCHED;
            PG8_LDA(At, 0, 1); PG8_STAGE(PG8_SB(0, 0), b2, voffB); PG8_STAGE(PG8_SB(0, 1), b2 + hstepB, voffB); PG8_STAGE(PG8_SA(0, 0), a2, voffA);
            PG8_WAIT_V(8); PG8_WAIT_L(0); PG8_BAR; PG8_MMA(1, 0, At, B0); PG8_MMA(1, 1, At, B1); PG8_BAR; PG8_SCHED;
            PG8_LDB(B0, 1, 0); PG8_LDB(B1, 1, 1); PG8_SCHED; PG8_LDA(At, 1, 0); PG8_STAGE(PG8_SA(0, 1), a2 + hstep, voffA);
            PG8_WAIT_V(8); PG8_WAIT_L(0); PG8_BAR; PG8_MMA(0, 0, At, B0); PG8_MMA(0, 1, At, B1); PG8_BAR; PG8_SCHED;
            PG8_LDA(At, 1, 1); PG8_STAGE(PG8_SB(1, 0), b3, voffB); PG8_STAGE(PG8_SB(1, 1), b3 + hstepB, voffB); PG8_STAGE(PG8_SA(1, 0), a3, voffA);
            PG8_WAIT_V(8); PG8_WAIT_L(0); PG8_BAR; PG8_MMA(1, 0, At, B0); PG8_MMA(1, 1, At, B1); PG8_BAR; PG8_SCHED;
            } else {
            PG8_LDB(B0, 0, 0); PG8_SCHED; PG8_LDA(At, 0, 0); PG8_STAGE(PG8_SA(1, 1), a1 + hstep, voffA);
            PG8_WAIT_L(8); PG8_BAR; PG8_WAIT_L(0); PG8_MMA(0, 0, At, B0); PG8_BAR; PG8_SCHED;
            PG8_LDB(B1, 0, 1); PG8_STAGE(PG8_SB(0, 0), b2, voffB);
            PG8_BAR; PG8_WAIT_L(0); PG8_MMA(0, 1, At, B1); PG8_BAR;
            PG8_LDA(At, 0, 1); PG8_STAGE(PG8_SA(0, 0), a2, voffA);
            PG8_BAR; PG8_WAIT_L(0); PG8_MMA(1, 0, At, B0); PG8_BAR; PG8_SCHED;
            PG8_STAGE(PG8_SB(0, 1), b2 + hstepB, voffB);
            PG8_WAIT_V(6); PG8_BAR; PG8_MMA(1, 1, At, B1); PG8_BAR;
            PG8_LDB(B0, 1, 0); PG8_SCHED; PG8_LDA(At, 1, 0); PG8_STAGE(PG8_SA(0, 1), a2 + hstep, voffA);
            PG8_WAIT_L(8); PG8_BAR; PG8_WAIT_L(0); PG8_MMA(0, 0, At, B0); PG8_BAR; PG8_SCHED;
            PG8_LDB(B1, 1, 1); PG8_STAGE(PG8_SB(1, 0), b3, voffB);
            PG8_BAR; PG8_WAIT_L(0); PG8_MMA(0, 1, At, B1); PG8_BAR;
            PG8_LDA(At, 1, 1); PG8_STAGE(PG8_SA(1, 0), a3, voffA);
            PG8_BAR; PG8_WAIT_L(0); PG8_MMA(1, 0, At, B0); PG8_BAR; PG8_SCHED;
            PG8_STAGE(PG8_SB(1, 1), b3 + hstepB, voffB);
            PG8_WAIT_V(6); PG8_BAR; PG8_MMA(1, 1, At, B1); PG8_BAR;
            }
        }
        if constexpr (ALIGN_EPI) { if (wr == 0) PG8_BAR; }
        if constexpr (FP8) { asm volatile("s_nop 15\n\ts_nop 7" ::: "memory"); PG8_SCHED; }
        if constexpr (!Epi::AFTER_DRAIN) { E(acc, cur, wr, wc, fr, fq); S.done(cur); }
        if (!has_next) break;
#pragma unroll
        for (int a = 0; a < 2; ++a)
#pragma unroll
            for (int b = 0; b < 2; ++b)
#pragma unroll
                for (int m = 0; m < 4; ++m)
#pragma unroll
                    for (int n = 0; n < 2; ++n) acc[a][b][m][n] = (f32x4){0.f, 0.f, 0.f, 0.f};
        cur = nxt; cA = nA; cB = nB; ++ui;
        if constexpr (ALIGN_EPI) { if (wr == 1) PG8_BAR; }
    }
    PG8_WAIT_V(0);
    if constexpr (!ALIGN_EPI) { if (wr == 0) PG8_BAR; }
    PG8_BAR;
    if constexpr (Epi::AFTER_DRAIN) { E.fused(acc, cur, wr, wc, fr, fq, lds, wid, lane); S.done(cur); }
#undef PG8_SA
#undef PG8_SB
#undef PG8_STAGE
#undef PG8_LDA
#undef PG8_LDB
#undef PG8_MMA
#undef PG8_WAIT_V
#undef PG8_WAIT_L
#undef PG8_BAR
#undef PG8_SCHED
}
}
namespace at {
using bf16 = __hip_bfloat16;
constexpr int   D = 128, NW = 8, QBLK = 32, KVBLK = 64;
constexpr float SCALE = 0.088388347648318440f;
constexpr float THR = 8.f;
constexpr int SDEPTH = 2;
constexpr size_t SHM_V = KVBLK * D * 2, SHM_K = KVBLK * D * 2, SHM_ATTN = 2 * SHM_V + 2 * SHM_K + NW * 64 * 4;
using bf16x8 = __attribute__((ext_vector_type(8))) short;
using s16x4  = __attribute__((ext_vector_type(4))) short;
using f32x16 = __attribute__((ext_vector_type(16))) float;
using f32x8  = __attribute__((ext_vector_type(8))) float;
using u32x4  = __attribute__((ext_vector_type(4))) unsigned;
#define KSWZ(row, colB) ((row) * 256 + ((colB) ^ (((row) & 7) << 4)))
#define SBAR() __builtin_amdgcn_sched_barrier(0)
__device__ __forceinline__ int crow(int r, int hi) { return (r & 3) + 8 * (r >> 2) + 4 * hi; }
__device__ __forceinline__ unsigned cvtpk(float lo, float hi) {
  unsigned r; asm volatile("v_cvt_pk_bf16_f32 %0, %1, %2" : "=v"(r) : "v"(lo), "v"(hi)); return r;
}
template <typename TIn> struct Stage;
template <> struct Stage<bf16>  { using T = bf16x8;
  __device__ static __forceinline__ T ld8(const bf16* p) { return *reinterpret_cast<const bf16x8*>(p); }
  __device__ static __forceinline__ bf16x8 tobf(T x) { return x; } };
template <> struct Stage<float> { using T = f32x8;
  __device__ static __forceinline__ T ld8(const float* p) { return *reinterpret_cast<const f32x8*>(p); }
  __device__ static __forceinline__ bf16x8 tobf(T x) {
    u32x4 w = {cvtpk(x[0], x[1]), cvtpk(x[2], x[3]), cvtpk(x[4], x[5]), cvtpk(x[6], x[7])}; return *reinterpret_cast<bf16x8*>(&w); } };

__device__ __forceinline__ void partialSM(f32x16& p0, f32x16& p1, float& m_reg, float& mn, float& alpha) {
  constexpr float C = SCALE * 1.4426950408889634f;
  float pmax = p0[0]; for (int r = 1; r < 16; ++r) pmax = fmaxf(pmax, p0[r]); for (int r = 0; r < 16; ++r) pmax = fmaxf(pmax, p1[r]);
  { auto rr = __builtin_amdgcn_permlane32_swap(__float_as_uint(pmax), __float_as_uint(pmax), false, false);
    pmax = fmaxf(__uint_as_float(rr[0]), __uint_as_float(rr[1])); }
  if (__builtin_expect(__all(pmax - m_reg <= THR / SCALE), 1)) { mn = m_reg; alpha = 1.f; }
  else { mn = fmaxf(m_reg, pmax); alpha = __builtin_amdgcn_exp2f((m_reg - mn) * C); m_reg = mn; }
  float mnC = -mn * C;
  for (int r = 0; r < 16; ++r) p0[r] = fmaf(p0[r], C, mnC); for (int r = 0; r < 16; ++r) p1[r] = fmaf(p1[r], C, mnC);
  for (int r = 0; r < 16; ++r) p0[r] = __builtin_amdgcn_exp2f(p0[r]);
}
__device__ __forceinline__ void finishSM(f32x16& p0, f32x16& p1, float alpha, float& l_reg, bf16x8& pa0, bf16x8& pa1, bf16x8& pa2, bf16x8& pa3) {
  for (int r = 0; r < 16; ++r) p1[r] = __builtin_amdgcn_exp2f(p1[r]);
  float ps = 0; for (int r = 0; r < 16; ++r) ps += p0[r]; for (int r = 0; r < 16; ++r) ps += p1[r];
  { auto rr = __builtin_amdgcn_permlane32_swap(__float_as_uint(ps), __float_as_uint(ps), false, false);
    ps = __uint_as_float(rr[0]) + __uint_as_float(rr[1]); }
  l_reg = l_reg * alpha + ps;
#define PK4(P, BASE, OUT) do { unsigned a0 = cvtpk(P[BASE + 0], P[BASE + 1]), a1 = cvtpk(P[BASE + 2], P[BASE + 3]);   \
    unsigned b0 = cvtpk(P[BASE + 4], P[BASE + 5]), b1 = cvtpk(P[BASE + 6], P[BASE + 7]);                              \
    auto r0 = __builtin_amdgcn_permlane32_swap(a0, b0, false, false); auto r1 = __builtin_amdgcn_permlane32_swap(a1, b1, false, false); \
    u32x4 w = {r0[0], r1[0], r0[1], r1[1]}; OUT = *reinterpret_cast<bf16x8*>(&w); } while (0)
  PK4(p0, 0, pa0); PK4(p0, 8, pa1); PK4(p1, 0, pa2); PK4(p1, 8, pa3);
#undef PK4
}
__device__ __forceinline__ void qkt(f32x16& p0, f32x16& p1, const bf16* Ks, const bf16x8* qr, int r32, int hi) {
  p0 = f32x16{}; p1 = f32x16{};
  for (int d0 = 0; d0 < 8; ++d0) { int cb = (d0 * 16 + hi * 8) * 2;
    bf16x8 b0 = *reinterpret_cast<const bf16x8*>((const char*)Ks + KSWZ(r32, cb));
    bf16x8 b1 = *reinterpret_cast<const bf16x8*>((const char*)Ks + KSWZ(32 + r32, cb));
    p0 = __builtin_amdgcn_mfma_f32_32x32x16_bf16(b0, qr[d0], p0, 0, 0, 0);
    p1 = __builtin_amdgcn_mfma_f32_32x32x16_bf16(b1, qr[d0], p1, 0, 0, 0); }
}
__device__ __forceinline__ int v_st(int k, int c) { const int kk = (k & ~0xC) | ((k & 4) << 1) | ((k & 8) >> 1); return ((kk >> 3) * 4 + (c >> 5)) * 512 + ((kk & 7) * 32 + (c & 31)) * 2; }
__device__ __forceinline__ int v_rd_base(int lane) { return ((lane & 3) << 3) | (((lane >> 2) & 3) << 6) | (((lane >> 4) & 1) << 5) | (((lane >> 5) & 1) << 8); }
constexpr int v_rd_off(int d0, int ks, int half) { return d0 * 512 + ks * 4096 + half * 2048; }
template <int OFF> __device__ __forceinline__ s16x4 tr_read(int vb) {
  s16x4 r; asm volatile("ds_read_b64_tr_b16 %0, %1 offset:%2" : "=&v"(r) : "v"(vb), "i"(OFF) : "memory"); return r;
}
template <int D0> __device__ __forceinline__ void pv_one(f32x16& od, int vb, bf16x8 pa0, bf16x8 pa1, bf16x8 pa2, bf16x8 pa3) {
  const s16x4 l0 = tr_read<v_rd_off(D0, 0, 0)>(vb), h0 = tr_read<v_rd_off(D0, 0, 1)>(vb), l1 = tr_read<v_rd_off(D0, 1, 0)>(vb), h1 = tr_read<v_rd_off(D0, 1, 1)>(vb);
  const s16x4 l2 = tr_read<v_rd_off(D0, 2, 0)>(vb), h2 = tr_read<v_rd_off(D0, 2, 1)>(vb), l3 = tr_read<v_rd_off(D0, 3, 0)>(vb), h3 = tr_read<v_rd_off(D0, 3, 1)>(vb);
  asm volatile("s_waitcnt lgkmcnt(0)" ::: "memory"); SBAR();
#define PK(L, H) (bf16x8){L[0], L[1], L[2], L[3], H[0], H[1], H[2], H[3]}
  od = __builtin_amdgcn_mfma_f32_32x32x16_bf16(pa0, PK(l0, h0), od, 0, 0, 0);
  od = __builtin_amdgcn_mfma_f32_32x32x16_bf16(pa1, PK(l1, h1), od, 0, 0, 0);
  od = __builtin_amdgcn_mfma_f32_32x32x16_bf16(pa2, PK(l2, h2), od, 0, 0, 0);
  od = __builtin_amdgcn_mfma_f32_32x32x16_bf16(pa3, PK(l3, h3), od, 0, 0, 0);
#undef PK
}
__device__ __forceinline__ void pv_d0(f32x16* o, int vb, bf16x8 pa0, bf16x8 pa1, bf16x8 pa2, bf16x8 pa3) {
  pv_one<0>(o[0], vb, pa0, pa1, pa2, pa3); pv_one<1>(o[1], vb, pa0, pa1, pa2, pa3); pv_one<2>(o[2], vb, pa0, pa1, pa2, pa3); pv_one<3>(o[3], vb, pa0, pa1, pa2, pa3);
}

template <int LDQ, int LDK, int LDV, int LDO>
__device__ __forceinline__ void attn_dense_body(const bf16* __restrict__ Qb, const bf16* __restrict__ Kh, const bf16* __restrict__ Vh,
                                                unsigned char* __restrict__ Ob, int seq, char* lds) {
  using St = Stage<bf16>; using SQ = Stage<bf16>;
  const int tid = threadIdx.x, wid = tid >> 6, lane = tid & 63, r32 = lane & 31, hi = lane >> 5;
  bf16* V_lds = (bf16*)lds; bf16* K_lds = (bf16*)(lds + 2 * SHM_V);
  float* ws = (float*)(lds + 2 * SHM_V + 2 * SHM_K) + wid * 64; float* li_l = ws; float* al_l = ws + 32;
  float m_reg = -1e30f, l_reg = 0; f32x16 o[4] = {}; bf16x8 qr[8];
  const bf16* Qw = Qb + (long)(wid * QBLK + r32) * LDQ + hi * 8;
#pragma unroll
  for (int d0 = 0; d0 < 8; ++d0) qr[d0] = SQ::tobf(SQ::ld8(Qw + d0 * 16));
  const int sr = tid >> 4, sc = (tid & 15) * 8, vst0 = v_st(sr, sc), vst1 = v_st(32 + sr, sc);
  const int vb0 = (int)(uintptr_t)V_lds + v_rd_base(lane);
  struct { typename St::T vs0, vs1, ks0, ks1; } sr_[SDEPTH];
#define SLOAD(i, k0) do { sr_[i].vs0 = St::ld8(&Vh[(long)((k0) + sr) * LDV + sc]); sr_[i].vs1 = St::ld8(&Vh[(long)((k0) + 32 + sr) * LDV + sc]); \
    sr_[i].ks0 = St::ld8(&Kh[(long)((k0) + sr) * LDK + sc]); sr_[i].ks1 = St::ld8(&Kh[(long)((k0) + 32 + sr) * LDK + sc]); } while (0)
#define SWRITE(b, i) do { *(bf16x8*)((char*)V_lds + (b) * SHM_V + vst0) = St::tobf(sr_[i].vs0);          \
    *(bf16x8*)((char*)V_lds + (b) * SHM_V + vst1) = St::tobf(sr_[i].vs1); int kc = sc * 2;               \
    *(bf16x8*)((char*)K_lds + (b) * SHM_K + KSWZ(sr, kc)) = St::tobf(sr_[i].ks0);                       \
    *(bf16x8*)((char*)K_lds + (b) * SHM_K + KSWZ(32 + sr, kc)) = St::tobf(sr_[i].ks1); } while (0)
#define SWAIT() do { if constexpr (SDEPTH == 2) asm volatile("s_waitcnt vmcnt(4)" ::: "memory"); else asm volatile("s_waitcnt vmcnt(0)" ::: "memory"); } while (0)
#define RESC(a) do { if (__any((a) < 1.f)) { if (hi == 0) al_l[r32] = (a); asm volatile("s_waitcnt lgkmcnt(0)" ::: "memory"); \
    for (int d = 0; d < 4; ++d) for (int r = 0; r < 16; ++r) o[d][r] *= al_l[crow(r, hi)]; } } while (0)
  f32x16 pA0, pA1, pB0, pB1; float mnA, mnB, alA, alB; bf16x8 pa0, pa1, pa2, pa3; const int NT = seq / KVBLK;
  constexpr int SE = 0, SO = SDEPTH - 1;
  SLOAD(SE, 0); asm volatile("s_waitcnt vmcnt(0)" ::: "memory"); SWRITE(0, SE); __syncthreads();
  qkt(pA0, pA1, K_lds, qr, r32, hi); partialSM(pA0, pA1, m_reg, mnA, alA);
  SLOAD(SO, KVBLK); if constexpr (SDEPTH == 2) { if (2 < NT) SLOAD(SE, 2 * KVBLK); }
  SWAIT(); SWRITE(1, SO); __syncthreads();
  for (int j = 1; j + 1 < NT; j += 2) {
    SBAR(); qkt(pB0, pB1, (bf16*)((char*)K_lds + SHM_K), qr, r32, hi);
    finishSM(pA0, pA1, alA, l_reg, pa0, pa1, pa2, pa3); SBAR();
    SLOAD(SO, (j + SDEPTH) * KVBLK); SBAR();
    pv_d0(o, vb0, pa0, pa1, pa2, pa3); partialSM(pB0, pB1, m_reg, mnB, alB);
    __syncthreads(); SWAIT(); SWRITE(0, SE);
    RESC(alB); __syncthreads();
    SBAR(); qkt(pA0, pA1, K_lds, qr, r32, hi);
    finishSM(pB0, pB1, alB, l_reg, pa0, pa1, pa2, pa3); SBAR();
    if (SDEPTH == 1 || j + 3 < NT) SLOAD(SE, (j + 1 + SDEPTH) * KVBLK); SBAR();
    pv_d0(o, vb0 + (int)SHM_V, pa0, pa1, pa2, pa3); partialSM(pA0, pA1, m_reg, mnA, alA);
    __syncthreads(); SWAIT(); SWRITE(1, SO);
    RESC(alA); __syncthreads();
  }
  SBAR(); qkt(pB0, pB1, (bf16*)((char*)K_lds + SHM_K), qr, r32, hi);
  finishSM(pA0, pA1, alA, l_reg, pa0, pa1, pa2, pa3); SBAR();
  pv_d0(o, vb0, pa0, pa1, pa2, pa3); partialSM(pB0, pB1, m_reg, mnB, alB);
  __syncthreads(); RESC(alB);
  finishSM(pB0, pB1, alB, l_reg, pa0, pa1, pa2, pa3); SBAR();
  pv_d0(o, vb0 + (int)SHM_V, pa0, pa1, pa2, pa3);
  if (hi == 0) li_l[r32] = l_reg; asm volatile("s_waitcnt lgkmcnt(0)" ::: "memory");
  float rli[16];
#pragma unroll
  for (int r = 0; r < 16; ++r) rli[r] = __builtin_amdgcn_rcpf(li_l[crow(r, hi)]);
  unsigned char* Ow = Ob + (long)(wid * QBLK) * LDO;
#pragma unroll
  for (int r = 0; r < 16; ++r) { int orow = crow(r, hi);
    for (int d0 = 0; d0 < 4; ++d0) Ow[(long)orow * LDO + d0 * 32 + r32] = (unsigned char)(__builtin_amdgcn_cvt_pk_fp8_f32(o[d0][r] * rli[r] * 64.0f, 0.f, 0, false) & 0xff); }
#undef SLOAD
#undef SWRITE
#undef SWAIT
#undef RESC
}


__device__ __forceinline__ void dilated_unit(const bf16* __restrict__ proj, const float* __restrict__ lutg, bf16* __restrict__ outg, float* __restrict__ lseg,
                                             int d, int hd12, int hh, int r, int i0, char* lds) {
  constexpr int LDP = 10240;
  constexpr float L2E = 1.4426950408889634f, C = SCALE * L2E;
  const int tid = threadIdx.x, wid = tid >> 6, lane = tid & 63, r32 = lane & 31, hi = lane >> 5;
  const int n = 8192 / d;
  char* KV = lds;
  float* lutx = (float*)(lds + 98304);
  float* wsx = (float*)(lds + 98304 + 2048) + wid * 64;
  const int qoff = hd12 * 128, koff = 1536 + hd12 * 128;
  if (tid < 320) { const int o = tid - 96; lutx[tid] = (o >= 0 && o <= 128) ? lutg[o] * L2E : -1e30f; }
  const int iq = i0 + wid * 32 + r32;
  const int sr = tid >> 4, sc = (tid & 15) * 8;
  f32x16 s00, s01, s10, s11, s20, s21;
  const int a = wid >> 1;
  {
    const bf16* Qw = proj + (size_t)(r + iq * d) * LDP + qoff + hi * 8;
    bf16x8 qr[8];
#pragma unroll
    for (int d0 = 0; d0 < 8; ++d0) qr[d0] = *reinterpret_cast<const bf16x8*>(Qw + d0 * 16);
#pragma unroll
    for (int ib = 0; ib < 12; ib += 6) {
      bf16x8 kv6[6];
#pragma unroll
      for (int i = 0; i < 6; ++i) { const int row = sr + 32 * (ib + i); int j = i0 - 64 + row; j = j < 0 ? 0 : (j >= n ? n - 1 : j);
        kv6[i] = *reinterpret_cast<const bf16x8*>(proj + (size_t)(r + j * d) * LDP + koff + sc); }
#pragma unroll
      for (int i = 0; i < 6; ++i) { const int row = sr + 32 * (ib + i);
        *reinterpret_cast<bf16x8*>(KV + (row >> 6) * 16384 + KSWZ(row & 63, sc * 2)) = kv6[i]; }
      SBAR();
    }
    __syncthreads();
    qkt(s00, s01, (const bf16*)(KV + (a + 0) * 16384), qr, r32, hi);
    qkt(s10, s11, (const bf16*)(KV + (a + 1) * 16384), qr, r32, hi);
    qkt(s20, s21, (const bf16*)(KV + (a + 2) * 16384), qr, r32, hi);
  }
  __syncthreads();
  SBAR();
  const int base = -32 * (wid & 1) - 64 - r32 + 4 * hi;
  const float* lp = lutx + (base + 160);
  float mx = -1e30f;
#define DIL_LOGITS(S, TT, HALF) _Pragma("unroll") for (int rr = 0; rr < 16; ++rr) { const float v = fmaf(S[rr], C, lp[64 * TT + 32 * HALF + (rr & 3) + 8 * (rr >> 2)]); S[rr] = v; }
  DIL_LOGITS(s00, 0, 0) DIL_LOGITS(s01, 0, 1) DIL_LOGITS(s10, 1, 0) DIL_LOGITS(s11, 1, 1) DIL_LOGITS(s20, 2, 0) DIL_LOGITS(s21, 2, 1)
#undef DIL_LOGITS
  if (i0 == 0 || i0 + 320 > n) {
    const int lo = -iq - base, hi_ = n - 1 - iq - base;
#define DIL_MASK(S, TT, HALF) _Pragma("unroll") for (int rr = 0; rr < 16; ++rr) { const int c = 64 * TT + 32 * HALF + (rr & 3) + 8 * (rr >> 2); S[rr] = (c >= lo && c <= hi_) ? S[rr] : -1e30f; }
    DIL_MASK(s00, 0, 0) DIL_MASK(s01, 0, 1) DIL_MASK(s10, 1, 0) DIL_MASK(s11, 1, 1) DIL_MASK(s20, 2, 0) DIL_MASK(s21, 2, 1)
#undef DIL_MASK
  }
#define DIL_MAX(S) _Pragma("unroll") for (int rr = 0; rr < 16; ++rr) mx = fmaxf(mx, S[rr]);
  DIL_MAX(s00) DIL_MAX(s01) DIL_MAX(s10) DIL_MAX(s11) DIL_MAX(s20) DIL_MAX(s21)
#undef DIL_MAX
  { auto rr = __builtin_amdgcn_permlane32_swap(__float_as_uint(mx), __float_as_uint(mx), false, false);
    mx = fmaxf(__uint_as_float(rr[0]), __uint_as_float(rr[1])); }
  float ps = 0.f;
#define DIL_EXP(S) _Pragma("unroll") for (int rr = 0; rr < 16; ++rr) { const float p = __builtin_amdgcn_exp2f(S[rr] - mx); S[rr] = p; ps += p; }
  DIL_EXP(s00) DIL_EXP(s01) DIL_EXP(s10) DIL_EXP(s11) DIL_EXP(s20) DIL_EXP(s21)
#undef DIL_EXP
  { auto rr = __builtin_amdgcn_permlane32_swap(__float_as_uint(ps), __float_as_uint(ps), false, false);
    ps = __uint_as_float(rr[0]) + __uint_as_float(rr[1]); }
  bf16x8 pa[12];
#define PK4(P, BASE, OUT) do { unsigned a0 = cvtpk(P[BASE + 0], P[BASE + 1]), a1 = cvtpk(P[BASE + 2], P[BASE + 3]);   \
    unsigned b0 = cvtpk(P[BASE + 4], P[BASE + 5]), b1 = cvtpk(P[BASE + 6], P[BASE + 7]);                              \
    auto r0 = __builtin_amdgcn_permlane32_swap(a0, b0, false, false); auto r1 = __builtin_amdgcn_permlane32_swap(a1, b1, false, false); \
    u32x4 w = {r0[0], r1[0], r0[1], r1[1]}; OUT = *reinterpret_cast<bf16x8*>(&w); } while (0)
  PK4(s00, 0, pa[0]); PK4(s00, 8, pa[1]); PK4(s01, 0, pa[2]); PK4(s01, 8, pa[3]);
  PK4(s10, 0, pa[4]); PK4(s10, 8, pa[5]); PK4(s11, 0, pa[6]); PK4(s11, 8, pa[7]);
  PK4(s20, 0, pa[8]); PK4(s20, 8, pa[9]); PK4(s21, 0, pa[10]); PK4(s21, 8, pa[11]);
#undef PK4
  SBAR();
#pragma unroll
  for (int ib = 0; ib < 12; ib += 6) {
    bf16x8 kv6[6];
#pragma unroll
    for (int i = 0; i < 6; ++i) { const int row = sr + 32 * (ib + i); int j = i0 - 64 + row; j = j < 0 ? 0 : (j >= n ? n - 1 : j);
      kv6[i] = *reinterpret_cast<const bf16x8*>(proj + (size_t)(r + j * d) * LDP + koff + 1536 + sc); }
#pragma unroll
    for (int i = 0; i < 6; ++i) { const int row = sr + 32 * (ib + i);
      *reinterpret_cast<bf16x8*>(KV + (row >> 6) * 16384 + v_st(row & 63, sc)) = kv6[i]; }
    SBAR();
  }
  if (hi == 0) wsx[r32] = ps;
  __syncthreads();
  f32x16 o[4] = {};
  const int vb = (int)(uintptr_t)KV + v_rd_base(lane);
  pv_d0(o, vb + (a + 0) * 16384, pa[0], pa[1], pa[2], pa[3]);
  pv_d0(o, vb + (a + 1) * 16384, pa[4], pa[5], pa[6], pa[7]);
  pv_d0(o, vb + (a + 2) * 16384, pa[8], pa[9], pa[10], pa[11]);
  float rli[16];
#pragma unroll
  for (int rr = 0; rr < 16; ++rr) rli[rr] = __builtin_amdgcn_rcpf(wsx[crow(rr, hi)]);
#pragma unroll
  for (int rr = 0; rr < 16; ++rr) { const int ir = i0 + wid * 32 + crow(rr, hi); bf16* orow = outg + (size_t)(r + ir * d) * 512 + hh * 128 + r32;
#pragma unroll
    for (int d0 = 0; d0 < 4; ++d0) orow[d0 * 32] = __float2bfloat16(o[d0][rr] * rli[rr]); }
  if (hi == 0) lseg[(size_t)(r + iq * d) * 4 + hh] = (mx + __builtin_amdgcn_logf(ps)) * 0.6931471805599453f;
  __syncthreads();
}

typedef int i32x4a __attribute__((ext_vector_type(4)));
typedef int i32x8a __attribute__((ext_vector_type(8)));
constexpr float THR8 = 3.f;
constexpr size_t SHM8_K = 64 * 128, SHM8_V = 64 * 128, SHM_ATTN8 = 2 * SHM8_K + 2 * SHM8_V + NW * 64 * 4;
#define A8_CAT(lo, hi) __builtin_shufflevector(lo, hi, 0, 1, 2, 3, 4, 5, 6, 7)
__device__ __forceinline__ f32x16 mfma8(i32x8a a, i32x8a b, f32x16 c) { return __builtin_amdgcn_mfma_scale_f32_32x32x64_f8f6f4(a, b, c, 0, 0, 0, 0, 0, 0); }
__device__ __forceinline__ int kchunk(int row, int c) { return row * 128 + ((c ^ ((row >> 1) & 7)) << 4); }
__device__ __forceinline__ void partialSM8(f32x16& p0, f32x16& p1, float& m_reg, float& mn, float& alpha) {
  constexpr float C = SCALE * 1.4426950408889634f;
  float pmax = p0[0]; for (int r = 1; r < 16; ++r) pmax = fmaxf(pmax, p0[r]); for (int r = 0; r < 16; ++r) pmax = fmaxf(pmax, p1[r]);
  { auto rr = __builtin_amdgcn_permlane32_swap(__float_as_uint(pmax), __float_as_uint(pmax), false, false);
    pmax = fmaxf(__uint_as_float(rr[0]), __uint_as_float(rr[1])); }
  if (__builtin_expect(__all(pmax - m_reg <= THR8 / SCALE), 1)) { mn = m_reg; alpha = 1.f; }
  else { mn = fmaxf(m_reg, pmax); alpha = __builtin_amdgcn_exp2f((m_reg - mn) * C); m_reg = mn; }
  const float mnC = 4.0f - mn * C;
  for (int r = 0; r < 16; ++r) p0[r] = fmaf(p0[r], C, mnC); for (int r = 0; r < 16; ++r) p1[r] = fmaf(p1[r], C, mnC);
  for (int r = 0; r < 16; ++r) p0[r] = __builtin_amdgcn_exp2f(p0[r]);
}
__device__ __forceinline__ unsigned pk4f8(float a, float b, float c, float d) { int w = __builtin_amdgcn_cvt_pk_fp8_f32(a, b, 0, false); w = __builtin_amdgcn_cvt_pk_fp8_f32(c, d, w, true); return (unsigned)w; }
__device__ __forceinline__ void finishSM8(f32x16& p0, f32x16& p1, float alpha, float& l_reg, i32x8a& pa) {
  for (int r = 0; r < 16; ++r) p1[r] = __builtin_amdgcn_exp2f(p1[r]);
  float ps = 0; for (int r = 0; r < 16; ++r) ps += p0[r]; for (int r = 0; r < 16; ++r) ps += p1[r];
  { auto rr = __builtin_amdgcn_permlane32_swap(__float_as_uint(ps), __float_as_uint(ps), false, false);
    ps = __uint_as_float(rr[0]) + __uint_as_float(rr[1]); }
  l_reg = l_reg * alpha + ps;
  pa[0] = (int)pk4f8(p0[0], p0[1], p0[2], p0[3]);   pa[1] = (int)pk4f8(p0[4], p0[5], p0[6], p0[7]);
  pa[2] = (int)pk4f8(p0[8], p0[9], p0[10], p0[11]); pa[3] = (int)pk4f8(p0[12], p0[13], p0[14], p0[15]);
  pa[4] = (int)pk4f8(p1[0], p1[1], p1[2], p1[3]);   pa[5] = (int)pk4f8(p1[4], p1[5], p1[6], p1[7]);
  pa[6] = (int)pk4f8(p1[8], p1[9], p1[10], p1[11]); pa[7] = (int)pk4f8(p1[12], p1[13], p1[14], p1[15]);
}
__device__ __forceinline__ void qkt8(f32x16& p0, f32x16& p1, const char* Ks, const i32x8a (&qr)[2], int r32, int hi) {
  p0 = f32x16{}; p1 = f32x16{};
#pragma unroll
  for (int s = 0; s < 2; ++s) { const int c0 = 4 * s + 2 * hi;
    const i32x8a a0 = A8_CAT(*reinterpret_cast<const i32x4a*>(Ks + kchunk(r32, c0)), *reinterpret_cast<const i32x4a*>(Ks + kchunk(r32, c0 + 1)));
    const i32x8a a1 = A8_CAT(*reinterpret_cast<const i32x4a*>(Ks + kchunk(32 + r32, c0)), *reinterpret_cast<const i32x4a*>(Ks + kchunk(32 + r32, c0 + 1)));
    p0 = mfma8(a0, qr[s], p0); p1 = mfma8(a1, qr[s], p1); }
}
__device__ __forceinline__ void pv8(f32x16* o, const char* Vs, i32x8a pa, int lane) {
#pragma unroll
  for (int d0 = 0; d0 < 4; ++d0) { const i32x8a b = A8_CAT(*reinterpret_cast<const i32x4a*>(Vs + d0 * 2048 + lane * 16), *reinterpret_cast<const i32x4a*>(Vs + d0 * 2048 + 1024 + lane * 16));
    o[d0] = mfma8(pa, b, o[d0]); }
}
template <int LDQ, int LDK, int LDO>
__device__ __forceinline__ void attn_dense_body8(const unsigned char* __restrict__ Qb, const unsigned char* __restrict__ Kh, const unsigned char* __restrict__ Vimg,
                                                 unsigned char* __restrict__ Ob, int seq, char* lds) {
  const int tid = threadIdx.x, wid = tid >> 6, lane = tid & 63, r32 = lane & 31, hi = lane >> 5;
  char* V_lds = lds; char* K_lds = lds + 2 * SHM8_V;
  float* ws = (float*)(lds + 2 * SHM8_V + 2 * SHM8_K) + wid * 64; float* li_l = ws; float* al_l = ws + 32;
  float m_reg = -1e30f, l_reg = 0; f32x16 o[4] = {}; i32x8a qr[2];
  const unsigned char* Qw = Qb + (long)(wid * QBLK + r32) * LDQ + hi * 32;
#pragma unroll
  for (int s = 0; s < 2; ++s) qr[s] = A8_CAT(*reinterpret_cast<const i32x4a*>(Qw + 64 * s), *reinterpret_cast<const i32x4a*>(Qw + 64 * s + 16));
  const int sr = tid >> 3, sc = tid & 7, kst = kchunk(sr, sc);
  struct { i32x4a vs, ks; } sr_[SDEPTH];
#define SLOAD8(i, k0) do { sr_[i].vs = *reinterpret_cast<const i32x4a*>(Vimg + (long)((k0) >> 6) * 8192 + tid * 16); sr_[i].ks = *reinterpret_cast<const i32x4a*>(Kh + (long)((k0) + sr) * LDK + sc * 16); } while (0)
#define SWRITE8(b, i) do { *reinterpret_cast<i32x4a*>(V_lds + (b) * SHM8_V + tid * 16) = sr_[i].vs; *reinterpret_cast<i32x4a*>(K_lds + (b) * SHM8_K + kst) = sr_[i].ks; } while (0)
#define SWAIT8() do { if constexpr (SDEPTH == 2) asm volatile("s_waitcnt vmcnt(2)" ::: "memory"); else asm volatile("s_waitcnt vmcnt(0)" ::: "memory"); } while (0)
#define RESC8(a) do { if (__any((a) < 1.f)) { if (hi == 0) al_l[r32] = (a); asm volatile("s_waitcnt lgkmcnt(0)" ::: "memory"); \
    for (int d = 0; d < 4; ++d) for (int r = 0; r < 16; ++r) o[d][r] *= al_l[crow(r, hi)]; } } while (0)
  f32x16 pA0, pA1, pB0, pB1; float mnA, mnB, alA, alB; i32x8a pa; const int NT = seq / KVBLK;
  constexpr int SE = 0, SO = SDEPTH - 1;
  SLOAD8(SE, 0); asm volatile("s_waitcnt vmcnt(0)" ::: "memory"); SWRITE8(0, SE); __syncthreads();
  qkt8(pA0, pA1, K_lds, qr, r32, hi); partialSM8(pA0, pA1, m_reg, mnA, alA);
  SLOAD8(SO, KVBLK); if constexpr (SDEPTH == 2) { if (2 < NT) SLOAD8(SE, 2 * KVBLK); }
  SWAIT8(); SWRITE8(1, SO); __syncthreads();
  for (int j = 1; j + 1 < NT; j += 2) {
    SBAR(); qkt8(pB0, pB1, K_lds + SHM8_K, qr, r32, hi);
    finishSM8(pA0, pA1, alA, l_reg, pa); SBAR();
    SLOAD8(SO, (j + SDEPTH) * KVBLK); SBAR();
    pv8(o, V_lds, pa, lane); partialSM8(pB0, pB1, m_reg, mnB, alB);
    __syncthreads(); SWAIT8(); SWRITE8(0, SE);
    RESC8(alB); __syncthreads();
    SBAR(); qkt8(pA0, pA1, K_lds, qr, r32, hi);
    finishSM8(pB0, pB1, alB, l_reg, pa); SBAR();
    if (SDEPTH == 1 || j + 3 < NT) SLOAD8(SE, (j + 1 + SDEPTH) * KVBLK); SBAR();
    pv8(o, V_lds + SHM8_V, pa, lane); partialSM8(pA0, pA1, m_reg, mnA, alA);
    __syncthreads(); SWAIT8(); SWRITE8(1, SO);
    RESC8(alA); __syncthreads();
  }
  SBAR(); qkt8(pB0, pB1, K_lds + SHM8_K, qr, r32, hi);
  finishSM8(pA0, pA1, alA, l_reg, pa); SBAR();
  pv8(o, V_lds, pa, lane); partialSM8(pB0, pB1, m_reg, mnB, alB);
  __syncthreads(); RESC8(alB);
  finishSM8(pB0, pB1, alB, l_reg, pa); SBAR();
  pv8(o, V_lds + SHM8_V, pa, lane);
  if (hi == 0) li_l[r32] = l_reg; asm volatile("s_waitcnt lgkmcnt(0)" ::: "memory");
  float rli[16];
#pragma unroll
  for (int r = 0; r < 16; ++r) rli[r] = 4.0f * __builtin_amdgcn_rcpf(li_l[crow(r, hi)]);
  unsigned char* Ow = Ob + (long)(wid * QBLK) * LDO;
#pragma unroll
  for (int r = 0; r < 16; ++r) { const int orow = crow(r, hi);
    for (int d0 = 0; d0 < 4; ++d0) Ow[(long)orow * LDO + d0 * 32 + r32] = (unsigned char)(__builtin_amdgcn_cvt_pk_fp8_f32(o[d0][r] * rli[r], 0.f, 0, false) & 0xff); }
#undef SLOAD8
#undef SWRITE8
#undef SWAIT8
#undef RESC8
}
}

#define GAS __attribute__((address_space(1)))
#define LAS __attribute__((address_space(3)))
typedef unsigned short bf16;
typedef unsigned v4u __attribute__((ext_vector_type(4)));
typedef unsigned v2u __attribute__((ext_vector_type(2)));
typedef float f32x4 __attribute__((ext_vector_type(4)));
#define LDS_WAIT() asm volatile("s_waitcnt lgkmcnt(0)" ::: "memory")
#define VM_WAIT() asm volatile("s_waitcnt vmcnt(0)" ::: "memory")
__device__ __forceinline__ unsigned pk2(float lo, float hi) { return pg8::cvt_pk_bf16(lo, hi); }
__device__ __forceinline__ float bflo(unsigned w) { return __builtin_bit_cast(float, w << 16); }
__device__ __forceinline__ float bfhi(unsigned w) { return __builtin_bit_cast(float, w & 0xffff0000u); }
#ifndef MK_Q8
#define MK_Q8 0
#endif
#ifndef MK_CHK_TOL
#define MK_CHK_TOL 0.15f
#endif
#ifndef MK_CHECK8
#define MK_CHECK8 0
#endif
__device__ __forceinline__ unsigned pk4_fp8(float a, float b, float c, float d) {
    int w = __builtin_amdgcn_cvt_pk_fp8_f32(a, b, 0, false); w = __builtin_amdgcn_cvt_pk_fp8_f32(c, d, w, true); return (unsigned)w; }
__device__ __forceinline__ float q8f(float v) { const int p = __builtin_amdgcn_cvt_pk_fp8_f32(v, v, 0, false); return __builtin_amdgcn_cvt_f32_fp8(p, 0); }
__device__ __forceinline__ float bf2f(bf16 b) { return __builtin_bit_cast(float, ((unsigned)b) << 16); }

#define XB_TMO      128
#define XB_XCNT(j)  (256  + 64 * (j))
#define XB_XSUB(j)  (1280 + 64 * (j))
#define XB_XGEN(j)  (2304 + 64 * (j))
#define XB_TOP      3328
#define XB_TOPGEN   3392
#define XCD_BAR_WORDS 3456
#define XB_SPIN_CAP (1u << 18)

__device__ __forceinline__ unsigned xb_ld(unsigned* p)              { return __hip_atomic_load(p, __ATOMIC_RELAXED, __HIP_MEMORY_SCOPE_AGENT); }
__device__ __forceinline__ unsigned xb_add(unsigned* p, unsigned v) { return __hip_atomic_fetch_add(p, v, __ATOMIC_RELAXED, __HIP_MEMORY_SCOPE_AGENT); }
__device__ __forceinline__ unsigned xb_xcc_id() { return (unsigned)__builtin_amdgcn_s_getreg((3 << 11) | 20) & 0xFu; }
#define XB_SPIN(cond, bar) do { unsigned _sp = 0; while (cond) { __builtin_amdgcn_s_sleep(1); \
    if ((++_sp & 255u) == 0u) { if (xb_ld(&(bar)[XB_TMO])) break; if (_sp > XB_SPIN_CAP) { atomicAdd(&(bar)[XB_TMO], 1u); break; } } } } while (0)

struct XcdBarrier {
    unsigned* bar; unsigned x;
    volatile LAS unsigned* st;
};

__device__ __forceinline__ XcdBarrier xcd_barrier_post(unsigned* bar, volatile LAS unsigned* st) {
    XcdBarrier b; b.bar = bar; b.x = xb_xcc_id(); b.st = st;
    if (threadIdx.x == 0) (void)xb_add(&bar[XB_XCNT(b.x)], 1u);
    return b;
}
__device__ __forceinline__ void xcd_barrier_complete(unsigned* bar, unsigned x, unsigned& nloc, unsigned& nx) {
    const unsigned G = gridDim.x * gridDim.y * gridDim.z;
    unsigned sum, cnt, mine, sp = 0u;
    for (;;) {
        sum = 0u; cnt = 0u; mine = 0u;
#pragma unroll
        for (unsigned j = 0; j < 16; ++j) { const unsigned c = xb_ld(&bar[XB_XCNT(j)]); sum += c; cnt += (c > 0u) ? 1u : 0u; mine = (j == x) ? c : mine; }
        if (sum == G) break;
        __builtin_amdgcn_s_sleep(1);
        if ((++sp & 255u) == 0u) { if (xb_ld(&bar[XB_TMO])) break; if (sp > XB_SPIN_CAP) { atomicAdd(&bar[XB_TMO], 1u); break; } }
    }
    nloc = mine > 0u ? mine : 1u; nx = cnt > 0u ? cnt : 1u;
}

__device__ __forceinline__ void xcd_barrier(const XcdBarrier& b) {
    asm volatile("s_waitcnt vmcnt(0)" ::: "memory");
    __syncthreads();
    if (threadIdx.x == 0) {
        unsigned* bar = b.bar;
        __builtin_amdgcn_s_waitcnt(0);
        unsigned nloc = b.st[0], nx = b.st[1];
        if (nloc == 0u) { xcd_barrier_complete(bar, b.x, nloc, nx); b.st[0] = nloc; b.st[1] = nx; }
        const unsigned old = xb_add(&bar[XB_XSUB(b.x)], 1u);
        const unsigned gen = old / nloc;
        if (old + 1u == (gen + 1u) * nloc) {
            __builtin_amdgcn_fence(__ATOMIC_RELEASE, "agent");
            asm volatile("s_waitcnt vmcnt(0)" ::: "memory");
            const unsigned og = xb_add(&bar[XB_TOP], 1u);
            const unsigned tg = og / nx;
            if (og + 1u == (tg + 1u) * nx) xb_add(&bar[XB_TOPGEN], 1u);
            else XB_SPIN(xb_ld(&bar[XB_TOPGEN]) == tg, bar);
            __builtin_amdgcn_fence(__ATOMIC_ACQUIRE, "agent");
            xb_add(&bar[XB_XGEN(b.x)], 1u);
            asm volatile("s_waitcnt vmcnt(0)" ::: "memory");
        } else {
            XB_SPIN(xb_ld(&bar[XB_XGEN(b.x)]) == gen, bar);
            __builtin_amdgcn_fence(__ATOMIC_ACQUIRE, "agent");
            asm volatile("s_waitcnt vmcnt(0)" ::: "memory");
        }
    }
    __syncthreads();
}

constexpr int S_ = 8192, DM = 2048, INW = 10240, NE = 32, TOPK = 4;
constexpr int A_W = 1536, A_V_OFF = 3072, B_Q_OFF = 4608, B_K_OFF = 5632, B_V_OFF = 5888, GATE_OFF = 6144;
constexpr int MAXSLOT = 40960;
constexpr float LN_EPS = 1e-5f, QK_EPS = 1e-6f;
constexpr float ALPHA = 1.189207115002721f;
constexpr int NPH = 11;

constexpr size_t MiB = 1u << 20;
constexpr size_t WS_CTL = 0, CTL_ZERO_BYTES = 64 * 1024;
constexpr int CW_BAR = 0;
constexpr int CW_CNT = 4096;
constexpr size_t WS_LUT = 1 * MiB;
constexpr size_t WS_ROPE = 1 * MiB + 8192;
constexpr size_t WS_WRT = 1 * MiB + 65536;
constexpr size_t WS_TOKE = 1 * MiB + 65536 + 262144;
constexpr size_t WS_TOKR = WS_TOKE + 131072;
constexpr size_t WS_TOKW = WS_TOKR + 131072;
constexpr size_t WS_TOKS = WS_TOKW + 131072;
constexpr size_t WS_SLOTW = WS_TOKS + 131072;
constexpr size_t WS_LSE = 3 * MiB;
constexpr size_t WS_XB = 4 * MiB;
constexpr size_t WS_WIN = WS_XB + 32 * MiB;
constexpr size_t WS_WA = WS_WIN + 40 * MiB;
constexpr size_t WS_WB = WS_WA + 2 * MiB;
constexpr size_t WS_WO = WS_WB + 4 * MiB;
constexpr size_t WS_WGL = WS_WO + 8 * MiB;
constexpr size_t WS_WD = WS_WGL + 512 * MiB;
constexpr size_t WS_PROJ = WS_WD + 256 * MiB;
constexpr size_t WS_QBR = WS_PROJ + 160 * MiB;
constexpr size_t WS_KBR = WS_QBR + 16 * MiB;
constexpr size_t WS_VBR = WS_KBR + 4 * MiB;
constexpr size_t WS_Q8 = WS_VBR + 4 * MiB;
constexpr size_t WS_K8 = WS_Q8 + 8 * MiB;
constexpr size_t WS_VIMG = WS_K8 + 2 * MiB;
constexpr size_t WS_DBG = WS_VIMG + 2 * MiB;
constexpr size_t WS_OUTA = WS_DBG + 64 * MiB;
constexpr size_t WS_YA = WS_OUTA + 24 * MiB;
constexpr size_t WS_YB = WS_YA + 8 * MiB;
constexpr size_t WS_T1 = WS_YB + 16 * MiB;
constexpr size_t WS_Y = WS_T1 + 64 * MiB;
constexpr size_t WS_X1 = WS_Y + 32 * MiB;
constexpr size_t WS_X1B = WS_X1 + 64 * MiB;
constexpr size_t WS_XS = WS_X1B + 32 * MiB;
constexpr size_t WS_H = WS_XS + 160 * MiB;
constexpr size_t WS_YS = WS_PROJ;
constexpr size_t WS_END = WS_H + 160 * MiB;

constexpr int RING_OFF = 0, RING_BYTES = 131072;
constexpr int L_XB = RING_BYTES;
constexpr int L_TILE = RING_BYTES + 64;
constexpr int L_PST = RING_BYTES + 1024;
constexpr int L_CNT = RING_BYTES + 1280;
constexpr int L_ASG = RING_BYTES + 2048;
constexpr int L_PTR = RING_BYTES + 3584;
constexpr int LDS_BYTES = 147456;

struct Frame {
    LAS unsigned char* lds; unsigned char* ldsg;
    int tid, lane, wave, G;
};
__device__ __forceinline__ unsigned char* wsp_(const Frame& F) {
    const LAS unsigned* p = (const LAS unsigned*)(F.lds + L_PTR) + 2 * 22;
    const unsigned lo = __builtin_amdgcn_readfirstlane(p[0]), hi = __builtin_amdgcn_readfirstlane(p[1]);
    return (unsigned char*)(((unsigned long long)hi << 32) | lo);
}
__device__ __forceinline__ const float* inp(const Frame& F, int i) {
    const LAS unsigned* p = (const LAS unsigned*)(F.lds + L_PTR) + 2 * i;
    const unsigned lo = __builtin_amdgcn_readfirstlane(p[0]), hi = __builtin_amdgcn_readfirstlane(p[1]);
    return (const float*)(((unsigned long long)hi << 32) | lo);
}
__device__ __forceinline__ float wave_sum(float v) {
#pragma unroll
    for (int o = 1; o < 64; o <<= 1) v += __shfl_xor(v, o);
    return v;
}

__device__ __forceinline__ void transpose_item(const float* __restrict__ W, int N, int k0, int n0, bf16* WT, int ldo, int orow0, int ocol0, LAS float* scr, int lane, const bool q8 = false) {
    f32x4 v[8];
#pragma unroll
    for (int i = 0; i < 8; ++i) v[i] = *(const f32x4*)(W + (size_t)(k0 + 8 * i + (lane >> 3)) * N + n0 + 4 * (lane & 7));
#pragma unroll
    for (int i = 0; i < 8; ++i) { LAS float* s = scr + (8 * i + (lane >> 3)) * 33 + 4 * (lane & 7); if (q8) { for (int e = 0; e < 4; ++e) v[i][e] = q8f(v[i][e] * 64.0f) * (1.0f / 64.0f); } s[0] = v[i][0]; s[1] = v[i][1]; s[2] = v[i][2]; s[3] = v[i][3]; }
    LDS_WAIT(); asm volatile("" ::: "memory");
    const int c = lane & 7;
#pragma unroll
    for (int j = 0; j < 4; ++j) { const int n = (lane >> 3) + 8 * j; const LAS float* s = scr + (8 * c) * 33 + n;
        v4u o; o.x = pk2(s[0 * 33], s[1 * 33]); o.y = pk2(s[2 * 33], s[3 * 33]); o.z = pk2(s[4 * 33], s[5 * 33]); o.w = pk2(s[6 * 33], s[7 * 33]);
        *(v4u*)(WT + (size_t)(orow0 + n) * ldo + ocol0 + 8 * c) = o; }
    LDS_WAIT(); asm volatile("" ::: "memory");
}
__device__ __forceinline__ void transpose_item8(const float* __restrict__ W, int N, int k0, int n0, unsigned char* WT, int ldo, int orow0, int ocol0, float scale, LAS float* scr, int lane) {
    f32x4 v[8];
#pragma unroll
    for (int i = 0; i < 8; ++i) v[i] = *(const f32x4*)(W + (size_t)(k0 + 8 * i + (lane >> 3)) * N + n0 + 4 * (lane & 7));
#pragma unroll
    for (int i = 0; i < 8; ++i) { LAS float* s = scr + (8 * i + (lane >> 3)) * 33 + 4 * (lane & 7); s[0] = v[i][0] * scale; s[1] = v[i][1] * scale; s[2] = v[i][2] * scale; s[3] = v[i][3] * scale; }
    LDS_WAIT(); asm volatile("" ::: "memory");
    const int c = lane & 3;
#pragma unroll
    for (int j = 0; j < 2; ++j) { const int n = (lane >> 2) + 16 * j; const LAS float* s = scr + (16 * c) * 33 + n;
        v4u o; o.x = pk4_fp8(s[0 * 33], s[1 * 33], s[2 * 33], s[3 * 33]); o.y = pk4_fp8(s[4 * 33], s[5 * 33], s[6 * 33], s[7 * 33]);
        o.z = pk4_fp8(s[8 * 33], s[9 * 33], s[10 * 33], s[11 * 33]); o.w = pk4_fp8(s[12 * 33], s[13 * 33], s[14 * 33], s[15 * 33]);
        *(v4u*)(WT + (size_t)(orow0 + n) * ldo + ocol0 + 16 * c) = o; }
    LDS_WAIT(); asm volatile("" ::: "memory");
}
__device__ __forceinline__ int t5_bucket(int rel) {
    const int n = rel < 0 ? -rel : rel; const float nf = (float)(n < 1 ? 1 : n);
    int large = 8 + (int)(logf(nf / 8.0f) / 4.852030263919617f * 8.0f); large = large < 15 ? large : 15;
    return (rel > 0 ? 16 : 0) + (n < 8 ? n : large);
}
__device__ __forceinline__ void p0_prologue(Frame& F) {
    LAS float* scr = (LAS float*)(F.lds + RING_OFF + F.wave * 16384);
    const int gw = blockIdx.x * 8 + F.wave, NGW = F.G * 8;
    const int gt = blockIdx.x * 512 + F.tid, NGT = F.G * 512;
    bf16* XB = (bf16*)(wsp_(F) + WS_XB); bf16* WIN = (bf16*)(wsp_(F) + WS_WIN); bf16* WA = (bf16*)(wsp_(F) + WS_WA); bf16* WB = (bf16*)(wsp_(F) + WS_WB); bf16* WO = (bf16*)(wsp_(F) + WS_WO);
    bf16* WGL = (bf16*)(wsp_(F) + WS_WGL); bf16* WD = (bf16*)(wsp_(F) + WS_WD);
    { float* lut = (float*)(wsp_(F) + WS_LUT); const float* rb = inp(F, 3);
      for (int i = gt; i < 3 * 4 * 129; i += NGT) { const int g = i / 516, hh = (i / 129) % 4, j = i % 129; const int d = (g == 0) ? 1 : (g == 1 ? 4 : 16);
          lut[i] = rb[t5_bucket((j - 64) * d) * 12 + g * 4 + hh]; }
      float* rope = (float*)(wsp_(F) + WS_ROPE);
      for (int i = gt; i < 128 * 32; i += NGT) { const int pos = i >> 5, fi = i & 31; const float inv = powf(10000.0f, -(float)(2 * fi) / 64.0f); const float ang = (float)pos * inv;
          rope[2 * i] = __cosf(ang); rope[2 * i + 1] = __sinf(ang); }
      float* wrt = (float*)(wsp_(F) + WS_WRT); const float* wr = inp(F, 11);
      for (int i = gt; i < 32 * 2048; i += NGT) { const int e = i >> 11, c = i & 2047; wrt[i] = wr[c * 32 + e]; }
    }
    { const float* x = inp(F, 0);
      for (int i = gw; i < S_ * DM / 512; i += NGW) { const size_t o = (size_t)i * 512 + F.lane * 8; const f32x4 a = *(const f32x4*)(x + o), b = *(const f32x4*)(x + o + 4);
          v2u w; w.x = pk4_fp8(a[0], a[1], a[2], a[3]); w.y = pk4_fp8(b[0], b[1], b[2], b[3]); *(v2u*)((unsigned char*)XB + o) = w; } }
    constexpr int T_WIN = 16 * 80, T_WA = 4 * 16, T_WB = 8 * 16, T_WO = 16 * 16;
    constexpr int NT = T_WIN + T_WA + T_WB + T_WO;
    const float* const w_in = inp(F, 1); const float* const w_ba = inp(F, 6); const float* const w_bb = inp(F, 7); const float* const w_o = inp(F, 8);
#define P0_DECODE(T, SRC, NN, DST, LDO, SCL) do { int r_ = (T); \
        if (r_ < T_WIN) { const int kt = r_ / 80, nt = r_ % 80; SRC = w_in + (size_t)(128 * kt) * INW + 128 * nt; NN = INW; DST = (unsigned char*)WIN + (size_t)(nt >> 1) * (256 * 2048) + kt * 32768 + (nt & 1) * 16384; LDO = 128; SCL = 64.0f; break; } r_ -= T_WIN; \
        if (r_ < T_WA) { const int kt = r_ / 16, nt = r_ % 16; SRC = w_ba + (size_t)(128 * kt) * DM + 128 * nt; NN = DM; DST = (unsigned char*)WA + (size_t)(nt >> 1) * (256 * 512) + kt * 32768 + (nt & 1) * 16384; LDO = 128; SCL = 32.0f; break; } r_ -= T_WA; \
        if (r_ < T_WB) { const int kt = r_ / 16, nt = r_ % 16; SRC = w_bb + (size_t)(128 * kt) * DM + 128 * nt; NN = DM; DST = (unsigned char*)WB + (size_t)(nt >> 1) * (256 * 1024) + kt * 32768 + (nt & 1) * 16384; LDO = 128; SCL = 32.0f; break; } r_ -= T_WB; \
        { const int kt = r_ / 16, nt = r_ % 16; SRC = w_o + (size_t)(128 * kt) * DM + 128 * nt; NN = DM; DST = (unsigned char*)WO + (size_t)(nt >> 1) * (256 * 2048) + kt * 32768 + (nt & 1) * 16384; LDO = 128; SCL = 64.0f; } } while (0)
    const int nq = F.tid & 31, kq0 = F.tid >> 5;
#define P0_LOAD(V, SRC, NN) do { _Pragma("unroll") for (int p = 0; p < 2; ++p) _Pragma("unroll") for (int i = 0; i < 4; ++i) V[p * 4 + i] = __builtin_nontemporal_load((const f32x4*)(SRC + (size_t)(4 * (kq0 + 16 * p) + i) * NN + 4 * nq)); } while (0)
    if ((int)blockIdx.x < NT) {
        const int nj = (NT - (int)blockIdx.x + F.G - 1) / F.G;
        const float* src; int nn; unsigned char* dst; int ldo; float scl;
        P0_DECODE((int)blockIdx.x, src, nn, dst, ldo, scl);
        f32x4 v[8]; P0_LOAD(v, src, nn);
        for (int j = 0; j < nj; ++j) {
            const int jn = (j + 1 < nj) ? j + 1 : j;
            const float* nsrc; int nnn; unsigned char* ndst; int nldo; float nscl;
            P0_DECODE((int)blockIdx.x + jn * F.G, nsrc, nnn, ndst, nldo, nscl);
            f32x4 nv[8]; P0_LOAD(nv, nsrc, nnn);
            LAS unsigned* t32 = (LAS unsigned*)(F.lds + RING_OFF + (j & 1) * 16384);
#pragma unroll
            for (int p = 0; p < 2; ++p)
#pragma unroll
                for (int c = 0; c < 4; ++c) t32[(4 * nq + c) * 32 + ((kq0 + 16 * p) ^ nq)] = pk4_fp8(v[p * 4 + 0][c] * scl, v[p * 4 + 1][c] * scl, v[p * 4 + 2][c] * scl, v[p * 4 + 3][c] * scl);
            __syncthreads();
#pragma unroll
            for (int jj = 0; jj < 2; ++jj) { const int n = (F.tid >> 3) + 64 * jj, c8 = F.tid & 7, g = n >> 2; const LAS unsigned* rp = t32 + n * 32;
                v4u o; o.x = rp[(4 * c8 + 0) ^ g]; o.y = rp[(4 * c8 + 1) ^ g]; o.z = rp[(4 * c8 + 2) ^ g]; o.w = rp[(4 * c8 + 3) ^ g];
                __builtin_nontemporal_store(o, (v4u*)(dst + (size_t)n * ldo + 16 * c8)); }
#pragma unroll
            for (int i = 0; i < 8; ++i) v[i] = nv[i];
            src = nsrc; nn = nnn; dst = ndst; ldo = nldo; scl = nscl;
        }
        __syncthreads();
    }
#undef P0_DECODE
#undef P0_LOAD
}

__device__ __forceinline__ void moe_convert_share(Frame& F) {
    constexpr int T_ALL = 3 * 32 * 256;
    const float* const w_g = inp(F, 13); const float* const w_l = inp(F, 15); const float* const w_d = inp(F, 17);
    unsigned char* const WGL = wsp_(F) + WS_WGL; unsigned char* const WD = wsp_(F) + WS_WD;
#define MC_DECODE(T, SRC, DST) do { const int r_ = (T); const int which = r_ / (32 * 256), rr = r_ % (32 * 256), e = rr >> 8, q = rr & 255, kt = q >> 4, nt = q & 15; \
        SRC = (which == 0 ? w_g : (which == 1 ? w_l : w_d)) + (size_t)e * DM * DM + (size_t)(128 * kt) * DM + 128 * nt; \
        DST = (which < 2) ? WGL + (size_t)e * (4096 * 2048) + (size_t)nt * (256 * 2048) + kt * 32768 + which * 16384 : WD + (size_t)e * (2048 * 2048) + (size_t)(nt >> 1) * (256 * 2048) + kt * 32768 + (nt & 1) * 16384; } while (0)
    const int nq = F.tid & 31, kq0 = F.tid >> 5;
#define MC_LOAD(V, SRC) do { _Pragma("unroll") for (int p = 0; p < 2; ++p) _Pragma("unroll") for (int i = 0; i < 4; ++i) V[p * 4 + i] = __builtin_nontemporal_load((const f32x4*)(SRC + (size_t)(4 * (kq0 + 16 * p) + i) * DM + 4 * nq)); } while (0)
    if ((int)blockIdx.x < T_ALL) {
        const int nj = (T_ALL - (int)blockIdx.x + F.G - 1) / F.G, t0_ = (int)blockIdx.x;
        f32x4 b0[8], b1[8], b2[8], b3[8];
        unsigned char *d0, *d1, *d2, *d3 = nullptr;
        { const float* sp; MC_DECODE(t0_ + (0 < nj ? 0 : nj - 1) * F.G, sp, d0); MC_LOAD(b0, sp); }
        { const float* sp; MC_DECODE(t0_ + (1 < nj ? 1 : nj - 1) * F.G, sp, d1); MC_LOAD(b1, sp); }
        { const float* sp; MC_DECODE(t0_ + (2 < nj ? 2 : nj - 1) * F.G, sp, d2); MC_LOAD(b2, sp); }
#define MC_STEP(K, CUR, DCUR, NXT, DNXT) do { const int k_ = (K); \
            { const int kn_ = (k_ + 3 < nj) ? k_ + 3 : nj - 1; const float* sp; MC_DECODE(t0_ + kn_ * F.G, sp, DNXT); MC_LOAD(NXT, sp); } \
            if (k_ < nj) { \
                LAS unsigned* t32 = (LAS unsigned*)(F.lds + RING_OFF + (k_ & 1) * 16384); \
                _Pragma("unroll") for (int p = 0; p < 2; ++p) _Pragma("unroll") for (int c = 0; c < 4; ++c) \
                    t32[(4 * nq + c) * 32 + ((kq0 + 16 * p) ^ nq)] = pk4_fp8(CUR[p * 4 + 0][c] * 64.0f, CUR[p * 4 + 1][c] * 64.0f, CUR[p * 4 + 2][c] * 64.0f, CUR[p * 4 + 3][c] * 64.0f); \
                __syncthreads(); \
                _Pragma("unroll") for (int jj = 0; jj < 2; ++jj) { const int n = (F.tid >> 3) + 64 * jj, c8 = F.tid & 7, g = n >> 2; const LAS unsigned* rp = t32 + n * 32; \
                    v4u o; o.x = rp[(4 * c8 + 0) ^ g]; o.y = rp[(4 * c8 + 1) ^ g]; o.z = rp[(4 * c8 + 2) ^ g]; o.w = rp[(4 * c8 + 3) ^ g]; \
                    __builtin_nontemporal_store(o, (v4u*)(DCUR + (size_t)n * 128 + 16 * c8)); } } } while (0)
        for (int j = 0; j < nj; j += 4) {
            MC_STEP(j + 0, b0, d0, b3, d3);
            MC_STEP(j + 1, b1, d1, b0, d0);
            MC_STEP(j + 2, b2, d2, b1, d1);
            MC_STEP(j + 3, b3, d3, b2, d2);
        }
#undef MC_STEP
        __syncthreads();
    }
#undef MC_DECODE
#undef MC_LOAD
}

__device__ __forceinline__ void p2_prep_dilated(Frame& F) {
    const bf16* proj = (const bf16*)(wsp_(F) + WS_PROJ);
    bf16* QBR = (bf16*)(wsp_(F) + WS_QBR); bf16* KBR = (bf16*)(wsp_(F) + WS_KBR); bf16* VBR = (bf16*)(wsp_(F) + WS_VBR);
    unsigned char* Q8 = wsp_(F) + WS_Q8; unsigned char* K8 = wsp_(F) + WS_K8; unsigned char* VIMG = wsp_(F) + WS_VIMG;
    const float* rope = (const float*)(wsp_(F) + WS_ROPE);
    const int gw = blockIdx.x * 8 + F.wave, NGW = F.G * 8;
    const int half = F.lane >> 5, fi = F.lane & 31, c1 = half * 64 + fi, c2 = c1 + 32;
    const float* const qn_g = inp(F, 4); const float* const kn_g = inp(F, 5);
    int tfirst, tstep_, tcount;
    if (F.G == 256) { if (blockIdx.x >= 128) { tfirst = ((int)blockIdx.x - 128) * 8 + F.wave; tstep_ = 1024; tcount = 6; } else { tfirst = 6144 + (int)blockIdx.x * 8 + F.wave; tstep_ = 1024; tcount = 2; } }
    else { tfirst = gw; tstep_ = NGW; tcount = (S_ - gw + NGW - 1) / NGW; }
    for (int ti = 0; ti < tcount; ++ti) {
        const int t = tfirst + ti * tstep_;
        const bf16* base = proj + (size_t)t * INW;
        float a1[10], a2[10], ss[10];
#pragma unroll
        for (int h = 0; h < 10; ++h) { const bf16* src = base + (h < 8 ? B_Q_OFF + h * 128 : B_K_OFF + (h - 8) * 128); a1[h] = bf2f(src[c1]); a2[h] = bf2f(src[c2]); }
        const unsigned vv0 = ((const unsigned*)(base + B_V_OFF))[F.lane], vv1 = ((const unsigned*)(base + B_V_OFF + 128))[F.lane];
        const int pos = half ? (t & 63) : (t >> 6);
        const float cs = rope[(pos * 32 + fi) * 2], sn = rope[(pos * 32 + fi) * 2 + 1];
        const float gq1 = qn_g[c1], gq2 = qn_g[c2], gk1 = kn_g[c1], gk2 = kn_g[c2];
#pragma unroll
        for (int h = 0; h < 10; ++h) ss[h] = a1[h] * a1[h] + a2[h] * a2[h];
#pragma unroll
        for (int o = 1; o < 64; o <<= 1)
#pragma unroll
            for (int h = 0; h < 10; ++h) ss[h] += __shfl_xor(ss[h], o);
#pragma unroll
        for (int h = 0; h < 10; ++h) {
            const float rs = 1.0f / sqrtf(ss[h] * (1.0f / 128.0f) + QK_EPS);
            const float v1 = a1[h] * rs * (h < 8 ? gq1 : gk1), v2 = a2[h] * rs * (h < 8 ? gq2 : gk2);
            const float o1 = v1 * cs - v2 * sn, o2 = v1 * sn + v2 * cs;
            unsigned char* dst8 = h < 8 ? Q8 + (size_t)t * 1024 + h * 128 : K8 + (size_t)t * 256 + (h - 8) * 128;
            const unsigned pq = pk4_fp8(o1, o2, 0.f, 0.f); dst8[c1] = (unsigned char)(pq & 0xffu); dst8[c2] = (unsigned char)((pq >> 8) & 0xffu);
            if (MK_CHECK8) { bf16* dst = h < 8 ? QBR + (size_t)t * 1024 + h * 128 : KBR + (size_t)t * 256 + (h - 8) * 128;
                dst[c1] = (bf16)(pk2(o1, 0.f) & 0xffffu); dst[c2] = (bf16)(pk2(o2, 0.f) & 0xffffu); }
        }
        if (MK_CHECK8) { ((unsigned*)(VBR + (size_t)t * 256))[F.lane] = vv0; ((unsigned*)(VBR + (size_t)t * 256 + 128))[F.lane] = vv1; }
        {
            const int kk = t & 63, part = kk >> 5, k32 = kk & 31, g = (k32 >> 2) & 1, ii = (k32 & 3) + 4 * (k32 >> 3);
            unsigned char* img = VIMG + (size_t)(t >> 6) * 8192 + part * 1024 + g * 512 + ii;
            const int ca = 2 * F.lane, cb = 2 * F.lane + 1;
            const unsigned p0 = pk4_fp8(bflo(vv0) * 16.0f, bfhi(vv0) * 16.0f, bflo(vv1) * 16.0f, bfhi(vv1) * 16.0f);
            img[(ca >> 5) * 2048 + (ca & 31) * 16] = (unsigned char)(p0 & 0xffu); img[(cb >> 5) * 2048 + (cb & 31) * 16] = (unsigned char)((p0 >> 8) & 0xffu);
            img[128 * 8192 + (ca >> 5) * 2048 + (ca & 31) * 16] = (unsigned char)((p0 >> 16) & 0xffu); img[128 * 8192 + (cb >> 5) * 2048 + (cb & 31) * 16] = (unsigned char)((p0 >> 24) & 0xffu);
        }
    }
    const float* lut = (const float*)(wsp_(F) + WS_LUT);
    for (int u = blockIdx.x; u < 384; u += F.G) {
        const int gh = u >> 5, blk = u & 31, g = gh >> 2, hh = gh & 3, d = (g == 0) ? 1 : (g == 1 ? 4 : 16);
        const int bps = 32 / d, r = blk / bps, qb = blk % bps;
        at::dilated_unit((const at::bf16*)proj, lut + (g * 4 + hh) * 129, (at::bf16*)(wsp_(F) + WS_OUTA) + (size_t)g * S_ * 512, (float*)(wsp_(F) + WS_LSE) + (size_t)g * S_ * 4,
                         d, gh, hh, r, qb * 256, (char*)F.ldsg + RING_OFF);
    }
}

__device__ __forceinline__ void p3_attn_combine(Frame& F) {
    const at::bf16* QBR = (const at::bf16*)(wsp_(F) + WS_QBR); const at::bf16* KBR = (const at::bf16*)(wsp_(F) + WS_KBR); const at::bf16* VBR = (const at::bf16*)(wsp_(F) + WS_VBR);
    unsigned char* YB = wsp_(F) + WS_YB;
    const bool conv_first = (((int)blockIdx.x >> 3) & 1) != 0;
#define P3_ATTN_UNITS() do { for (int u = blockIdx.x; u < 256; u += F.G) { const int h = u & 7, qb = u >> 3, kv = h >> 2; \
        at::attn_dense_body8<1024, 256, 1024>(wsp_(F) + WS_Q8 + (size_t)qb * 256 * 1024 + h * 128, wsp_(F) + WS_K8 + kv * 128, wsp_(F) + WS_VIMG + (size_t)kv * 128 * 8192, YB + (size_t)qb * 256 * 1024 + h * 128, S_, (char*)F.ldsg + RING_OFF); \
        __syncthreads(); } } while (0)
    if (!conv_first) P3_ATTN_UNITS();
    moe_convert_share(F); __syncthreads();
    if (conv_first) P3_ATTN_UNITS();
#undef P3_ATTN_UNITS
    if (MK_CHECK8) for (int u = blockIdx.x; u < 256; u += F.G) { const int h = u & 7, qb = u >> 3, kv = h >> 2;
        at::attn_dense_body<1024, 256, 256, 1024>(QBR + (size_t)qb * 256 * 1024 + h * 128, KBR + kv * 128, VBR + kv * 128, wsp_(F) + WS_DBG + (size_t)qb * 256 * 1024 + h * 128, S_, (char*)F.ldsg + RING_OFF); __syncthreads(); }
    const bf16* OUTA = (const bf16*)(wsp_(F) + WS_OUTA); const float* LSE = (const float*)(wsp_(F) + WS_LSE); bf16* YA = (bf16*)(wsp_(F) + WS_YA);
    for (int tb = blockIdx.x; tb < 256; tb += F.G) {
        const int t = tb * 32 + (F.tid >> 4), c0 = (F.tid & 15) * 32, hh = c0 >> 7;
        const float l0 = LSE[(size_t)t * 4 + hh], l1 = LSE[(size_t)(S_ + t) * 4 + hh], l2 = LSE[(size_t)(2 * S_ + t) * 4 + hh];
        const float m = fmaxf(l0, fmaxf(l1, l2)); float w0 = __expf(l0 - m), w1 = __expf(l1 - m), w2 = __expf(l2 - m); const float inv = 16.0f / (w0 + w1 + w2); w0 *= inv; w1 *= inv; w2 *= inv;
#pragma unroll
        for (int q = 0; q < 4; ++q) { const size_t o = (size_t)t * 512 + c0 + q * 8;
            const v4u a = *(const v4u*)(OUTA + o), b = *(const v4u*)(OUTA + (size_t)S_ * 512 + o), c = *(const v4u*)(OUTA + (size_t)2 * S_ * 512 + o);
            v2u w;
            w.x = pk4_fp8(w0 * bflo(a.x) + w1 * bflo(b.x) + w2 * bflo(c.x), w0 * bfhi(a.x) + w1 * bfhi(b.x) + w2 * bfhi(c.x), w0 * bflo(a.y) + w1 * bflo(b.y) + w2 * bflo(c.y), w0 * bfhi(a.y) + w1 * bfhi(b.y) + w2 * bfhi(c.y));
            w.y = pk4_fp8(w0 * bflo(a.z) + w1 * bflo(b.z) + w2 * bflo(c.z), w0 * bfhi(a.z) + w1 * bfhi(b.z) + w2 * bfhi(c.z), w0 * bflo(a.w) + w1 * bflo(b.w) + w2 * bflo(c.w), w0 * bfhi(a.w) + w1 * bfhi(b.w) + w2 * bfhi(c.w));
            *(v2u*)((unsigned char*)YA + o) = w; }
    }
}

typedef float f32x16m __attribute__((ext_vector_type(16)));
__device__ __forceinline__ void p6_ln_router(Frame& F, const int bank = 0) {
    LAS int* cntl = (LAS int*)(F.lds + L_CNT); LAS int* basel = cntl + 32;
    LAS int* asg_e = (LAS int*)(F.lds + L_ASG); LAS int* asg_lr = asg_e + 128; LAS float* asg_w = (LAS float*)(asg_lr + 128);
    LAS float* x1s = (LAS float*)(F.lds + RING_OFF);
    LAS float* red = (LAS float*)(F.lds + RING_OFF + 73728);
    const float* Z1 = (const float*)(wsp_(F) + WS_T1); bf16* X1 = (bf16*)(wsp_(F) + WS_X1); unsigned char* X1Q = wsp_(F) + WS_X1B;
    const f32x4* G4 = (const f32x4*)inp(F, 9); const f32x4* B4 = (const f32x4*)inp(F, 10);
    const float* wr = inp(F, 11); const float* br = inp(F, 12);
    unsigned* gcnt = ((unsigned*)(wsp_(F) + WS_CTL)) + CW_CNT + bank * 64;
    int* TOKE = (int*)(wsp_(F) + (bank ? WS_H : WS_TOKE)); int* TOKR = (int*)(wsp_(F) + (bank ? WS_H + MiB : WS_TOKR)); float* TOKW = (float*)(wsp_(F) + (bank ? WS_H + 2 * MiB : WS_TOKW));
    const int li = F.lane & 31, kk = F.lane >> 5;
    for (int tb = blockIdx.x; tb < 256; tb += F.G) {
        if (F.tid < 32) cntl[F.tid] = 0;
        const int t0 = tb * 32 + F.wave * 4;
        f32x4 xv[4][8];
#pragma unroll
        for (int tk = 0; tk < 4; ++tk) {
            const f32x4* zr = (const f32x4*)(Z1 + (size_t)(t0 + tk) * DM) + F.lane;
#pragma unroll
            for (int j = 0; j < 8; ++j) xv[tk][j] = zr[64 * j];
            float s = 0.f;
#pragma unroll
            for (int j = 0; j < 8; ++j) s += (xv[tk][j][0] + xv[tk][j][1]) + (xv[tk][j][2] + xv[tk][j][3]);
            const float mean = wave_sum(s) * (1.0f / DM); float s2 = 0.f;
#pragma unroll
            for (int j = 0; j < 8; ++j) { xv[tk][j] = xv[tk][j] - mean; s2 += (xv[tk][j][0] * xv[tk][j][0] + xv[tk][j][1] * xv[tk][j][1]) + (xv[tk][j][2] * xv[tk][j][2] + xv[tk][j][3] * xv[tk][j][3]); }
            const float rstd = 1.0f / sqrtf(wave_sum(s2) * (1.0f / DM) + LN_EPS);
            v2u* xo = (v2u*)(X1 + (size_t)(t0 + tk) * DM) + F.lane; unsigned* xb = (unsigned*)(X1Q + (size_t)(t0 + tk) * DM) + F.lane;
#pragma unroll
            for (int j = 0; j < 8; ++j) { const f32x4 v = xv[tk][j] * rstd * G4[64 * j + F.lane] + B4[64 * j + F.lane]; xv[tk][j] = v;
                v2u w; w.x = pk2(v[0], v[1]); w.y = pk2(v[2], v[3]); xo[64 * j] = w; xb[64 * j] = pk4_fp8(v[0], v[1], v[2], v[3]); }
            asm volatile("" ::: "memory"); __builtin_amdgcn_sched_barrier(0);
        }
        f32x16m acc = {0.f, 0.f, 0.f, 0.f, 0.f, 0.f, 0.f, 0.f, 0.f, 0.f, 0.f, 0.f, 0.f, 0.f, 0.f, 0.f};
        const float* wp = wr + (size_t)(32 * F.wave + 4 * kk) * 32 + li;
#pragma unroll
        for (int c = 0; c < 8; ++c) {
            LAS float* buf = x1s + (c & 1) * (32 * 260);
#pragma unroll
            for (int tk = 0; tk < 4; ++tk) *(LAS f32x4*)(buf + (4 * F.wave + tk) * 260 + 4 * F.lane) = xv[tk][c];
            __syncthreads();
#pragma unroll
            for (int b = 0; b < 4; ++b) {
                const f32x4 a4 = *(const LAS f32x4*)(buf + li * 260 + 32 * F.wave + 8 * b + 4 * kk);
                asm volatile("" : "+v"(wp));
                const float b0 = wp[0], b1 = wp[32], b2 = wp[64], b3 = wp[96]; wp += (b == 3) ? (256 - 24) * 32 : 8 * 32;
                acc = __builtin_amdgcn_mfma_f32_32x32x2f32(a4[0], b0, acc, 0, 0, 0);
                acc = __builtin_amdgcn_mfma_f32_32x32x2f32(a4[1], b1, acc, 0, 0, 0);
                acc = __builtin_amdgcn_mfma_f32_32x32x2f32(a4[2], b2, acc, 0, 0, 0);
                acc = __builtin_amdgcn_mfma_f32_32x32x2f32(a4[3], b3, acc, 0, 0, 0);
            }
            __builtin_amdgcn_sched_barrier(0);
        }
#pragma unroll
        for (int r = 0; r < 16; ++r) red[(F.wave * 32 + ((r & 3) + 8 * (r >> 2) + 4 * kk)) * 32 + li] = acc[r];
        __syncthreads();
#pragma unroll
        for (int tk = 0; tk < 4; ++tk) {
            float v = -3.0e38f;
            if (F.lane < 32) { float sres = br[F.lane];
#pragma unroll
                for (int w8 = 0; w8 < 8; ++w8) sres += red[(w8 * 32 + 4 * F.wave + tk) * 32 + F.lane];
                v = sres; }
            float tv[4]; int ti[4];
#pragma unroll
            for (int k = 0; k < 4; ++k) { float bv = v; int bi = F.lane;
#pragma unroll
                for (int o = 1; o < 64; o <<= 1) { const float ov = __shfl_xor(bv, o); const int oi = __shfl_xor(bi, o); if (ov > bv || (ov == bv && oi < bi)) { bv = ov; bi = oi; } }
                tv[k] = bv; ti[k] = bi; if (F.lane == bi) v = -3.0e38f; }
            const float e1 = __expf(tv[1] - tv[0]), e2 = __expf(tv[2] - tv[0]), e3 = __expf(tv[3] - tv[0]); const float inv = 1.0f / (1.0f + e1 + e2 + e3);
            if (F.lane < 4) { const int me = F.lane == 0 ? ti[0] : (F.lane == 1 ? ti[1] : (F.lane == 2 ? ti[2] : ti[3]));
                const float mw = (F.lane == 0 ? 1.0f : (F.lane == 1 ? e1 : (F.lane == 2 ? e2 : e3))) * inv;
                const int lr = atomicAdd((int*)(cntl + me), 1);
                const int a = (F.wave * 4 + tk) * 4 + F.lane; asg_e[a] = me; asg_lr[a] = lr; asg_w[a] = mw; }
        }
        __syncthreads();
        if (F.tid < 32) basel[F.tid] = (int)atomicAdd(gcnt + F.tid, (unsigned)cntl[F.tid]);
        __syncthreads();
        if (F.tid < 128) { const int a = tb * 128 + F.tid; const int e = asg_e[F.tid]; TOKE[a] = e; TOKR[a] = basel[e] + asg_lr[F.tid]; TOKW[a] = asg_w[F.tid]; }
        __syncthreads();
    }
}

__device__ __forceinline__ void p7_gather(Frame& F) {
    LAS int* pst = (LAS int*)(F.lds + L_PST);
    const unsigned* gcnt = ((unsigned*)(wsp_(F) + WS_CTL)) + CW_CNT;
    if (F.tid == 0) { int acc = 0; for (int e = 0; e < 32; ++e) { pst[e] = acc; acc += ((int)gcnt[e] + 255) & ~255; } pst[32] = acc; }
    __syncthreads();
    const int* TOKE = (const int*)(wsp_(F) + WS_TOKE); const int* TOKR = (const int*)(wsp_(F) + WS_TOKR); const float* TOKW = (const float*)(wsp_(F) + WS_TOKW);
    int* TOKS = (int*)(wsp_(F) + WS_TOKS); float* SLOTW = (float*)(wsp_(F) + WS_SLOTW);
    const bf16* X1B = (const bf16*)(wsp_(F) + WS_X1B); bf16* XS = (bf16*)(wsp_(F) + WS_XS);
    const int gw = blockIdx.x * 8 + F.wave, NGW = F.G * 8;
    for (int a0 = gw; a0 < S_ * TOPK; a0 += 4 * NGW) {
        int slot[4]; float w[4]; v4u r0[4], r1[4];
#pragma unroll
        for (int q = 0; q < 4; ++q) { const int a = a0 + q * NGW; const int ac = a < S_ * TOPK ? a : a0; slot[q] = pst[TOKE[ac]] + TOKR[ac]; w[q] = TOKW[ac]; }
#pragma unroll
        for (int q = 0; q < 4; ++q) { const int a = a0 + q * NGW; const int ac = a < S_ * TOPK ? a : a0; const v4u* src = (const v4u*)((const unsigned char*)X1B + (size_t)(ac >> 2) * DM) + F.lane; r0[q] = src[0]; r1[q] = src[64]; }
#pragma unroll
        for (int q = 0; q < 4; ++q) { const int a = a0 + q * NGW; if (a < S_ * TOPK) { if (F.lane == 0) { TOKS[a] = slot[q]; SLOTW[slot[q]] = w[q]; }
            v4u* dst = (v4u*)((unsigned char*)XS + (size_t)slot[q] * DM) + F.lane; dst[0] = r0[q]; dst[64] = r1[q]; } }
    }
}
__device__ __forceinline__ int moe_tiles(Frame& F) {
    LAS int* tile_e = (LAS int*)(F.lds + L_TILE);
    const unsigned* gcnt = ((unsigned*)(wsp_(F) + WS_CTL)) + CW_CNT;
    __syncthreads();
    if (F.tid == 0) { int ti = 0; for (int e = 0; e < 32; ++e) { const int nt = ((int)gcnt[e] + 255) >> 8; for (int k = 0; k < nt && ti < 160; ++k) tile_e[ti++] = e; } tile_e[160] = ti; }
    __syncthreads();
    return tile_e[160];
}

__device__ __forceinline__ void p10_final(Frame& F) {
    const bf16* X1 = (const bf16*)(wsp_(F) + WS_X1); const bf16* YS = (const bf16*)(wsp_(F) + WS_YS); const int* TOKS = (const int*)(wsp_(F) + WS_TOKS);
    const f32x4* G4 = (const f32x4*)inp(F, 19); const f32x4* B4 = (const f32x4*)inp(F, 20);
    float* outp = (float*)inp(F, 21);
    const int gw = blockIdx.x * 8 + F.wave, NGW = F.G * 8;
    for (int t0 = gw; t0 < S_; t0 += 2 * NGW) {
        f32x4 v[2][8]; int tt[2]; int sl[2][4];
#pragma unroll
        for (int q = 0; q < 2; ++q) { const int t = t0 + q * NGW; tt[q] = t < S_ ? t : t0; }
#pragma unroll
        for (int q = 0; q < 2; ++q)
#pragma unroll
            for (int k = 0; k < 4; ++k) sl[q][k] = TOKS[tt[q] * 4 + k];
#pragma unroll
        for (int q = 0; q < 2; ++q) {
            const v4u* xr = (const v4u*)(X1 + (size_t)tt[q] * DM) + F.lane;
            const v4u* y0 = (const v4u*)(YS + (size_t)sl[q][0] * DM) + F.lane; const v4u* y1 = (const v4u*)(YS + (size_t)sl[q][1] * DM) + F.lane;
            const v4u* y2 = (const v4u*)(YS + (size_t)sl[q][2] * DM) + F.lane; const v4u* y3 = (const v4u*)(YS + (size_t)sl[q][3] * DM) + F.lane;
#pragma unroll
            for (int jj = 0; jj < 4; ++jj) { const v4u x = xr[64 * jj], a = y0[64 * jj], b = y1[64 * jj], c = y2[64 * jj], d = y3[64 * jj];
#define P10_LO(W) (bflo(x.W) * ALPHA + ((bflo(a.W) + bflo(b.W)) + (bflo(c.W) + bflo(d.W))))
#define P10_HI(W) (bfhi(x.W) * ALPHA + ((bfhi(a.W) + bfhi(b.W)) + (bfhi(c.W) + bfhi(d.W))))
                v[q][2 * jj] = (f32x4){P10_LO(x), P10_HI(x), P10_LO(y), P10_HI(y)}; v[q][2 * jj + 1] = (f32x4){P10_LO(z), P10_HI(z), P10_LO(w), P10_HI(w)};
#undef P10_LO
#undef P10_HI
            }
        }
#pragma unroll
        for (int q = 0; q < 2; ++q) {
            float s = 0.f;
#pragma unroll
            for (int j = 0; j < 8; ++j) s += (v[q][j][0] + v[q][j][1]) + (v[q][j][2] + v[q][j][3]);
            const float mean = wave_sum(s) * (1.0f / DM); float s2 = 0.f;
#pragma unroll
            for (int j = 0; j < 8; ++j) { v[q][j] = v[q][j] - mean; s2 += (v[q][j][0] * v[q][j][0] + v[q][j][1] * v[q][j][1]) + (v[q][j][2] * v[q][j][2] + v[q][j][3] * v[q][j][3]); }
            const float rstd = 1.0f / sqrtf(wave_sum(s2) * (1.0f / DM) + LN_EPS);
            if (t0 + q * NGW < S_) { f32x4* o = (f32x4*)(outp + (size_t)tt[q] * DM) + 2 * F.lane;
#pragma unroll
                for (int jj = 0; jj < 4; ++jj) { o[128 * jj] = v[q][2 * jj] * rstd * G4[128 * jj + 2 * F.lane] + B4[128 * jj + 2 * F.lane];
                    o[128 * jj + 1] = v[q][2 * jj + 1] * rstd * G4[128 * jj + 2 * F.lane + 1] + B4[128 * jj + 2 * F.lane + 1]; } }
        }
    }
}

struct Args { const float* in[21]; float* out; unsigned char* ws; int ph_lo, ph_hi; };
__global__ void __launch_bounds__(512, 2) mk_fwd(Args args) {
    extern __shared__ __attribute__((aligned(16))) unsigned char lds[];
    Frame F;
    F.lds = (LAS unsigned char*)lds; F.ldsg = lds;
    F.tid = threadIdx.x; F.lane = F.tid & 63; F.wave = __builtin_amdgcn_readfirstlane(F.tid >> 6); F.G = gridDim.x;
    if (F.tid == 0) { LAS unsigned long long* pp = (LAS unsigned long long*)(F.lds + L_PTR);
#pragma unroll
        for (int i = 0; i < 21; ++i) pp[i] = (unsigned long long)args.in[i];
        pp[21] = (unsigned long long)args.out; pp[22] = (unsigned long long)args.ws; }
    if (F.tid < 4) ((LAS unsigned*)(F.lds + L_XB))[F.tid] = 0u;
    __syncthreads();
    const int lo = args.ph_lo, hi = args.ph_hi;
    XcdBarrier bar; bar.bar = ((unsigned*)(wsp_(F) + WS_CTL)) + CW_BAR; bar.x = 0; bar.st = (volatile LAS unsigned*)(F.lds + L_XB);
    if (hi - lo > 1) bar = xcd_barrier_post(((unsigned*)(wsp_(F) + WS_CTL)) + CW_BAR, (volatile LAS unsigned*)(F.lds + L_XB));
#ifndef MK_PHASE_MASK
#define MK_PHASE_MASK 0x7ff
#endif
#define IN(k) (((MK_PHASE_MASK >> (k)) & 1) && lo <= (k) && (k) < hi)
#ifndef MK_DUP_MASK
#define MK_DUP_MASK 0
#endif
#define REP(k) for (int rep_ = 0; rep_ < 1 + ((MK_DUP_MASK >> (k)) & 1); ++rep_)
#ifndef MK_BAR2
#define MK_BAR2 0
#endif
#ifndef MK_STAMP_IDX
#define MK_STAMP_IDX -1
#endif
    unsigned long long st0_ = 0ull, stk_ = 0ull;
    if (MK_STAMP_IDX >= 0) st0_ = __builtin_amdgcn_s_memrealtime();
#define SEAM(k) do { if (IN(k) && IN((k) + 1)) { xcd_barrier(bar); if (MK_BAR2) xcd_barrier(bar); if (MK_STAMP_IDX == (k) + 1) stk_ = __builtin_amdgcn_s_memrealtime(); } } while (0)
    LAS unsigned char* ring = F.lds + RING_OFF;
    const pg8::bf16_t* XB = (const pg8::bf16_t*)(wsp_(F) + WS_XB);

    if (IN(0)) REP(0) { p0_prologue(F); }
    SEAM(0);
    if (IN(1)) REP(1) {
        pg8::Gemm g{XB, (const pg8::bf16_t*)(wsp_(F) + WS_WIN), S_, INW, DM / 2}; pg8::StaticOrder S; S.init(S_, INW, F.G, (int)blockIdx.x);
        pg8::EpiStoreBf16 E{(pg8::bf16_t*)(wsp_(F) + WS_PROJ), INW, 1.0f / 64.0f};
        pg8::gemm_phase<pg8::EpiStoreBf16, pg8::StaticOrder, true, true, true, true>(ring, g, S, E);
    }
    SEAM(1);
    if (IN(2)) { p2_prep_dilated(F); if ((MK_DUP_MASK >> 2) & 1) p2_prep_dilated(F); }
    SEAM(2);
    if (IN(3)) REP(3) { p3_attn_combine(F); }
    SEAM(3);
#define PHASE4_BODY { \
        { pg8::Gemm g{(const pg8::bf16_t*)(wsp_(F) + WS_YA), (const pg8::bf16_t*)(wsp_(F) + WS_WA), S_, DM, 256}; pg8::StaticOrder S; S.init(S_, DM, F.G, (int)blockIdx.x); \
          pg8::EpiGateA E{(const pg8::bf16_t*)(wsp_(F) + WS_PROJ), INW, GATE_OFF, inp(F, 2), (float*)(wsp_(F) + WS_T1), DM, 1.0f / 512.0f}; \
          pg8::gemm_phase<pg8::EpiGateA, pg8::StaticOrder, true, true, true, true>(ring, g, S, E); } \
        { pg8::Gemm g{(const pg8::bf16_t*)(wsp_(F) + WS_YB), (const pg8::bf16_t*)(wsp_(F) + WS_WB), S_, DM, 512}; pg8::StaticOrder S; S.init(S_, DM, F.G, (int)blockIdx.x); \
          pg8::EpiGateB E{(const pg8::bf16_t*)(wsp_(F) + WS_PROJ), INW, GATE_OFF + DM, inp(F, 2) + DM, (const float*)(wsp_(F) + WS_T1), wsp_(F) + WS_Y, DM, 1.0f / 2048.0f}; \
          pg8::gemm_phase<pg8::EpiGateB, pg8::StaticOrder, true, true, true, true>(ring, g, S, E); } \
    }
    if (MK_CHECK8 && IN(4)) {
        const unsigned* a32 = (const unsigned*)(wsp_(F) + WS_YB); const unsigned* b32 = (const unsigned*)(wsp_(F) + WS_DBG); float num = 0.f, den = 0.f;
        for (int i = blockIdx.x * 512 + F.tid; i < S_ * 1024 / 4; i += F.G * 512) { const unsigned a = a32[i], b = b32[i];
            for (int q = 0; q < 4; ++q) { const float fa = __builtin_amdgcn_cvt_f32_fp8((int)(a >> (8 * q)), 0), fb = __builtin_amdgcn_cvt_f32_fp8((int)(b >> (8 * q)), 0); num += fabsf(fa - fb); den += fabsf(fb); } }
        num = wave_sum(num); den = wave_sum(den);
        if (F.lane == 0) { atomicAdd((float*)(((unsigned*)(wsp_(F) + WS_CTL)) + 4224), num); atomicAdd((float*)(((unsigned*)(wsp_(F) + WS_CTL)) + 4225), den); }
    }
    if (IN(4)) { PHASE4_BODY if ((MK_DUP_MASK >> 4) & 1) PHASE4_BODY }
    SEAM(4);
    if (IN(5)) REP(5) {
        pg8::Gemm g{(const pg8::bf16_t*)(wsp_(F) + WS_Y), (const pg8::bf16_t*)(wsp_(F) + WS_WO), S_, DM, DM / 2}; pg8::StaticOrder S; S.init(S_, DM, F.G, (int)blockIdx.x);
        pg8::EpiResF32 E{inp(F, 0), (float*)(wsp_(F) + WS_T1), DM, ALPHA, 1.0f / 4096.0f};
        pg8::gemm_phase<pg8::EpiResF32, pg8::StaticOrder, true, true, true, true>(ring, g, S, E);
    }
    SEAM(5);
    if (IN(6)) { p6_ln_router(F); if ((MK_DUP_MASK >> 6) & 1) p6_ln_router(F, 1); }
    SEAM(6);
    if (IN(7)) REP(7) { p7_gather(F); }
    SEAM(7);
    if (IN(8)) REP(8) {
        const int nt = moe_tiles(F);
        pg8::Gemm g{(const pg8::bf16_t*)(wsp_(F) + WS_XS), (const pg8::bf16_t*)(wsp_(F) + WS_WGL), nt * 256, 4096, DM / 2};
        pg8::MoeOrder S; S.init(nt * 256, 4096, F.G, (int)blockIdx.x); S.tile_e = (const LAS int*)(F.lds + L_TILE); S.estride = (size_t)4096 * 2048;
        pg8::EpiSwiglu E{(const LAS int*)(F.lds + L_TILE), inp(F, 14), inp(F, 16), wsp_(F) + WS_H, DM, 1.0f / 64.0f};
        pg8::gemm_phase<pg8::EpiSwiglu, pg8::MoeOrder, true, true, true, true>(ring, g, S, E);
    }
    SEAM(8);
    if (IN(9)) REP(9) {
        const int nt = moe_tiles(F);
        pg8::Gemm g{(const pg8::bf16_t*)(wsp_(F) + WS_H), (const pg8::bf16_t*)(wsp_(F) + WS_WD), nt * 256, DM, DM / 2};
        pg8::MoeOrder S; S.init(nt * 256, DM, F.G, (int)blockIdx.x); S.tile_e = (const LAS int*)(F.lds + L_TILE); S.estride = (size_t)2048 * 2048;
        pg8::EpiDown E{(const LAS int*)(F.lds + L_TILE), inp(F, 18), (const float*)(wsp_(F) + WS_SLOTW), (pg8::bf16_t*)(wsp_(F) + WS_YS), DM, 1.0f / 64.0f};
        pg8::gemm_phase<pg8::EpiDown, pg8::MoeOrder, true, true, true, true>(ring, g, S, E);
    }
    SEAM(9);
    if (IN(10)) REP(10) { p10_final(F); }
    if (MK_CHECK8 && IN(10)) {
        const float num = *(const float*)(((unsigned*)(wsp_(F) + WS_CTL)) + 4224), den = *(const float*)(((unsigned*)(wsp_(F) + WS_CTL)) + 4225);
        if (!(num <= MK_CHK_TOL * den) || !(den > 0.f)) { float* o = (float*)inp(F, 21); __syncthreads(); for (int i = blockIdx.x * 512 + F.tid; i < S_ * DM; i += F.G * 512) o[i] = __builtin_nanf(""); }
    }
    if (MK_STAMP_IDX >= 0 && blockIdx.x == 0 && F.tid == 0) {
        const unsigned long long te = __builtin_amdgcn_s_memrealtime(), dt = stk_ - st0_;
        while (__builtin_amdgcn_s_memrealtime() - te < dt) __builtin_amdgcn_s_sleep(8);
    }
#undef IN
#undef SEAM
}

#ifndef MK_CUTS
#define MK_CUTS 0
#endif
extern "C" void kernel_launch(void* const* d_in, const int* in_sizes, int n_in, void* d_out, int out_size, void* d_ws, size_t ws_size, hipStream_t stream) {
    static int grid = 0;
    if (grid == 0) {
        if (n_in != 21 || out_size != S_ * DM || ws_size < WS_END) { fprintf(stderr, "kernel_launch: unexpected shapes (n_in %d out %d ws %zu, need %zu)\n", n_in, out_size, ws_size, (size_t)WS_END); grid = -1; return; }
        int dev = 0, cus = 0, per_cu = 0;
        if (hipGetDevice(&dev) != hipSuccess || hipDeviceGetAttribute(&cus, hipDeviceAttributeMultiprocessorCount, dev) != hipSuccess) { grid = -1; return; }
        if (hipFuncSetAttribute((const void*)mk_fwd, hipFuncAttributeMaxDynamicSharedMemorySize, LDS_BYTES) != hipSuccess) { fprintf(stderr, "kernel_launch: hipFuncSetAttribute failed\n"); grid = -1; return; }
        if (hipOccupancyMaxActiveBlocksPerMultiprocessor(&per_cu, (const void*)mk_fwd, 512, LDS_BYTES) != hipSuccess || per_cu < 1) { fprintf(stderr, "kernel_launch: occupancy query says %d\n", per_cu); per_cu = 1; }
        (void)hipGetLastError();
        grid = cus;
    }
    if (grid < 0) return;
    (void)hipMemsetAsync((char*)d_ws + WS_CTL, 0, CTL_ZERO_BYTES, stream);
    Args a{};
    for (int i = 0; i < 21; ++i) a.in[i] = (const float*)d_in[i];
    a.out = (float*)d_out; a.ws = (unsigned char*)d_ws;
#if MK_CUTS
    for (int p = 0; p < NPH; ++p) { a.ph_lo = p; a.ph_hi = p + 1; hipLaunchKernelGGL(mk_fwd, dim3(grid), dim3(512), LDS_BYTES, stream, a); }
#else
    a.ph_lo = 0; a.ph_hi = NPH; hipLaunchKernelGGL(mk_fwd, dim3(grid), dim3(512), LDS_BYTES, stream, a);
#endif
}
```

```cpp
#include <hip/hip_runtime.h>
#include <hip/hip_bf16.h>
#include <cstdio>
#include <cstdint>
#define MK_CUTS 0
namespace pg8 {
#define PG8_LAS __attribute__((address_space(3)))
typedef unsigned short bf16_t;
typedef short bf16x8 __attribute__((ext_vector_type(8)));
typedef float f32x4 __attribute__((ext_vector_type(4)));
typedef unsigned u32x4 __attribute__((ext_vector_type(4)));
constexpr int BM = 256, BK = 64, HALF = 128, HTB = HALF * BK * 2  , STAGE_BYTES = 8 * HTB, NXCD = 8, WGM = 8;

__host__ __device__ __forceinline__ int lds_byte(int r, int c) { const int st = (r >> 4) * 2 + (c >> 5), rr = r & 15, cc = c & 31, ob = rr * 64 + cc * 2; return st * 1024 + (ob ^ (((ob >> 9) & 1) << 5)); }
__host__ __device__ __forceinline__ void stage_rc(int b, int& R, int& C) { const int st = b / 1024, sb = b % 1024, swz = sb ^ (((sb >> 9) & 1) << 5); R = (st >> 1) * 16 + swz / 64; C = (st & 1) * 32 + (swz % 64) / 2; }
__host__ __device__ __forceinline__ int perm32(int rho) { const int n = rho >> 4, i = rho & 15; return 8 * (i >> 2) + 4 * n + (i & 3); }

struct Unit { int pm, pn; };
struct Gemm { const bf16_t* A; const bf16_t* Bt; int M, N, K; };

struct StaticOrder {
    int nM, nN, nwg, G, c;
    __host__ __device__ void init(int M, int N, int G_, int c_) { nM = M / BM; nN = N / BM; nwg = nM * nN; G = G_; c = c_; }
    __host__ __device__ bool next(int i, Unit& u) const {
        const long L = (long)i * G + c; if (L >= nwg) return false;
        int wgid = (int)L; { const int q = nwg / NXCD, r = nwg % NXCD, xcd = wgid % NXCD, off = wgid / NXCD; wgid = (xcd < r ? xcd * (q + 1) : r * (q + 1) + (xcd - r) * q) + off; }
        const int nig = WGM * nN, gid = wgid / nig, fm = gid * WGM, gsz = (nM - fm) < WGM ? (nM - fm) : WGM;
        u.pm = fm + ((wgid % nig) % gsz); u.pn = (wgid % nig) / gsz; return true;
    }
    __device__ __forceinline__ void a_ready(const Unit&) const {}
    __device__ __forceinline__ size_t b_off(const Unit&) const { return 0; }
    __device__ __forceinline__ void done(const Unit&) const {}
};


typedef unsigned u32x2 __attribute__((ext_vector_type(2)));
__device__ __forceinline__ unsigned cvt_pk_bf16(float lo, float hi) { unsigned r; asm volatile("v_cvt_pk_bf16_f32 %0, %1, %2" : "=v"(r) : "v"(lo), "v"(hi)); return r; }
__device__ __forceinline__ unsigned pk4_fp8_(float a, float b, float c, float d) { int w = __builtin_amdgcn_cvt_pk_fp8_f32(a, b, 0, false); w = __builtin_amdgcn_cvt_pk_fp8_f32(c, d, w, true); return (unsigned)w; }
__device__ __forceinline__ float bf_lo(unsigned w) { return __builtin_bit_cast(float, w << 16); }
__device__ __forceinline__ float bf_hi(unsigned w) { return __builtin_bit_cast(float, w & 0xffff0000u); }
__device__ __forceinline__ float sigmoidf_(float v) { return __builtin_amdgcn_rcpf(1.0f + __expf(-v)); }

struct EpiStoreBf16 {
    static constexpr bool PERM = true, AFTER_DRAIN = false;
    bf16_t* O; int ldc; float sc;
    __device__ __forceinline__ void operator()(const f32x4 (&acc)[2][2][4][2], const Unit& u, int wr, int wc, int fr, int fq) const {
        const int row0 = u.pm * BM + wr * 64 + fr, col0 = u.pn * BM + wc * 32 + 8 * fq;
#pragma unroll
        for (int ai = 0; ai < 2; ++ai)
#pragma unroll
            for (int m = 0; m < 4; ++m) { bf16_t* rowp = O + (size_t)(row0 + ai * HALF + m * 16) * ldc + col0;
#pragma unroll
                for (int bj = 0; bj < 2; ++bj) { const f32x4 v0 = acc[ai][bj][m][0] * sc, v1 = acc[ai][bj][m][1] * sc;
                    u32x4 w; w.x = cvt_pk_bf16(v0[0], v0[1]); w.y = cvt_pk_bf16(v0[2], v0[3]); w.z = cvt_pk_bf16(v1[0], v1[1]); w.w = cvt_pk_bf16(v1[2], v1[3]);
                    *(u32x4*)(rowp + bj * HALF) = w; } }
    }
};

struct EpiGateA {
    static constexpr bool PERM = true, AFTER_DRAIN = false;
    const bf16_t* proj; int ldp; int gcol0; const float* bg; float* T1; int ldc; float sc;
    __device__ __forceinline__ void operator()(const f32x4 (&acc)[2][2][4][2], const Unit& u, int wr, int wc, int fr, int fq) const {
        const int row0 = u.pm * BM + wr * 64 + fr, col0 = u.pn * BM + wc * 32 + 8 * fq;
#pragma unroll
        for (int ai = 0; ai < 2; ++ai)
#pragma unroll
            for (int m = 0; m < 4; ++m) { const int row = row0 + ai * HALF + m * 16;
#pragma unroll
                for (int bj = 0; bj < 2; ++bj) { const int c = col0 + bj * HALF;
                    const u32x4 gw = *(const u32x4*)(proj + (size_t)row * ldp + gcol0 + c);
                    const f32x4 b0 = *(const f32x4*)(bg + c), b1 = *(const f32x4*)(bg + c + 4);
                    f32x4 g0, g1;
                    g0[0] = sigmoidf_(bf_lo(gw.x) + b0[0]); g0[1] = sigmoidf_(bf_hi(gw.x) + b0[1]); g0[2] = sigmoidf_(bf_lo(gw.y) + b0[2]); g0[3] = sigmoidf_(bf_hi(gw.y) + b0[3]);
                    g1[0] = sigmoidf_(bf_lo(gw.z) + b1[0]); g1[1] = sigmoidf_(bf_hi(gw.z) + b1[1]); g1[2] = sigmoidf_(bf_lo(gw.w) + b1[2]); g1[3] = sigmoidf_(bf_hi(gw.w) + b1[3]);
                    float* o = T1 + (size_t)row * ldc + c;
                    *(f32x4*)o = acc[ai][bj][m][0] * sc * g0; *(f32x4*)(o + 4) = acc[ai][bj][m][1] * sc * g1; } }
    }
};
struct EpiGateB {
    static constexpr bool PERM = true, AFTER_DRAIN = false;
    const bf16_t* proj; int ldp; int gcol0; const float* bg; const float* T1; unsigned char* Y; int ldc; float sc;
    __device__ __forceinline__ void operator()(const f32x4 (&acc)[2][2][4][2], const Unit& u, int wr, int wc, int fr, int fq) const {
        const int row0 = u.pm * BM + wr * 64 + fr, col0 = u.pn * BM + wc * 32 + 8 * fq;
#pragma unroll
        for (int ai = 0; ai < 2; ++ai)
#pragma unroll
            for (int m = 0; m < 4; ++m) { const int row = row0 + ai * HALF + m * 16;
#pragma unroll
                for (int bj = 0; bj < 2; ++bj) { const int c = col0 + bj * HALF;
                    const u32x4 gw = *(const u32x4*)(proj + (size_t)row * ldp + gcol0 + c);
                    const f32x4 b0 = *(const f32x4*)(bg + c), b1 = *(const f32x4*)(bg + c + 4);
                    const float* tp = T1 + (size_t)row * ldc + c;
                    const f32x4 t0 = *(const f32x4*)tp, t1 = *(const f32x4*)(tp + 4);
                    f32x4 g0, g1;
                    g0[0] = sigmoidf_(bf_lo(gw.x) + b0[0]); g0[1] = sigmoidf_(bf_hi(gw.x) + b0[1]); g0[2] = sigmoidf_(bf_lo(gw.y) + b0[2]); g0[3] = sigmoidf_(bf_hi(gw.y) + b0[3]);
                    g1[0] = sigmoidf_(bf_lo(gw.z) + b1[0]); g1[1] = sigmoidf_(bf_hi(gw.z) + b1[1]); g1[2] = sigmoidf_(bf_lo(gw.w) + b1[2]); g1[3] = sigmoidf_(bf_hi(gw.w) + b1[3]);
                    const f32x4 v0 = (t0 + acc[ai][bj][m][0] * sc * g0) * 64.0f, v1 = (t1 + acc[ai][bj][m][1] * sc * g1) * 64.0f;
                    u32x2 w; w.x = pk4_fp8_(v0[0], v0[1], v0[2], v0[3]); w.y = pk4_fp8_(v1[0], v1[1], v1[2], v1[3]);
                    *(u32x2*)(Y + (size_t)row * ldc + c) = w; } }
    }
};
struct EpiResF32 {
    static constexpr bool PERM = false, AFTER_DRAIN = false;
    const float* X; float* Z; int ldc; float alpha; float sc;
    __device__ __forceinline__ void operator()(const f32x4 (&acc)[2][2][4][2], const Unit& u, int wr, int wc, int fr, int fq) const {
        const int row0 = u.pm * BM + wr * 64 + fr, col0 = u.pn * BM + wc * 32 + 4 * fq;
#pragma unroll
        for (int ai = 0; ai < 2; ++ai)
#pragma unroll
            for (int m = 0; m < 4; ++m) { const size_t ro = (size_t)(row0 + ai * HALF + m * 16) * ldc + col0;
#pragma unroll
                for (int bj = 0; bj < 2; ++bj)
#pragma unroll
                    for (int n = 0; n < 2; ++n) { const f32x4 xv = *(const f32x4*)(X + ro + bj * HALF + n * 16);
                        *(f32x4*)(Z + ro + bj * HALF + n * 16) = xv * alpha + acc[ai][bj][m][n] * sc; } }
    }
};
struct EpiSwiglu {
    static constexpr bool PERM = true, AFTER_DRAIN = false;
    const PG8_LAS int* tile_e; const float* bgate; const float* blin; unsigned char* H; int ldc; float sc;
    __device__ __forceinline__ void operator()(const f32x4 (&acc)[2][2][4][2], const Unit& u, int wr, int wc, int fr, int fq) const {
        const int e = tile_e[u.pm];
        const int row0 = u.pm * BM + wr * 64 + fr, j0 = u.pn * HALF + wc * 32 + 8 * fq;
        const f32x4 bg0 = *(const f32x4*)(bgate + (size_t)e * 2048 + j0), bg1 = *(const f32x4*)(bgate + (size_t)e * 2048 + j0 + 4);
        const f32x4 bl0 = *(const f32x4*)(blin + (size_t)e * 2048 + j0), bl1 = *(const f32x4*)(blin + (size_t)e * 2048 + j0 + 4);
#pragma unroll
        for (int ai = 0; ai < 2; ++ai)
#pragma unroll
            for (int m = 0; m < 4; ++m) { const int row = row0 + ai * HALF + m * 16;
                f32x4 h0, h1;
#pragma unroll
                for (int i = 0; i < 4; ++i) {
                    float g = fminf(acc[ai][0][m][0][i] * sc + bg0[i], 7.0f); float l = fminf(fmaxf(acc[ai][1][m][0][i] * sc + bl0[i], -7.0f), 7.0f);
                    h0[i] = (l + 1.0f) * (g * sigmoidf_(1.702f * g));
                    g = fminf(acc[ai][0][m][1][i] * sc + bg1[i], 7.0f); l = fminf(fmaxf(acc[ai][1][m][1][i] * sc + bl1[i], -7.0f), 7.0f);
                    h1[i] = (l + 1.0f) * (g * sigmoidf_(1.702f * g)); }
                u32x2 w; w.x = pk4_fp8_(h0[0], h0[1], h0[2], h0[3]); w.y = pk4_fp8_(h1[0], h1[1], h1[2], h1[3]);
                *(u32x2*)(H + (size_t)row * ldc + j0) = w; }
    }
};
struct EpiDown {
    static constexpr bool PERM = true, AFTER_DRAIN = false;
    const PG8_LAS int* tile_e; const float* bdown; const float* slot_w; bf16_t* YS; int ldc; float sc;
    __device__ __forceinline__ void operator()(const f32x4 (&acc)[2][2][4][2], const Unit& u, int wr, int wc, int fr, int fq) const {
        const int e = tile_e[u.pm];
        const int row0 = u.pm * BM + wr * 64 + fr, col0 = u.pn * BM + wc * 32 + 8 * fq;
        f32x4 bv[2][2];
#pragma unroll
        for (int bj = 0; bj < 2; ++bj)
#pragma unroll
            for (int n = 0; n < 2; ++n) bv[bj][n] = *(const f32x4*)(bdown + (size_t)e * 2048 + col0 + bj * HALF + 4 * n);
#pragma unroll
        for (int ai = 0; ai < 2; ++ai)
#pragma unroll
            for (int m = 0; m < 4; ++m) { const int row = row0 + ai * HALF + m * 16; const float sw = slot_w[row];
#pragma unroll
                for (int bj = 0; bj < 2; ++bj) { const f32x4 v0 = (acc[ai][bj][m][0] * sc + bv[bj][0]) * sw, v1 = (acc[ai][bj][m][1] * sc + bv[bj][1]) * sw;
                    u32x4 w; w.x = cvt_pk_bf16(v0[0], v0[1]); w.y = cvt_pk_bf16(v0[2], v0[3]); w.z = cvt_pk_bf16(v1[0], v1[1]); w.w = cvt_pk_bf16(v1[2], v1[3]);
                    *(u32x4*)(YS + (size_t)row * ldc + col0 + bj * HALF) = w; } }
    }
};
struct MoeOrder : StaticOrder {
    const PG8_LAS int* tile_e; size_t estride;
    __device__ __forceinline__ size_t b_off(const Unit& u) const { return (size_t)__builtin_amdgcn_readfirstlane(tile_e[u.pm]) * estride; }
};
typedef int i32x4_ __attribute__((ext_vector_type(4)));
typedef int i32x8_ __attribute__((ext_vector_type(8)));
#define PG8_CAT(lo, hi) __builtin_shufflevector(__builtin_bit_cast(i32x4_, lo), __builtin_bit_cast(i32x4_, hi), 0, 1, 2, 3, 4, 5, 6, 7)
template <class Epi, class Sched, bool ALIGN_EPI = false, bool SP2 = false, bool FP8 = false, bool BTILED = false>
__device__ __forceinline__ void gemm_phase(PG8_LAS unsigned char* lds, const Gemm g, const Sched& S, const Epi& E) {
    const int tid = threadIdx.x, wid = __builtin_amdgcn_readfirstlane(tid >> 6), lane = tid & 63, wr = wid >> 2, wc = wid & 3, fr = lane & 15, fq = lane >> 4;
    const int K = g.K, nt = K / BK;
    unsigned voffA[2], voffB[2];
#pragma unroll
    for (int i = 0; i < 2; ++i) { int R, C; stage_rc(tid * 16 + i * 8192, R, C); const int Rb = Epi::PERM ? ((R & ~31) + perm32(R & 31)) : R;
        voffA[i] = (unsigned)(R * K + C) * 2u; voffB[i] = BTILED ? (unsigned)(Rb * 64 + C) * 2u : (unsigned)(Rb * K + C) * 2u; }
    const size_t kstep = (size_t)(BK * 2);
    const size_t hstep = (size_t)HALF * K * 2;
    const size_t tstep = 2 * hstep;
    const size_t kstepB = BTILED ? (size_t)32768 : kstep, hstepB = BTILED ? (size_t)16384 : hstep;
    const unsigned ldsw = (unsigned)wid * 1024u;
    const int aoff = lds_byte(wr * 64 + fr, fq * 8), boff = lds_byte(wc * 32 + fr, fq * 8);
#define PG8_SA(b, h) (((b) * 2 + (h)) * HTB)
#define PG8_SB(b, h) ((4 + (b) * 2 + (h)) * HTB)
#define PG8_STAGE(bufoff, gbase, voff) do { _Pragma("unroll") for (int _i = 0; _i < 2; ++_i) \
        __builtin_amdgcn_global_load_lds((const unsigned*)((const char*)(gbase) + (voff)[_i]), (PG8_LAS unsigned*)(lds + (bufoff) + ldsw + _i * 8192), 16, 0, 0); } while (0)
#define PG8_LDA(dst, b, h) do { _Pragma("unroll") for (int m = 0; m < 4; ++m) _Pragma("unroll") for (int k = 0; k < 2; ++k) dst[m][k] = *(const PG8_LAS bf16x8*)(lds + PG8_SA(b, h) + aoff + m * 2048 + k * 1024); } while (0)
#define PG8_LDB(dst, b, h) do { _Pragma("unroll") for (int n = 0; n < 2; ++n) _Pragma("unroll") for (int k = 0; k < 2; ++k) dst[n][k] = *(const PG8_LAS bf16x8*)(lds + PG8_SB(b, h) + boff + n * 2048 + k * 1024); } while (0)
#define PG8_MFMA8(C, Bv, Av) asm volatile("v_mfma_f32_16x16x128_f8f6f4 %0, %1, %2, %0" : "+v"(C) : "v"(Bv), "v"(Av))
#define PG8_MMA(ai, bj, At, Bt) do { __builtin_amdgcn_s_setprio(1); if constexpr (FP8) { const i32x8_ b0_ = PG8_CAT(Bt[0][0], Bt[0][1]), b1_ = PG8_CAT(Bt[1][0], Bt[1][1]); _Pragma("unroll") for (int m = 0; m < 4; ++m) { \
        const i32x8_ a_ = PG8_CAT(At[m][0], At[m][1]); PG8_MFMA8(acc[ai][bj][m][0], b0_, a_); PG8_MFMA8(acc[ai][bj][m][1], b1_, a_); } } else { \
        _Pragma("unroll") for (int m = 0; m < 4; ++m) _Pragma("unroll") for (int n = 0; n < 2; ++n) _Pragma("unroll") for (int k = 0; k < 2; ++k) \
        acc[ai][bj][m][n] = __builtin_amdgcn_mfma_f32_16x16x32_bf16(Bt[n][k], At[m][k], acc[ai][bj][m][n], 0, 0, 0); } __builtin_amdgcn_s_setprio(0); } while (0)
#define PG8_WAIT_V(n) asm volatile("s_waitcnt vmcnt(" #n ")" ::: "memory")
#define PG8_WAIT_L(n) asm volatile("s_waitcnt lgkmcnt(" #n ")" ::: "memory")
#define PG8_BAR __builtin_amdgcn_s_barrier()
#define PG8_SCHED __builtin_amdgcn_sched_barrier(0)
    Unit cur, nxt; int ui = 0;
    if (!S.next(0, cur)) return;
    f32x4 acc[2][2][4][2];
#pragma unroll
    for (int a = 0; a < 2; ++a)
#pragma unroll
        for (int b = 0; b < 2; ++b)
#pragma unroll
            for (int m = 0; m < 4; ++m)
#pragma unroll
                for (int n = 0; n < 2; ++n) acc[a][b][m][n] = (f32x4){0.f, 0.f, 0.f, 0.f};
    bf16x8 At[4][2], B0[2][2], B1[2][2];
    const char* cA = (const char*)g.A + (size_t)cur.pm * tstep; const char* cB = (const char*)g.Bt + S.b_off(cur) + (size_t)cur.pn * tstep;
    S.a_ready(cur);
    if constexpr (SP2) {
        PG8_STAGE(PG8_SB(0, 0), cB, voffB); PG8_STAGE(PG8_SB(0, 1), cB + hstepB, voffB); PG8_STAGE(PG8_SA(0, 0), cA, voffA); PG8_STAGE(PG8_SA(0, 1), cA + hstep, voffA);
        if (wr == 1) PG8_BAR;
        PG8_WAIT_V(2); PG8_BAR;
        PG8_STAGE(PG8_SB(1, 0), cB + kstepB, voffB); PG8_STAGE(PG8_SA(1, 0), cA + kstep, voffA); PG8_STAGE(PG8_SB(1, 1), cB + hstepB + kstepB, voffB);
        PG8_WAIT_V(6); PG8_BAR;
    } else {
        PG8_STAGE(PG8_SB(0, 0), cB, voffB); PG8_STAGE(PG8_SA(0, 0), cA, voffA); PG8_STAGE(PG8_SB(0, 1), cB + hstepB, voffB); PG8_STAGE(PG8_SA(0, 1), cA + hstep, voffA);
        if (wr == 1) PG8_BAR;
        PG8_WAIT_V(4); PG8_BAR;
        PG8_STAGE(PG8_SB(1, 0), cB + kstepB, voffB); PG8_STAGE(PG8_SA(1, 0), cA + kstep, voffA); PG8_STAGE(PG8_SB(1, 1), cB + hstepB + kstepB, voffB);
        PG8_WAIT_V(6); PG8_BAR;
    }
    for (;;) {
        const bool has_next = S.next(ui + 1, nxt);
        const char* nA = has_next ? (const char*)g.A + (size_t)nxt.pm * tstep : cA; const char* nB = has_next ? (const char*)g.Bt + S.b_off(nxt) + (size_t)nxt.pn * tstep : cB;
        for (int t = 0; t < nt; t += 2) {
            const bool last = (t == nt - 2);
            const char* a1 = cA + (size_t)(t + 1) * kstep;
            const char* a2 = last ? nA : cA + (size_t)(t + 2) * kstep; const char* b2 = last ? nB : cB + (size_t)(t + 2) * kstepB;
            const char* a3 = a2 + kstep; const char* b3 = b2 + kstepB;
            if (last && has_next) S.a_ready(nxt);
            if constexpr (SP2) {
            PG8_LDB(B0, 0, 0); PG8_LDB(B1, 0, 1); PG8_SCHED; PG8_LDA(At, 0, 0); PG8_STAGE(PG8_SA(1, 1), a1 + hstep, voffA);
            PG8_WAIT_V(8); PG8_WAIT_L(0); PG8_BAR; PG8_MMA(0, 0, At, B0); PG8_MMA(0, 1, At, B1); PG8_BAR; PG8_SCHED;
            PG8_LDA(At, 0, 1); PG8_STAGE(PG8_SB(0, 0), b2, voffB); PG8_STAGE(PG8_SB(0, 1), b2 + hstepB, voffB); PG8_STAGE(PG8_SA(0, 0), a2, voffA);
            PG8_WAIT_V(8); PG8_WAIT_L(0); PG8_BAR; PG8_MMA(1, 0, At, B0); PG8_MMA(1, 1, At, B1); PG8_BAR; PG8_SCHED;
            PG8_LDB(B0, 1, 0); PG8_LDB(B1, 1, 1); PG8_SCHED; PG8_LDA(At, 1, 0); PG8_STAGE(PG8_SA(0, 1), a2 + hstep, voffA);
            PG8_WAIT_V(8); PG8_WAIT_L(0); PG8_BAR; PG8_MMA(0, 0, At, B0); PG8_MMA(0, 1, At, B1); PG8_BAR; PG8_SCHED;
            PG8_LDA(At, 1, 1); PG8_STAGE(PG8_SB(1, 0), b3, voffB); PG8_STAGE(PG8_SB(1, 1), b3 + hstepB, voffB); PG8_STAGE(PG8_SA(1, 0), a3, voffA);
            PG8_WAIT_V(8); PG8_WAIT_L(0); PG8_BAR; PG8_MMA(1, 0, At, B0); PG8_MMA(1, 1, At, B1); PG8_BAR; PG8_SCHED;
            } else {
            PG8_LDB(B0, 0, 0); PG8_SCHED; PG8_LDA(At, 0, 0); PG8_STAGE(PG8_SA(1, 1), a1 + hstep, voffA);
            PG8_WAIT_L(8); PG8_BAR; PG8_WAIT_L(0); PG8_MMA(0, 0, At, B0); PG8_BAR; PG8_SCHED;
            PG8_LDB(B1, 0, 1); PG8_STAGE(PG8_SB(0, 0), b2, voffB);
            PG8_BAR; PG8_WAIT_L(0); PG8_MMA(0, 1, At, B1); PG8_BAR;
            PG8_LDA(At, 0, 1); PG8_STAGE(PG8_SA(0, 0), a2, voffA);
            PG8_BAR; PG8_WAIT_L(0); PG8_MMA(1, 0, At, B0); PG8_BAR; PG8_SCHED;
            PG8_STAGE(PG8_SB(0, 1), b2 + hstepB, voffB);
            PG8_WAIT_V(6); PG8_BAR; PG8_MMA(1, 1, At, B1); PG8_BAR;
            PG8_LDB(B0, 1, 0); PG8_SCHED; PG8_LDA(At, 1, 0); PG8_STAGE(PG8_SA(0, 1), a2 + hstep, voffA);
            PG8_WAIT_L(8); PG8_BAR; PG8_WAIT_L(0); PG8_MMA(0, 0, At, B0); PG8_BAR; PG8_SCHED;
            PG8_LDB(B1, 1, 1); PG8_STAGE(PG8_SB(1, 0), b3, voffB);
            PG8_BAR; PG8_WAIT_L(0); PG8_MMA(0, 1, At, B1); PG8_BAR;
            PG8_LDA(At, 1, 1); PG8_STAGE(PG8_SA(1, 0), a3, voffA);
            PG8_BAR; PG8_WAIT_L(0); PG8_MMA(1, 0, At, B0); PG8_BAR; PG8_SCHED;
            PG8_STAGE(PG8_SB(1, 1), b3 + hstepB, voffB);
            PG8_WAIT_V(6); PG8_BAR; PG8_MMA(1, 1, At, B1); PG8_BAR;
            }
        }
        if constexpr (ALIGN_EPI) { if (wr == 0) PG8_BAR; }
        if constexpr (FP8) { asm volatile("s_nop 15\n\ts_nop 7" ::: "memory"); PG8_SCHED; }
        if constexpr (!Epi::AFTER_DRAIN) { E(acc, cur, wr, wc, fr, fq); S.done(cur); }
        if (!has_next) break;
#pragma unroll
        for (int a = 0; a < 2; ++a)
#pragma unroll
            for (int b = 0; b < 2; ++b)
#pragma unroll
                for (int m = 0; m < 4; ++m)
#pragma unroll
                    for (int n = 0; n < 2; ++n) acc[a][b][m][n] = (f32x4){0.f, 0.f, 0.f, 0.f};
        cur = nxt; cA = nA; cB = nB; ++ui;
        if constexpr (ALIGN_EPI) { if (wr == 1) PG8_BAR; }
    }
    PG8_WAIT_V(0);
    if constexpr (!ALIGN_EPI) { if (wr == 0) PG8_BAR; }
    PG8_BAR;
    if constexpr (Epi::AFTER_DRAIN) { E.fused(acc, cur, wr, wc, fr, fq, lds, wid, lane); S.done(cur); }
#undef PG8_SA
#undef PG8_SB
#undef PG8_STAGE
#undef PG8_LDA
#undef PG8_LDB
#undef PG8_MMA
#undef PG8_WAIT_V
#undef PG8_WAIT_L
#undef PG8_BAR
#undef PG8_SCHED
}
}
namespace at {
using bf16 = __hip_bfloat16;
constexpr int   D = 128, NW = 8, QBLK = 32, KVBLK = 64;
constexpr float SCALE = 0.088388347648318440f;
constexpr float THR = 8.f;
constexpr int SDEPTH = 2;
constexpr size_t SHM_V = KVBLK * D * 2, SHM_K = KVBLK * D * 2, SHM_ATTN = 2 * SHM_V + 2 * SHM_K + NW * 64 * 4;
using bf16x8 = __attribute__((ext_vector_type(8))) short;
using s16x4  = __attribute__((ext_vector_type(4))) short;
using f32x16 = __attribute__((ext_vector_type(16))) float;
using f32x8  = __attribute__((ext_vector_type(8))) float;
using u32x4  = __attribute__((ext_vector_type(4))) unsigned;
#define KSWZ(row, colB) ((row) * 256 + ((colB) ^ (((row) & 7) << 4)))
#define SBAR() __builtin_amdgcn_sched_barrier(0)
__device__ __forceinline__ int crow(int r, int hi) { return (r & 3) + 8 * (r >> 2) + 4 * hi; }
__device__ __forceinline__ unsigned cvtpk(float lo, float hi) {
  unsigned r; asm volatile("v_cvt_pk_bf16_f32 %0, %1, %2" : "=v"(r) : "v"(lo), "v"(hi)); return r;
}
template <typename TIn> struct Stage;
template <> struct Stage<bf16>  { using T = bf16x8;
  __device__ static __forceinline__ T ld8(const bf16* p) { return *reinterpret_cast<const bf16x8*>(p); }
  __device__ static __forceinline__ bf16x8 tobf(T x) { return x; } };
template <> struct Stage<float> { using T = f32x8;
  __device__ static __forceinline__ T ld8(const float* p) { return *reinterpret_cast<const f32x8*>(p); }
  __device__ static __forceinline__ bf16x8 tobf(T x) {
    u32x4 w = {cvtpk(x[0], x[1]), cvtpk(x[2], x[3]), cvtpk(x[4], x[5]), cvtpk(x[6], x[7])}; return *reinterpret_cast<bf16x8*>(&w); } };

__device__ __forceinline__ void partialSM(f32x16& p0, f32x16& p1, float& m_reg, float& mn, float& alpha) {
  constexpr float C = SCALE * 1.4426950408889634f;
  float pmax = p0[0]; for (int r = 1; r < 16; ++r) pmax = fmaxf(pmax, p0[r]); for (int r = 0; r < 16; ++r) pmax = fmaxf(pmax, p1[r]);
  { auto rr = __builtin_amdgcn_permlane32_swap(__float_as_uint(pmax), __float_as_uint(pmax), false, false);
    pmax = fmaxf(__uint_as_float(rr[0]), __uint_as_float(rr[1])); }
  if (__builtin_expect(__all(pmax - m_reg <= THR / SCALE), 1)) { mn = m_reg; alpha = 1.f; }
  else { mn = fmaxf(m_reg, pmax); alpha = __builtin_amdgcn_exp2f((m_reg - mn) * C); m_reg = mn; }
  float mnC = -mn * C;
  for (int r = 0; r < 16; ++r) p0[r] = fmaf(p0[r], C, mnC); for (int r = 0; r < 16; ++r) p1[r] = fmaf(p1[r], C, mnC);
  for (int r = 0; r < 16; ++r) p0[r] = __builtin_amdgcn_exp2f(p0[r]);
}
__device__ __forceinline__ void finishSM(f32x16& p0, f32x16& p1, float alpha, float& l_reg, bf16x8& pa0, bf16x8& pa1, bf16x8& pa2, bf16x8& pa3) {
  for (int r = 0; r < 16; ++r) p1[r] = __builtin_amdgcn_exp2f(p1[r]);
  float ps = 0; for (int r = 0; r < 16; ++r) ps += p0[r]; for (int r = 0; r < 16; ++r) ps += p1[r];
  { auto rr = __builtin_amdgcn_permlane32_swap(__float_as_uint(ps), __float_as_uint(ps), false, false);
    ps = __uint_as_float(rr[0]) + __uint_as_float(rr[1]); }
  l_reg = l_reg * alpha + ps;
#define PK4(P, BASE, OUT) do { unsigned a0 = cvtpk(P[BASE + 0], P[BASE + 1]), a1 = cvtpk(P[BASE + 2], P[BASE + 3]);   \
    unsigned b0 = cvtpk(P[BASE + 4], P[BASE + 5]), b1 = cvtpk(P[BASE + 6], P[BASE + 7]);                              \
    auto r0 = __builtin_amdgcn_permlane32_swap(a0, b0, false, false); auto r1 = __builtin_amdgcn_permlane32_swap(a1, b1, false, false); \
    u32x4 w = {r0[0], r1[0], r0[1], r1[1]}; OUT = *reinterpret_cast<bf16x8*>(&w); } while (0)
  PK4(p0, 0, pa0); PK4(p0, 8, pa1); PK4(p1, 0, pa2); PK4(p1, 8, pa3);
#undef PK4
}
__device__ __forceinline__ void qkt(f32x16& p0, f32x16& p1, const bf16* Ks, const bf16x8* qr, int r32, int hi) {
  p0 = f32x16{}; p1 = f32x16{};
  for (int d0 = 0; d0 < 8; ++d0) { int cb = (d0 * 16 + hi * 8) * 2;
    bf16x8 b0 = *reinterpret_cast<const bf16x8*>((const char*)Ks + KSWZ(r32, cb));
    bf16x8 b1 = *reinterpret_cast<const bf16x8*>((const char*)Ks + KSWZ(32 + r32, cb));
    p0 = __builtin_amdgcn_mfma_f32_32x32x16_bf16(b0, qr[d0], p0, 0, 0, 0);
    p1 = __builtin_amdgcn_mfma_f32_32x32x16_bf16(b1, qr[d0], p1, 0, 0, 0); }
}
__device__ __forceinline__ int v_st(int k, int c) { const int kk = (k & ~0xC) | ((k & 4) << 1) | ((k & 8) >> 1); return ((kk >> 3) * 4 + (c >> 5)) * 512 + ((kk & 7) * 32 + (c & 31)) * 2; }
__device__ __forceinline__ int v_rd_base(int lane) { return ((lane & 3) << 3) | (((lane >> 2) & 3) << 6) | (((lane >> 4) & 1) << 5) | (((lane >> 5) & 1) << 8); }
constexpr int v_rd_off(int d0, int ks, int half) { return d0 * 512 + ks * 4096 + half * 2048; }
template <int OFF> __device__ __forceinline__ s16x4 tr_read(int vb) {
  s16x4 r; asm volatile("ds_read_b64_tr_b16 %0, %1 offset:%2" : "=&v"(r) : "v"(vb), "i"(OFF) : "memory"); return r;
}
template <int D0> __device__ __forceinline__ void pv_one(f32x16& od, int vb, bf16x8 pa0, bf16x8 pa1, bf16x8 pa2, bf16x8 pa3) {
  const s16x4 l0 = tr_read<v_rd_off(D0, 0, 0)>(vb), h0 = tr_read<v_rd_off(D0, 0, 1)>(vb), l1 = tr_read<v_rd_off(D0, 1, 0)>(vb), h1 = tr_read<v_rd_off(D0, 1, 1)>(vb);
  const s16x4 l2 = tr_read<v_rd_off(D0, 2, 0)>(vb), h2 = tr_read<v_rd_off(D0, 2, 1)>(vb), l3 = tr_read<v_rd_off(D0, 3, 0)>(vb), h3 = tr_read<v_rd_off(D0, 3, 1)>(vb);
  asm volatile("s_waitcnt lgkmcnt(0)" ::: "memory"); SBAR();
#define PK(L, H) (bf16x8){L[0], L[1], L[2], L[3], H[0], H[1], H[2], H[3]}
  od = __builtin_amdgcn_mfma_f32_32x32x16_bf16(pa0, PK(l0, h0), od, 0, 0, 0);
  od = __builtin_amdgcn_mfma_f32_32x32x16_bf16(pa1, PK(l1, h1), od, 0, 0, 0);
  od = __builtin_amdgcn_mfma_f32_32x32x16_bf16(pa2, PK(l2, h2), od, 0, 0, 0);
  od = __builtin_amdgcn_mfma_f32_32x32x16_bf16(pa3, PK(l3, h3), od, 0, 0, 0);
#undef PK
}
__device__ __forceinline__ void pv_d0(f32x16* o, int vb, bf16x8 pa0, bf16x8 pa1, bf16x8 pa2, bf16x8 pa3) {
  pv_one<0>(o[0], vb, pa0, pa1, pa2, pa3); pv_one<1>(o[1], vb, pa0, pa1, pa2, pa3); pv_one<2>(o[2], vb, pa0, pa1, pa2, pa3); pv_one<3>(o[3], vb, pa0, pa1, pa2, pa3);
}

template <int LDQ, int LDK, int LDV, int LDO>
__device__ __forceinline__ void attn_dense_body(const bf16* __restrict__ Qb, const bf16* __restrict__ Kh, const bf16* __restrict__ Vh,
                                                unsigned char* __restrict__ Ob, int seq, char* lds) {
  using St = Stage<bf16>; using SQ = Stage<bf16>;
  const int tid = threadIdx.x, wid = __builtin_amdgcn_readfirstlane(tid >> 6), lane = tid & 63, r32 = lane & 31, hi = lane >> 5;
  bf16* V_lds = (bf16*)lds; bf16* K_lds = (bf16*)(lds + 2 * SHM_V);
  float* ws = (float*)(lds + 2 * SHM_V + 2 * SHM_K) + wid * 64; float* li_l = ws; float* al_l = ws + 32;
  float m_reg = -1e30f, l_reg = 0; f32x16 o[4] = {}; bf16x8 qr[8];
  const bf16* Qw = Qb + (long)(wid * QBLK + r32) * LDQ + hi * 8;
#pragma unroll
  for (int d0 = 0; d0 < 8; ++d0) qr[d0] = SQ::tobf(SQ::ld8(Qw + d0 * 16));
  const int sr = tid >> 4, sc = (tid & 15) * 8, vst0 = v_st(sr, sc), vst1 = v_st(32 + sr, sc);
  const int vb0 = (int)(uintptr_t)V_lds + v_rd_base(lane);
  struct { typename St::T vs0, vs1, ks0, ks1; } sr_[SDEPTH];
#define SLOAD(i, k0) do { sr_[i].vs0 = St::ld8(&Vh[(long)((k0) + sr) * LDV + sc]); sr_[i].vs1 = St::ld8(&Vh[(long)((k0) + 32 + sr) * LDV + sc]); \
    sr_[i].ks0 = St::ld8(&Kh[(long)((k0) + sr) * LDK + sc]); sr_[i].ks1 = St::ld8(&Kh[(long)((k0) + 32 + sr) * LDK + sc]); } while (0)
#define SWRITE(b, i) do { *(bf16x8*)((char*)V_lds + (b) * SHM_V + vst0) = St::tobf(sr_[i].vs0);          \
    *(bf16x8*)((char*)V_lds + (b) * SHM_V + vst1) = St::tobf(sr_[i].vs1); int kc = sc * 2;               \
    *(bf16x8*)((char*)K_lds + (b) * SHM_K + KSWZ(sr, kc)) = St::tobf(sr_[i].ks0);                       \
    *(bf16x8*)((char*)K_lds + (b) * SHM_K + KSWZ(32 + sr, kc)) = St::tobf(sr_[i].ks1); } while (0)
#define SWAIT() do { if constexpr (SDEPTH == 2) asm volatile("s_waitcnt vmcnt(4)" ::: "memory"); else asm volatile("s_waitcnt vmcnt(0)" ::: "memory"); } while (0)
#define RESC(a) do { if (__any((a) < 1.f)) { if (hi == 0) al_l[r32] = (a); asm volatile("s_waitcnt lgkmcnt(0)" ::: "memory"); \
    for (int d = 0; d < 4; ++d) for (int r = 0; r < 16; ++r) o[d][r] *= al_l[crow(r, hi)]; } } while (0)
  f32x16 pA0, pA1, pB0, pB1; float mnA, mnB, alA, alB; bf16x8 pa0, pa1, pa2, pa3; const int NT = seq / KVBLK;
  constexpr int SE = 0, SO = SDEPTH - 1;
  SLOAD(SE, 0); asm volatile("s_waitcnt vmcnt(0)" ::: "memory"); SWRITE(0, SE); __syncthreads();
  qkt(pA0, pA1, K_lds, qr, r32, hi); partialSM(pA0, pA1, m_reg, mnA, alA);
  SLOAD(SO, KVBLK); if constexpr (SDEPTH == 2) { if (2 < NT) SLOAD(SE, 2 * KVBLK); }
  SWAIT(); SWRITE(1, SO); __syncthreads();
  for (int j = 1; j + 1 < NT; j += 2) {
    SBAR(); qkt(pB0, pB1, (bf16*)((char*)K_lds + SHM_K), qr, r32, hi);
    finishSM(pA0, pA1, alA, l_reg, pa0, pa1, pa2, pa3); SBAR();
    SLOAD(SO, (j + SDEPTH) * KVBLK); SBAR();
    pv_d0(o, vb0, pa0, pa1, pa2, pa3); partialSM(pB0, pB1, m_reg, mnB, alB);
    __syncthreads(); SWAIT(); SWRITE(0, SE);
    RESC(alB); __syncthreads();
    SBAR(); qkt(pA0, pA1, K_lds, qr, r32, hi);
    finishSM(pB0, pB1, alB, l_reg, pa0, pa1, pa2, pa3); SBAR();
    if (SDEPTH == 1 || j + 3 < NT) SLOAD(SE, (j + 1 + SDEPTH) * KVBLK); SBAR();
    pv_d0(o, vb0 + (int)SHM_V, pa0, pa1, pa2, pa3); partialSM(pA0, pA1, m_reg, mnA, alA);
    __syncthreads(); SWAIT(); SWRITE(1, SO);
    RESC(alA); __syncthreads();
  }
  SBAR(); qkt(pB0, pB1, (bf16*)((char*)K_lds + SHM_K), qr, r32, hi);
  finishSM(pA0, pA1, alA, l_reg, pa0, pa1, pa2, pa3); SBAR();
  pv_d0(o, vb0, pa0, pa1, pa2, pa3); partialSM(pB0, pB1, m_reg, mnB, alB);
  __syncthreads(); RESC(alB);
  finishSM(pB0, pB1, alB, l_reg, pa0, pa1, pa2, pa3); SBAR();
  pv_d0(o, vb0 + (int)SHM_V, pa0, pa1, pa2, pa3);
  if (hi == 0) li_l[r32] = l_reg; asm volatile("s_waitcnt lgkmcnt(0)" ::: "memory");
  float rli[16];
#pragma unroll
  for (int r = 0; r < 16; ++r) rli[r] = __builtin_amdgcn_rcpf(li_l[crow(r, hi)]);
  unsigned char* Ow = Ob + (long)(wid * QBLK) * LDO;
#pragma unroll
  for (int r = 0; r < 16; ++r) { int orow = crow(r, hi);
    for (int d0 = 0; d0 < 4; ++d0) Ow[(long)orow * LDO + d0 * 32 + r32] = (unsigned char)(__builtin_amdgcn_cvt_pk_fp8_f32(o[d0][r] * rli[r] * 64.0f, 0.f, 0, false) & 0xff); }
#undef SLOAD
#undef SWRITE
#undef SWAIT
#undef RESC
}


__device__ __forceinline__ void dilated_unit(const bf16* __restrict__ proj, const float* __restrict__ lutg, bf16* __restrict__ outg, float* __restrict__ lseg,
                                             int d, int hd12, int hh, int r, int i0, char* lds) {
  constexpr int LDP = 10240;
  constexpr float L2E = 1.4426950408889634f, C = SCALE * L2E;
  const int tid = threadIdx.x, wid = tid >> 6, lane = tid & 63, r32 = lane & 31, hi = lane >> 5;
  const int n = 8192 / d;
  char* KV = lds;
  float* lutx = (float*)(lds + 98304);
  float* wsx = (float*)(lds + 98304 + 2048) + wid * 64;
  const int qoff = hd12 * 128, koff = 1536 + hd12 * 128;
  if (tid < 320) { const int o = tid - 96; lutx[tid] = (o >= 0 && o <= 128) ? lutg[o] * L2E : -1e30f; }
  const int iq = i0 + wid * 32 + r32;
  const int sr = tid >> 4, sc = (tid & 15) * 8;
  f32x16 s00, s01, s10, s11, s20, s21;
  const int a = wid >> 1;
  {
    const bf16* Qw = proj + (size_t)(r + iq * d) * LDP + qoff + hi * 8;
    bf16x8 qr[8];
#pragma unroll
    for (int d0 = 0; d0 < 8; ++d0) qr[d0] = *reinterpret_cast<const bf16x8*>(Qw + d0 * 16);
    const int wu = __builtin_amdgcn_readfirstlane(wid);
    const unsigned kvbase = (unsigned)(uintptr_t)KV;
#pragma unroll
    for (int i = 0; i < 12; ++i) { const int P = 8 * i + wu, rit = (P & 15) * 4 + (lane >> 4), colB = ((lane & 15) << 4) ^ ((rit & 7) << 4), row = (P >> 4) * 64 + rit;
      int j = i0 - 64 + row; j = j < 0 ? 0 : (j >= n ? n - 1 : j);
      __builtin_amdgcn_global_load_lds((const unsigned*)(proj + (size_t)(r + j * d) * LDP + koff + (colB >> 1)), (__attribute__((address_space(3))) unsigned*)(kvbase + (unsigned)P * 1024u), 16, 0, 0); }
    asm volatile("s_waitcnt vmcnt(0)" ::: "memory");
    __syncthreads();
    qkt(s00, s01, (const bf16*)(KV + (a + 0) * 16384), qr, r32, hi);
    qkt(s10, s11, (const bf16*)(KV + (a + 1) * 16384), qr, r32, hi);
    qkt(s20, s21, (const bf16*)(KV + (a + 2) * 16384), qr, r32, hi);
  }
  __syncthreads();
  {
    const int wu = __builtin_amdgcn_readfirstlane(wid);
    const unsigned kvbase = (unsigned)(uintptr_t)KV;
#pragma unroll
    for (int i = 0; i < 12; ++i) { const int P = 8 * i + wu, sub = (P & 15) * 2 + (lane >> 5), kk = (sub >> 2) * 8 + ((lane & 31) >> 2), c = (sub & 3) * 32 + (lane & 3) * 8;
      const int k = (kk & ~0xC) | ((kk & 4) << 1) | ((kk & 8) >> 1), row = (P >> 4) * 64 + k;
      int j = i0 - 64 + row; j = j < 0 ? 0 : (j >= n ? n - 1 : j);
      __builtin_amdgcn_global_load_lds((const unsigned*)(proj + (size_t)(r + j * d) * LDP + koff + 1536 + c), (__attribute__((address_space(3))) unsigned*)(kvbase + (unsigned)P * 1024u), 16, 0, 0); }
  }
  SBAR();
  const int base = -32 * (wid & 1) - 64 - r32 + 4 * hi;
  const float* lp = lutx + (base + 160);
  float mx = -1e30f;
#define DIL_LOGITS(S, TT, HALF) _Pragma("unroll") for (int rr = 0; rr < 16; ++rr) { const float v = fmaf(S[rr], C, lp[64 * TT + 32 * HALF + (rr & 3) + 8 * (rr >> 2)]); S[rr] = v; }
  DIL_LOGITS(s00, 0, 0) DIL_LOGITS(s01, 0, 1) DIL_LOGITS(s10, 1, 0) DIL_LOGITS(s11, 1, 1) DIL_LOGITS(s20, 2, 0) DIL_LOGITS(s21, 2, 1)
#undef DIL_LOGITS
  if (i0 == 0 || i0 + 320 > n) {
    const int lo = -iq - base, hi_ = n - 1 - iq - base;
#define DIL_MASK(S, TT, HALF) _Pragma("unroll") for (int rr = 0; rr < 16; ++rr) { const int c = 64 * TT + 32 * HALF + (rr & 3) + 8 * (rr >> 2); S[rr] = (c >= lo && c <= hi_) ? S[rr] : -1e30f; }
    DIL_MASK(s00, 0, 0) DIL_MASK(s01, 0, 1) DIL_MASK(s10, 1, 0) DIL_MASK(s11, 1, 1) DIL_MASK(s20, 2, 0) DIL_MASK(s21, 2, 1)
#undef DIL_MASK
  }
#define DIL_MAX(S) _Pragma("unroll") for (int rr = 0; rr < 16; ++rr) mx = fmaxf(mx, S[rr]);
  DIL_MAX(s00) DIL_MAX(s01) DIL_MAX(s10) DIL_MAX(s11) DIL_MAX(s20) DIL_MAX(s21)
#undef DIL_MAX
  { auto rr = __builtin_amdgcn_permlane32_swap(__float_as_uint(mx), __float_as_uint(mx), false, false);
    mx = fmaxf(__uint_as_float(rr[0]), __uint_as_float(rr[1])); }
  float ps = 0.f;
#define DIL_EXP(S) _Pragma("unroll") for (int rr = 0; rr < 16; ++rr) { const float p = __builtin_amdgcn_exp2f(S[rr] - mx); S[rr] = p; ps += p; }
  DIL_EXP(s00) DIL_EXP(s01) DIL_EXP(s10) DIL_EXP(s11) DIL_EXP(s20) DIL_EXP(s21)
#undef DIL_EXP
  { auto rr = __builtin_amdgcn_permlane32_swap(__float_as_uint(ps), __float_as_uint(ps), false, false);
    ps = __uint_as_float(rr[0]) + __uint_as_float(rr[1]); }
  bf16x8 pa[12];
#define PK4(P, BASE, OUT) do { unsigned a0 = cvtpk(P[BASE + 0], P[BASE + 1]), a1 = cvtpk(P[BASE + 2], P[BASE + 3]);   \
    unsigned b0 = cvtpk(P[BASE + 4], P[BASE + 5]), b1 = cvtpk(P[BASE + 6], P[BASE + 7]);                              \
    auto r0 = __builtin_amdgcn_permlane32_swap(a0, b0, false, false); auto r1 = __builtin_amdgcn_permlane32_swap(a1, b1, false, false); \
    u32x4 w = {r0[0], r1[0], r0[1], r1[1]}; OUT = *reinterpret_cast<bf16x8*>(&w); } while (0)
  PK4(s00, 0, pa[0]); PK4(s00, 8, pa[1]); PK4(s01, 0, pa[2]); PK4(s01, 8, pa[3]);
  PK4(s10, 0, pa[4]); PK4(s10, 8, pa[5]); PK4(s11, 0, pa[6]); PK4(s11, 8, pa[7]);
  PK4(s20, 0, pa[8]); PK4(s20, 8, pa[9]); PK4(s21, 0, pa[10]); PK4(s21, 8, pa[11]);
#undef PK4
  SBAR();
  if (hi == 0) wsx[r32] = ps;
  asm volatile("s_waitcnt vmcnt(0)" ::: "memory");
  __syncthreads();
  f32x16 o[4] = {};
  const int vb = (int)(uintptr_t)KV + v_rd_base(lane);
  pv_d0(o, vb + (a + 0) * 16384, pa[0], pa[1], pa[2], pa[3]);
  pv_d0(o, vb + (a + 1) * 16384, pa[4], pa[5], pa[6], pa[7]);
  pv_d0(o, vb + (a + 2) * 16384, pa[8], pa[9], pa[10], pa[11]);
  float rli[16];
#pragma unroll
  for (int rr = 0; rr < 16; ++rr) rli[rr] = __builtin_amdgcn_rcpf(wsx[crow(rr, hi)]);
#pragma unroll
  for (int rr = 0; rr < 16; ++rr) { const int ir = i0 + wid * 32 + crow(rr, hi); bf16* orow = outg + (size_t)(r + ir * d) * 512 + hh * 128 + r32;
#pragma unroll
    for (int d0 = 0; d0 < 4; ++d0) orow[d0 * 32] = __float2bfloat16(o[d0][rr] * rli[rr]); }
  if (hi == 0) lseg[(size_t)(r + iq * d) * 4 + hh] = (mx + __builtin_amdgcn_logf(ps)) * 0.6931471805599453f;
  __syncthreads();
}

typedef int i32x4a __attribute__((ext_vector_type(4)));
typedef int i32x8a __attribute__((ext_vector_type(8)));
constexpr float THR8 = 3.f;
constexpr size_t SHM8_K = 64 * 128, SHM8_V = 64 * 128, SHM_ATTN8 = 2 * SHM8_K + 2 * SHM8_V + NW * 64 * 4 + NW * 4096;
#define A8_CAT(lo, hi) __builtin_shufflevector(lo, hi, 0, 1, 2, 3, 4, 5, 6, 7)
__device__ __forceinline__ f32x16 mfma8(i32x8a a, i32x8a b, f32x16 c) { return __builtin_amdgcn_mfma_scale_f32_32x32x64_f8f6f4(a, b, c, 0, 0, 0, 0, 0, 0); }
__device__ __forceinline__ int kchunk(int row, int c) { return row * 128 + ((c ^ ((row >> 1) & 7)) << 4); }
constexpr float THR8L = THR8 * 1.4426950408889634f;
__device__ __forceinline__ void partialSM8(f32x16& p0, f32x16& p1, float& m_reg, float& alpha) {
  float pmax = fmaxf(p0[0], p1[0]);
  for (int r = 1; r < 16; ++r) pmax = fmaxf(fmaxf(pmax, p0[r]), p1[r]);
  { auto rr = __builtin_amdgcn_permlane32_swap(__float_as_uint(pmax), __float_as_uint(pmax), false, false);
    pmax = fmaxf(__uint_as_float(rr[0]), __uint_as_float(rr[1])); }
  if (__builtin_expect(__all(pmax <= THR8L + 4.0f), 1)) { alpha = 1.f; }
  else { const float delta = fmaxf(pmax - 4.0f, 0.f); m_reg += delta; alpha = __builtin_amdgcn_exp2f(-delta);
    for (int r = 0; r < 16; ++r) { p0[r] -= delta; p1[r] -= delta; } }
  for (int r = 0; r < 16; ++r) p0[r] = __builtin_amdgcn_exp2f(p0[r]);
}
__device__ __forceinline__ unsigned pk4f8(float a, float b, float c, float d) { int w = __builtin_amdgcn_cvt_pk_fp8_f32(a, b, 0, false); w = __builtin_amdgcn_cvt_pk_fp8_f32(c, d, w, true); return (unsigned)w; }
__device__ __forceinline__ void finishSM8(f32x16& p0, f32x16& p1, i32x8a& pa) {
  for (int r = 0; r < 16; ++r) p1[r] = __builtin_amdgcn_exp2f(p1[r]);
  pa[0] = (int)pk4f8(p0[0], p0[1], p0[2], p0[3]);   pa[1] = (int)pk4f8(p0[4], p0[5], p0[6], p0[7]);
  pa[2] = (int)pk4f8(p0[8], p0[9], p0[10], p0[11]); pa[3] = (int)pk4f8(p0[12], p0[13], p0[14], p0[15]);
  pa[4] = (int)pk4f8(p1[0], p1[1], p1[2], p1[3]);   pa[5] = (int)pk4f8(p1[4], p1[5], p1[6], p1[7]);
  pa[6] = (int)pk4f8(p1[8], p1[9], p1[10], p1[11]); pa[7] = (int)pk4f8(p1[12], p1[13], p1[14], p1[15]);
}
__device__ __forceinline__ void qkt8(f32x16& p0, f32x16& p1, const char* Ks, const char* Qs, int r32, int hi, float init) {
  for (int r = 0; r < 16; ++r) { p0[r] = init; p1[r] = init; }
#pragma unroll
  for (int s = 0; s < 2; ++s) { const int c0 = 4 * s + 2 * hi;
    const i32x8a a0 = A8_CAT(*reinterpret_cast<const i32x4a*>(Ks + kchunk(r32, c0)), *reinterpret_cast<const i32x4a*>(Ks + kchunk(r32, c0 + 1)));
    const i32x8a a1 = A8_CAT(*reinterpret_cast<const i32x4a*>(Ks + kchunk(32 + r32, c0)), *reinterpret_cast<const i32x4a*>(Ks + kchunk(32 + r32, c0 + 1)));
    const i32x8a qs = A8_CAT(*reinterpret_cast<const i32x4a*>(Qs + (2 * s) * 1024), *reinterpret_cast<const i32x4a*>(Qs + (2 * s + 1) * 1024));
    p0 = mfma8(a0, qs, p0); p1 = mfma8(a1, qs, p1); }
}
__device__ __forceinline__ void pv8(f32x16* o, const char* Vs, i32x8a pa, int lane) {
#pragma unroll
  for (int d0 = 0; d0 < 4; ++d0) { const i32x8a b = A8_CAT(*reinterpret_cast<const i32x4a*>(Vs + d0 * 2048 + lane * 16), *reinterpret_cast<const i32x4a*>(Vs + d0 * 2048 + 1024 + lane * 16));
    o[d0] = mfma8(pa, b, o[d0]); }
  const i32x8a ones = {0x38383838, 0x38383838, 0x38383838, 0x38383838, 0x38383838, 0x38383838, 0x38383838, 0x38383838};
  o[4] = mfma8(pa, ones, o[4]);
}
template <int LDQ, int LDK, int LDO>
__device__ __forceinline__ void attn_dense_body8(const unsigned char* __restrict__ Qb, const unsigned char* __restrict__ Kh, const unsigned char* __restrict__ Vimg,
                                                 unsigned char* __restrict__ Ob, int seq, char* lds) {
  const int tid = threadIdx.x, wid = __builtin_amdgcn_readfirstlane(tid >> 6), lane = tid & 63, r32 = lane & 31, hi = lane >> 5;
  char* V_lds = lds; char* K_lds = lds + 2 * SHM8_V;
  float* ws = (float*)(lds + 2 * SHM8_V + 2 * SHM8_K) + wid * 64; float* al_l = ws + 32;
  float m_reg = 0.f; f32x16 o[5] = {};
  const unsigned char* Qw = Qb + (long)(wid * QBLK + r32) * LDQ + hi * 32;
  char* Qs = lds + 2 * SHM8_V + 2 * SHM8_K + NW * 64 * 4 + wid * 4096 + lane * 16;
#pragma unroll
  for (int s = 0; s < 2; ++s) { *reinterpret_cast<i32x4a*>(Qs + (2 * s) * 1024) = *reinterpret_cast<const i32x4a*>(Qw + 64 * s); *reinterpret_cast<i32x4a*>(Qs + (2 * s + 1) * 1024) = *reinterpret_cast<const i32x4a*>(Qw + 64 * s + 16); }
  const int sr = tid >> 3, sc = tid & 7, kst = kchunk(sr, sc);
  struct { i32x4a vs, ks; } sr_[SDEPTH];
#define SLOAD8(i, k0) do { sr_[i].vs = *reinterpret_cast<const i32x4a*>(Vimg + (long)((k0) >> 6) * 8192 + tid * 16); sr_[i].ks = *reinterpret_cast<const i32x4a*>(Kh + (long)((k0) + sr) * LDK + sc * 16); } while (0)
#define SWRITE8(b, i) do { *reinterpret_cast<i32x4a*>(V_lds + (b) * SHM8_V + tid * 16) = sr_[i].vs; *reinterpret_cast<i32x4a*>(K_lds + (b) * SHM8_K + kst) = sr_[i].ks; } while (0)
#define SWAIT8() do { if constexpr (SDEPTH == 2) asm volatile("s_waitcnt vmcnt(2)" ::: "memory"); else asm volatile("s_waitcnt vmcnt(0)" ::: "memory"); } while (0)
#define RESC8(a) do { if (__any((a) < 1.f)) { if (hi == 0) al_l[r32] = (a); asm volatile("s_waitcnt lgkmcnt(0)" ::: "memory"); \
    for (int d = 0; d < 5; ++d) for (int r = 0; r < 16; ++r) o[d][r] *= al_l[crow(r, hi)]; } } while (0)
  f32x16 pA0, pA1, pB0, pB1; float alA, alB; i32x8a pa; const int NT = seq / KVBLK;
  constexpr int SE = 0, SO = SDEPTH - 1;
  SLOAD8(SE, 0); asm volatile("s_waitcnt vmcnt(0)" ::: "memory"); SWRITE8(0, SE); __syncthreads();
  qkt8(pA0, pA1, K_lds, Qs, r32, hi, 4.0f - m_reg); partialSM8(pA0, pA1, m_reg, alA);
  SLOAD8(SO, KVBLK); if constexpr (SDEPTH == 2) { if (2 < NT) SLOAD8(SE, 2 * KVBLK); }
  SWAIT8(); SWRITE8(1, SO); __syncthreads();
  for (int j = 1; j + 1 < NT; j += 2) {
    SBAR(); qkt8(pB0, pB1, K_lds + SHM8_K, Qs, r32, hi, 4.0f - m_reg);
    finishSM8(pA0, pA1, pa); SBAR();
    SLOAD8(SO, (j + SDEPTH) * KVBLK); SBAR();
    pv8(o, V_lds, pa, lane); partialSM8(pB0, pB1, m_reg, alB);
    __syncthreads(); SWAIT8(); SWRITE8(0, SE);
    RESC8(alB); __syncthreads();
    SBAR(); qkt8(pA0, pA1, K_lds, Qs, r32, hi, 4.0f - m_reg);
    finishSM8(pB0, pB1, pa); SBAR();
    if (SDEPTH == 1 || j + 3 < NT) SLOAD8(SE, (j + 1 + SDEPTH) * KVBLK); SBAR();
    pv8(o, V_lds + SHM8_V, pa, lane); partialSM8(pA0, pA1, m_reg, alA);
    __syncthreads(); SWAIT8(); SWRITE8(1, SO);
    RESC8(alA); __syncthreads();
  }
  SBAR(); qkt8(pB0, pB1, K_lds + SHM8_K, Qs, r32, hi, 4.0f - m_reg);
  finishSM8(pA0, pA1, pa); SBAR();
  pv8(o, V_lds, pa, lane); partialSM8(pB0, pB1, m_reg, alB);
  __syncthreads(); RESC8(alB);
  finishSM8(pB0, pB1, pa); SBAR();
  pv8(o, V_lds + SHM8_V, pa, lane);
  float rli[16];
#pragma unroll
  for (int r = 0; r < 16; ++r) rli[r] = 4.0f * __builtin_amdgcn_rcpf(o[4][r]);
  unsigned char* Ow = Ob + (long)(wid * QBLK) * LDO;
#pragma unroll
  for (int r = 0; r < 16; ++r) { const int orow = crow(r, hi);
    for (int d0 = 0; d0 < 4; ++d0) Ow[(long)orow * LDO + d0 * 32 + r32] = (unsigned char)(__builtin_amdgcn_cvt_pk_fp8_f32(o[d0][r] * rli[r], 0.f, 0, false) & 0xff); }
#undef SLOAD8
#undef SWRITE8
#undef SWAIT8
#undef RESC8
}
}

#define GAS __attribute__((address_space(1)))
#define LAS __attribute__((address_space(3)))
typedef unsigned short bf16;
typedef unsigned v4u __attribute__((ext_vector_type(4)));
typedef unsigned v2u __attribute__((ext_vector_type(2)));
typedef float f32x4 __attribute__((ext_vector_type(4)));
#define LDS_WAIT() asm volatile("s_waitcnt lgkmcnt(0)" ::: "memory")
#define VM_WAIT() asm volatile("s_waitcnt vmcnt(0)" ::: "memory")
__device__ __forceinline__ unsigned pk2(float lo, float hi) { return pg8::cvt_pk_bf16(lo, hi); }
__device__ __forceinline__ float bflo(unsigned w) { return __builtin_bit_cast(float, w << 16); }
__device__ __forceinline__ float bfhi(unsigned w) { return __builtin_bit_cast(float, w & 0xffff0000u); }
#ifndef MK_Q8
#define MK_Q8 0
#endif
#ifndef MK_CHK_TOL
#define MK_CHK_TOL 0.15f
#endif
#ifndef MK_CHECK8
#define MK_CHECK8 0
#endif
__device__ __forceinline__ unsigned pk4_fp8(float a, float b, float c, float d) {
    int w = __builtin_amdgcn_cvt_pk_fp8_f32(a, b, 0, false); w = __builtin_amdgcn_cvt_pk_fp8_f32(c, d, w, true); return (unsigned)w; }
__device__ __forceinline__ float q8f(float v) { const int p = __builtin_amdgcn_cvt_pk_fp8_f32(v, v, 0, false); return __builtin_amdgcn_cvt_f32_fp8(p, 0); }
__device__ __forceinline__ float bf2f(bf16 b) { return __builtin_bit_cast(float, ((unsigned)b) << 16); }

#define XB_TMO      128
#define XB_XCNT(j)  (256  + 64 * (j))
#define XB_XSUB(j)  (1280 + 64 * (j))
#define XB_XGEN(j)  (2304 + 64 * (j))
#define XB_TOP      3328
#define XB_TOPGEN   3392
#define XCD_BAR_WORDS 3456
#define XB_SPIN_CAP (1u << 18)

__device__ __forceinline__ unsigned xb_ld(unsigned* p)              { return __hip_atomic_load(p, __ATOMIC_RELAXED, __HIP_MEMORY_SCOPE_AGENT); }
__device__ __forceinline__ unsigned xb_add(unsigned* p, unsigned v) { return __hip_atomic_fetch_add(p, v, __ATOMIC_RELAXED, __HIP_MEMORY_SCOPE_AGENT); }
__device__ __forceinline__ unsigned xb_xcc_id() { return (unsigned)__builtin_amdgcn_s_getreg((3 << 11) | 20) & 0xFu; }
#define XB_SPIN(cond, bar) do { unsigned _sp = 0; while (cond) { __builtin_amdgcn_s_sleep(1); \
    if ((++_sp & 255u) == 0u) { if (xb_ld(&(bar)[XB_TMO])) break; if (_sp > XB_SPIN_CAP) { atomicAdd(&(bar)[XB_TMO], 1u); break; } } } } while (0)

struct XcdBarrier {
    unsigned* bar; unsigned x;
    volatile LAS unsigned* st;
};

__device__ __forceinline__ XcdBarrier xcd_barrier_post(unsigned* bar, volatile LAS unsigned* st) {
    XcdBarrier b; b.bar = bar; b.x = xb_xcc_id(); b.st = st;
    if (threadIdx.x == 0) (void)xb_add(&bar[XB_XCNT(b.x)], 1u);
    return b;
}
__device__ __forceinline__ void xcd_barrier_complete(unsigned* bar, unsigned x, unsigned& nloc, unsigned& nx) {
    const unsigned G = gridDim.x * gridDim.y * gridDim.z;
    unsigned sum, cnt, mine, sp = 0u;
    for (;;) {
        sum = 0u; cnt = 0u; mine = 0u;
#pragma unroll
        for (unsigned j = 0; j < 16; ++j) { const unsigned c = xb_ld(&bar[XB_XCNT(j)]); sum += c; cnt += (c > 0u) ? 1u : 0u; mine = (j == x) ? c : mine; }
        if (sum == G) break;
        __builtin_amdgcn_s_sleep(1);
        if ((++sp & 255u) == 0u) { if (xb_ld(&bar[XB_TMO])) break; if (sp > XB_SPIN_CAP) { atomicAdd(&bar[XB_TMO], 1u); break; } }
    }
    nloc = mine > 0u ? mine : 1u; nx = cnt > 0u ? cnt : 1u;
}

__device__ __forceinline__ void xcd_barrier(const XcdBarrier& b) {
    asm volatile("s_waitcnt vmcnt(0)" ::: "memory");
    __syncthreads();
    if (threadIdx.x == 0) {
        unsigned* bar = b.bar;
        __builtin_amdgcn_s_waitcnt(0);
        unsigned nloc = b.st[0], nx = b.st[1];
        if (nloc == 0u) { xcd_barrier_complete(bar, b.x, nloc, nx); b.st[0] = nloc; b.st[1] = nx; }
        const unsigned old = xb_add(&bar[XB_XSUB(b.x)], 1u);
        const unsigned gen = old / nloc;
        if (old + 1u == (gen + 1u) * nloc) {
            __builtin_amdgcn_fence(__ATOMIC_RELEASE, "agent");
            asm volatile("s_waitcnt vmcnt(0)" ::: "memory");
            const unsigned og = xb_add(&bar[XB_TOP], 1u);
            const unsigned tg = og / nx;
            if (og + 1u == (tg + 1u) * nx) xb_add(&bar[XB_TOPGEN], 1u);
            else XB_SPIN(xb_ld(&bar[XB_TOPGEN]) == tg, bar);
            __builtin_amdgcn_fence(__ATOMIC_ACQUIRE, "agent");
            xb_add(&bar[XB_XGEN(b.x)], 1u);
            asm volatile("s_waitcnt vmcnt(0)" ::: "memory");
        } else {
            XB_SPIN(xb_ld(&bar[XB_XGEN(b.x)]) == gen, bar);
            __builtin_amdgcn_fence(__ATOMIC_ACQUIRE, "agent");
            asm volatile("s_waitcnt vmcnt(0)" ::: "memory");
        }
    }
    __syncthreads();
}

constexpr int S_ = 8192, DM = 2048, INW = 10240, NE = 32, TOPK = 4;
constexpr int A_W = 1536, A_V_OFF = 3072, B_Q_OFF = 4608, B_K_OFF = 5632, B_V_OFF = 5888, GATE_OFF = 6144;
constexpr int MAXSLOT = 40960;
constexpr float LN_EPS = 1e-5f, QK_EPS = 1e-6f;
constexpr float ALPHA = 1.189207115002721f;
constexpr int NPH = 11;

constexpr size_t MiB = 1u << 20;
constexpr size_t WS_CTL = 0, CTL_ZERO_BYTES = 32 * 1024;
constexpr int CW_BAR = 0;
constexpr int CW_CNT = 4096;
constexpr size_t WS_LUT = 1 * MiB;
constexpr size_t WS_ROPE = 1 * MiB + 8192;
constexpr size_t WS_WRT = 1 * MiB + 65536;
constexpr size_t WS_TOKE = 1 * MiB + 65536 + 262144;
constexpr size_t WS_TOKR = WS_TOKE + 131072;
constexpr size_t WS_TOKW = WS_TOKR + 131072;
constexpr size_t WS_TOKS = WS_TOKW + 131072;
constexpr size_t WS_SLOTW = WS_TOKS + 131072;
constexpr size_t WS_LSE = 3 * MiB;
constexpr size_t WS_XB = 4 * MiB;
constexpr size_t WS_WIN = WS_XB + 32 * MiB;
constexpr size_t WS_WA = WS_WIN + 40 * MiB;
constexpr size_t WS_WB = WS_WA + 2 * MiB;
constexpr size_t WS_WO = WS_WB + 4 * MiB;
constexpr size_t WS_WGL = WS_WO + 8 * MiB;
constexpr size_t WS_WD = WS_WGL + 512 * MiB;
constexpr size_t WS_PROJ = WS_WD + 256 * MiB;
constexpr size_t WS_QBR = WS_PROJ + 160 * MiB;
constexpr size_t WS_KBR = WS_QBR + 16 * MiB;
constexpr size_t WS_VBR = WS_KBR + 4 * MiB;
constexpr size_t WS_Q8 = WS_VBR + 4 * MiB;
constexpr size_t WS_K8 = WS_Q8 + 8 * MiB;
constexpr size_t WS_VIMG = WS_K8 + 2 * MiB;
constexpr size_t WS_DBG = WS_VIMG + 2 * MiB;
constexpr size_t WS_OUTA = WS_DBG + 64 * MiB;
constexpr size_t WS_YA = WS_OUTA + 24 * MiB;
constexpr size_t WS_YB = WS_YA + 8 * MiB;
constexpr size_t WS_T1 = WS_YB + 16 * MiB;
constexpr size_t WS_Y = WS_T1 + 64 * MiB;
constexpr size_t WS_X1 = WS_Y + 32 * MiB;
constexpr size_t WS_X1B = WS_X1 + 64 * MiB;
constexpr size_t WS_XS = WS_X1B + 32 * MiB;
constexpr size_t WS_H = WS_XS + 160 * MiB;
constexpr size_t WS_YS = WS_PROJ;
constexpr size_t WS_END = WS_H + 160 * MiB;

constexpr int RING_OFF = 0, RING_BYTES = 131072;
constexpr int L_XB = RING_BYTES;
constexpr int L_TILE = RING_BYTES + 64;
constexpr int L_PST = RING_BYTES + 1024;
constexpr int L_CNT = RING_BYTES + 1280;
constexpr int L_ASG = RING_BYTES + 2048;
constexpr int L_PTR = RING_BYTES + 3584;
constexpr int LDS_BYTES = 147456;

struct Frame {
    LAS unsigned char* lds; unsigned char* ldsg;
    int tid, lane, wave, G;
};
__device__ __forceinline__ unsigned char* wsp_(const Frame& F) {
    const LAS unsigned* p = (const LAS unsigned*)(F.lds + L_PTR) + 2 * 22;
    const unsigned lo = __builtin_amdgcn_readfirstlane(p[0]), hi = __builtin_amdgcn_readfirstlane(p[1]);
    return (unsigned char*)(((unsigned long long)hi << 32) | lo);
}
__device__ __forceinline__ const float* inp(const Frame& F, int i) {
    const LAS unsigned* p = (const LAS unsigned*)(F.lds + L_PTR) + 2 * i;
    const unsigned lo = __builtin_amdgcn_readfirstlane(p[0]), hi = __builtin_amdgcn_readfirstlane(p[1]);
    return (const float*)(((unsigned long long)hi << 32) | lo);
}
__device__ __forceinline__ float wave_sum(float v) {
#pragma unroll
    for (int o = 1; o < 64; o <<= 1) v += __shfl_xor(v, o);
    return v;
}

__device__ __forceinline__ void transpose_item(const float* __restrict__ W, int N, int k0, int n0, bf16* WT, int ldo, int orow0, int ocol0, LAS float* scr, int lane, const bool q8 = false) {
    f32x4 v[8];
#pragma unroll
    for (int i = 0; i < 8; ++i) v[i] = *(const f32x4*)(W + (size_t)(k0 + 8 * i + (lane >> 3)) * N + n0 + 4 * (lane & 7));
#pragma unroll
    for (int i = 0; i < 8; ++i) { LAS float* s = scr + (8 * i + (lane >> 3)) * 33 + 4 * (lane & 7); if (q8) { for (int e = 0; e < 4; ++e) v[i][e] = q8f(v[i][e] * 64.0f) * (1.0f / 64.0f); } s[0] = v[i][0]; s[1] = v[i][1]; s[2] = v[i][2]; s[3] = v[i][3]; }
    LDS_WAIT(); asm volatile("" ::: "memory");
    const int c = lane & 7;
#pragma unroll
    for (int j = 0; j < 4; ++j) { const int n = (lane >> 3) + 8 * j; const LAS float* s = scr + (8 * c) * 33 + n;
        v4u o; o.x = pk2(s[0 * 33], s[1 * 33]); o.y = pk2(s[2 * 33], s[3 * 33]); o.z = pk2(s[4 * 33], s[5 * 33]); o.w = pk2(s[6 * 33], s[7 * 33]);
        *(v4u*)(WT + (size_t)(orow0 + n) * ldo + ocol0 + 8 * c) = o; }
    LDS_WAIT(); asm volatile("" ::: "memory");
}
__device__ __forceinline__ void transpose_item8(const float* __restrict__ W, int N, int k0, int n0, unsigned char* WT, int ldo, int orow0, int ocol0, float scale, LAS float* scr, int lane) {
    f32x4 v[8];
#pragma unroll
    for (int i = 0; i < 8; ++i) v[i] = *(const f32x4*)(W + (size_t)(k0 + 8 * i + (lane >> 3)) * N + n0 + 4 * (lane & 7));
#pragma unroll
    for (int i = 0; i < 8; ++i) { LAS float* s = scr + (8 * i + (lane >> 3)) * 33 + 4 * (lane & 7); s[0] = v[i][0] * scale; s[1] = v[i][1] * scale; s[2] = v[i][2] * scale; s[3] = v[i][3] * scale; }
    LDS_WAIT(); asm volatile("" ::: "memory");
    const int c = lane & 3;
#pragma unroll
    for (int j = 0; j < 2; ++j) { const int n = (lane >> 2) + 16 * j; const LAS float* s = scr + (16 * c) * 33 + n;
        v4u o; o.x = pk4_fp8(s[0 * 33], s[1 * 33], s[2 * 33], s[3 * 33]); o.y = pk4_fp8(s[4 * 33], s[5 * 33], s[6 * 33], s[7 * 33]);
        o.z = pk4_fp8(s[8 * 33], s[9 * 33], s[10 * 33], s[11 * 33]); o.w = pk4_fp8(s[12 * 33], s[13 * 33], s[14 * 33], s[15 * 33]);
        *(v4u*)(WT + (size_t)(orow0 + n) * ldo + ocol0 + 16 * c) = o; }
    LDS_WAIT(); asm volatile("" ::: "memory");
}
__device__ __forceinline__ int t5_bucket(int rel) {
    const int n = rel < 0 ? -rel : rel; const float nf = (float)(n < 1 ? 1 : n);
    int large = 8 + (int)(logf(nf / 8.0f) / 4.852030263919617f * 8.0f); large = large < 15 ? large : 15;
    return (rel > 0 ? 16 : 0) + (n < 8 ? n : large);
}
__device__ __forceinline__ void p0_prologue(Frame& F) {
    LAS float* scr = (LAS float*)(F.lds + RING_OFF + F.wave * 16384);
    const int gw = blockIdx.x * 8 + F.wave, NGW = F.G * 8;
    const int gt = blockIdx.x * 512 + F.tid, NGT = F.G * 512;
    bf16* XB = (bf16*)(wsp_(F) + WS_XB); bf16* WIN = (bf16*)(wsp_(F) + WS_WIN); bf16* WA = (bf16*)(wsp_(F) + WS_WA); bf16* WB = (bf16*)(wsp_(F) + WS_WB); bf16* WO = (bf16*)(wsp_(F) + WS_WO);
    bf16* WGL = (bf16*)(wsp_(F) + WS_WGL); bf16* WD = (bf16*)(wsp_(F) + WS_WD);
    { float* lut = (float*)(wsp_(F) + WS_LUT); const float* rb = inp(F, 3);
      for (int i = gt; i < 3 * 4 * 129; i += NGT) { const int g = i / 516, hh = (i / 129) % 4, j = i % 129; const int d = (g == 0) ? 1 : (g == 1 ? 4 : 16);
          lut[i] = rb[t5_bucket((j - 64) * d) * 12 + g * 4 + hh]; }
      float* rope = (float*)(wsp_(F) + WS_ROPE);
      for (int i = gt; i < 128 * 32; i += NGT) { const int pos = i >> 5, fi = i & 31; const float inv = powf(10000.0f, -(float)(2 * fi) / 64.0f); const float ang = (float)pos * inv;
          rope[2 * i] = __cosf(ang); rope[2 * i + 1] = __sinf(ang); }
      float* wrt = (float*)(wsp_(F) + WS_WRT); const float* wr = inp(F, 11);
      for (int i = gt; i < 32 * 2048; i += NGT) { const int e = i >> 11, c = i & 2047; wrt[i] = wr[c * 32 + e]; }
    }
    { const float* x = inp(F, 0);
      for (int i = gw; i < S_ * DM / 512; i += NGW) { const size_t o = (size_t)i * 512 + F.lane * 8; const f32x4 a = *(const f32x4*)(x + o), b = *(const f32x4*)(x + o + 4);
          v2u w; w.x = pk4_fp8(a[0], a[1], a[2], a[3]); w.y = pk4_fp8(b[0], b[1], b[2], b[3]); *(v2u*)((unsigned char*)XB + o) = w; } }
    constexpr int T_WIN = 16 * 80, T_WA = 4 * 16, T_WB = 8 * 16, T_WO = 16 * 16;
    constexpr int NT = T_WIN + T_WA + T_WB + T_WO;
    const float* const w_in = inp(F, 1); const float* const w_ba = inp(F, 6); const float* const w_bb = inp(F, 7); const float* const w_o = inp(F, 8);
#define P0_DECODE(T, SRC, NN, DST, LDO, SCL) do { int r_ = (T); \
        if (r_ < T_WIN) { const int kt = r_ / 80, nt = r_ % 80; SRC = w_in + (size_t)(128 * kt) * INW + 128 * nt; NN = INW; DST = (unsigned char*)WIN + (size_t)(nt >> 1) * (256 * 2048) + kt * 32768 + (nt & 1) * 16384; LDO = 128; SCL = 64.0f; break; } r_ -= T_WIN; \
        if (r_ < T_WA) { const int kt = r_ / 16, nt = r_ % 16; SRC = w_ba + (size_t)(128 * kt) * DM + 128 * nt; NN = DM; DST = (unsigned char*)WA + (size_t)(nt >> 1) * (256 * 512) + kt * 32768 + (nt & 1) * 16384; LDO = 128; SCL = 32.0f; break; } r_ -= T_WA; \
        if (r_ < T_WB) { const int kt = r_ / 16, nt = r_ % 16; SRC = w_bb + (size_t)(128 * kt) * DM + 128 * nt; NN = DM; DST = (unsigned char*)WB + (size_t)(nt >> 1) * (256 * 1024) + kt * 32768 + (nt & 1) * 16384; LDO = 128; SCL = 32.0f; break; } r_ -= T_WB; \
        { const int kt = r_ / 16, nt = r_ % 16; SRC = w_o + (size_t)(128 * kt) * DM + 128 * nt; NN = DM; DST = (unsigned char*)WO + (size_t)(nt >> 1) * (256 * 2048) + kt * 32768 + (nt & 1) * 16384; LDO = 128; SCL = 64.0f; } } while (0)
    const int nq = F.tid & 31, kq0 = F.tid >> 5;
#define P0_LOAD(V, SRC, NN) do { _Pragma("unroll") for (int p = 0; p < 2; ++p) _Pragma("unroll") for (int i = 0; i < 4; ++i) V[p * 4 + i] = __builtin_nontemporal_load((const f32x4*)(SRC + (size_t)(4 * (kq0 + 16 * p) + i) * NN + 4 * nq)); } while (0)
    if ((int)blockIdx.x < NT) {
        const int nj = (NT - (int)blockIdx.x + F.G - 1) / F.G;
        const float* src; int nn; unsigned char* dst; int ldo; float scl;
        P0_DECODE((int)blockIdx.x, src, nn, dst, ldo, scl);
        f32x4 v[8]; P0_LOAD(v, src, nn);
        for (int j = 0; j < nj; ++j) {
            const int jn = (j + 1 < nj) ? j + 1 : j;
            const float* nsrc; int nnn; unsigned char* ndst; int nldo; float nscl;
            P0_DECODE((int)blockIdx.x + jn * F.G, nsrc, nnn, ndst, nldo, nscl);
            f32x4 nv[8]; P0_LOAD(nv, nsrc, nnn);
            LAS unsigned* t32 = (LAS unsigned*)(F.lds + RING_OFF + (j & 1) * 16384);
#pragma unroll
            for (int p = 0; p < 2; ++p)
#pragma unroll
                for (int c = 0; c < 4; ++c) t32[(4 * nq + c) * 32 + ((kq0 + 16 * p) ^ nq)] = pk4_fp8(v[p * 4 + 0][c] * scl, v[p * 4 + 1][c] * scl, v[p * 4 + 2][c] * scl, v[p * 4 + 3][c] * scl);
            __syncthreads();
#pragma unroll
            for (int jj = 0; jj < 2; ++jj) { const int n = (F.tid >> 3) + 64 * jj, c8 = F.tid & 7, g = n >> 2; const LAS unsigned* rp = t32 + n * 32;
                v4u o; o.x = rp[(4 * c8 + 0) ^ g]; o.y = rp[(4 * c8 + 1) ^ g]; o.z = rp[(4 * c8 + 2) ^ g]; o.w = rp[(4 * c8 + 3) ^ g];
                __builtin_nontemporal_store(o, (v4u*)(dst + (size_t)n * ldo + 16 * c8)); }
#pragma unroll
            for (int i = 0; i < 8; ++i) v[i] = nv[i];
            src = nsrc; nn = nnn; dst = ndst; ldo = nldo; scl = nscl;
        }
        __syncthreads();
    }
#undef P0_DECODE
#undef P0_LOAD
}

__device__ __forceinline__ void moe_convert_share(Frame& F) {
    constexpr int T_ALL = 3 * 32 * 256;
    const float* const w_g = inp(F, 13); const float* const w_l = inp(F, 15); const float* const w_d = inp(F, 17);
    unsigned char* const WGL = wsp_(F) + WS_WGL; unsigned char* const WD = wsp_(F) + WS_WD;
#define MC_DECODE(T, SRC, DST) do { const int r_ = (T); const int which = r_ / (32 * 256), rr = r_ % (32 * 256), e = rr >> 8, q = rr & 255, kt = q >> 4, nt = q & 15; \
        SRC = (which == 0 ? w_g : (which == 1 ? w_l : w_d)) + (size_t)e * DM * DM + (size_t)(128 * kt) * DM + 128 * nt; \
        DST = (which < 2) ? WGL + (size_t)e * (4096 * 2048) + (size_t)nt * (256 * 2048) + kt * 32768 + which * 16384 : WD + (size_t)e * (2048 * 2048) + (size_t)(nt >> 1) * (256 * 2048) + kt * 32768 + (nt & 1) * 16384; } while (0)
    const int nq = F.tid & 31, kq0 = F.tid >> 5;
#define MC_LOAD(V, SRC) do { _Pragma("unroll") for (int p = 0; p < 2; ++p) _Pragma("unroll") for (int i = 0; i < 4; ++i) V[p * 4 + i] = __builtin_nontemporal_load((const f32x4*)(SRC + (size_t)(4 * (kq0 + 16 * p) + i) * DM + 4 * nq)); } while (0)
    if ((int)blockIdx.x < T_ALL) {
        const int nj = (T_ALL - (int)blockIdx.x + F.G - 1) / F.G, t0_ = (int)blockIdx.x;
        f32x4 b0[8], b1[8], b2[8], b3[8];
        unsigned char *d0, *d1, *d2, *d3 = nullptr;
        { const float* sp; MC_DECODE(t0_ + (0 < nj ? 0 : nj - 1) * F.G, sp, d0); MC_LOAD(b0, sp); }
        { const float* sp; MC_DECODE(t0_ + (1 < nj ? 1 : nj - 1) * F.G, sp, d1); MC_LOAD(b1, sp); }
        { const float* sp; MC_DECODE(t0_ + (2 < nj ? 2 : nj - 1) * F.G, sp, d2); MC_LOAD(b2, sp); }
#define MC_STEP(K, CUR, DCUR, NXT, DNXT) do { const int k_ = (K); \
            { const int kn_ = (k_ + 3 < nj) ? k_ + 3 : nj - 1; const float* sp; MC_DECODE(t0_ + kn_ * F.G, sp, DNXT); MC_LOAD(NXT, sp); } \
            if (k_ < nj) { \
                LAS unsigned* t32 = (LAS unsigned*)(F.lds + RING_OFF + (k_ & 1) * 16384); \
                _Pragma("unroll") for (int p = 0; p < 2; ++p) _Pragma("unroll") for (int c = 0; c < 4; ++c) \
                    t32[(4 * nq + c) * 32 + ((kq0 + 16 * p) ^ nq)] = pk4_fp8(CUR[p * 4 + 0][c] * 64.0f, CUR[p * 4 + 1][c] * 64.0f, CUR[p * 4 + 2][c] * 64.0f, CUR[p * 4 + 3][c] * 64.0f); \
                __syncthreads(); \
                _Pragma("unroll") for (int jj = 0; jj < 2; ++jj) { const int n = (F.tid >> 3) + 64 * jj, c8 = F.tid & 7, g = n >> 2; const LAS unsigned* rp = t32 + n * 32; \
                    v4u o; o.x = rp[(4 * c8 + 0) ^ g]; o.y = rp[(4 * c8 + 1) ^ g]; o.z = rp[(4 * c8 + 2) ^ g]; o.w = rp[(4 * c8 + 3) ^ g]; \
                    __builtin_nontemporal_store(o, (v4u*)(DCUR + (size_t)n * 128 + 16 * c8)); } } } while (0)
        for (int j = 0; j < nj; j += 4) {
            MC_STEP(j + 0, b0, d0, b3, d3);
            MC_STEP(j + 1, b1, d1, b0, d0);
            MC_STEP(j + 2, b2, d2, b1, d1);
            MC_STEP(j + 3, b3, d3, b2, d2);
        }
#undef MC_STEP
        __syncthreads();
    }
#undef MC_DECODE
#undef MC_LOAD
}

__device__ __forceinline__ void p2_prep_dilated(Frame& F) {
    const bf16* proj = (const bf16*)(wsp_(F) + WS_PROJ);
    bf16* QBR = (bf16*)(wsp_(F) + WS_QBR); bf16* KBR = (bf16*)(wsp_(F) + WS_KBR); bf16* VBR = (bf16*)(wsp_(F) + WS_VBR);
    unsigned char* Q8 = wsp_(F) + WS_Q8; unsigned char* K8 = wsp_(F) + WS_K8; unsigned char* VIMG = wsp_(F) + WS_VIMG;
    const float* rope = (const float*)(wsp_(F) + WS_ROPE);
    const int gw = blockIdx.x * 8 + F.wave, NGW = F.G * 8;
    const int half = F.lane >> 5, fi = F.lane & 31, c1 = half * 64 + fi, c2 = c1 + 32;
    const float* const qn_g = inp(F, 4); const float* const kn_g = inp(F, 5);
    int tfirst, tstep_, tcount;
    if (F.G == 256) { if (blockIdx.x >= 128) { tfirst = ((int)blockIdx.x - 128) * 8 + F.wave; tstep_ = 1024; tcount = 6; } else { tfirst = 6144 + (int)blockIdx.x * 8 + F.wave; tstep_ = 1024; tcount = 2; } }
    else { tfirst = gw; tstep_ = NGW; tcount = (S_ - gw + NGW - 1) / NGW; }
    for (int ti = 0; ti < tcount; ++ti) {
        const int t = tfirst + ti * tstep_;
        const bf16* base = proj + (size_t)t * INW;
        float a1[10], a2[10], ss[10];
#pragma unroll
        for (int h = 0; h < 10; ++h) { const bf16* src = base + (h < 8 ? B_Q_OFF + h * 128 : B_K_OFF + (h - 8) * 128); a1[h] = bf2f(src[c1]); a2[h] = bf2f(src[c2]); }
        const unsigned vv0 = ((const unsigned*)(base + B_V_OFF))[F.lane], vv1 = ((const unsigned*)(base + B_V_OFF + 128))[F.lane];
        const int pos = half ? (t & 63) : (t >> 6);
        const float cs = rope[(pos * 32 + fi) * 2], sn = rope[(pos * 32 + fi) * 2 + 1];
        const float gq1 = qn_g[c1], gq2 = qn_g[c2], gk1 = kn_g[c1], gk2 = kn_g[c2];
#pragma unroll
        for (int h = 0; h < 10; ++h) ss[h] = a1[h] * a1[h] + a2[h] * a2[h];
#pragma unroll
        for (int o = 1; o < 64; o <<= 1)
#pragma unroll
            for (int h = 0; h < 10; ++h) ss[h] += __shfl_xor(ss[h], o);
#pragma unroll
        for (int h = 0; h < 10; ++h) {
            const float rs = 1.0f / sqrtf(ss[h] * (1.0f / 128.0f) + QK_EPS);
            const float v1 = a1[h] * rs * (h < 8 ? gq1 : gk1), v2 = a2[h] * rs * (h < 8 ? gq2 : gk2);
            const float o1 = v1 * cs - v2 * sn, o2 = v1 * sn + v2 * cs;
            unsigned char* dst8 = h < 8 ? Q8 + (size_t)t * 1024 + h * 128 : K8 + (size_t)t * 256 + (h - 8) * 128;
            const unsigned pq = pk4_fp8(o1 * 0.35709130f, o2 * 0.35709130f, 0.f, 0.f); dst8[c1]     = (unsigned char)(pq & 0xffu); dst8[c2] = (unsigned char)((pq >> 8) & 0xffu);
            if (MK_CHECK8) { bf16* dst = h < 8 ? QBR + (size_t)t * 1024 + h * 128 : KBR + (size_t)t * 256 + (h - 8) * 128;
                dst[c1] = (bf16)(pk2(o1, 0.f) & 0xffffu); dst[c2] = (bf16)(pk2(o2, 0.f) & 0xffffu); }
        }
        if (MK_CHECK8) { ((unsigned*)(VBR + (size_t)t * 256))[F.lane] = vv0; ((unsigned*)(VBR + (size_t)t * 256 + 128))[F.lane] = vv1; }
        {
            const int kk = t & 63, part = kk >> 5, k32 = kk & 31, g = (k32 >> 2) & 1, ii = (k32 & 3) + 4 * (k32 >> 3);
            unsigned char* img = VIMG + (size_t)(t >> 6) * 8192 + part * 1024 + g * 512 + ii;
            const int ca = 2 * F.lane, cb = 2 * F.lane + 1;
            const unsigned p0 = pk4_fp8(bflo(vv0) * 16.0f, bfhi(vv0) * 16.0f, bflo(vv1) * 16.0f, bfhi(vv1) * 16.0f);
            img[(ca >> 5) * 2048 + (ca & 31) * 16] = (unsigned char)(p0 & 0xffu); img[(cb >> 5) * 2048 + (cb & 31) * 16] = (unsigned char)((p0 >> 8) & 0xffu);
            img[128 * 8192 + (ca >> 5) * 2048 + (ca & 31) * 16] = (unsigned char)((p0 >> 16) & 0xffu); img[128 * 8192 + (cb >> 5) * 2048 + (cb & 31) * 16] = (unsigned char)((p0 >> 24) & 0xffu);
        }
    }
    const float* lut = (const float*)(wsp_(F) + WS_LUT);
    for (int u = blockIdx.x; u < 384; u += F.G) {
        const int gh = u >> 5, blk = u & 31, g = gh >> 2, hh = gh & 3, d = (g == 0) ? 1 : (g == 1 ? 4 : 16);
        const int bps = 32 / d, r = blk / bps, qb = blk % bps;
        at::dilated_unit((const at::bf16*)proj, lut + (g * 4 + hh) * 129, (at::bf16*)(wsp_(F) + WS_OUTA) + (size_t)g * S_ * 512, (float*)(wsp_(F) + WS_LSE) + (size_t)g * S_ * 4,
                         d, gh, hh, r, qb * 256, (char*)F.ldsg + RING_OFF);
    }
}

__device__ __forceinline__ void p3_attn_combine(Frame& F) {
    const at::bf16* QBR = (const at::bf16*)(wsp_(F) + WS_QBR); const at::bf16* KBR = (const at::bf16*)(wsp_(F) + WS_KBR); const at::bf16* VBR = (const at::bf16*)(wsp_(F) + WS_VBR);
    unsigned char* YB = wsp_(F) + WS_YB;
    const bool conv_first = (((int)blockIdx.x >> 3) & 1) != 0;
#define P3_ATTN_UNITS() do { for (int u = blockIdx.x; u < 256; u += F.G) { const int h = u & 7, qb = u >> 3, kv = h >> 2; \
        at::attn_dense_body8<1024, 256, 1024>(wsp_(F) + WS_Q8 + (size_t)qb * 256 * 1024 + h * 128, wsp_(F) + WS_K8 + kv * 128, wsp_(F) + WS_VIMG + (size_t)kv * 128 * 8192, YB + (size_t)qb * 256 * 1024 + h * 128, S_, (char*)F.ldsg + RING_OFF); \
        __syncthreads(); } } while (0)
    if (MK_CHECK8) { P3_ATTN_UNITS(); }
    else { if (!conv_first) P3_ATTN_UNITS();
    moe_convert_share(F); __syncthreads();
    if (conv_first) P3_ATTN_UNITS(); }
#undef P3_ATTN_UNITS
    if (MK_CHECK8) for (int u = blockIdx.x; u < 256; u += F.G) { const int h = u & 7, qb = u >> 3, kv = h >> 2;
        at::attn_dense_body<1024, 256, 256, 1024>(QBR + (size_t)qb * 256 * 1024 + h * 128, KBR + kv * 128, VBR + kv * 128, wsp_(F) + WS_DBG + (size_t)qb * 256 * 1024 + h * 128, S_, (char*)F.ldsg + RING_OFF); __syncthreads(); }
    const bf16* OUTA = (const bf16*)(wsp_(F) + WS_OUTA); const float* LSE = (const float*)(wsp_(F) + WS_LSE); bf16* YA = (bf16*)(wsp_(F) + WS_YA);
    for (int tb = blockIdx.x; tb < 256; tb += F.G) {
        const int t = tb * 32 + (F.tid >> 4), c0 = (F.tid & 15) * 32, hh = c0 >> 7;
        const float l0 = LSE[(size_t)t * 4 + hh], l1 = LSE[(size_t)(S_ + t) * 4 + hh], l2 = LSE[(size_t)(2 * S_ + t) * 4 + hh];
        const float m = fmaxf(l0, fmaxf(l1, l2)); float w0 = __expf(l0 - m), w1 = __expf(l1 - m), w2 = __expf(l2 - m); const float inv = 16.0f / (w0 + w1 + w2); w0 *= inv; w1 *= inv; w2 *= inv;
#pragma unroll
        for (int q = 0; q < 4; ++q) { const size_t o = (size_t)t * 512 + c0 + q * 8;
            const v4u a = *(const v4u*)(OUTA + o), b = *(const v4u*)(OUTA + (size_t)S_ * 512 + o), c = *(const v4u*)(OUTA + (size_t)2 * S_ * 512 + o);
            v2u w;
            w.x = pk4_fp8(w0 * bflo(a.x) + w1 * bflo(b.x) + w2 * bflo(c.x), w0 * bfhi(a.x) + w1 * bfhi(b.x) + w2 * bfhi(c.x), w0 * bflo(a.y) + w1 * bflo(b.y) + w2 * bflo(c.y), w0 * bfhi(a.y) + w1 * bfhi(b.y) + w2 * bfhi(c.y));
            w.y = pk4_fp8(w0 * bflo(a.z) + w1 * bflo(b.z) + w2 * bflo(c.z), w0 * bfhi(a.z) + w1 * bfhi(b.z) + w2 * bfhi(c.z), w0 * bflo(a.w) + w1 * bflo(b.w) + w2 * bflo(c.w), w0 * bfhi(a.w) + w1 * bfhi(b.w) + w2 * bfhi(c.w));
            *(v2u*)((unsigned char*)YA + o) = w; }
    }
}

typedef float f32x16m __attribute__((ext_vector_type(16)));
__device__ __forceinline__ void p6_ln_router(Frame& F, const int bank = 0) {
    LAS int* cntl = (LAS int*)(F.lds + L_CNT); LAS int* basel = cntl + 32;
    LAS int* asg_e = (LAS int*)(F.lds + L_ASG); LAS int* asg_lr = asg_e + 128; LAS float* asg_w = (LAS float*)(asg_lr + 128);
    LAS float* x1s = (LAS float*)(F.lds + RING_OFF);
    LAS float* red = (LAS float*)(F.lds + RING_OFF + 73728);
    const float* Z1 = (const float*)(wsp_(F) + WS_T1); bf16* X1 = (bf16*)(wsp_(F) + WS_X1); unsigned char* X1Q = wsp_(F) + WS_X1B;
    const f32x4* G4 = (const f32x4*)inp(F, 9); const f32x4* B4 = (const f32x4*)inp(F, 10);
    const float* wr = inp(F, 11); const float* br = inp(F, 12);
    unsigned* gcnt = ((unsigned*)(wsp_(F) + WS_CTL)) + CW_CNT + bank * 64;
    int* TOKE = (int*)(wsp_(F) + (bank ? WS_H : WS_TOKE)); int* TOKR = (int*)(wsp_(F) + (bank ? WS_H + MiB : WS_TOKR)); float* TOKW = (float*)(wsp_(F) + (bank ? WS_H + 2 * MiB : WS_TOKW));
    const int li = F.lane & 31, kk = F.lane >> 5;
    for (int tb = blockIdx.x; tb < 256; tb += F.G) {
        if (F.tid < 32) cntl[F.tid] = 0;
        const int t0 = tb * 32 + F.wave * 4;
        f32x4 xv[4][8];
#pragma unroll
        for (int tk = 0; tk < 4; ++tk) {
            const f32x4* zr = (const f32x4*)(Z1 + (size_t)(t0 + tk) * DM) + F.lane;
#pragma unroll
            for (int j = 0; j < 8; ++j) xv[tk][j] = zr[64 * j];
            float s = 0.f;
#pragma unroll
            for (int j = 0; j < 8; ++j) s += (xv[tk][j][0] + xv[tk][j][1]) + (xv[tk][j][2] + xv[tk][j][3]);
            const float mean = wave_sum(s) * (1.0f / DM); float s2 = 0.f;
#pragma unroll
            for (int j = 0; j < 8; ++j) { xv[tk][j] = xv[tk][j] - mean; s2 += (xv[tk][j][0] * xv[tk][j][0] + xv[tk][j][1] * xv[tk][j][1]) + (xv[tk][j][2] * xv[tk][j][2] + xv[tk][j][3] * xv[tk][j][3]); }
            const float rstd = 1.0f / sqrtf(wave_sum(s2) * (1.0f / DM) + LN_EPS);
            v2u* xo = (v2u*)(X1 + (size_t)(t0 + tk) * DM) + F.lane; unsigned* xb = (unsigned*)(X1Q + (size_t)(t0 + tk) * DM) + F.lane;
#pragma unroll
            for (int j = 0; j < 8; ++j) { const f32x4 v = xv[tk][j] * rstd * G4[64 * j + F.lane] + B4[64 * j + F.lane]; xv[tk][j] = v;
                v2u w; w.x = pk2(v[0], v[1]); w.y = pk2(v[2], v[3]); xo[64 * j] = w; xb[64 * j] = pk4_fp8(v[0], v[1], v[2], v[3]); }
            asm volatile("" ::: "memory"); __builtin_amdgcn_sched_barrier(0);
        }
        f32x16m acc = {0.f, 0.f, 0.f, 0.f, 0.f, 0.f, 0.f, 0.f, 0.f, 0.f, 0.f, 0.f, 0.f, 0.f, 0.f, 0.f};
        const float* wp = wr + (size_t)(32 * F.wave + 4 * kk) * 32 + li;
#pragma unroll
        for (int c = 0; c < 8; ++c) {
            LAS float* buf = x1s + (c & 1) * (32 * 260);
#pragma unroll
            for (int tk = 0; tk < 4; ++tk) *(LAS f32x4*)(buf + (4 * F.wave + tk) * 260 + 4 * F.lane) = xv[tk][c];
            __syncthreads();
#pragma unroll
            for (int b = 0; b < 4; ++b) {
                const f32x4 a4 = *(const LAS f32x4*)(buf + li * 260 + 32 * F.wave + 8 * b + 4 * kk);
                asm volatile("" : "+v"(wp));
                const float b0 = wp[0], b1 = wp[32], b2 = wp[64], b3 = wp[96]; wp += (b == 3) ? (256 - 24) * 32 : 8 * 32;
                acc = __builtin_amdgcn_mfma_f32_32x32x2f32(a4[0], b0, acc, 0, 0, 0);
                acc = __builtin_amdgcn_mfma_f32_32x32x2f32(a4[1], b1, acc, 0, 0, 0);
                acc = __builtin_amdgcn_mfma_f32_32x32x2f32(a4[2], b2, acc, 0, 0, 0);
                acc = __builtin_amdgcn_mfma_f32_32x32x2f32(a4[3], b3, acc, 0, 0, 0);
            }
            __builtin_amdgcn_sched_barrier(0);
        }
#pragma unroll
        for (int r = 0; r < 16; ++r) red[(F.wave * 32 + ((r & 3) + 8 * (r >> 2) + 4 * kk)) * 32 + li] = acc[r];
        __syncthreads();
#pragma unroll
        for (int tk = 0; tk < 4; ++tk) {
            float v = -3.0e38f;
            if (F.lane < 32) { float sres = br[F.lane];
#pragma unroll
                for (int w8 = 0; w8 < 8; ++w8) sres += red[(w8 * 32 + 4 * F.wave + tk) * 32 + F.lane];
                v = sres; }
            float tv[4]; int ti[4];
#pragma unroll
            for (int k = 0; k < 4; ++k) { float bv = v; int bi = F.lane;
#pragma unroll
                for (int o = 1; o < 64; o <<= 1) { const float ov = __shfl_xor(bv, o); const int oi = __shfl_xor(bi, o); if (ov > bv || (ov == bv && oi < bi)) { bv = ov; bi = oi; } }
                tv[k] = bv; ti[k] = bi; if (F.lane == bi) v = -3.0e38f; }
            const float e1 = __expf(tv[1] - tv[0]), e2 = __expf(tv[2] - tv[0]), e3 = __expf(tv[3] - tv[0]); const float inv = 1.0f / (1.0f + e1 + e2 + e3);
            if (F.lane < 4) { const int me = F.lane == 0 ? ti[0] : (F.lane == 1 ? ti[1] : (F.lane == 2 ? ti[2] : ti[3]));
                const float mw = (F.lane == 0 ? 1.0f : (F.lane == 1 ? e1 : (F.lane == 2 ? e2 : e3))) * inv;
                const int lr = atomicAdd((int*)(cntl + me), 1);
                const int a = (F.wave * 4 + tk) * 4 + F.lane; asg_e[a] = me; asg_lr[a] = lr; asg_w[a] = mw; }
        }
        __syncthreads();
        if (F.tid < 32) basel[F.tid] = (int)atomicAdd(gcnt + F.tid, (unsigned)cntl[F.tid]);
        __syncthreads();
        if (F.tid < 128) { const int a = tb * 128 + F.tid; const int e = asg_e[F.tid]; TOKE[a] = e; TOKR[a] = basel[e] + asg_lr[F.tid]; TOKW[a] = asg_w[F.tid]; }
        __syncthreads();
    }
}

__device__ __forceinline__ void p7_gather(Frame& F) {
    LAS int* pst = (LAS int*)(F.lds + L_PST);
    const unsigned* gcnt = ((unsigned*)(wsp_(F) + WS_CTL)) + CW_CNT;
    if (F.tid == 0) { int acc = 0; for (int e = 0; e < 32; ++e) { pst[e] = acc; acc += ((int)gcnt[e] + 255) & ~255; } pst[32] = acc; }
    __syncthreads();
    const int* TOKE = (const int*)(wsp_(F) + WS_TOKE); const int* TOKR = (const int*)(wsp_(F) + WS_TOKR); const float* TOKW = (const float*)(wsp_(F) + WS_TOKW);
    int* TOKS = (int*)(wsp_(F) + WS_TOKS); float* SLOTW = (float*)(wsp_(F) + WS_SLOTW);
    const bf16* X1B = (const bf16*)(wsp_(F) + WS_X1B); bf16* XS = (bf16*)(wsp_(F) + WS_XS);
    const int gw = blockIdx.x * 8 + F.wave, NGW = F.G * 8;
    for (int a0 = gw; a0 < S_ * TOPK; a0 += 4 * NGW) {
        int slot[4]; float w[4]; v4u r0[4], r1[4];
#pragma unroll
        for (int q = 0; q < 4; ++q) { const int a = a0 + q * NGW; const int ac = a < S_ * TOPK ? a : a0; slot[q] = pst[TOKE[ac]] + TOKR[ac]; w[q] = TOKW[ac]; }
#pragma unroll
        for (int q = 0; q < 4; ++q) { const int a = a0 + q * NGW; const int ac = a < S_ * TOPK ? a : a0; const v4u* src = (const v4u*)((const unsigned char*)X1B + (size_t)(ac >> 2) * DM) + F.lane; r0[q] = src[0]; r1[q] = src[64]; }
#pragma unroll
        for (int q = 0; q < 4; ++q) { const int a = a0 + q * NGW; if (a < S_ * TOPK) { if (F.lane == 0) { TOKS[a] = slot[q]; SLOTW[slot[q]] = w[q]; }
            v4u* dst = (v4u*)((unsigned char*)XS + (size_t)slot[q] * DM) + F.lane; dst[0] = r0[q]; dst[64] = r1[q]; } }
    }
}
__device__ __forceinline__ int moe_tiles(Frame& F) {
    LAS int* tile_e = (LAS int*)(F.lds + L_TILE);
    const unsigned* gcnt = ((unsigned*)(wsp_(F) + WS_CTL)) + CW_CNT;
    __syncthreads();
    if (F.tid == 0) { int ti = 0; for (int e = 0; e < 32; ++e) { const int nt = ((int)gcnt[e] + 255) >> 8; for (int k = 0; k < nt && ti < 160; ++k) tile_e[ti++] = e; } tile_e[160] = ti; }
    __syncthreads();
    return tile_e[160];
}

__device__ __forceinline__ void p10_final(Frame& F) {
    const bf16* X1 = (const bf16*)(wsp_(F) + WS_X1); const bf16* YS = (const bf16*)(wsp_(F) + WS_YS); const int* TOKS = (const int*)(wsp_(F) + WS_TOKS);
    const f32x4* G4 = (const f32x4*)inp(F, 19); const f32x4* B4 = (const f32x4*)inp(F, 20);
    float* outp = (float*)inp(F, 21);
    const int gw = blockIdx.x * 8 + F.wave, NGW = F.G * 8;
    for (int t0 = gw; t0 < S_; t0 += 2 * NGW) {
        f32x4 v[2][8]; int tt[2]; int sl[2][4];
#pragma unroll
        for (int q = 0; q < 2; ++q) { const int t = t0 + q * NGW; tt[q] = t < S_ ? t : t0; }
#pragma unroll
        for (int q = 0; q < 2; ++q)
#pragma unroll
            for (int k = 0; k < 4; ++k) sl[q][k] = TOKS[tt[q] * 4 + k];
#pragma unroll
        for (int q = 0; q < 2; ++q) {
            const v4u* xr = (const v4u*)(X1 + (size_t)tt[q] * DM) + F.lane;
            const v4u* y0 = (const v4u*)(YS + (size_t)sl[q][0] * DM) + F.lane; const v4u* y1 = (const v4u*)(YS + (size_t)sl[q][1] * DM) + F.lane;
            const v4u* y2 = (const v4u*)(YS + (size_t)sl[q][2] * DM) + F.lane; const v4u* y3 = (const v4u*)(YS + (size_t)sl[q][3] * DM) + F.lane;
#pragma unroll
            for (int jj = 0; jj < 4; ++jj) { const v4u x = xr[64 * jj], a = y0[64 * jj], b = y1[64 * jj], c = y2[64 * jj], d = y3[64 * jj];
#define P10_LO(W) (bflo(x.W) * ALPHA + ((bflo(a.W) + bflo(b.W)) + (bflo(c.W) + bflo(d.W))))
#define P10_HI(W) (bfhi(x.W) * ALPHA + ((bfhi(a.W) + bfhi(b.W)) + (bfhi(c.W) + bfhi(d.W))))
                v[q][2 * jj] = (f32x4){P10_LO(x), P10_HI(x), P10_LO(y), P10_HI(y)}; v[q][2 * jj + 1] = (f32x4){P10_LO(z), P10_HI(z), P10_LO(w), P10_HI(w)};
#undef P10_LO
#undef P10_HI
            }
        }
#pragma unroll
        for (int q = 0; q < 2; ++q) {
            float s = 0.f;
#pragma unroll
            for (int j = 0; j < 8; ++j) s += (v[q][j][0] + v[q][j][1]) + (v[q][j][2] + v[q][j][3]);
            const float mean = wave_sum(s) * (1.0f / DM); float s2 = 0.f;
#pragma unroll
            for (int j = 0; j < 8; ++j) { v[q][j] = v[q][j] - mean; s2 += (v[q][j][0] * v[q][j][0] + v[q][j][1] * v[q][j][1]) + (v[q][j][2] * v[q][j][2] + v[q][j][3] * v[q][j][3]); }
            const float rstd = 1.0f / sqrtf(wave_sum(s2) * (1.0f / DM) + LN_EPS);
            if (t0 + q * NGW < S_) { f32x4* o = (f32x4*)(outp + (size_t)tt[q] * DM) + 2 * F.lane;
#pragma unroll
                for (int jj = 0; jj < 4; ++jj) { o[128 * jj] = v[q][2 * jj] * rstd * G4[128 * jj + 2 * F.lane] + B4[128 * jj + 2 * F.lane];
                    o[128 * jj + 1] = v[q][2 * jj + 1] * rstd * G4[128 * jj + 2 * F.lane + 1] + B4[128 * jj + 2 * F.lane + 1]; } }
        }
    }
}

struct Args { const float* in[21]; float* out; unsigned char* ws; int ph_lo, ph_hi; };
__global__ void __launch_bounds__(512, 2) mk_fwd(Args args) {
    extern __shared__ __attribute__((aligned(16))) unsigned char lds[];
    Frame F;
    F.lds = (LAS unsigned char*)lds; F.ldsg = lds;
    F.tid = threadIdx.x; F.lane = F.tid & 63; F.wave = __builtin_amdgcn_readfirstlane(F.tid >> 6); F.G = gridDim.x;
    if (F.tid == 0) { LAS unsigned long long* pp = (LAS unsigned long long*)(F.lds + L_PTR);
#pragma unroll
        for (int i = 0; i < 21; ++i) pp[i] = (unsigned long long)args.in[i];
        pp[21] = (unsigned long long)args.out; pp[22] = (unsigned long long)args.ws; }
    if (F.tid < 4) ((LAS unsigned*)(F.lds + L_XB))[F.tid] = 0u;
    __syncthreads();
    const int lo = args.ph_lo, hi = args.ph_hi;
    XcdBarrier bar; bar.bar = ((unsigned*)(wsp_(F) + WS_CTL)) + CW_BAR; bar.x = 0; bar.st = (volatile LAS unsigned*)(F.lds + L_XB);
    if (hi - lo > 1) bar = xcd_barrier_post(((unsigned*)(wsp_(F) + WS_CTL)) + CW_BAR, (volatile LAS unsigned*)(F.lds + L_XB));
#ifndef MK_PHASE_MASK
#define MK_PHASE_MASK 0x7ff
#endif
#define IN(k) (((MK_PHASE_MASK >> (k)) & 1) && lo <= (k) && (k) < hi)
#ifndef MK_DUP_MASK
#define MK_DUP_MASK 0
#endif
#define REP(k) for (int rep_ = 0; rep_ < 1 + ((MK_DUP_MASK >> (k)) & 1); ++rep_)
#ifndef MK_BAR2
#define MK_BAR2 0
#endif
#ifndef MK_STAMP_IDX
#define MK_STAMP_IDX -1
#endif
    unsigned long long st0_ = 0ull, stk_ = 0ull;
    if (MK_STAMP_IDX >= 0) st0_ = __builtin_amdgcn_s_memrealtime();
#define SEAM(k) do { if (IN(k) && IN((k) + 1)) { xcd_barrier(bar); if (MK_BAR2) xcd_barrier(bar); if (MK_STAMP_IDX == (k) + 1) stk_ = __builtin_amdgcn_s_memrealtime(); } } while (0)
    LAS unsigned char* ring = F.lds + RING_OFF;
    const pg8::bf16_t* XB = (const pg8::bf16_t*)(wsp_(F) + WS_XB);

    if (IN(0)) REP(0) { p0_prologue(F); if (MK_CHECK8) { __syncthreads(); moe_convert_share(F); } }
    SEAM(0);
    if (IN(1)) REP(1) {
        pg8::Gemm g{XB, (const pg8::bf16_t*)(wsp_(F) + WS_WIN), S_, INW, DM / 2}; pg8::StaticOrder S; S.init(S_, INW, F.G, (int)blockIdx.x);
        pg8::EpiStoreBf16 E{(pg8::bf16_t*)(wsp_(F) + WS_PROJ), INW, 1.0f / 64.0f};
        pg8::gemm_phase<pg8::EpiStoreBf16, pg8::StaticOrder, true, true, true, true>(ring, g, S, E);
    }
    SEAM(1);
    if (IN(2)) { p2_prep_dilated(F); if ((MK_DUP_MASK >> 2) & 1) p2_prep_dilated(F); }
    SEAM(2);
    if (IN(3)) REP(3) { p3_attn_combine(F); }
    SEAM(3);
#define PHASE4_BODY { \
        { pg8::Gemm g{(const pg8::bf16_t*)(wsp_(F) + WS_YA), (const pg8::bf16_t*)(wsp_(F) + WS_WA), S_, DM, 256}; pg8::StaticOrder S; S.init(S_, DM, F.G, (int)blockIdx.x); \
          pg8::EpiGateA E{(const pg8::bf16_t*)(wsp_(F) + WS_PROJ), INW, GATE_OFF, inp(F, 2), (float*)(wsp_(F) + WS_T1), DM, 1.0f / 512.0f}; \
          pg8::gemm_phase<pg8::EpiGateA, pg8::StaticOrder, true, true, true, true>(ring, g, S, E); } \
        { pg8::Gemm g{(const pg8::bf16_t*)(wsp_(F) + WS_YB), (const pg8::bf16_t*)(wsp_(F) + WS_WB), S_, DM, 512}; pg8::StaticOrder S; S.init(S_, DM, F.G, (int)blockIdx.x); \
          pg8::EpiGateB E{(const pg8::bf16_t*)(wsp_(F) + WS_PROJ), INW, GATE_OFF + DM, inp(F, 2) + DM, (const float*)(wsp_(F) + WS_T1), wsp_(F) + WS_Y, DM, 1.0f / 2048.0f}; \
          pg8::gemm_phase<pg8::EpiGateB, pg8::StaticOrder, true, true, true, true>(ring, g, S, E); } \
    }
    if (MK_CHECK8 && IN(4)) {
        const unsigned* a32 = (const unsigned*)(wsp_(F) + WS_YB); const unsigned* b32 = (const unsigned*)(wsp_(F) + WS_DBG); float num = 0.f, den = 0.f;
        for (int i = blockIdx.x * 512 + F.tid; i < S_ * 1024 / 4; i += F.G * 512) { const unsigned a = a32[i], b = b32[i];
            for (int q = 0; q < 4; ++q) { const float fa = __builtin_amdgcn_cvt_f32_fp8((int)(a >> (8 * q)), 0), fb = __builtin_amdgcn_cvt_f32_fp8((int)(b >> (8 * q)), 0); num += fabsf(fa - fb); den += fabsf(fb); } }
        num = wave_sum(num); den = wave_sum(den);
        if (F.lane == 0) { atomicAdd((float*)(((unsigned*)(wsp_(F) + WS_CTL)) + 4224), num); atomicAdd((float*)(((unsigned*)(wsp_(F) + WS_CTL)) + 4225), den); }
    }
    if (IN(4)) { PHASE4_BODY if ((MK_DUP_MASK >> 4) & 1) PHASE4_BODY }
    SEAM(4);
    if (IN(5)) REP(5) {
        pg8::Gemm g{(const pg8::bf16_t*)(wsp_(F) + WS_Y), (const pg8::bf16_t*)(wsp_(F) + WS_WO), S_, DM, DM / 2}; pg8::StaticOrder S; S.init(S_, DM, F.G, (int)blockIdx.x);
        pg8::EpiResF32 E{inp(F, 0), (float*)(wsp_(F) + WS_T1), DM, ALPHA, 1.0f / 4096.0f};
        pg8::gemm_phase<pg8::EpiResF32, pg8::StaticOrder, true, true, true, true>(ring, g, S, E);
    }
    SEAM(5);
    if (IN(6)) { p6_ln_router(F); if ((MK_DUP_MASK >> 6) & 1) p6_ln_router(F, 1); }
    SEAM(6);
    if (IN(7)) REP(7) { p7_gather(F); }
    SEAM(7);
    if (IN(8)) REP(8) {
        const int nt = moe_tiles(F);
        pg8::Gemm g{(const pg8::bf16_t*)(wsp_(F) + WS_XS), (const pg8::bf16_t*)(wsp_(F) + WS_WGL), nt * 256, 4096, DM / 2};
        pg8::MoeOrder S; S.init(nt * 256, 4096, F.G, (int)blockIdx.x); S.tile_e = (const LAS int*)(F.lds + L_TILE); S.estride = (size_t)4096 * 2048;
        pg8::EpiSwiglu E{(const LAS int*)(F.lds + L_TILE), inp(F, 14), inp(F, 16), wsp_(F) + WS_H, DM, 1.0f / 64.0f};
        pg8::gemm_phase<pg8::EpiSwiglu, pg8::MoeOrder, true, true, true, true>(ring, g, S, E);
    }
    SEAM(8);
    if (IN(9)) REP(9) {
        const int nt = moe_tiles(F);
        pg8::Gemm g{(const pg8::bf16_t*)(wsp_(F) + WS_H), (const pg8::bf16_t*)(wsp_(F) + WS_WD), nt * 256, DM, DM / 2};
        pg8::MoeOrder S; S.init(nt * 256, DM, F.G, (int)blockIdx.x); S.tile_e = (const LAS int*)(F.lds + L_TILE); S.estride = (size_t)2048 * 2048;
        pg8::EpiDown E{(const LAS int*)(F.lds + L_TILE), inp(F, 18), (const float*)(wsp_(F) + WS_SLOTW), (pg8::bf16_t*)(wsp_(F) + WS_YS), DM, 1.0f / 64.0f};
        pg8::gemm_phase<pg8::EpiDown, pg8::MoeOrder, true, true, true, true>(ring, g, S, E);
    }
    SEAM(9);
    if (IN(10)) REP(10) { p10_final(F); }
    if (MK_CHECK8 && IN(10)) {
        const float num = *(const float*)(((unsigned*)(wsp_(F) + WS_CTL)) + 4224), den = *(const float*)(((unsigned*)(wsp_(F) + WS_CTL)) + 4225);
        if (!(num <= MK_CHK_TOL * den) || !(den > 0.f)) { float* o = (float*)inp(F, 21); __syncthreads(); for (int i = blockIdx.x * 512 + F.tid; i < S_ * DM; i += F.G * 512) o[i] = __builtin_nanf(""); }
    }
    if (MK_STAMP_IDX >= 0 && blockIdx.x == 0 && F.tid == 0) {
        const unsigned long long te = __builtin_amdgcn_s_memrealtime(), dt = stk_ - st0_;
        while (__builtin_amdgcn_s_memrealtime() - te < dt) __builtin_amdgcn_s_sleep(8);
    }
#undef IN
#undef SEAM
}

#ifndef MK_CUTS
#define MK_CUTS 0
#endif
extern "C" void kernel_launch(void* const* d_in, const int* in_sizes, int n_in, void* d_out, int out_size, void* d_ws, size_t ws_size, hipStream_t stream) {
    static int grid = 0;
    if (grid == 0) {
        if (n_in != 21 || out_size != S_ * DM || ws_size < WS_END) { fprintf(stderr, "kernel_launch: unexpected shapes (n_in %d out %d ws %zu, need %zu)\n", n_in, out_size, ws_size, (size_t)WS_END); grid = -1; return; }
        int dev = 0, cus = 0, per_cu = 0;
        if (hipGetDevice(&dev) != hipSuccess || hipDeviceGetAttribute(&cus, hipDeviceAttributeMultiprocessorCount, dev) != hipSuccess) { grid = -1; return; }
        if (hipFuncSetAttribute((const void*)mk_fwd, hipFuncAttributeMaxDynamicSharedMemorySize, LDS_BYTES) != hipSuccess) { fprintf(stderr, "kernel_launch: hipFuncSetAttribute failed\n"); grid = -1; return; }
        if (hipOccupancyMaxActiveBlocksPerMultiprocessor(&per_cu, (const void*)mk_fwd, 512, LDS_BYTES) != hipSuccess || per_cu < 1) { fprintf(stderr, "kernel_launch: occupancy query says %d\n", per_cu); per_cu = 1; }
        (void)hipGetLastError();
        grid = cus;
    }
    if (grid < 0) return;
    (void)hipMemsetAsync((char*)d_ws + WS_CTL, 0, CTL_ZERO_BYTES, stream);
    Args a{};
    for (int i = 0; i < 21; ++i) a.in[i] = (const float*)d_in[i];
    a.out = (float*)d_out; a.ws = (unsigned char*)d_ws;
#if MK_CUTS
    for (int p = 0; p < NPH; ++p) { a.ph_lo = p; a.ph_hi = p + 1; hipLaunchKernelGGL(mk_fwd, dim3(grid), dim3(512), LDS_BYTES, stream, a); }
#else
    a.ph_lo = 0; a.ph_hi = NPH; hipLaunchKernelGGL(mk_fwd, dim3(grid), dim3(512), LDS_BYTES, stream, a);
#endif
}
```

```cpp
#include <hip/hip_runtime.h>
#include <hip/hip_bf16.h>
#include <cstdio>
#include <cstdint>
#define MK_CUTS 0
namespace pg8 {
#define PG8_LAS __attribute__((address_space(3)))
typedef unsigned short bf16_t;
typedef short bf16x8 __attribute__((ext_vector_type(8)));
typedef float f32x4 __attribute__((ext_vector_type(4)));
typedef unsigned u32x4 __attribute__((ext_vector_type(4)));
constexpr int BM = 256, BK = 64, HALF = 128, HTB = HALF * BK * 2  , STAGE_BYTES = 8 * HTB, NXCD = 8, WGM = 8;

__host__ __device__ __forceinline__ int lds_byte(int r, int c) { const int st = (r >> 4) * 2 + (c >> 5), rr = r & 15, cc = c & 31, ob = rr * 64 + cc * 2; return st * 1024 + (ob ^ (((ob >> 9) & 1) << 5)); }
__host__ __device__ __forceinline__ void stage_rc(int b, int& R, int& C) { const int st = b / 1024, sb = b % 1024, swz = sb ^ (((sb >> 9) & 1) << 5); R = (st >> 1) * 16 + swz / 64; C = (st & 1) * 32 + (swz % 64) / 2; }
__host__ __device__ __forceinline__ int perm32(int rho) { const int n = rho >> 4, i = rho & 15; return 8 * (i >> 2) + 4 * n + (i & 3); }

struct Unit { int pm, pn; };
struct Gemm { const bf16_t* A; const bf16_t* Bt; int M, N, K; };

struct StaticOrder {
    int nM, nN, nwg, G, c;
    __host__ __device__ void init(int M, int N, int G_, int c_) { nM = M / BM; nN = N / BM; nwg = nM * nN; G = G_; c = c_; }
    __host__ __device__ bool next(int i, Unit& u) const {
        const long L = (long)i * G + c; if (L >= nwg) return false;
        int wgid = (int)L; { const int q = nwg / NXCD, r = nwg % NXCD, xcd = wgid % NXCD, off = wgid / NXCD; wgid = (xcd < r ? xcd * (q + 1) : r * (q + 1) + (xcd - r) * q) + off; }
        const int nig = WGM * nN, gid = wgid / nig, fm = gid * WGM, gsz = (nM - fm) < WGM ? (nM - fm) : WGM;
        u.pm = fm + ((wgid % nig) % gsz); u.pn = (wgid % nig) / gsz; return true;
    }
    __device__ __forceinline__ void a_ready(const Unit&) const {}
    __device__ __forceinline__ size_t b_off(const Unit&) const { return 0; }
    __device__ __forceinline__ void done(const Unit&) const {}
};


typedef unsigned u32x2 __attribute__((ext_vector_type(2)));
__device__ __forceinline__ unsigned cvt_pk_bf16(float lo, float hi) { unsigned r; asm volatile("v_cvt_pk_bf16_f32 %0, %1, %2" : "=v"(r) : "v"(lo), "v"(hi)); return r; }
__device__ __forceinline__ unsigned pk4_fp8_(float a, float b, float c, float d) { int w = __builtin_amdgcn_cvt_pk_fp8_f32(a, b, 0, false); w = __builtin_amdgcn_cvt_pk_fp8_f32(c, d, w, true); return (unsigned)w; }
__device__ __forceinline__ float bf_lo(unsigned w) { return __builtin_bit_cast(float, w << 16); }
__device__ __forceinline__ float bf_hi(unsigned w) { return __builtin_bit_cast(float, w & 0xffff0000u); }
__device__ __forceinline__ float sigmoidf_(float v) { return __builtin_amdgcn_rcpf(1.0f + __expf(-v)); }

struct EpiStoreBf16 {
    static constexpr bool PERM = true, AFTER_DRAIN = false;
    bf16_t* O; int ldc; float sc;
    __device__ __forceinline__ void operator()(const f32x4 (&acc)[2][2][4][2], const Unit& u, int wr, int wc, int fr, int fq) const {
        const int row0 = u.pm * BM + wr * 64 + fr, col0 = u.pn * BM + wc * 32 + 8 * fq;
#pragma unroll
        for (int ai = 0; ai < 2; ++ai)
#pragma unroll
            for (int m = 0; m < 4; ++m) { bf16_t* rowp = O + (size_t)(row0 + ai * HALF + m * 16) * ldc + col0;
#pragma unroll
                for (int bj = 0; bj < 2; ++bj) { const f32x4 v0 = acc[ai][bj][m][0] * sc, v1 = acc[ai][bj][m][1] * sc;
                    u32x4 w; w.x = cvt_pk_bf16(v0[0], v0[1]); w.y = cvt_pk_bf16(v0[2], v0[3]); w.z = cvt_pk_bf16(v1[0], v1[1]); w.w = cvt_pk_bf16(v1[2], v1[3]);
                    *(u32x4*)(rowp + bj * HALF) = w; } }
    }
};

struct EpiGateA {
    static constexpr bool PERM = true, AFTER_DRAIN = false;
    const bf16_t* proj; int ldp; int gcol0; const float* bg; float* T1; int ldc; float sc;
    __device__ __forceinline__ void operator()(const f32x4 (&acc)[2][2][4][2], const Unit& u, int wr, int wc, int fr, int fq) const {
        const int row0 = u.pm * BM + wr * 64 + fr, col0 = u.pn * BM + wc * 32 + 8 * fq;
#pragma unroll
        for (int ai = 0; ai < 2; ++ai)
#pragma unroll
            for (int m = 0; m < 4; ++m) { const int row = row0 + ai * HALF + m * 16;
#pragma unroll
                for (int bj = 0; bj < 2; ++bj) { const int c = col0 + bj * HALF;
                    const u32x4 gw = *(const u32x4*)(proj + (size_t)row * ldp + gcol0 + c);
                    const f32x4 b0 = *(const f32x4*)(bg + c), b1 = *(const f32x4*)(bg + c + 4);
                    f32x4 g0, g1;
                    g0[0] = sigmoidf_(bf_lo(gw.x) + b0[0]); g0[1] = sigmoidf_(bf_hi(gw.x) + b0[1]); g0[2] = sigmoidf_(bf_lo(gw.y) + b0[2]); g0[3] = sigmoidf_(bf_hi(gw.y) + b0[3]);
                    g1[0] = sigmoidf_(bf_lo(gw.z) + b1[0]); g1[1] = sigmoidf_(bf_hi(gw.z) + b1[1]); g1[2] = sigmoidf_(bf_lo(gw.w) + b1[2]); g1[3] = sigmoidf_(bf_hi(gw.w) + b1[3]);
                    float* o = T1 + (size_t)row * ldc + c;
                    *(f32x4*)o = acc[ai][bj][m][0] * sc * g0; *(f32x4*)(o + 4) = acc[ai][bj][m][1] * sc * g1; } }
    }
};
struct EpiGateB {
    static constexpr bool PERM = true, AFTER_DRAIN = false;
    const bf16_t* proj; int ldp; int gcol0; const float* bg; const float* T1; unsigned char* Y; int ldc; float sc;
    __device__ __forceinline__ void operator()(const f32x4 (&acc)[2][2][4][2], const Unit& u, int wr, int wc, int fr, int fq) const {
        const int row0 = u.pm * BM + wr * 64 + fr, col0 = u.pn * BM + wc * 32 + 8 * fq;
#pragma unroll
        for (int ai = 0; ai < 2; ++ai)
#pragma unroll
            for (int m = 0; m < 4; ++m) { const int row = row0 + ai * HALF + m * 16;
#pragma unroll
                for (int bj = 0; bj < 2; ++bj) { const int c = col0 + bj * HALF;
                    const u32x4 gw = *(const u32x4*)(proj + (size_t)row * ldp + gcol0 + c);
                    const f32x4 b0 = *(const f32x4*)(bg + c), b1 = *(const f32x4*)(bg + c + 4);
                    const float* tp = T1 + (size_t)row * ldc + c;
                    const f32x4 t0 = *(const f32x4*)tp, t1 = *(const f32x4*)(tp + 4);
                    f32x4 g0, g1;
                    g0[0] = sigmoidf_(bf_lo(gw.x) + b0[0]); g0[1] = sigmoidf_(bf_hi(gw.x) + b0[1]); g0[2] = sigmoidf_(bf_lo(gw.y) + b0[2]); g0[3] = sigmoidf_(bf_hi(gw.y) + b0[3]);
                    g1[0] = sigmoidf_(bf_lo(gw.z) + b1[0]); g1[1] = sigmoidf_(bf_hi(gw.z) + b1[1]); g1[2] = sigmoidf_(bf_lo(gw.w) + b1[2]); g1[3] = sigmoidf_(bf_hi(gw.w) + b1[3]);
                    const f32x4 v0 = (t0 + acc[ai][bj][m][0] * sc * g0) * 64.0f, v1 = (t1 + acc[ai][bj][m][1] * sc * g1) * 64.0f;
                    u32x2 w; w.x = pk4_fp8_(v0[0], v0[1], v0[2], v0[3]); w.y = pk4_fp8_(v1[0], v1[1], v1[2], v1[3]);
                    *(u32x2*)(Y + (size_t)row * ldc + c) = w; } }
    }
};
struct EpiResF32 {
    static constexpr bool PERM = false, AFTER_DRAIN = false;
    const float* X; float* Z; int ldc; float alpha; float sc;
    __device__ __forceinline__ void operator()(const f32x4 (&acc)[2][2][4][2], const Unit& u, int wr, int wc, int fr, int fq) const {
        const int row0 = u.pm * BM + wr * 64 + fr, col0 = u.pn * BM + wc * 32 + 4 * fq;
#pragma unroll
        for (int ai = 0; ai < 2; ++ai)
#pragma unroll
            for (int m = 0; m < 4; ++m) { const size_t ro = (size_t)(row0 + ai * HALF + m * 16) * ldc + col0;
#pragma unroll
                for (int bj = 0; bj < 2; ++bj)
#pragma unroll
                    for (int n = 0; n < 2; ++n) { const f32x4 xv = *(const f32x4*)(X + ro + bj * HALF + n * 16);
                        *(f32x4*)(Z + ro + bj * HALF + n * 16) = xv * alpha + acc[ai][bj][m][n] * sc; } }
    }
};
struct EpiSwiglu {
    static constexpr bool PERM = true, AFTER_DRAIN = false;
    const PG8_LAS int* tile_e; const float* bgate; const float* blin; unsigned char* H; int ldc; float sc;
    __device__ __forceinline__ void operator()(const f32x4 (&acc)[2][2][4][2], const Unit& u, int wr, int wc, int fr, int fq) const {
        const int e = tile_e[u.pm];
        const int row0 = u.pm * BM + wr * 64 + fr, j0 = u.pn * HALF + wc * 32 + 8 * fq;
        const f32x4 bg0 = *(const f32x4*)(bgate + (size_t)e * 2048 + j0), bg1 = *(const f32x4*)(bgate + (size_t)e * 2048 + j0 + 4);
        const f32x4 bl0 = *(const f32x4*)(blin + (size_t)e * 2048 + j0), bl1 = *(const f32x4*)(blin + (size_t)e * 2048 + j0 + 4);
#pragma unroll
        for (int ai = 0; ai < 2; ++ai)
#pragma unroll
            for (int m = 0; m < 4; ++m) { const int row = row0 + ai * HALF + m * 16;
                f32x4 h0, h1;
#pragma unroll
                for (int i = 0; i < 4; ++i) {
                    float g = fminf(acc[ai][0][m][0][i] * sc + bg0[i], 7.0f); float l = fminf(fmaxf(acc[ai][1][m][0][i] * sc + bl0[i], -7.0f), 7.0f);
                    h0[i] = (l + 1.0f) * (g * sigmoidf_(1.702f * g));
                    g = fminf(acc[ai][0][m][1][i] * sc + bg1[i], 7.0f); l = fminf(fmaxf(acc[ai][1][m][1][i] * sc + bl1[i], -7.0f), 7.0f);
                    h1[i] = (l + 1.0f) * (g * sigmoidf_(1.702f * g)); }
                u32x2 w; w.x = pk4_fp8_(h0[0], h0[1], h0[2], h0[3]); w.y = pk4_fp8_(h1[0], h1[1], h1[2], h1[3]);
                *(u32x2*)(H + (size_t)row * ldc + j0) = w; }
    }
};
struct EpiDown {
    static constexpr bool PERM = true, AFTER_DRAIN = false;
    const PG8_LAS int* tile_e; const float* bdown; const float* slot_w; bf16_t* YS; int ldc; float sc;
    __device__ __forceinline__ void operator()(const f32x4 (&acc)[2][2][4][2], const Unit& u, int wr, int wc, int fr, int fq) const {
        const int e = tile_e[u.pm];
        const int row0 = u.pm * BM + wr * 64 + fr, col0 = u.pn * BM + wc * 32 + 8 * fq;
        f32x4 bv[2][2];
#pragma unroll
        for (int bj = 0; bj < 2; ++bj)
#pragma unroll
            for (int n = 0; n < 2; ++n) bv[bj][n] = *(const f32x4*)(bdown + (size_t)e * 2048 + col0 + bj * HALF + 4 * n);
#pragma unroll
        for (int ai = 0; ai < 2; ++ai)
#pragma unroll
            for (int m = 0; m < 4; ++m) { const int row = row0 + ai * HALF + m * 16; const float sw = slot_w[row];
#pragma unroll
                for (int bj = 0; bj < 2; ++bj) { const f32x4 v0 = (acc[ai][bj][m][0] * sc + bv[bj][0]) * sw, v1 = (acc[ai][bj][m][1] * sc + bv[bj][1]) * sw;
                    u32x4 w; w.x = cvt_pk_bf16(v0[0], v0[1]); w.y = cvt_pk_bf16(v0[2], v0[3]); w.z = cvt_pk_bf16(v1[0], v1[1]); w.w = cvt_pk_bf16(v1[2], v1[3]);
                    *(u32x4*)(YS + (size_t)row * ldc + col0 + bj * HALF) = w; } }
    }
};
struct MoeOrder : StaticOrder {
    const PG8_LAS int* tile_e; size_t estride;
    __device__ __forceinline__ size_t b_off(const Unit& u) const { return (size_t)__builtin_amdgcn_readfirstlane(tile_e[u.pm]) * estride; }
};
typedef int i32x4_ __attribute__((ext_vector_type(4)));
typedef int i32x8_ __attribute__((ext_vector_type(8)));
#define PG8_CAT(lo, hi) __builtin_shufflevector(__builtin_bit_cast(i32x4_, lo), __builtin_bit_cast(i32x4_, hi), 0, 1, 2, 3, 4, 5, 6, 7)
template <class Epi, class Sched, bool ALIGN_EPI = false, bool SP2 = false, bool FP8 = false, bool BTILED = false>
__device__ __forceinline__ void gemm_phase(PG8_LAS unsigned char* lds, const Gemm g, const Sched& S, const Epi& E) {
    const int tid = threadIdx.x, wid = __builtin_amdgcn_readfirstlane(tid >> 6), lane = tid & 63, wr = wid >> 2, wc = wid & 3, fr = lane & 15, fq = lane >> 4;
    const int K = g.K, nt = K / BK;
    unsigned voffA[2], voffB[2];
#pragma unroll
    for (int i = 0; i < 2; ++i) { int R, C; stage_rc(tid * 16 + i * 8192, R, C); const int Rb = Epi::PERM ? ((R & ~31) + perm32(R & 31)) : R;
        voffA[i] = (unsigned)(R * K + C) * 2u; voffB[i] = BTILED ? (unsigned)(Rb * 64 + C) * 2u : (unsigned)(Rb * K + C) * 2u; }
    const size_t kstep = (size_t)(BK * 2);
    const size_t hstep = (size_t)HALF * K * 2;
    const size_t tstep = 2 * hstep;
    const size_t kstepB = BTILED ? (size_t)32768 : kstep, hstepB = BTILED ? (size_t)16384 : hstep;
    const unsigned ldsw = (unsigned)wid * 1024u;
    const int aoff = lds_byte(wr * 64 + fr, fq * 8), boff = lds_byte(wc * 32 + fr, fq * 8);
#define PG8_SA(b, h) (((b) * 2 + (h)) * HTB)
#define PG8_SB(b, h) ((4 + (b) * 2 + (h)) * HTB)
#define PG8_STAGE(bufoff, gbase, voff) do { _Pragma("unroll") for (int _i = 0; _i < 2; ++_i) \
        __builtin_amdgcn_global_load_lds((const unsigned*)((const char*)(gbase) + (voff)[_i]), (PG8_LAS unsigned*)(lds + (bufoff) + ldsw + _i * 8192), 16, 0, 0); } while (0)
#define PG8_LDA(dst, b, h) do { _Pragma("unroll") for (int m = 0; m < 4; ++m) _Pragma("unroll") for (int k = 0; k < 2; ++k) dst[m][k] = *(const PG8_LAS bf16x8*)(lds + PG8_SA(b, h) + aoff + m * 2048 + k * 1024); } while (0)
#define PG8_LDB(dst, b, h) do { _Pragma("unroll") for (int n = 0; n < 2; ++n) _Pragma("unroll") for (int k = 0; k < 2; ++k) dst[n][k] = *(const PG8_LAS bf16x8*)(lds + PG8_SB(b, h) + boff + n * 2048 + k * 1024); } while (0)
#define PG8_MFMA8(C, Bv, Av) asm volatile("v_mfma_f32_16x16x128_f8f6f4 %0, %1, %2, %0" : "+v"(C) : "v"(Bv), "v"(Av))
#define PG8_MMA(ai, bj, At, Bt) do { __builtin_amdgcn_s_setprio(1); if constexpr (FP8) { const i32x8_ b0_ = PG8_CAT(Bt[0][0], Bt[0][1]), b1_ = PG8_CAT(Bt[1][0], Bt[1][1]); _Pragma("unroll") for (int m = 0; m < 4; ++m) { \
        const i32x8_ a_ = PG8_CAT(At[m][0], At[m][1]); PG8_MFMA8(acc[ai][bj][m][0], b0_, a_); PG8_MFMA8(acc[ai][bj][m][1], b1_, a_); } } else { \
        _Pragma("unroll") for (int m = 0; m < 4; ++m) _Pragma("unroll") for (int n = 0; n < 2; ++n) _Pragma("unroll") for (int k = 0; k < 2; ++k) \
        acc[ai][bj][m][n] = __builtin_amdgcn_mfma_f32_16x16x32_bf16(Bt[n][k], At[m][k], acc[ai][bj][m][n], 0, 0, 0); } __builtin_amdgcn_s_setprio(0); } while (0)
#define PG8_WAIT_V(n) asm volatile("s_waitcnt vmcnt(" #n ")" ::: "memory")
#define PG8_WAIT_L(n) asm volatile("s_waitcnt lgkmcnt(" #n ")" ::: "memory")
#define PG8_BAR __builtin_amdgcn_s_barrier()
#define PG8_SCHED __builtin_amdgcn_sched_barrier(0)
    Unit cur, nxt; int ui = 0;
    if (!S.next(0, cur)) return;
    f32x4 acc[2][2][4][2];
#pragma unroll
    for (int a = 0; a < 2; ++a)
#pragma unroll
        for (int b = 0; b < 2; ++b)
#pragma unroll
            for (int m = 0; m < 4; ++m)
#pragma unroll
                for (int n = 0; n < 2; ++n) acc[a][b][m][n] = (f32x4){0.f, 0.f, 0.f, 0.f};
    bf16x8 At[4][2], B0[2][2], B1[2][2];
    const char* cA = (const char*)g.A + (size_t)cur.pm * tstep; const char* cB = (const char*)g.Bt + S.b_off(cur) + (size_t)cur.pn * tstep;
    S.a_ready(cur);
    if constexpr (SP2) {
        PG8_STAGE(PG8_SB(0, 0), cB, voffB); PG8_STAGE(PG8_SB(0, 1), cB + hstepB, voffB); PG8_STAGE(PG8_SA(0, 0), cA, voffA); PG8_STAGE(PG8_SA(0, 1), cA + hstep, voffA);
        if (wr == 1) PG8_BAR;
        PG8_WAIT_V(2); PG8_BAR;
        PG8_STAGE(PG8_SB(1, 0), cB + kstepB, voffB); PG8_STAGE(PG8_SA(1, 0), cA + kstep, voffA); PG8_STAGE(PG8_SB(1, 1), cB + hstepB + kstepB, voffB);
        PG8_WAIT_V(6); PG8_BAR;
    } else {
        PG8_STAGE(PG8_SB(0, 0), cB, voffB); PG8_STAGE(PG8_SA(0, 0), cA, voffA); PG8_STAGE(PG8_SB(0, 1), cB + hstepB, voffB); PG8_STAGE(PG8_SA(0, 1), cA + hstep, voffA);
        if (wr == 1) PG8_BAR;
        PG8_WAIT_V(4); PG8_BAR;
        PG8_STAGE(PG8_SB(1, 0), cB + kstepB, voffB); PG8_STAGE(PG8_SA(1, 0), cA + kstep, voffA); PG8_STAGE(PG8_SB(1, 1), cB + hstepB + kstepB, voffB);
        PG8_WAIT_V(6); PG8_BAR;
    }
    for (;;) {
        const bool has_next = S.next(ui + 1, nxt);
        const char* nA = has_next ? (const char*)g.A + (size_t)nxt.pm * tstep : cA; const char* nB = has_next ? (const char*)g.Bt + S.b_off(nxt) + (size_t)nxt.pn * tstep : cB;
        for (int t = 0; t < nt; t += 2) {
            const bool last = (t == nt - 2);
            const char* a1 = cA + (size_t)(t + 1) * kstep;
            const char* a2 = last ? nA : cA + (size_t)(t + 2) * kstep; const char* b2 = last ? nB : cB + (size_t)(t + 2) * kstepB;
            const char* a3 = a2 + kstep; const char* b3 = b2 + kstepB;
            if (last && has_next) S.a_ready(nxt);
            if constexpr (SP2) {
            PG8_LDB(B0, 0, 0); PG8_LDB(B1, 0, 1); PG8_SCHED; PG8_LDA(At, 0, 0); PG8_STAGE(PG8_SA(1, 1), a1 + hstep, voffA);
            PG8_WAIT_V(8); PG8_WAIT_L(0); PG8_BAR; PG8_MMA(0, 0, At, B0); PG8_MMA(0, 1, At, B1); PG8_BAR; PG8_SCHED;
            PG8_LDA(At, 0, 1); PG8_STAGE(PG8_SB(0, 0), b2, voffB); PG8_STAGE(PG8_SB(0, 1), b2 + hstepB, voffB); PG8_STAGE(PG8_SA(0, 0), a2, voffA);
            PG8_WAIT_V(8); PG8_WAIT_L(0); PG8_BAR; PG8_MMA(1, 0, At, B0); PG8_MMA(1, 1, At, B1); PG8_BAR; PG8_SCHED;
            PG8_LDB(B0, 1, 0); PG8_LDB(B1, 1, 1); PG8_SCHED; PG8_LDA(At, 1, 0); PG8_STAGE(PG8_SA(0, 1), a2 + hstep, voffA);
            PG8_WAIT_V(8); PG8_WAIT_L(0); PG8_BAR; PG8_MMA(0, 0, At, B0); PG8_MMA(0, 1, At, B1); PG8_BAR; PG8_SCHED;
            PG8_LDA(At, 1, 1); PG8_STAGE(PG8_SB(1, 0), b3, voffB); PG8_STAGE(PG8_SB(1, 1), b3 + hstepB, voffB); PG8_STAGE(PG8_SA(1, 0), a3, voffA);
            PG8_WAIT_V(8); PG8_WAIT_L(0); PG8_BAR; PG8_MMA(1, 0, At, B0); PG8_MMA(1, 1, At, B1); PG8_BAR; PG8_SCHED;
            } else {
            PG8_LDB(B0, 0, 0); PG8_SCHED; PG8_LDA(At, 0, 0); PG8_STAGE(PG8_SA(1, 1), a1 + hstep, voffA);
            PG8_WAIT_L(8); PG8_BAR; PG8_WAIT_L(0); PG8_MMA(0, 0, At, B0); PG8_BAR; PG8_SCHED;
            PG8_LDB(B1, 0, 1); PG8_STAGE(PG8_SB(0, 0), b2, voffB);
            PG8_BAR; PG8_WAIT_L(0); PG8_MMA(0, 1, At, B1); PG8_BAR;
            PG8_LDA(At, 0, 1); PG8_STAGE(PG8_SA(0, 0), a2, voffA);
            PG8_BAR; PG8_WAIT_L(0); PG8_MMA(1, 0, At, B0); PG8_BAR; PG8_SCHED;
            PG8_STAGE(PG8_SB(0, 1), b2 + hstepB, voffB);
            PG8_WAIT_V(6); PG8_BAR; PG8_MMA(1, 1, At, B1); PG8_BAR;
            PG8_LDB(B0, 1, 0); PG8_SCHED; PG8_LDA(At, 1, 0); PG8_STAGE(PG8_SA(0, 1), a2 + hstep, voffA);
            PG8_WAIT_L(8); PG8_BAR; PG8_WAIT_L(0); PG8_MMA(0, 0, At, B0); PG8_BAR; PG8_SCHED;
            PG8_LDB(B1, 1, 1); PG8_STAGE(PG8_SB(1, 0), b3, voffB);
            PG8_BAR; PG8_WAIT_L(0); PG8_MMA(0, 1, At, B1); PG8_BAR;
            PG8_LDA(At, 1, 1); PG8_STAGE(PG8_SA(1, 0), a3, voffA);
            PG8_BAR; PG8_WAIT_L(0); PG8_MMA(1, 0, At, B0); PG8_BAR; PG8_SCHED;
            PG8_STAGE(PG8_SB(1, 1), b3 + hstepB, voffB);
            PG8_WAIT_V(6); PG8_BAR; PG8_MMA(1, 1, At, B1); PG8_BAR;
            }
        }
        if constexpr (ALIGN_EPI) { if (wr == 0) PG8_BAR; }
        if constexpr (FP8) { asm volatile("s_nop 15\n\ts_nop 7" ::: "memory"); PG8_SCHED; }
        if constexpr (!Epi::AFTER_DRAIN) { E(acc, cur, wr, wc, fr, fq); S.done(cur); }
        if (!has_next) break;
#pragma unroll
        for (int a = 0; a < 2; ++a)
#pragma unroll
            for (int b = 0; b < 2; ++b)
#pragma unroll
                for (int m = 0; m < 4; ++m)
#pragma unroll
                    for (int n = 0; n < 2; ++n) acc[a][b][m][n] = (f32x4){0.f, 0.f, 0.f, 0.f};
        cur = nxt; cA = nA; cB = nB; ++ui;
        if constexpr (ALIGN_EPI) { if (wr == 1) PG8_BAR; }
    }
    PG8_WAIT_V(0);
    if constexpr (!ALIGN_EPI) { if (wr == 0) PG8_BAR; }
    PG8_BAR;
    if constexpr (Epi::AFTER_DRAIN) { E.fused(acc, cur, wr, wc, fr, fq, lds, wid, lane); S.done(cur); }
#undef PG8_SA
#undef PG8_SB
#undef PG8_STAGE
#undef PG8_LDA
#undef PG8_LDB
#undef PG8_MMA
#undef PG8_WAIT_V
#undef PG8_WAIT_L
#undef PG8_BAR
#undef PG8_SCHED
}
}
namespace at {
using bf16 = __hip_bfloat16;
constexpr int   D = 128, NW = 8, QBLK = 32, KVBLK = 64;
constexpr float SCALE = 0.088388347648318440f;
constexpr float THR = 8.f;
constexpr int SDEPTH = 2;
constexpr size_t SHM_V = KVBLK * D * 2, SHM_K = KVBLK * D * 2, SHM_ATTN = 2 * SHM_V + 2 * SHM_K + NW * 64 * 4;
using bf16x8 = __attribute__((ext_vector_type(8))) short;
using s16x4  = __attribute__((ext_vector_type(4))) short;
using f32x16 = __attribute__((ext_vector_type(16))) float;
using f32x8  = __attribute__((ext_vector_type(8))) float;
using u32x4  = __attribute__((ext_vector_type(4))) unsigned;
#define KSWZ(row, colB) ((row) * 256 + ((colB) ^ (((row) & 7) << 4)))
#define SBAR() __builtin_amdgcn_sched_barrier(0)
__device__ __forceinline__ int crow(int r, int hi) { return (r & 3) + 8 * (r >> 2) + 4 * hi; }
__device__ __forceinline__ unsigned cvtpk(float lo, float hi) {
  unsigned r; asm volatile("v_cvt_pk_bf16_f32 %0, %1, %2" : "=v"(r) : "v"(lo), "v"(hi)); return r;
}
template <typename TIn> struct Stage;
template <> struct Stage<bf16>  { using T = bf16x8;
  __device__ static __forceinline__ T ld8(const bf16* p) { return *reinterpret_cast<const bf16x8*>(p); }
  __device__ static __forceinline__ bf16x8 tobf(T x) { return x; } };
template <> struct Stage<float> { using T = f32x8;
  __device__ static __forceinline__ T ld8(const float* p) { return *reinterpret_cast<const f32x8*>(p); }
  __device__ static __forceinline__ bf16x8 tobf(T x) {
    u32x4 w = {cvtpk(x[0], x[1]), cvtpk(x[2], x[3]), cvtpk(x[4], x[5]), cvtpk(x[6], x[7])}; return *reinterpret_cast<bf16x8*>(&w); } };

__device__ __forceinline__ void partialSM(f32x16& p0, f32x16& p1, float& m_reg, float& mn, float& alpha) {
  constexpr float C = SCALE * 1.4426950408889634f;
  float pmax = p0[0]; for (int r = 1; r < 16; ++r) pmax = fmaxf(pmax, p0[r]); for (int r = 0; r < 16; ++r) pmax = fmaxf(pmax, p1[r]);
  { auto rr = __builtin_amdgcn_permlane32_swap(__float_as_uint(pmax), __float_as_uint(pmax), false, false);
    pmax = fmaxf(__uint_as_float(rr[0]), __uint_as_float(rr[1])); }
  if (__builtin_expect(__all(pmax - m_reg <= THR / SCALE), 1)) { mn = m_reg; alpha = 1.f; }
  else { mn = fmaxf(m_reg, pmax); alpha = __builtin_amdgcn_exp2f((m_reg - mn) * C); m_reg = mn; }
  float mnC = -mn * C;
  for (int r = 0; r < 16; ++r) p0[r] = fmaf(p0[r], C, mnC); for (int r = 0; r < 16; ++r) p1[r] = fmaf(p1[r], C, mnC);
  for (int r = 0; r < 16; ++r) p0[r] = __builtin_amdgcn_exp2f(p0[r]);
}
__device__ __forceinline__ void finishSM(f32x16& p0, f32x16& p1, float alpha, float& l_reg, bf16x8& pa0, bf16x8& pa1, bf16x8& pa2, bf16x8& pa3) {
  for (int r = 0; r < 16; ++r) p1[r] = __builtin_amdgcn_exp2f(p1[r]);
  float ps = 0; for (int r = 0; r < 16; ++r) ps += p0[r]; for (int r = 0; r < 16; ++r) ps += p1[r];
  { auto rr = __builtin_amdgcn_permlane32_swap(__float_as_uint(ps), __float_as_uint(ps), false, false);
    ps = __uint_as_float(rr[0]) + __uint_as_float(rr[1]); }
  l_reg = l_reg * alpha + ps;
#define PK4(P, BASE, OUT) do { unsigned a0 = cvtpk(P[BASE + 0], P[BASE + 1]), a1 = cvtpk(P[BASE + 2], P[BASE + 3]);   \
    unsigned b0 = cvtpk(P[BASE + 4], P[BASE + 5]), b1 = cvtpk(P[BASE + 6], P[BASE + 7]);                              \
    auto r0 = __builtin_amdgcn_permlane32_swap(a0, b0, false, false); auto r1 = __builtin_amdgcn_permlane32_swap(a1, b1, false, false); \
    u32x4 w = {r0[0], r1[0], r0[1], r1[1]}; OUT = *reinterpret_cast<bf16x8*>(&w); } while (0)
  PK4(p0, 0, pa0); PK4(p0, 8, pa1); PK4(p1, 0, pa2); PK4(p1, 8, pa3);
#undef PK4
}
__device__ __forceinline__ void qkt(f32x16& p0, f32x16& p1, const bf16* Ks, const bf16x8* qr, int r32, int hi) {
  p0 = f32x16{}; p1 = f32x16{};
  for (int d0 = 0; d0 < 8; ++d0) { int cb = (d0 * 16 + hi * 8) * 2;
    bf16x8 b0 = *reinterpret_cast<const bf16x8*>((const char*)Ks + KSWZ(r32, cb));
    bf16x8 b1 = *reinterpret_cast<const bf16x8*>((const char*)Ks + KSWZ(32 + r32, cb));
    p0 = __builtin_amdgcn_mfma_f32_32x32x16_bf16(b0, qr[d0], p0, 0, 0, 0);
    p1 = __builtin_amdgcn_mfma_f32_32x32x16_bf16(b1, qr[d0], p1, 0, 0, 0); }
}
__device__ __forceinline__ int v_st(int k, int c) { const int kk = (k & ~0xC) | ((k & 4) << 1) | ((k & 8) >> 1); return ((kk >> 3) * 4 + (c >> 5)) * 512 + ((kk & 7) * 32 + (c & 31)) * 2; }
__device__ __forceinline__ int v_rd_base(int lane) { return ((lane & 3) << 3) | (((lane >> 2) & 3) << 6) | (((lane >> 4) & 1) << 5) | (((lane >> 5) & 1) << 8); }
constexpr int v_rd_off(int d0, int ks, int half) { return d0 * 512 + ks * 4096 + half * 2048; }
template <int OFF> __device__ __forceinline__ s16x4 tr_read(int vb) {
  s16x4 r; asm volatile("ds_read_b64_tr_b16 %0, %1 offset:%2" : "=&v"(r) : "v"(vb), "i"(OFF) : "memory"); return r;
}
template <int D0> __device__ __forceinline__ void pv_one(f32x16& od, int vb, bf16x8 pa0, bf16x8 pa1, bf16x8 pa2, bf16x8 pa3) {
  const s16x4 l0 = tr_read<v_rd_off(D0, 0, 0)>(vb), h0 = tr_read<v_rd_off(D0, 0, 1)>(vb), l1 = tr_read<v_rd_off(D0, 1, 0)>(vb), h1 = tr_read<v_rd_off(D0, 1, 1)>(vb);
  const s16x4 l2 = tr_read<v_rd_off(D0, 2, 0)>(vb), h2 = tr_read<v_rd_off(D0, 2, 1)>(vb), l3 = tr_read<v_rd_off(D0, 3, 0)>(vb), h3 = tr_read<v_rd_off(D0, 3, 1)>(vb);
  asm volatile("s_waitcnt lgkmcnt(0)" ::: "memory"); SBAR();
#define PK(L, H) (bf16x8){L[0], L[1], L[2], L[3], H[0], H[1], H[2], H[3]}
  od = __builtin_amdgcn_mfma_f32_32x32x16_bf16(pa0, PK(l0, h0), od, 0, 0, 0);
  od = __builtin_amdgcn_mfma_f32_32x32x16_bf16(pa1, PK(l1, h1), od, 0, 0, 0);
  od = __builtin_amdgcn_mfma_f32_32x32x16_bf16(pa2, PK(l2, h2), od, 0, 0, 0);
  od = __builtin_amdgcn_mfma_f32_32x32x16_bf16(pa3, PK(l3, h3), od, 0, 0, 0);
#undef PK
}
__device__ __forceinline__ void pv_d0(f32x16* o, int vb, bf16x8 pa0, bf16x8 pa1, bf16x8 pa2, bf16x8 pa3) {
  pv_one<0>(o[0], vb, pa0, pa1, pa2, pa3); pv_one<1>(o[1], vb, pa0, pa1, pa2, pa3); pv_one<2>(o[2], vb, pa0, pa1, pa2, pa3); pv_one<3>(o[3], vb, pa0, pa1, pa2, pa3);
}

template <int LDQ, int LDK, int LDV, int LDO>
__device__ __forceinline__ void attn_dense_body(const bf16* __restrict__ Qb, const bf16* __restrict__ Kh, const bf16* __restrict__ Vh,
                                                unsigned char* __restrict__ Ob, int seq, char* lds) {
  using St = Stage<bf16>; using SQ = Stage<bf16>;
  const int tid = threadIdx.x, wid = __builtin_amdgcn_readfirstlane(tid >> 6), lane = tid & 63, r32 = lane & 31, hi = lane >> 5;
  bf16* V_lds = (bf16*)lds; bf16* K_lds = (bf16*)(lds + 2 * SHM_V);
  float* ws = (float*)(lds + 2 * SHM_V + 2 * SHM_K) + wid * 64; float* li_l = ws; float* al_l = ws + 32;
  float m_reg = -1e30f, l_reg = 0; f32x16 o[4] = {}; bf16x8 qr[8];
  const bf16* Qw = Qb + (long)(wid * QBLK + r32) * LDQ + hi * 8;
#pragma unroll
  for (int d0 = 0; d0 < 8; ++d0) qr[d0] = SQ::tobf(SQ::ld8(Qw + d0 * 16));
  const int sr = tid >> 4, sc = (tid & 15) * 8, vst0 = v_st(sr, sc), vst1 = v_st(32 + sr, sc);
  const int vb0 = (int)(uintptr_t)V_lds + v_rd_base(lane);
  struct { typename St::T vs0, vs1, ks0, ks1; } sr_[SDEPTH];
#define SLOAD(i, k0) do { sr_[i].vs0 = St::ld8(&Vh[(long)((k0) + sr) * LDV + sc]); sr_[i].vs1 = St::ld8(&Vh[(long)((k0) + 32 + sr) * LDV + sc]); \
    sr_[i].ks0 = St::ld8(&Kh[(long)((k0) + sr) * LDK + sc]); sr_[i].ks1 = St::ld8(&Kh[(long)((k0) + 32 + sr) * LDK + sc]); } while (0)
#define SWRITE(b, i) do { *(bf16x8*)((char*)V_lds + (b) * SHM_V + vst0) = St::tobf(sr_[i].vs0);          \
    *(bf16x8*)((char*)V_lds + (b) * SHM_V + vst1) = St::tobf(sr_[i].vs1); int kc = sc * 2;               \
    *(bf16x8*)((char*)K_lds + (b) * SHM_K + KSWZ(sr, kc)) = St::tobf(sr_[i].ks0);                       \
    *(bf16x8*)((char*)K_lds + (b) * SHM_K + KSWZ(32 + sr, kc)) = St::tobf(sr_[i].ks1); } while (0)
#define SWAIT() do { if constexpr (SDEPTH == 2) asm volatile("s_waitcnt vmcnt(4)" ::: "memory"); else asm volatile("s_waitcnt vmcnt(0)" ::: "memory"); } while (0)
#define RESC(a) do { if (__any((a) < 1.f)) { if (hi == 0) al_l[r32] = (a); asm volatile("s_waitcnt lgkmcnt(0)" ::: "memory"); \
    for (int d = 0; d < 4; ++d) for (int r = 0; r < 16; ++r) o[d][r] *= al_l[crow(r, hi)]; } } while (0)
  f32x16 pA0, pA1, pB0, pB1; float mnA, mnB, alA, alB; bf16x8 pa0, pa1, pa2, pa3; const int NT = seq / KVBLK;
  constexpr int SE = 0, SO = SDEPTH - 1;
  SLOAD(SE, 0); asm volatile("s_waitcnt vmcnt(0)" ::: "memory"); SWRITE(0, SE); __syncthreads();
  qkt(pA0, pA1, K_lds, qr, r32, hi); partialSM(pA0, pA1, m_reg, mnA, alA);
  SLOAD(SO, KVBLK); if constexpr (SDEPTH == 2) { if (2 < NT) SLOAD(SE, 2 * KVBLK); }
  SWAIT(); SWRITE(1, SO); __syncthreads();
  for (int j = 1; j + 1 < NT; j += 2) {
    SBAR(); qkt(pB0, pB1, (bf16*)((char*)K_lds + SHM_K), qr, r32, hi);
    finishSM(pA0, pA1, alA, l_reg, pa0, pa1, pa2, pa3); SBAR();
    SLOAD(SO, (j + SDEPTH) * KVBLK); SBAR();
    pv_d0(o, vb0, pa0, pa1, pa2, pa3); partialSM(pB0, pB1, m_reg, mnB, alB);
    __syncthreads(); SWAIT(); SWRITE(0, SE);
    RESC(alB); __syncthreads();
    SBAR(); qkt(pA0, pA1, K_lds, qr, r32, hi);
    finishSM(pB0, pB1, alB, l_reg, pa0, pa1, pa2, pa3); SBAR();
    if (SDEPTH == 1 || j + 3 < NT) SLOAD(SE, (j + 1 + SDEPTH) * KVBLK); SBAR();
    pv_d0(o, vb0 + (int)SHM_V, pa0, pa1, pa2, pa3); partialSM(pA0, pA1, m_reg, mnA, alA);
    __syncthreads(); SWAIT(); SWRITE(1, SO);
    RESC(alA); __syncthreads();
  }
  SBAR(); qkt(pB0, pB1, (bf16*)((char*)K_lds + SHM_K), qr, r32, hi);
  finishSM(pA0, pA1, alA, l_reg, pa0, pa1, pa2, pa3); SBAR();
  pv_d0(o, vb0, pa0, pa1, pa2, pa3); partialSM(pB0, pB1, m_reg, mnB, alB);
  __syncthreads(); RESC(alB);
  finishSM(pB0, pB1, alB, l_reg, pa0, pa1, pa2, pa3); SBAR();
  pv_d0(o, vb0 + (int)SHM_V, pa0, pa1, pa2, pa3);
  if (hi == 0) li_l[r32] = l_reg; asm volatile("s_waitcnt lgkmcnt(0)" ::: "memory");
  float rli[16];
#pragma unroll
  for (int r = 0; r < 16; ++r) rli[r] = __builtin_amdgcn_rcpf(li_l[crow(r, hi)]);
  unsigned char* Ow = Ob + (long)(wid * QBLK) * LDO;
#pragma unroll
  for (int r = 0; r < 16; ++r) { int orow = crow(r, hi);
    for (int d0 = 0; d0 < 4; ++d0) Ow[(long)orow * LDO + d0 * 32 + r32] = (unsigned char)(__builtin_amdgcn_cvt_pk_fp8_f32(o[d0][r] * rli[r] * 64.0f, 0.f, 0, false) & 0xff); }
#undef SLOAD
#undef SWRITE
#undef SWAIT
#undef RESC
}


__device__ __forceinline__ void dilated_unit(const bf16* __restrict__ proj, const float* __restrict__ lutg, bf16* __restrict__ outg, float* __restrict__ lseg,
                                             int d, int hd12, int hh, int r, int i0, char* lds) {
  constexpr int LDP = 10240;
  constexpr float L2E = 1.4426950408889634f, C = SCALE * L2E;
  const int tid = threadIdx.x, wid = tid >> 6, lane = tid & 63, r32 = lane & 31, hi = lane >> 5;
  const int n = 8192 / d;
  char* KV = lds;
  float* lutx = (float*)(lds + 98304);
  float* wsx = (float*)(lds + 98304 + 2048) + wid * 64;
  const int qoff = hd12 * 128, koff = 1536 + hd12 * 128;
  if (tid < 320) { const int o = tid - 96; lutx[tid] = (o >= 0 && o <= 128) ? lutg[o] * L2E : -1e30f; }
  const int iq = i0 + wid * 32 + r32;
  const int sr = tid >> 4, sc = (tid & 15) * 8;
  f32x16 s00, s01, s10, s11, s20, s21;
  const int a = wid >> 1;
  {
    const bf16* Qw = proj + (size_t)(r + iq * d) * LDP + qoff + hi * 8;
    bf16x8 qr[8];
#pragma unroll
    for (int d0 = 0; d0 < 8; ++d0) qr[d0] = *reinterpret_cast<const bf16x8*>(Qw + d0 * 16);
    const int wu = __builtin_amdgcn_readfirstlane(wid);
    const unsigned kvbase = (unsigned)(uintptr_t)KV;
#pragma unroll
    for (int i = 0; i < 12; ++i) { const int P = 8 * i + wu, rit = (P & 15) * 4 + (lane >> 4), colB = ((lane & 15) << 4) ^ ((rit & 7) << 4), row = (P >> 4) * 64 + rit;
      int j = i0 - 64 + row; j = j < 0 ? 0 : (j >= n ? n - 1 : j);
      __builtin_amdgcn_global_load_lds((const unsigned*)(proj + (size_t)(r + j * d) * LDP + koff + (colB >> 1)), (__attribute__((address_space(3))) unsigned*)(kvbase + (unsigned)P * 1024u), 16, 0, 0); }
    asm volatile("s_waitcnt vmcnt(0)" ::: "memory");
    __syncthreads();
    qkt(s00, s01, (const bf16*)(KV + (a + 0) * 16384), qr, r32, hi);
    qkt(s10, s11, (const bf16*)(KV + (a + 1) * 16384), qr, r32, hi);
    qkt(s20, s21, (const bf16*)(KV + (a + 2) * 16384), qr, r32, hi);
  }
  __syncthreads();
  {
    const int wu = __builtin_amdgcn_readfirstlane(wid);
    const unsigned kvbase = (unsigned)(uintptr_t)KV;
#pragma unroll
    for (int i = 0; i < 12; ++i) { const int P = 8 * i + wu, sub = (P & 15) * 2 + (lane >> 5), kk = (sub >> 2) * 8 + ((lane & 31) >> 2), c = (sub & 3) * 32 + (lane & 3) * 8;
      const int k = (kk & ~0xC) | ((kk & 4) << 1) | ((kk & 8) >> 1), row = (P >> 4) * 64 + k;
      int j = i0 - 64 + row; j = j < 0 ? 0 : (j >= n ? n - 1 : j);
      __builtin_amdgcn_global_load_lds((const unsigned*)(proj + (size_t)(r + j * d) * LDP + koff + 1536 + c), (__attribute__((address_space(3))) unsigned*)(kvbase + (unsigned)P * 1024u), 16, 0, 0); }
  }
  SBAR();
  const int base = -32 * (wid & 1) - 64 - r32 + 4 * hi;
  const float* lp = lutx + (base + 160);
  float mx = -1e30f;
#define DIL_LOGITS(S, TT, HALF) _Pragma("unroll") for (int rr = 0; rr < 16; ++rr) { const float v = fmaf(S[rr], C, lp[64 * TT + 32 * HALF + (rr & 3) + 8 * (rr >> 2)]); S[rr] = v; }
  DIL_LOGITS(s00, 0, 0) DIL_LOGITS(s01, 0, 1) DIL_LOGITS(s10, 1, 0) DIL_LOGITS(s11, 1, 1) DIL_LOGITS(s20, 2, 0) DIL_LOGITS(s21, 2, 1)
#undef DIL_LOGITS
  if (i0 == 0 || i0 + 320 > n) {
    const int lo = -iq - base, hi_ = n - 1 - iq - base;
#define DIL_MASK(S, TT, HALF) _Pragma("unroll") for (int rr = 0; rr < 16; ++rr) { const int c = 64 * TT + 32 * HALF + (rr & 3) + 8 * (rr >> 2); S[rr] = (c >= lo && c <= hi_) ? S[rr] : -1e30f; }
    DIL_MASK(s00, 0, 0) DIL_MASK(s01, 0, 1) DIL_MASK(s10, 1, 0) DIL_MASK(s11, 1, 1) DIL_MASK(s20, 2, 0) DIL_MASK(s21, 2, 1)
#undef DIL_MASK
  }
#define DIL_MAX(S) _Pragma("unroll") for (int rr = 0; rr < 16; ++rr) mx = fmaxf(mx, S[rr]);
  DIL_MAX(s00) DIL_MAX(s01) DIL_MAX(s10) DIL_MAX(s11) DIL_MAX(s20) DIL_MAX(s21)
#undef DIL_MAX
  { auto rr = __builtin_amdgcn_permlane32_swap(__float_as_uint(mx), __float_as_uint(mx), false, false);
    mx = fmaxf(__uint_as_float(rr[0]), __uint_as_float(rr[1])); }
  float ps = 0.f;
#define DIL_EXP(S) _Pragma("unroll") for (int rr = 0; rr < 16; ++rr) { const float p = __builtin_amdgcn_exp2f(S[rr] - mx); S[rr] = p; ps += p; }
  DIL_EXP(s00) DIL_EXP(s01) DIL_EXP(s10) DIL_EXP(s11) DIL_EXP(s20) DIL_EXP(s21)
#undef DIL_EXP
  { auto rr = __builtin_amdgcn_permlane32_swap(__float_as_uint(ps), __float_as_uint(ps), false, false);
    ps = __uint_as_float(rr[0]) + __uint_as_float(rr[1]); }
  bf16x8 pa[12];
#define PK4(P, BASE, OUT) do { unsigned a0 = cvtpk(P[BASE + 0], P[BASE + 1]), a1 = cvtpk(P[BASE + 2], P[BASE + 3]);   \
    unsigned b0 = cvtpk(P[BASE + 4], P[BASE + 5]), b1 = cvtpk(P[BASE + 6], P[BASE + 7]);                              \
    auto r0 = __builtin_amdgcn_permlane32_swap(a0, b0, false, false); auto r1 = __builtin_amdgcn_permlane32_swap(a1, b1, false, false); \
    u32x4 w = {r0[0], r1[0], r0[1], r1[1]}; OUT = *reinterpret_cast<bf16x8*>(&w); } while (0)
  PK4(s00, 0, pa[0]); PK4(s00, 8, pa[1]); PK4(s01, 0, pa[2]); PK4(s01, 8, pa[3]);
  PK4(s10, 0, pa[4]); PK4(s10, 8, pa[5]); PK4(s11, 0, pa[6]); PK4(s11, 8, pa[7]);
  PK4(s20, 0, pa[8]); PK4(s20, 8, pa[9]); PK4(s21, 0, pa[10]); PK4(s21, 8, pa[11]);
#undef PK4
  SBAR();
  if (hi == 0) wsx[r32] = ps;
  asm volatile("s_waitcnt vmcnt(0)" ::: "memory");
  __syncthreads();
  f32x16 o[4] = {};
  const int vb = (int)(uintptr_t)KV + v_rd_base(lane);
  pv_d0(o, vb + (a + 0) * 16384, pa[0], pa[1], pa[2], pa[3]);
  pv_d0(o, vb + (a + 1) * 16384, pa[4], pa[5], pa[6], pa[7]);
  pv_d0(o, vb + (a + 2) * 16384, pa[8], pa[9], pa[10], pa[11]);
  float rli[16];
#pragma unroll
  for (int rr = 0; rr < 16; ++rr) rli[rr] = __builtin_amdgcn_rcpf(wsx[crow(rr, hi)]);
#pragma unroll
  for (int rr = 0; rr < 16; ++rr) { const int ir = i0 + wid * 32 + crow(rr, hi); bf16* orow = outg + (size_t)(r + ir * d) * 512 + hh * 128 + r32;
#pragma unroll
    for (int d0 = 0; d0 < 4; ++d0) orow[d0 * 32] = __float2bfloat16(o[d0][rr] * rli[rr]); }
  if (hi == 0) lseg[(size_t)(r + iq * d) * 4 + hh] = (mx + __builtin_amdgcn_logf(ps)) * 0.6931471805599453f;
  __syncthreads();
}

typedef int i32x4a __attribute__((ext_vector_type(4)));
typedef int i32x8a __attribute__((ext_vector_type(8)));
constexpr float THR8 = 3.f;
constexpr size_t SHM8_K = 64 * 128, SHM8_V = 64 * 128, SHM_ATTN8 = 2 * SHM8_K + 2 * SHM8_V + NW * 64 * 4 + NW * 4096;
#define A8_CAT(lo, hi) __builtin_shufflevector(lo, hi, 0, 1, 2, 3, 4, 5, 6, 7)
__device__ __forceinline__ f32x16 mfma8(i32x8a a, i32x8a b, f32x16 c) { return __builtin_amdgcn_mfma_scale_f32_32x32x64_f8f6f4(a, b, c, 0, 0, 0, 0, 0, 0); }
__device__ __forceinline__ int kchunk(int row, int c) { return row * 128 + ((c ^ ((row >> 1) & 7)) << 4); }
constexpr float THR8L = THR8 * 1.4426950408889634f;
__device__ __forceinline__ void partialSM8(f32x16& p0, f32x16& p1, float& m_reg, float& alpha) {
  float pmax = fmaxf(p0[0], p1[0]);
  for (int r = 1; r < 16; ++r) pmax = fmaxf(fmaxf(pmax, p0[r]), p1[r]);
  { auto rr = __builtin_amdgcn_permlane32_swap(__float_as_uint(pmax), __float_as_uint(pmax), false, false);
    pmax = fmaxf(__uint_as_float(rr[0]), __uint_as_float(rr[1])); }
  if (__builtin_expect(__all(pmax <= THR8L + 4.0f), 1)) { alpha = 1.f; }
  else { const float delta = fmaxf(pmax - 4.0f, 0.f); m_reg += delta; alpha = __builtin_amdgcn_exp2f(-delta);
    for (int r = 0; r < 16; ++r) { p0[r] -= delta; p1[r] -= delta; } }
  for (int r = 0; r < 16; ++r) p0[r] = __builtin_amdgcn_exp2f(p0[r]);
}
__device__ __forceinline__ unsigned pk4f8(float a, float b, float c, float d) { int w = __builtin_amdgcn_cvt_pk_fp8_f32(a, b, 0, false); w = __builtin_amdgcn_cvt_pk_fp8_f32(c, d, w, true); return (unsigned)w; }
__device__ __forceinline__ void finishSM8(f32x16& p0, f32x16& p1, i32x8a& pa) {
  for (int r = 0; r < 16; ++r) p1[r] = __builtin_amdgcn_exp2f(p1[r]);
  pa[0] = (int)pk4f8(p0[0], p0[1], p0[2], p0[3]);   pa[1] = (int)pk4f8(p0[4], p0[5], p0[6], p0[7]);
  pa[2] = (int)pk4f8(p0[8], p0[9], p0[10], p0[11]); pa[3] = (int)pk4f8(p0[12], p0[13], p0[14], p0[15]);
  pa[4] = (int)pk4f8(p1[0], p1[1], p1[2], p1[3]);   pa[5] = (int)pk4f8(p1[4], p1[5], p1[6], p1[7]);
  pa[6] = (int)pk4f8(p1[8], p1[9], p1[10], p1[11]); pa[7] = (int)pk4f8(p1[12], p1[13], p1[14], p1[15]);
}
__device__ __forceinline__ void qkt8(f32x16& p0, f32x16& p1, const char* Ks, const char* Qs, int r32, int hi, float init) {
  for (int r = 0; r < 16; ++r) { p0[r] = init; p1[r] = init; }
#pragma unroll
  for (int s = 0; s < 2; ++s) { const int c0 = 4 * s + 2 * hi;
    const i32x8a a0 = A8_CAT(*reinterpret_cast<const i32x4a*>(Ks + kchunk(r32, c0)), *reinterpret_cast<const i32x4a*>(Ks + kchunk(r32, c0 + 1)));
    const i32x8a a1 = A8_CAT(*reinterpret_cast<const i32x4a*>(Ks + kchunk(32 + r32, c0)), *reinterpret_cast<const i32x4a*>(Ks + kchunk(32 + r32, c0 + 1)));
    const i32x8a qs = A8_CAT(*reinterpret_cast<const i32x4a*>(Qs + (2 * s) * 1024), *reinterpret_cast<const i32x4a*>(Qs + (2 * s + 1) * 1024));
    p0 = mfma8(a0, qs, p0); p1 = mfma8(a1, qs, p1); }
}
__device__ __forceinline__ void pv8(f32x16* o, const char* Vs, i32x8a pa, int lane) {
#pragma unroll
  for (int d0 = 0; d0 < 4; ++d0) { const i32x8a b = A8_CAT(*reinterpret_cast<const i32x4a*>(Vs + d0 * 2048 + lane * 16), *reinterpret_cast<const i32x4a*>(Vs + d0 * 2048 + 1024 + lane * 16));
    o[d0] = mfma8(pa, b, o[d0]); }
  const i32x8a ones = {0x38383838, 0x38383838, 0x38383838, 0x38383838, 0x38383838, 0x38383838, 0x38383838, 0x38383838};
  o[4] = mfma8(pa, ones, o[4]);
}
template <int LDQ, int LDK, int LDO>
__device__ __forceinline__ void attn_dense_body8(const unsigned char* __restrict__ Qb, const unsigned char* __restrict__ Kh, const unsigned char* __restrict__ Vimg,
                                                 unsigned char* __restrict__ Ob, int seq, char* lds) {
  const int tid = threadIdx.x, wid = __builtin_amdgcn_readfirstlane(tid >> 6), lane = tid & 63, r32 = lane & 31, hi = lane >> 5;
  char* V_lds = lds; char* K_lds = lds + 2 * SHM8_V;
  float* ws = (float*)(lds + 2 * SHM8_V + 2 * SHM8_K) + wid * 64; float* al_l = ws + 32;
  float m_reg = 0.f; f32x16 o[5] = {};
  const unsigned char* Qw = Qb + (long)(wid * QBLK + r32) * LDQ + hi * 32;
  char* Qs = lds + 2 * SHM8_V + 2 * SHM8_K + NW * 64 * 4 + wid * 4096 + lane * 16;
#pragma unroll
  for (int s = 0; s < 2; ++s) { *reinterpret_cast<i32x4a*>(Qs + (2 * s) * 1024) = *reinterpret_cast<const i32x4a*>(Qw + 64 * s); *reinterpret_cast<i32x4a*>(Qs + (2 * s + 1) * 1024) = *reinterpret_cast<const i32x4a*>(Qw + 64 * s + 16); }
  const int sr = tid >> 3, sc = tid & 7, kst = kchunk(sr, sc);
  struct { i32x4a vs, ks; } sr_[SDEPTH];
#define SLOAD8(i, k0) do { sr_[i].vs = *reinterpret_cast<const i32x4a*>(Vimg + (long)((k0) >> 6) * 8192 + tid * 16); sr_[i].ks = *reinterpret_cast<const i32x4a*>(Kh + (long)((k0) + sr) * LDK + sc * 16); } while (0)
#define SWRITE8(b, i) do { *reinterpret_cast<i32x4a*>(V_lds + (b) * SHM8_V + tid * 16) = sr_[i].vs; *reinterpret_cast<i32x4a*>(K_lds + (b) * SHM8_K + kst) = sr_[i].ks; } while (0)
#define SWAIT8() do { if constexpr (SDEPTH == 2) asm volatile("s_waitcnt vmcnt(2)" ::: "memory"); else asm volatile("s_waitcnt vmcnt(0)" ::: "memory"); } while (0)
#define RESC8(a) do { if (__any((a) < 1.f)) { if (hi == 0) al_l[r32] = (a); asm volatile("s_waitcnt lgkmcnt(0)" ::: "memory"); \
    for (int d = 0; d < 5; ++d) for (int r = 0; r < 16; ++r) o[d][r] *= al_l[crow(r, hi)]; } } while (0)
  f32x16 pA0, pA1, pB0, pB1; float alA, alB; i32x8a pa; const int NT = seq / KVBLK;
  constexpr int SE = 0, SO = SDEPTH - 1;
  SLOAD8(SE, 0); asm volatile("s_waitcnt vmcnt(0)" ::: "memory"); SWRITE8(0, SE); __syncthreads();
  qkt8(pA0, pA1, K_lds, Qs, r32, hi, 4.0f - m_reg); partialSM8(pA0, pA1, m_reg, alA);
  SLOAD8(SO, KVBLK); if constexpr (SDEPTH == 2) { if (2 < NT) SLOAD8(SE, 2 * KVBLK); }
  SWAIT8(); SWRITE8(1, SO); __syncthreads();
  for (int j = 1; j + 1 < NT; j += 2) {
    SBAR(); qkt8(pB0, pB1, K_lds + SHM8_K, Qs, r32, hi, 4.0f - m_reg);
    finishSM8(pA0, pA1, pa); SBAR();
    SLOAD8(SO, (j + SDEPTH) * KVBLK); SBAR();
    pv8(o, V_lds, pa, lane); partialSM8(pB0, pB1, m_reg, alB);
    __syncthreads(); SWAIT8(); SWRITE8(0, SE);
    RESC8(alB); __syncthreads();
    SBAR(); qkt8(pA0, pA1, K_lds, Qs, r32, hi, 4.0f - m_reg);
    finishSM8(pB0, pB1, pa); SBAR();
    if (SDEPTH == 1 || j + 3 < NT) SLOAD8(SE, (j + 1 + SDEPTH) * KVBLK); SBAR();
    pv8(o, V_lds + SHM8_V, pa, lane); partialSM8(pA0, pA1, m_reg, alA);
    __syncthreads(); SWAIT8(); SWRITE8(1, SO);
    RESC8(alA); __syncthreads();
  }
  SBAR(); qkt8(pB0, pB1, K_lds + SHM8_K, Qs, r32, hi, 4.0f - m_reg);
  finishSM8(pA0, pA1, pa); SBAR();
  pv8(o, V_lds, pa, lane); partialSM8(pB0, pB1, m_reg, alB);
  __syncthreads(); RESC8(alB);
  finishSM8(pB0, pB1, pa); SBAR();
  pv8(o, V_lds + SHM8_V, pa, lane);
  float rli[16];
#pragma unroll
  for (int r = 0; r < 16; ++r) rli[r] = 4.0f * __builtin_amdgcn_rcpf(o[4][r]);
  unsigned char* Ow = Ob + (long)(wid * QBLK) * LDO;
#pragma unroll
  for (int r = 0; r < 16; ++r) { const int orow = crow(r, hi);
    for (int d0 = 0; d0 < 4; ++d0) Ow[(long)orow * LDO + d0 * 32 + r32] = (unsigned char)(__builtin_amdgcn_cvt_pk_fp8_f32(o[d0][r] * rli[r], 0.f, 0, false) & 0xff); }
#undef SLOAD8
#undef SWRITE8
#undef SWAIT8
#undef RESC8
}
}

#define GAS __attribute__((address_space(1)))
#define LAS __attribute__((address_space(3)))
typedef unsigned short bf16;
typedef unsigned v4u __attribute__((ext_vector_type(4)));
typedef unsigned v2u __attribute__((ext_vector_type(2)));
typedef float f32x4 __attribute__((ext_vector_type(4)));
#define LDS_WAIT() asm volatile("s_waitcnt lgkmcnt(0)" ::: "memory")
#define VM_WAIT() asm volatile("s_waitcnt vmcnt(0)" ::: "memory")
__device__ __forceinline__ unsigned pk2(float lo, float hi) { return pg8::cvt_pk_bf16(lo, hi); }
__device__ __forceinline__ float bflo(unsigned w) { return __builtin_bit_cast(float, w << 16); }
__device__ __forceinline__ float bfhi(unsigned w) { return __builtin_bit_cast(float, w & 0xffff0000u); }
#ifndef MK_Q8
#define MK_Q8 0
#endif
#ifndef MK_CHK_TOL
#define MK_CHK_TOL 0.15f
#endif
#ifndef MK_CHECK8
#define MK_CHECK8 0
#endif
__device__ __forceinline__ unsigned pk4_fp8(float a, float b, float c, float d) {
    int w = __builtin_amdgcn_cvt_pk_fp8_f32(a, b, 0, false); w = __builtin_amdgcn_cvt_pk_fp8_f32(c, d, w, true); return (unsigned)w; }
__device__ __forceinline__ float q8f(float v) { const int p = __builtin_amdgcn_cvt_pk_fp8_f32(v, v, 0, false); return __builtin_amdgcn_cvt_f32_fp8(p, 0); }
__device__ __forceinline__ float bf2f(bf16 b) { return __builtin_bit_cast(float, ((unsigned)b) << 16); }

#define XB_TMO      128
#define XB_XCNT(j)  (256  + 64 * (j))
#define XB_XSUB(j)  (1280 + 64 * (j))
#define XB_XGEN(j)  (2304 + 64 * (j))
#define XB_TOP      3328
#define XB_TOPGEN   3392
#define XCD_BAR_WORDS 3456
#define XB_SPIN_CAP (1u << 18)

__device__ __forceinline__ unsigned xb_ld(unsigned* p)              { return __hip_atomic_load(p, __ATOMIC_RELAXED, __HIP_MEMORY_SCOPE_AGENT); }
__device__ __forceinline__ unsigned xb_add(unsigned* p, unsigned v) { return __hip_atomic_fetch_add(p, v, __ATOMIC_RELAXED, __HIP_MEMORY_SCOPE_AGENT); }
__device__ __forceinline__ unsigned xb_xcc_id() { return (unsigned)__builtin_amdgcn_s_getreg((3 << 11) | 20) & 0xFu; }
#define XB_SPIN(cond, bar) do { unsigned _sp = 0; while (cond) { __builtin_amdgcn_s_sleep(1); \
    if ((++_sp & 255u) == 0u) { if (xb_ld(&(bar)[XB_TMO])) break; if (_sp > XB_SPIN_CAP) { atomicAdd(&(bar)[XB_TMO], 1u); break; } } } } while (0)

struct XcdBarrier {
    unsigned* bar; unsigned x;
    volatile LAS unsigned* st;
};

__device__ __forceinline__ XcdBarrier xcd_barrier_post(unsigned* bar, volatile LAS unsigned* st) {
    XcdBarrier b; b.bar = bar; b.x = xb_xcc_id(); b.st = st;
    if (threadIdx.x == 0) (void)xb_add(&bar[XB_XCNT(b.x)], 1u);
    return b;
}
__device__ __forceinline__ void xcd_barrier_complete(unsigned* bar, unsigned x, unsigned& nloc, unsigned& nx) {
    const unsigned G = gridDim.x * gridDim.y * gridDim.z;
    unsigned sum, cnt, mine, sp = 0u;
    for (;;) {
        sum = 0u; cnt = 0u; mine = 0u;
#pragma unroll
        for (unsigned j = 0; j < 16; ++j) { const unsigned c = xb_ld(&bar[XB_XCNT(j)]); sum += c; cnt += (c > 0u) ? 1u : 0u; mine = (j == x) ? c : mine; }
        if (sum == G) break;
        __builtin_amdgcn_s_sleep(1);
        if ((++sp & 255u) == 0u) { if (xb_ld(&bar[XB_TMO])) break; if (sp > XB_SPIN_CAP) { atomicAdd(&bar[XB_TMO], 1u); break; } }
    }
    nloc = mine > 0u ? mine : 1u; nx = cnt > 0u ? cnt : 1u;
}

__device__ __forceinline__ void xcd_barrier(const XcdBarrier& b) {
    asm volatile("s_waitcnt vmcnt(0)" ::: "memory");
    __syncthreads();
    if (threadIdx.x == 0) {
        unsigned* bar = b.bar;
        __builtin_amdgcn_s_waitcnt(0);
        unsigned nloc = b.st[0], nx = b.st[1];
        if (nloc == 0u) { xcd_barrier_complete(bar, b.x, nloc, nx); b.st[0] = nloc; b.st[1] = nx; }
        const unsigned old = xb_add(&bar[XB_XSUB(b.x)], 1u);
        const unsigned gen = old / nloc;
        if (old + 1u == (gen + 1u) * nloc) {
            __builtin_amdgcn_fence(__ATOMIC_RELEASE, "agent");
            asm volatile("s_waitcnt vmcnt(0)" ::: "memory");
            const unsigned og = xb_add(&bar[XB_TOP], 1u);
            const unsigned tg = og / nx;
            if (og + 1u == (tg + 1u) * nx) xb_add(&bar[XB_TOPGEN], 1u);
            else XB_SPIN(xb_ld(&bar[XB_TOPGEN]) == tg, bar);
            __builtin_amdgcn_fence(__ATOMIC_ACQUIRE, "agent");
            xb_add(&bar[XB_XGEN(b.x)], 1u);
            asm volatile("s_waitcnt vmcnt(0)" ::: "memory");
        } else {
            XB_SPIN(xb_ld(&bar[XB_XGEN(b.x)]) == gen, bar);
            __builtin_amdgcn_fence(__ATOMIC_ACQUIRE, "agent");
            asm volatile("s_waitcnt vmcnt(0)" ::: "memory");
        }
    }
    __syncthreads();
}

constexpr int S_ = 8192, DM = 2048, INW = 10240, NE = 32, TOPK = 4;
constexpr int A_W = 1536, A_V_OFF = 3072, B_Q_OFF = 4608, B_K_OFF = 5632, B_V_OFF = 5888, GATE_OFF = 6144;
constexpr int MAXSLOT = 40960;
constexpr float LN_EPS = 1e-5f, QK_EPS = 1e-6f;
constexpr float ALPHA = 1.189207115002721f;
constexpr int NPH = 11;

constexpr size_t MiB = 1u << 20;
constexpr size_t WS_CTL = 0, CTL_ZERO_BYTES = 32 * 1024;
constexpr int CW_BAR = 0;
constexpr int CW_CNT = 4096;
constexpr size_t WS_LUT = 1 * MiB;
constexpr size_t WS_ROPE = 1 * MiB + 8192;
constexpr size_t WS_WRT = 1 * MiB + 65536;
constexpr size_t WS_TOKE = 1 * MiB + 65536 + 262144;
constexpr size_t WS_TOKR = WS_TOKE + 131072;
constexpr size_t WS_TOKW = WS_TOKR + 131072;
constexpr size_t WS_TOKS = WS_TOKW + 131072;
constexpr size_t WS_SLOTW = WS_TOKS + 131072;
constexpr size_t WS_LSE = 3 * MiB;
constexpr size_t WS_XB = 4 * MiB;
constexpr size_t WS_WIN = WS_XB + 32 * MiB;
constexpr size_t WS_WA = WS_WIN + 40 * MiB;
constexpr size_t WS_WB = WS_WA + 2 * MiB;
constexpr size_t WS_WO = WS_WB + 4 * MiB;
constexpr size_t WS_WGL = WS_WO + 8 * MiB;
constexpr size_t WS_WD = WS_WGL + 512 * MiB;
constexpr size_t WS_PROJ = WS_WD + 256 * MiB;
constexpr size_t WS_QBR = WS_PROJ + 160 * MiB;
constexpr size_t WS_KBR = WS_QBR + 16 * MiB;
constexpr size_t WS_VBR = WS_KBR + 4 * MiB;
constexpr size_t WS_Q8 = WS_VBR + 4 * MiB;
constexpr size_t WS_K8 = WS_Q8 + 8 * MiB;
constexpr size_t WS_VIMG = WS_K8 + 2 * MiB;
constexpr size_t WS_DBG = WS_VIMG + 2 * MiB;
constexpr size_t WS_OUTA = WS_DBG + 64 * MiB;
constexpr size_t WS_YA = WS_OUTA + 24 * MiB;
constexpr size_t WS_YB = WS_YA + 8 * MiB;
constexpr size_t WS_T1 = WS_YB + 16 * MiB;
constexpr size_t WS_Y = WS_T1 + 64 * MiB;
constexpr size_t WS_X1 = WS_Y + 32 * MiB;
constexpr size_t WS_X1B = WS_X1 + 64 * MiB;
constexpr size_t WS_XS = WS_X1B + 32 * MiB;
constexpr size_t WS_H = WS_XS + 160 * MiB;
constexpr size_t WS_YS = WS_PROJ;
constexpr size_t WS_END = WS_H + 160 * MiB;

constexpr int RING_OFF = 0, RING_BYTES = 131072;
constexpr int L_XB = RING_BYTES;
constexpr int L_TILE = RING_BYTES + 64;
constexpr int L_PST = RING_BYTES + 1024;
constexpr int L_CNT = RING_BYTES + 1280;
constexpr int L_ASG = RING_BYTES + 2048;
constexpr int L_PTR = RING_BYTES + 3584;
constexpr int LDS_BYTES = 147456;

struct Frame {
    LAS unsigned char* lds; unsigned char* ldsg;
    int tid, lane, wave, G;
};
__device__ __forceinline__ unsigned char* wsp_(const Frame& F) {
    const LAS unsigned* p = (const LAS unsigned*)(F.lds + L_PTR) + 2 * 22;
    const unsigned lo = __builtin_amdgcn_readfirstlane(p[0]), hi = __builtin_amdgcn_readfirstlane(p[1]);
    return (unsigned char*)(((unsigned long long)hi << 32) | lo);
}
__device__ __forceinline__ const float* inp(const Frame& F, int i) {
    const LAS unsigned* p = (const LAS unsigned*)(F.lds + L_PTR) + 2 * i;
    const unsigned lo = __builtin_amdgcn_readfirstlane(p[0]), hi = __builtin_amdgcn_readfirstlane(p[1]);
    return (const float*)(((unsigned long long)hi << 32) | lo);
}
__device__ __forceinline__ float wave_sum(float v) {
#pragma unroll
    for (int o = 1; o < 64; o <<= 1) v += __shfl_xor(v, o);
    return v;
}

__device__ __forceinline__ void transpose_item(const float* __restrict__ W, int N, int k0, int n0, bf16* WT, int ldo, int orow0, int ocol0, LAS float* scr, int lane, const bool q8 = false) {
    f32x4 v[8];
#pragma unroll
    for (int i = 0; i < 8; ++i) v[i] = *(const f32x4*)(W + (size_t)(k0 + 8 * i + (lane >> 3)) * N + n0 + 4 * (lane & 7));
#pragma unroll
    for (int i = 0; i < 8; ++i) { LAS float* s = scr + (8 * i + (lane >> 3)) * 33 + 4 * (lane & 7); if (q8) { for (int e = 0; e < 4; ++e) v[i][e] = q8f(v[i][e] * 64.0f) * (1.0f / 64.0f); } s[0] = v[i][0]; s[1] = v[i][1]; s[2] = v[i][2]; s[3] = v[i][3]; }
    LDS_WAIT(); asm volatile("" ::: "memory");
    const int c = lane & 7;
#pragma unroll
    for (int j = 0; j < 4; ++j) { const int n = (lane >> 3) + 8 * j; const LAS float* s = scr + (8 * c) * 33 + n;
        v4u o; o.x = pk2(s[0 * 33], s[1 * 33]); o.y = pk2(s[2 * 33], s[3 * 33]); o.z = pk2(s[4 * 33], s[5 * 33]); o.w = pk2(s[6 * 33], s[7 * 33]);
        *(v4u*)(WT + (size_t)(orow0 + n) * ldo + ocol0 + 8 * c) = o; }
    LDS_WAIT(); asm volatile("" ::: "memory");
}
__device__ __forceinline__ void transpose_item8(const float* __restrict__ W, int N, int k0, int n0, unsigned char* WT, int ldo, int orow0, int ocol0, float scale, LAS float* scr, int lane) {
    f32x4 v[8];
#pragma unroll
    for (int i = 0; i < 8; ++i) v[i] = *(const f32x4*)(W + (size_t)(k0 + 8 * i + (lane >> 3)) * N + n0 + 4 * (lane & 7));
#pragma unroll
    for (int i = 0; i < 8; ++i) { LAS float* s = scr + (8 * i + (lane >> 3)) * 33 + 4 * (lane & 7); s[0] = v[i][0] * scale; s[1] = v[i][1] * scale; s[2] = v[i][2] * scale; s[3] = v[i][3] * scale; }
    LDS_WAIT(); asm volatile("" ::: "memory");
    const int c = lane & 3;
#pragma unroll
    for (int j = 0; j < 2; ++j) { const int n = (lane >> 2) + 16 * j; const LAS float* s = scr + (16 * c) * 33 + n;
        v4u o; o.x = pk4_fp8(s[0 * 33], s[1 * 33], s[2 * 33], s[3 * 33]); o.y = pk4_fp8(s[4 * 33], s[5 * 33], s[6 * 33], s[7 * 33]);
        o.z = pk4_fp8(s[8 * 33], s[9 * 33], s[10 * 33], s[11 * 33]); o.w = pk4_fp8(s[12 * 33], s[13 * 33], s[14 * 33], s[15 * 33]);
        *(v4u*)(WT + (size_t)(orow0 + n) * ldo + ocol0 + 16 * c) = o; }
    LDS_WAIT(); asm volatile("" ::: "memory");
}
__device__ __forceinline__ int t5_bucket(int rel) {
    const int n = rel < 0 ? -rel : rel; const float nf = (float)(n < 1 ? 1 : n);
    int large = 8 + (int)(logf(nf / 8.0f) / 4.852030263919617f * 8.0f); large = large < 15 ? large : 15;
    return (rel > 0 ? 16 : 0) + (n < 8 ? n : large);
}
__device__ __forceinline__ void p0_prologue(Frame& F) {
    LAS float* scr = (LAS float*)(F.lds + RING_OFF + F.wave * 16384);
    const int gw = blockIdx.x * 8 + F.wave, NGW = F.G * 8;
    const int gt = blockIdx.x * 512 + F.tid, NGT = F.G * 512;
    bf16* XB = (bf16*)(wsp_(F) + WS_XB); bf16* WIN = (bf16*)(wsp_(F) + WS_WIN); bf16* WA = (bf16*)(wsp_(F) + WS_WA); bf16* WB = (bf16*)(wsp_(F) + WS_WB); bf16* WO = (bf16*)(wsp_(F) + WS_WO);
    bf16* WGL = (bf16*)(wsp_(F) + WS_WGL); bf16* WD = (bf16*)(wsp_(F) + WS_WD);
    { float* lut = (float*)(wsp_(F) + WS_LUT); const float* rb = inp(F, 3);
      for (int i = gt; i < 3 * 4 * 129; i += NGT) { const int g = i / 516, hh = (i / 129) % 4, j = i % 129; const int d = (g == 0) ? 1 : (g == 1 ? 4 : 16);
          lut[i] = rb[t5_bucket((j - 64) * d) * 12 + g * 4 + hh]; }
      float* rope = (float*)(wsp_(F) + WS_ROPE);
      for (int i = gt; i < 128 * 32; i += NGT) { const int pos = i >> 5, fi = i & 31; const float inv = powf(10000.0f, -(float)(2 * fi) / 64.0f); const float ang = (float)pos * inv;
          rope[2 * i] = __cosf(ang); rope[2 * i + 1] = __sinf(ang); }
    }
    { const float* x = inp(F, 0);
      for (int i = gw; i < S_ * DM / 512; i += NGW) { const size_t o = (size_t)i * 512 + F.lane * 8; const f32x4 a = *(const f32x4*)(x + o), b = *(const f32x4*)(x + o + 4);
          v2u w; w.x = pk4_fp8(a[0], a[1], a[2], a[3]); w.y = pk4_fp8(b[0], b[1], b[2], b[3]); *(v2u*)((unsigned char*)XB + o) = w; } }
    constexpr int T_WIN = 16 * 80, T_WA = 4 * 16, T_WB = 8 * 16, T_WO = 16 * 16;
    constexpr int NT = T_WIN + T_WA + T_WB + T_WO;
    const float* const w_in = inp(F, 1); const float* const w_ba = inp(F, 6); const float* const w_bb = inp(F, 7); const float* const w_o = inp(F, 8);
#define P0_DECODE(T, SRC, NN, DST, LDO, SCL) do { int r_ = (T); \
        if (r_ < T_WIN) { const int kt = r_ / 80, nt = r_ % 80; SRC = w_in + (size_t)(128 * kt) * INW + 128 * nt; NN = INW; DST = (unsigned char*)WIN + (size_t)(nt >> 1) * (256 * 2048) + kt * 32768 + (nt & 1) * 16384; LDO = 128; SCL = 64.0f; break; } r_ -= T_WIN; \
        if (r_ < T_WA) { const int kt = r_ / 16, nt = r_ % 16; SRC = w_ba + (size_t)(128 * kt) * DM + 128 * nt; NN = DM; DST = (unsigned char*)WA + (size_t)(nt >> 1) * (256 * 512) + kt * 32768 + (nt & 1) * 16384; LDO = 128; SCL = 32.0f; break; } r_ -= T_WA; \
        if (r_ < T_WB) { const int kt = r_ / 16, nt = r_ % 16; SRC = w_bb + (size_t)(128 * kt) * DM + 128 * nt; NN = DM; DST = (unsigned char*)WB + (size_t)(nt >> 1) * (256 * 1024) + kt * 32768 + (nt & 1) * 16384; LDO = 128; SCL = 32.0f; break; } r_ -= T_WB; \
        { const int kt = r_ / 16, nt = r_ % 16; SRC = w_o + (size_t)(128 * kt) * DM + 128 * nt; NN = DM; DST = (unsigned char*)WO + (size_t)(nt >> 1) * (256 * 2048) + kt * 32768 + (nt & 1) * 16384; LDO = 128; SCL = 64.0f; } } while (0)
    const int nq = F.tid & 31, kq0 = F.tid >> 5;
#define P0_LOAD(V, SRC, NN) do { _Pragma("unroll") for (int p = 0; p < 2; ++p) _Pragma("unroll") for (int i = 0; i < 4; ++i) V[p * 4 + i] = __builtin_nontemporal_load((const f32x4*)(SRC + (size_t)(4 * (kq0 + 16 * p) + i) * NN + 4 * nq)); } while (0)
    if ((int)blockIdx.x < NT) {
        const int nj = (NT - (int)blockIdx.x + F.G - 1) / F.G;
        const float* src; int nn; unsigned char* dst; int ldo; float scl;
        P0_DECODE((int)blockIdx.x, src, nn, dst, ldo, scl);
        f32x4 v[8]; P0_LOAD(v, src, nn);
        for (int j = 0; j < nj; ++j) {
            const int jn = (j + 1 < nj) ? j + 1 : j;
            const float* nsrc; int nnn; unsigned char* ndst; int nldo; float nscl;
            P0_DECODE((int)blockIdx.x + jn * F.G, nsrc, nnn, ndst, nldo, nscl);
            f32x4 nv[8]; P0_LOAD(nv, nsrc, nnn);
            LAS unsigned* t32 = (LAS unsigned*)(F.lds + RING_OFF + (j & 1) * 16384);
#pragma unroll
            for (int p = 0; p < 2; ++p)
#pragma unroll
                for (int c = 0; c < 4; ++c) t32[(4 * nq + c) * 32 + ((kq0 + 16 * p) ^ nq)] = pk4_fp8(v[p * 4 + 0][c] * scl, v[p * 4 + 1][c] * scl, v[p * 4 + 2][c] * scl, v[p * 4 + 3][c] * scl);
            __syncthreads();
#pragma unroll
            for (int jj = 0; jj < 2; ++jj) { const int n = (F.tid >> 3) + 64 * jj, c8 = F.tid & 7, g = n >> 2; const LAS unsigned* rp = t32 + n * 32;
                v4u o; o.x = rp[(4 * c8 + 0) ^ g]; o.y = rp[(4 * c8 + 1) ^ g]; o.z = rp[(4 * c8 + 2) ^ g]; o.w = rp[(4 * c8 + 3) ^ g];
                __builtin_nontemporal_store(o, (v4u*)(dst + (size_t)n * ldo + 16 * c8)); }
#pragma unroll
            for (int i = 0; i < 8; ++i) v[i] = nv[i];
            src = nsrc; nn = nnn; dst = ndst; ldo = nldo; scl = nscl;
        }
        __syncthreads();
    }
#undef P0_DECODE
#undef P0_LOAD
}

__device__ __forceinline__ void moe_convert_share(Frame& F) {
    constexpr int T_ALL = 3 * 32 * 256;
    const float* const w_g = inp(F, 13); const float* const w_l = inp(F, 15); const float* const w_d = inp(F, 17);
    unsigned char* const WGL = wsp_(F) + WS_WGL; unsigned char* const WD = wsp_(F) + WS_WD;
#define MC_DECODE(T, SRC, DST) do { const int r_ = (T); const int which = r_ / (32 * 256), rr = r_ % (32 * 256), e = rr >> 8, q = rr & 255, kt = q >> 4, nt = q & 15; \
        SRC = (which == 0 ? w_g : (which == 1 ? w_l : w_d)) + (size_t)e * DM * DM + (size_t)(128 * kt) * DM + 128 * nt; \
        DST = (which < 2) ? WGL + (size_t)e * (4096 * 2048) + (size_t)nt * (256 * 2048) + kt * 32768 + which * 16384 : WD + (size_t)e * (2048 * 2048) + (size_t)(nt >> 1) * (256 * 2048) + kt * 32768 + (nt & 1) * 16384; } while (0)
    const int nq = F.tid & 31, kq0 = F.tid >> 5;
#define MC_LOAD(V, SRC) do { _Pragma("unroll") for (int p = 0; p < 2; ++p) _Pragma("unroll") for (int i = 0; i < 4; ++i) V[p * 4 + i] = __builtin_nontemporal_load((const f32x4*)(SRC + (size_t)(4 * (kq0 + 16 * p) + i) * DM + 4 * nq)); } while (0)
    if ((int)blockIdx.x < T_ALL) {
        const int nj = (T_ALL - (int)blockIdx.x + F.G - 1) / F.G, t0_ = (int)blockIdx.x;
        f32x4 b0[8], b1[8], b2[8], b3[8];
        unsigned char *d0, *d1, *d2, *d3 = nullptr;
        { const float* sp; MC_DECODE(t0_ + (0 < nj ? 0 : nj - 1) * F.G, sp, d0); MC_LOAD(b0, sp); }
        { const float* sp; MC_DECODE(t0_ + (1 < nj ? 1 : nj - 1) * F.G, sp, d1); MC_LOAD(b1, sp); }
        { const float* sp; MC_DECODE(t0_ + (2 < nj ? 2 : nj - 1) * F.G, sp, d2); MC_LOAD(b2, sp); }
#define MC_STEP(K, CUR, DCUR, NXT, DNXT) do { const int k_ = (K); \
            { const int kn_ = (k_ + 3 < nj) ? k_ + 3 : nj - 1; const float* sp; MC_DECODE(t0_ + kn_ * F.G, sp, DNXT); MC_LOAD(NXT, sp); } \
            if (k_ < nj) { \
                LAS unsigned* t32 = (LAS unsigned*)(F.lds + RING_OFF + (k_ & 1) * 16384); \
                _Pragma("unroll") for (int p = 0; p < 2; ++p) _Pragma("unroll") for (int c = 0; c < 4; ++c) \
                    t32[(4 * nq + c) * 32 + ((kq0 + 16 * p) ^ nq)] = pk4_fp8(CUR[p * 4 + 0][c] * 64.0f, CUR[p * 4 + 1][c] * 64.0f, CUR[p * 4 + 2][c] * 64.0f, CUR[p * 4 + 3][c] * 64.0f); \
                __syncthreads(); \
                _Pragma("unroll") for (int jj = 0; jj < 2; ++jj) { const int n = (F.tid >> 3) + 64 * jj, c8 = F.tid & 7, g = n >> 2; const LAS unsigned* rp = t32 + n * 32; \
                    v4u o; o.x = rp[(4 * c8 + 0) ^ g]; o.y = rp[(4 * c8 + 1) ^ g]; o.z = rp[(4 * c8 + 2) ^ g]; o.w = rp[(4 * c8 + 3) ^ g]; \
                    __builtin_nontemporal_store(o, (v4u*)(DCUR + (size_t)n * 128 + 16 * c8)); } } } while (0)
        for (int j = 0; j < nj; j += 4) {
            MC_STEP(j + 0, b0, d0, b3, d3);
            MC_STEP(j + 1, b1, d1, b0, d0);
            MC_STEP(j + 2, b2, d2, b1, d1);
            MC_STEP(j + 3, b3, d3, b2, d2);
        }
#undef MC_STEP
        __syncthreads();
    }
#undef MC_DECODE
#undef MC_LOAD
}

__device__ __forceinline__ void p2_prep_dilated(Frame& F) {
    const bf16* proj = (const bf16*)(wsp_(F) + WS_PROJ);
    bf16* QBR = (bf16*)(wsp_(F) + WS_QBR); bf16* KBR = (bf16*)(wsp_(F) + WS_KBR); bf16* VBR = (bf16*)(wsp_(F) + WS_VBR);
    unsigned char* Q8 = wsp_(F) + WS_Q8; unsigned char* K8 = wsp_(F) + WS_K8; unsigned char* VIMG = wsp_(F) + WS_VIMG;
    const float* rope = (const float*)(wsp_(F) + WS_ROPE);
    const int gw = blockIdx.x * 8 + F.wave, NGW = F.G * 8;
    const int half = F.lane >> 5, fi = F.lane & 31, c1 = half * 64 + fi, c2 = c1 + 32;
    const float* const qn_g = inp(F, 4); const float* const kn_g = inp(F, 5);
    int tfirst, tstep_, tcount;
    if (F.G == 256) { if (blockIdx.x >= 128) { tfirst = ((int)blockIdx.x - 128) * 8 + F.wave; tstep_ = 1024; tcount = 6; } else { tfirst = 6144 + (int)blockIdx.x * 8 + F.wave; tstep_ = 1024; tcount = 2; } }
    else { tfirst = gw; tstep_ = NGW; tcount = (S_ - gw + NGW - 1) / NGW; }
    for (int ti = 0; ti < tcount; ++ti) {
        const int t = tfirst + ti * tstep_;
        const bf16* base = proj + (size_t)t * INW;
        float a1[10], a2[10], ss[10];
#pragma unroll
        for (int h = 0; h < 10; ++h) { const bf16* src = base + (h < 8 ? B_Q_OFF + h * 128 : B_K_OFF + (h - 8) * 128); a1[h] = bf2f(src[c1]); a2[h] = bf2f(src[c2]); }
        const unsigned vv0 = ((const unsigned*)(base + B_V_OFF))[F.lane], vv1 = ((const unsigned*)(base + B_V_OFF + 128))[F.lane];
        const int pos = half ? (t & 63) : (t >> 6);
        const float cs = rope[(pos * 32 + fi) * 2], sn = rope[(pos * 32 + fi) * 2 + 1];
        const float gq1 = qn_g[c1], gq2 = qn_g[c2], gk1 = kn_g[c1], gk2 = kn_g[c2];
#pragma unroll
        for (int h = 0; h < 10; ++h) ss[h] = a1[h] * a1[h] + a2[h] * a2[h];
#pragma unroll
        for (int o = 1; o < 64; o <<= 1)
#pragma unroll
            for (int h = 0; h < 10; ++h) ss[h] += __shfl_xor(ss[h], o);
#pragma unroll
        for (int h = 0; h < 10; ++h) {
            const float rs = 1.0f / sqrtf(ss[h] * (1.0f / 128.0f) + QK_EPS);
            const float v1 = a1[h] * rs * (h < 8 ? gq1 : gk1), v2 = a2[h] * rs * (h < 8 ? gq2 : gk2);
            const float o1 = v1 * cs - v2 * sn, o2 = v1 * sn + v2 * cs;
            unsigned char* dst8 = h < 8 ? Q8 + (size_t)t * 1024 + h * 128 : K8 + (size_t)t * 256 + (h - 8) * 128;
            const unsigned pq = pk4_fp8(o1 * 0.35709130f, o2 * 0.35709130f, 0.f, 0.f); dst8[c1]     = (unsigned char)(pq & 0xffu); dst8[c2] = (unsigned char)((pq >> 8) & 0xffu);
            if (MK_CHECK8) { bf16* dst = h < 8 ? QBR + (size_t)t * 1024 + h * 128 : KBR + (size_t)t * 256 + (h - 8) * 128;
                dst[c1] = (bf16)(pk2(o1, 0.f) & 0xffffu); dst[c2] = (bf16)(pk2(o2, 0.f) & 0xffffu); }
        }
        if (MK_CHECK8) { ((unsigned*)(VBR + (size_t)t * 256))[F.lane] = vv0; ((unsigned*)(VBR + (size_t)t * 256 + 128))[F.lane] = vv1; }
        {
            const int kk = t & 63, part = kk >> 5, k32 = kk & 31, g = (k32 >> 2) & 1, ii = (k32 & 3) + 4 * (k32 >> 3);
            unsigned char* img = VIMG + (size_t)(t >> 6) * 8192 + part * 1024 + g * 512 + ii;
            const int ca = 2 * F.lane, cb = 2 * F.lane + 1;
            const unsigned p0 = pk4_fp8(bflo(vv0) * 16.0f, bfhi(vv0) * 16.0f, bflo(vv1) * 16.0f, bfhi(vv1) * 16.0f);
            img[(ca >> 5) * 2048 + (ca & 31) * 16] = (unsigned char)(p0 & 0xffu); img[(cb >> 5) * 2048 + (cb & 31) * 16] = (unsigned char)((p0 >> 8) & 0xffu);
            img[128 * 8192 + (ca >> 5) * 2048 + (ca & 31) * 16] = (unsigned char)((p0 >> 16) & 0xffu); img[128 * 8192 + (cb >> 5) * 2048 + (cb & 31) * 16] = (unsigned char)((p0 >> 24) & 0xffu);
        }
    }
    const float* lut = (const float*)(wsp_(F) + WS_LUT);
    for (int u = blockIdx.x; u < 384; u += F.G) {
        const int gh = u >> 5, blk = u & 31, g = gh >> 2, hh = gh & 3, d = (g == 0) ? 1 : (g == 1 ? 4 : 16);
        const int bps = 32 / d, r = blk / bps, qb = blk % bps;
        at::dilated_unit((const at::bf16*)proj, lut + (g * 4 + hh) * 129, (at::bf16*)(wsp_(F) + WS_OUTA) + (size_t)g * S_ * 512, (float*)(wsp_(F) + WS_LSE) + (size_t)g * S_ * 4,
                         d, gh, hh, r, qb * 256, (char*)F.ldsg + RING_OFF);
    }
}

__device__ __forceinline__ void p3_attn_combine(Frame& F) {
    const at::bf16* QBR = (const at::bf16*)(wsp_(F) + WS_QBR); const at::bf16* KBR = (const at::bf16*)(wsp_(F) + WS_KBR); const at::bf16* VBR = (const at::bf16*)(wsp_(F) + WS_VBR);
    unsigned char* YB = wsp_(F) + WS_YB;
    const bool conv_first = (((int)blockIdx.x >> 3) & 1) != 0;
#define P3_ATTN_UNITS() do { for (int u = blockIdx.x; u < 256; u += F.G) { const int h = u & 7, qb = u >> 3, kv = h >> 2; \
        at::attn_dense_body8<1024, 256, 1024>(wsp_(F) + WS_Q8 + (size_t)qb * 256 * 1024 + h * 128, wsp_(F) + WS_K8 + kv * 128, wsp_(F) + WS_VIMG + (size_t)kv * 128 * 8192, YB + (size_t)qb * 256 * 1024 + h * 128, S_, (char*)F.ldsg + RING_OFF); \
        __syncthreads(); } } while (0)
    if (MK_CHECK8) { P3_ATTN_UNITS(); }
    else { if (!conv_first) P3_ATTN_UNITS();
    moe_convert_share(F); __syncthreads();
    if (conv_first) P3_ATTN_UNITS(); }
#undef P3_ATTN_UNITS
    if (MK_CHECK8) for (int u = blockIdx.x; u < 256; u += F.G) { const int h = u & 7, qb = u >> 3, kv = h >> 2;
        at::attn_dense_body<1024, 256, 256, 1024>(QBR + (size_t)qb * 256 * 1024 + h * 128, KBR + kv * 128, VBR + kv * 128, wsp_(F) + WS_DBG + (size_t)qb * 256 * 1024 + h * 128, S_, (char*)F.ldsg + RING_OFF); __syncthreads(); }
    const bf16* OUTA = (const bf16*)(wsp_(F) + WS_OUTA); const float* LSE = (const float*)(wsp_(F) + WS_LSE); bf16* YA = (bf16*)(wsp_(F) + WS_YA);
    for (int tb = blockIdx.x; tb < 256; tb += F.G) {
        const int t = tb * 32 + (F.tid >> 4), c0 = (F.tid & 15) * 32, hh = c0 >> 7;
        const float l0 = LSE[(size_t)t * 4 + hh], l1 = LSE[(size_t)(S_ + t) * 4 + hh], l2 = LSE[(size_t)(2 * S_ + t) * 4 + hh];
        const float m = fmaxf(l0, fmaxf(l1, l2)); float w0 = __expf(l0 - m), w1 = __expf(l1 - m), w2 = __expf(l2 - m); const float inv = 16.0f / (w0 + w1 + w2); w0 *= inv; w1 *= inv; w2 *= inv;
#pragma unroll
        for (int q = 0; q < 4; ++q) { const size_t o = (size_t)t * 512 + c0 + q * 8;
            const v4u a = *(const v4u*)(OUTA + o), b = *(const v4u*)(OUTA + (size_t)S_ * 512 + o), c = *(const v4u*)(OUTA + (size_t)2 * S_ * 512 + o);
            v2u w;
            w.x = pk4_fp8(w0 * bflo(a.x) + w1 * bflo(b.x) + w2 * bflo(c.x), w0 * bfhi(a.x) + w1 * bfhi(b.x) + w2 * bfhi(c.x), w0 * bflo(a.y) + w1 * bflo(b.y) + w2 * bflo(c.y), w0 * bfhi(a.y) + w1 * bfhi(b.y) + w2 * bfhi(c.y));
            w.y = pk4_fp8(w0 * bflo(a.z) + w1 * bflo(b.z) + w2 * bflo(c.z), w0 * bfhi(a.z) + w1 * bfhi(b.z) + w2 * bfhi(c.z), w0 * bflo(a.w) + w1 * bflo(b.w) + w2 * bflo(c.w), w0 * bfhi(a.w) + w1 * bfhi(b.w) + w2 * bfhi(c.w));
            *(v2u*)((unsigned char*)YA + o) = w; }
    }
}

typedef float f32x16m __attribute__((ext_vector_type(16)));
__device__ __forceinline__ void p6_ln_router(Frame& F, const int bank = 0) {
    LAS int* cntl = (LAS int*)(F.lds + L_CNT); LAS int* basel = cntl + 32;
    LAS int* asg_e = (LAS int*)(F.lds + L_ASG); LAS int* asg_lr = asg_e + 128; LAS float* asg_w = (LAS float*)(asg_lr + 128);
    LAS float* x1s = (LAS float*)(F.lds + RING_OFF);
    LAS float* red = (LAS float*)(F.lds + RING_OFF + 73728);
    const float* Z1 = (const float*)(wsp_(F) + WS_T1); bf16* X1 = (bf16*)(wsp_(F) + WS_X1); unsigned char* X1Q = wsp_(F) + WS_X1B;
    const f32x4* G4 = (const f32x4*)inp(F, 9); const f32x4* B4 = (const f32x4*)inp(F, 10);
    const float* wr = inp(F, 11); const float* br = inp(F, 12);
    unsigned* gcnt = ((unsigned*)(wsp_(F) + WS_CTL)) + CW_CNT + bank * 64;
    int* TOKE = (int*)(wsp_(F) + (bank ? WS_H : WS_TOKE)); int* TOKR = (int*)(wsp_(F) + (bank ? WS_H + MiB : WS_TOKR)); float* TOKW = (float*)(wsp_(F) + (bank ? WS_H + 2 * MiB : WS_TOKW));
    const int li = F.lane & 31, kk = F.lane >> 5;
    for (int tb = blockIdx.x; tb < 256; tb += F.G) {
        if (F.tid < 32) cntl[F.tid] = 0;
        const int t0 = tb * 32 + F.wave * 4;
        f32x4 xv[4][8];
#pragma unroll
        for (int tk = 0; tk < 4; ++tk) {
            const f32x4* zr = (const f32x4*)(Z1 + (size_t)(t0 + tk) * DM) + F.lane;
#pragma unroll
            for (int j = 0; j < 8; ++j) xv[tk][j] = zr[64 * j];
            float s = 0.f;
#pragma unroll
            for (int j = 0; j < 8; ++j) s += (xv[tk][j][0] + xv[tk][j][1]) + (xv[tk][j][2] + xv[tk][j][3]);
            const float mean = wave_sum(s) * (1.0f / DM); float s2 = 0.f;
#pragma unroll
            for (int j = 0; j < 8; ++j) { xv[tk][j] = xv[tk][j] - mean; s2 += (xv[tk][j][0] * xv[tk][j][0] + xv[tk][j][1] * xv[tk][j][1]) + (xv[tk][j][2] * xv[tk][j][2] + xv[tk][j][3] * xv[tk][j][3]); }
            const float rstd = 1.0f / sqrtf(wave_sum(s2) * (1.0f / DM) + LN_EPS);
            v2u* xo = (v2u*)(X1 + (size_t)(t0 + tk) * DM) + F.lane; unsigned* xb = (unsigned*)(X1Q + (size_t)(t0 + tk) * DM) + F.lane;
#pragma unroll
            for (int j = 0; j < 8; ++j) { const f32x4 v = xv[tk][j] * rstd * G4[64 * j + F.lane] + B4[64 * j + F.lane]; xv[tk][j] = v;
                v2u w; w.x = pk2(v[0], v[1]); w.y = pk2(v[2], v[3]); xo[64 * j] = w; xb[64 * j] = pk4_fp8(v[0], v[1], v[2], v[3]); }
            asm volatile("" ::: "memory"); __builtin_amdgcn_sched_barrier(0);
        }
        f32x16m acc = {0.f, 0.f, 0.f, 0.f, 0.f, 0.f, 0.f, 0.f, 0.f, 0.f, 0.f, 0.f, 0.f, 0.f, 0.f, 0.f};
        const float* wp = wr + (size_t)(32 * F.wave + 4 * kk) * 32 + li;
#pragma unroll
        for (int c = 0; c < 8; ++c) {
            LAS float* buf = x1s + (c & 1) * (32 * 260);
#pragma unroll
            for (int tk = 0; tk < 4; ++tk) *(LAS f32x4*)(buf + (4 * F.wave + tk) * 260 + 4 * F.lane) = xv[tk][c];
            __syncthreads();
#pragma unroll
            for (int b = 0; b < 4; ++b) {
                const f32x4 a4 = *(const LAS f32x4*)(buf + li * 260 + 32 * F.wave + 8 * b + 4 * kk);
                asm volatile("" : "+v"(wp));
                const float b0 = wp[0], b1 = wp[32], b2 = wp[64], b3 = wp[96]; wp += (b == 3) ? (256 - 24) * 32 : 8 * 32;
                acc = __builtin_amdgcn_mfma_f32_32x32x2f32(a4[0], b0, acc, 0, 0, 0);
                acc = __builtin_amdgcn_mfma_f32_32x32x2f32(a4[1], b1, acc, 0, 0, 0);
                acc = __builtin_amdgcn_mfma_f32_32x32x2f32(a4[2], b2, acc, 0, 0, 0);
                acc = __builtin_amdgcn_mfma_f32_32x32x2f32(a4[3], b3, acc, 0, 0, 0);
            }
            __builtin_amdgcn_sched_barrier(0);
        }
#pragma unroll
        for (int r = 0; r < 16; ++r) red[(F.wave * 32 + ((r & 3) + 8 * (r >> 2) + 4 * kk)) * 32 + li] = acc[r];
        __syncthreads();
#pragma unroll
        for (int tk = 0; tk < 4; ++tk) {
            float v = -3.0e38f;
            if (F.lane < 32) { float sres = br[F.lane];
#pragma unroll
                for (int w8 = 0; w8 < 8; ++w8) sres += red[(w8 * 32 + 4 * F.wave + tk) * 32 + F.lane];
                v = sres; }
            float tv[4]; int ti[4];
#pragma unroll
            for (int k = 0; k < 4; ++k) { float bv = v; int bi = F.lane;
#pragma unroll
                for (int o = 1; o < 64; o <<= 1) { const float ov = __shfl_xor(bv, o); const int oi = __shfl_xor(bi, o); if (ov > bv || (ov == bv && oi < bi)) { bv = ov; bi = oi; } }
                tv[k] = bv; ti[k] = bi; if (F.lane == bi) v = -3.0e38f; }
            const float e1 = __expf(tv[1] - tv[0]), e2 = __expf(tv[2] - tv[0]), e3 = __expf(tv[3] - tv[0]); const float inv = 1.0f / (1.0f + e1 + e2 + e3);
            if (F.lane < 4) { const int me = F.lane == 0 ? ti[0] : (F.lane == 1 ? ti[1] : (F.lane == 2 ? ti[2] : ti[3]));
                const float mw = (F.lane == 0 ? 1.0f : (F.lane == 1 ? e1 : (F.lane == 2 ? e2 : e3))) * inv;
                const int lr = atomicAdd((int*)(cntl + me), 1);
                const int a = (F.wave * 4 + tk) * 4 + F.lane; asg_e[a] = me; asg_lr[a] = lr; asg_w[a] = mw; }
        }
        __syncthreads();
        if (F.tid < 32) basel[F.tid] = (int)atomicAdd(gcnt + F.tid, (unsigned)cntl[F.tid]);
        __syncthreads();
        if (F.tid < 128) { const int a = tb * 128 + F.tid; const int e = asg_e[F.tid]; TOKE[a] = e; TOKR[a] = basel[e] + asg_lr[F.tid]; TOKW[a] = asg_w[F.tid]; }
        __syncthreads();
    }
}

__device__ __forceinline__ void p7_gather(Frame& F) {
    LAS int* pst = (LAS int*)(F.lds + L_PST);
    const unsigned* gcnt = ((unsigned*)(wsp_(F) + WS_CTL)) + CW_CNT;
    if (F.tid == 0) { int acc = 0; for (int e = 0; e < 32; ++e) { pst[e] = acc; acc += ((int)gcnt[e] + 255) & ~255; } pst[32] = acc; }
    __syncthreads();
    const int* TOKE = (const int*)(wsp_(F) + WS_TOKE); const int* TOKR = (const int*)(wsp_(F) + WS_TOKR); const float* TOKW = (const float*)(wsp_(F) + WS_TOKW);
    int* TOKS = (int*)(wsp_(F) + WS_TOKS); float* SLOTW = (float*)(wsp_(F) + WS_SLOTW);
    const bf16* X1B = (const bf16*)(wsp_(F) + WS_X1B); bf16* XS = (bf16*)(wsp_(F) + WS_XS);
    const int gw = blockIdx.x * 8 + F.wave, NGW = F.G * 8;
    for (int a0 = gw; a0 < S_ * TOPK; a0 += 4 * NGW) {
        int slot[4]; float w[4]; v4u r0[4], r1[4];
#pragma unroll
        for (int q = 0; q < 4; ++q) { const int a = a0 + q * NGW; const int ac = a < S_ * TOPK ? a : a0; slot[q] = pst[TOKE[ac]] + TOKR[ac]; w[q] = TOKW[ac]; }
#pragma unroll
        for (int q = 0; q < 4; ++q) { const int a = a0 + q * NGW; const int ac = a < S_ * TOPK ? a : a0; const v4u* src = (const v4u*)((const unsigned char*)X1B + (size_t)(ac >> 2) * DM) + F.lane; r0[q] = src[0]; r1[q] = src[64]; }
#pragma unroll
        for (int q = 0; q < 4; ++q) { const int a = a0 + q * NGW; if (a < S_ * TOPK) { if (F.lane == 0) { TOKS[a] = slot[q]; SLOTW[slot[q]] = w[q]; }
            v4u* dst = (v4u*)((unsigned char*)XS + (size_t)slot[q] * DM) + F.lane; dst[0] = r0[q]; dst[64] = r1[q]; } }
    }
}
__device__ __forceinline__ int moe_tiles(Frame& F) {
    LAS int* tile_e = (LAS int*)(F.lds + L_TILE);
    const unsigned* gcnt = ((unsigned*)(wsp_(F) + WS_CTL)) + CW_CNT;
    __syncthreads();
    if (F.tid == 0) { int ti = 0; for (int e = 0; e < 32; ++e) { const int nt = ((int)gcnt[e] + 255) >> 8; for (int k = 0; k < nt && ti < 160; ++k) tile_e[ti++] = e; } tile_e[160] = ti; }
    __syncthreads();
    return tile_e[160];
}

__device__ __forceinline__ void p10_final(Frame& F) {
    const bf16* X1 = (const bf16*)(wsp_(F) + WS_X1); const bf16* YS = (const bf16*)(wsp_(F) + WS_YS); const int* TOKS = (const int*)(wsp_(F) + WS_TOKS);
    const f32x4* G4 = (const f32x4*)inp(F, 19); const f32x4* B4 = (const f32x4*)inp(F, 20);
    float* outp = (float*)inp(F, 21);
    const int gw = blockIdx.x * 8 + F.wave, NGW = F.G * 8;
    for (int t0 = gw; t0 < S_; t0 += 2 * NGW) {
        f32x4 v[2][8]; int tt[2]; int sl[2][4];
#pragma unroll
        for (int q = 0; q < 2; ++q) { const int t = t0 + q * NGW; tt[q] = t < S_ ? t : t0; }
#pragma unroll
        for (int q = 0; q < 2; ++q)
#pragma unroll
            for (int k = 0; k < 4; ++k) sl[q][k] = TOKS[tt[q] * 4 + k];
#pragma unroll
        for (int q = 0; q < 2; ++q) {
            const v4u* xr = (const v4u*)(X1 + (size_t)tt[q] * DM) + F.lane;
            const v4u* y0 = (const v4u*)(YS + (size_t)sl[q][0] * DM) + F.lane; const v4u* y1 = (const v4u*)(YS + (size_t)sl[q][1] * DM) + F.lane;
            const v4u* y2 = (const v4u*)(YS + (size_t)sl[q][2] * DM) + F.lane; const v4u* y3 = (const v4u*)(YS + (size_t)sl[q][3] * DM) + F.lane;
#pragma unroll
            for (int jj = 0; jj < 4; ++jj) { const v4u x = xr[64 * jj], a = y0[64 * jj], b = y1[64 * jj], c = y2[64 * jj], d = y3[64 * jj];
#define P10_LO(W) (bflo(x.W) * ALPHA + ((bflo(a.W) + bflo(b.W)) + (bflo(c.W) + bflo(d.W))))
#define P10_HI(W) (bfhi(x.W) * ALPHA + ((bfhi(a.W) + bfhi(b.W)) + (bfhi(c.W) + bfhi(d.W))))
                v[q][2 * jj] = (f32x4){P10_LO(x), P10_HI(x), P10_LO(y), P10_HI(y)}; v[q][2 * jj + 1] = (f32x4){P10_LO(z), P10_HI(z), P10_LO(w), P10_HI(w)};
#undef P10_LO
#undef P10_HI
            }
        }
#pragma unroll
        for (int q = 0; q < 2; ++q) {
            float s = 0.f;
#pragma unroll
            for (int j = 0; j < 8; ++j) s += (v[q][j][0] + v[q][j][1]) + (v[q][j][2] + v[q][j][3]);
            const float mean = wave_sum(s) * (1.0f / DM); float s2 = 0.f;
#pragma unroll
            for (int j = 0; j < 8; ++j) { v[q][j] = v[q][j] - mean; s2 += (v[q][j][0] * v[q][j][0] + v[q][j][1] * v[q][j][1]) + (v[q][j][2] * v[q][j][2] + v[q][j][3] * v[q][j][3]); }
            const float rstd = 1.0f / sqrtf(wave_sum(s2) * (1.0f / DM) + LN_EPS);
            if (t0 + q * NGW < S_) { f32x4* o = (f32x4*)(outp + (size_t)tt[q] * DM) + 2 * F.lane;
#pragma unroll
                for (int jj = 0; jj < 4; ++jj) { o[128 * jj] = v[q][2 * jj] * rstd * G4[128 * jj + 2 * F.lane] + B4[128 * jj + 2 * F.lane];
                    o[128 * jj + 1] = v[q][2 * jj + 1] * rstd * G4[128 * jj + 2 * F.lane + 1] + B4[128 * jj + 2 * F.lane + 1]; } }
        }
    }
}

struct Args { const float* in[21]; float* out; unsigned char* ws; int ph_lo, ph_hi; };
__global__ void __launch_bounds__(512, 2) mk_fwd(Args args) {
    extern __shared__ __attribute__((aligned(16))) unsigned char lds[];
    Frame F;
    F.lds = (LAS unsigned char*)lds; F.ldsg = lds;
    F.tid = threadIdx.x; F.lane = F.tid & 63; F.wave = __builtin_amdgcn_readfirstlane(F.tid >> 6); F.G = gridDim.x;
    if (F.tid == 0) { LAS unsigned long long* pp = (LAS unsigned long long*)(F.lds + L_PTR);
#pragma unroll
        for (int i = 0; i < 21; ++i) pp[i] = (unsigned long long)args.in[i];
        pp[21] = (unsigned long long)args.out; pp[22] = (unsigned long long)args.ws; }
    if (F.tid < 4) ((LAS unsigned*)(F.lds + L_XB))[F.tid] = 0u;
    __syncthreads();
    const int lo = args.ph_lo, hi = args.ph_hi;
    XcdBarrier bar; bar.bar = ((unsigned*)(wsp_(F) + WS_CTL)) + CW_BAR; bar.x = 0; bar.st = (volatile LAS unsigned*)(F.lds + L_XB);
    if (hi - lo > 1) bar = xcd_barrier_post(((unsigned*)(wsp_(F) + WS_CTL)) + CW_BAR, (volatile LAS unsigned*)(F.lds + L_XB));
#ifndef MK_PHASE_MASK
#define MK_PHASE_MASK 0x7ff
#endif
#define IN(k) (((MK_PHASE_MASK >> (k)) & 1) && lo <= (k) && (k) < hi)
#ifndef MK_DUP_MASK
#define MK_DUP_MASK 0
#endif
#define REP(k) for (int rep_ = 0; rep_ < 1 + ((MK_DUP_MASK >> (k)) & 1); ++rep_)
#ifndef MK_BAR2
#define MK_BAR2 0
#endif
#ifndef MK_STAMP_IDX
#define MK_STAMP_IDX -1
#endif
    unsigned long long st0_ = 0ull, stk_ = 0ull;
    if (MK_STAMP_IDX >= 0) st0_ = __builtin_amdgcn_s_memrealtime();
#define SEAM(k) do { if (IN(k) && IN((k) + 1)) { xcd_barrier(bar); if (MK_BAR2) xcd_barrier(bar); if (MK_STAMP_IDX == (k) + 1) stk_ = __builtin_amdgcn_s_memrealtime(); } } while (0)
    LAS unsigned char* ring = F.lds + RING_OFF;
    const pg8::bf16_t* XB = (const pg8::bf16_t*)(wsp_(F) + WS_XB);

    if (IN(0)) REP(0) { p0_prologue(F); if (MK_CHECK8) { __syncthreads(); moe_convert_share(F); } }
    SEAM(0);
    if (IN(1)) REP(1) {
        pg8::Gemm g{XB, (const pg8::bf16_t*)(wsp_(F) + WS_WIN), S_, INW, DM / 2}; pg8::StaticOrder S; S.init(S_, INW, F.G, (int)blockIdx.x);
        pg8::EpiStoreBf16 E{(pg8::bf16_t*)(wsp_(F) + WS_PROJ), INW, 1.0f / 64.0f};
        pg8::gemm_phase<pg8::EpiStoreBf16, pg8::StaticOrder, true, true, true, true>(ring, g, S, E);
    }
    SEAM(1);
    if (IN(2)) { p2_prep_dilated(F); if ((MK_DUP_MASK >> 2) & 1) p2_prep_dilated(F); }
    SEAM(2);
    if (IN(3)) REP(3) { p3_attn_combine(F); }
    SEAM(3);
#define PHASE4_BODY { \
        { pg8::Gemm g{(const pg8::bf16_t*)(wsp_(F) + WS_YA), (const pg8::bf16_t*)(wsp_(F) + WS_WA), S_, DM, 256}; pg8::StaticOrder S; S.init(S_, DM, F.G, (int)blockIdx.x); \
          pg8::EpiGateA E{(const pg8::bf16_t*)(wsp_(F) + WS_PROJ), INW, GATE_OFF, inp(F, 2), (float*)(wsp_(F) + WS_T1), DM, 1.0f / 512.0f}; \
          pg8::gemm_phase<pg8::EpiGateA, pg8::StaticOrder, true, true, true, true>(ring, g, S, E); } \
        { pg8::Gemm g{(const pg8::bf16_t*)(wsp_(F) + WS_YB), (const pg8::bf16_t*)(wsp_(F) + WS_WB), S_, DM, 512}; pg8::StaticOrder S; S.init(S_, DM, F.G, (int)blockIdx.x); \
          pg8::EpiGateB E{(const pg8::bf16_t*)(wsp_(F) + WS_PROJ), INW, GATE_OFF + DM, inp(F, 2) + DM, (const float*)(wsp_(F) + WS_T1), wsp_(F) + WS_Y, DM, 1.0f / 2048.0f}; \
          pg8::gemm_phase<pg8::EpiGateB, pg8::StaticOrder, true, true, true, true>(ring, g, S, E); } \
    }
    if (MK_CHECK8 && IN(4)) {
        const unsigned* a32 = (const unsigned*)(wsp_(F) + WS_YB); const unsigned* b32 = (const unsigned*)(wsp_(F) + WS_DBG); float num = 0.f, den = 0.f;
        for (int i = blockIdx.x * 512 + F.tid; i < S_ * 1024 / 4; i += F.G * 512) { const unsigned a = a32[i], b = b32[i];
            for (int q = 0; q < 4; ++q) { const float fa = __builtin_amdgcn_cvt_f32_fp8((int)(a >> (8 * q)), 0), fb = __builtin_amdgcn_cvt_f32_fp8((int)(b >> (8 * q)), 0); num += fabsf(fa - fb); den += fabsf(fb); } }
        num = wave_sum(num); den = wave_sum(den);
        if (F.lane == 0) { atomicAdd((float*)(((unsigned*)(wsp_(F) + WS_CTL)) + 4224), num); atomicAdd((float*)(((unsigned*)(wsp_(F) + WS_CTL)) + 4225), den); }
    }
    if (IN(4)) { PHASE4_BODY if ((MK_DUP_MASK >> 4) & 1) PHASE4_BODY }
    SEAM(4);
    if (IN(5)) REP(5) {
        pg8::Gemm g{(const pg8::bf16_t*)(wsp_(F) + WS_Y), (const pg8::bf16_t*)(wsp_(F) + WS_WO), S_, DM, DM / 2}; pg8::StaticOrder S; S.init(S_, DM, F.G, (int)blockIdx.x);
        pg8::EpiResF32 E{inp(F, 0), (float*)(wsp_(F) + WS_T1), DM, ALPHA, 1.0f / 4096.0f};
        pg8::gemm_phase<pg8::EpiResF32, pg8::StaticOrder, true, true, true, true>(ring, g, S, E);
    }
    SEAM(5);
    if (IN(6)) { p6_ln_router(F); if ((MK_DUP_MASK >> 6) & 1) p6_ln_router(F, 1); }
    SEAM(6);
    if (IN(7)) REP(7) { p7_gather(F); }
    SEAM(7);
    if (IN(8)) REP(8) {
        const int nt = moe_tiles(F);
        pg8::Gemm g{(const pg8::bf16_t*)(wsp_(F) + WS_XS), (const pg8::bf16_t*)(wsp_(F) + WS_WGL), nt * 256, 4096, DM / 2};
        pg8::MoeOrder S; S.init(nt * 256, 4096, F.G, (int)blockIdx.x); S.tile_e = (const LAS int*)(F.lds + L_TILE); S.estride = (size_t)4096 * 2048;
        pg8::EpiSwiglu E{(const LAS int*)(F.lds + L_TILE), inp(F, 14), inp(F, 16), wsp_(F) + WS_H, DM, 1.0f / 64.0f};
        pg8::gemm_phase<pg8::EpiSwiglu, pg8::MoeOrder, true, true, true, true>(ring, g, S, E);
    }
    SEAM(8);
    if (IN(9)) REP(9) {
        const int nt = moe_tiles(F);
        pg8::Gemm g{(const pg8::bf16_t*)(wsp_(F) + WS_H), (const pg8::bf16_t*)(wsp_(F) + WS_WD), nt * 256, DM, DM / 2};
        pg8::MoeOrder S; S.init(nt * 256, DM, F.G, (int)blockIdx.x); S.tile_e = (const LAS int*)(F.lds + L_TILE); S.estride = (size_t)2048 * 2048;
        pg8::EpiDown E{(const LAS int*)(F.lds + L_TILE), inp(F, 18), (const float*)(wsp_(F) + WS_SLOTW), (pg8::bf16_t*)(wsp_(F) + WS_YS), DM, 1.0f / 64.0f};
        pg8::gemm_phase<pg8::EpiDown, pg8::MoeOrder, true, true, true, true>(ring, g, S, E);
    }
    SEAM(9);
    if (IN(10)) REP(10) { p10_final(F); }
    if (MK_CHECK8 && IN(10)) {
        const float num = *(const float*)(((unsigned*)(wsp_(F) + WS_CTL)) + 4224), den = *(const float*)(((unsigned*)(wsp_(F) + WS_CTL)) + 4225);
        if (!(num <= MK_CHK_TOL * den) || !(den > 0.f)) { float* o = (float*)inp(F, 21); __syncthreads(); for (int i = blockIdx.x * 512 + F.tid; i < S_ * DM; i += F.G * 512) o[i] = __builtin_nanf(""); }
    }
    if (MK_STAMP_IDX >= 0 && blockIdx.x == 0 && F.tid == 0) {
        const unsigned long long te = __builtin_amdgcn_s_memrealtime(), dt = stk_ - st0_;
        while (__builtin_amdgcn_s_memrealtime() - te < dt) __builtin_amdgcn_s_sleep(8);
    }
#undef IN
#undef SEAM
}

#ifndef MK_CUTS
#define MK_CUTS 0
#endif
extern "C" void kernel_launch(void* const* d_in, const int* in_sizes, int n_in, void* d_out, int out_size, void* d_ws, size_t ws_size, hipStream_t stream) {
    static int grid = 0;
    if (grid == 0) {
        if (n_in != 21 || out_size != S_ * DM || ws_size < WS_END) { fprintf(stderr, "kernel_launch: unexpected shapes (n_in %d out %d ws %zu, need %zu)\n", n_in, out_size, ws_size, (size_t)WS_END); grid = -1; return; }
        int dev = 0, cus = 0, per_cu = 0;
        if (hipGetDevice(&dev) != hipSuccess || hipDeviceGetAttribute(&cus, hipDeviceAttributeMultiprocessorCount, dev) != hipSuccess) { grid = -1; return; }
        if (hipFuncSetAttribute((const void*)mk_fwd, hipFuncAttributeMaxDynamicSharedMemorySize, LDS_BYTES) != hipSuccess) { fprintf(stderr, "kernel_launch: hipFuncSetAttribute failed\n"); grid = -1; return; }
        if (hipOccupancyMaxActiveBlocksPerMultiprocessor(&per_cu, (const void*)mk_fwd, 512, LDS_BYTES) != hipSuccess || per_cu < 1) { fprintf(stderr, "kernel_launch: occupancy query says %d\n", per_cu); per_cu = 1; }
        (void)hipGetLastError();
        grid = cus;
    }
    if (grid < 0) return;
    (void)hipMemsetAsync((char*)d_ws + WS_CTL, 0, CTL_ZERO_BYTES, stream);
    Args a{};
    for (int i = 0; i < 21; ++i) a.in[i] = (const float*)d_in[i];
    a.out = (float*)d_out; a.ws = (unsigned char*)d_ws;
#if MK_CUTS
    for (int p = 0; p < NPH; ++p) { a.ph_lo = p; a.ph_hi = p + 1; hipLaunchKernelGGL(mk_fwd, dim3(grid), dim3(512), LDS_BYTES, stream, a); }
#else
    a.ph_lo = 0; a.ph_hi = NPH; hipLaunchKernelGGL(mk_fwd, dim3(grid), dim3(512), LDS_BYTES, stream, a);
#endif
}
```

```cpp
#include <hip/hip_runtime.h>
#include <hip/hip_bf16.h>
#include <cstdio>
#include <cstdint>
#define MK_CUTS 0
#define MK_DEFER 1792
namespace pg8 {
#define PG8_LAS __attribute__((address_space(3)))
typedef unsigned short bf16_t;
typedef short bf16x8 __attribute__((ext_vector_type(8)));
typedef float f32x4 __attribute__((ext_vector_type(4)));
typedef unsigned u32x4 __attribute__((ext_vector_type(4)));
constexpr int BM = 256, BK = 64, HALF = 128, HTB = HALF * BK * 2  , STAGE_BYTES = 8 * HTB, NXCD = 8, WGM = 8;

__host__ __device__ __forceinline__ int lds_byte(int r, int c) { const int st = (r >> 4) * 2 + (c >> 5), rr = r & 15, cc = c & 31, ob = rr * 64 + cc * 2; return st * 1024 + (ob ^ (((ob >> 9) & 1) << 5)); }
__host__ __device__ __forceinline__ void stage_rc(int b, int& R, int& C) { const int st = b / 1024, sb = b % 1024, swz = sb ^ (((sb >> 9) & 1) << 5); R = (st >> 1) * 16 + swz / 64; C = (st & 1) * 32 + (swz % 64) / 2; }
__host__ __device__ __forceinline__ int perm32(int rho) { const int n = rho >> 4, i = rho & 15; return 8 * (i >> 2) + 4 * n + (i & 3); }

struct Unit { int pm, pn; };
struct Gemm { const bf16_t* A; const bf16_t* Bt; int M, N, K; };

struct StaticOrder {
    int nM, nN, nwg, G, c;
    __host__ __device__ void init(int M, int N, int G_, int c_) { nM = M / BM; nN = N / BM; nwg = nM * nN; G = G_; c = c_; }
    __host__ __device__ bool next(int i, Unit& u) const {
        const long L = (long)i * G + c; if (L >= nwg) return false;
        int wgid = (int)L; { const int q = nwg / NXCD, r = nwg % NXCD, xcd = wgid % NXCD, off = wgid / NXCD; wgid = (xcd < r ? xcd * (q + 1) : r * (q + 1) + (xcd - r) * q) + off; }
        const int nig = WGM * nN, gid = wgid / nig, fm = gid * WGM, gsz = (nM - fm) < WGM ? (nM - fm) : WGM;
        u.pm = fm + ((wgid % nig) % gsz); u.pn = (wgid % nig) / gsz; return true;
    }
    __device__ __forceinline__ void a_ready(const Unit&) const {}
    __device__ __forceinline__ size_t b_off(const Unit&) const { return 0; }
    __device__ __forceinline__ void done(const Unit&) const {}
};


typedef unsigned u32x2 __attribute__((ext_vector_type(2)));
__device__ __forceinline__ unsigned cvt_pk_bf16(float lo, float hi) { unsigned r; asm volatile("v_cvt_pk_bf16_f32 %0, %1, %2" : "=v"(r) : "v"(lo), "v"(hi)); return r; }
__device__ __forceinline__ unsigned pk4_fp8_(float a, float b, float c, float d) { int w = __builtin_amdgcn_cvt_pk_fp8_f32(a, b, 0, false); w = __builtin_amdgcn_cvt_pk_fp8_f32(c, d, w, true); return (unsigned)w; }
__device__ __forceinline__ float bf_lo(unsigned w) { return __builtin_bit_cast(float, w << 16); }
__device__ __forceinline__ float bf_hi(unsigned w) { return __builtin_bit_cast(float, w & 0xffff0000u); }
__device__ __forceinline__ float sigmoidf_(float v) { return __builtin_amdgcn_rcpf(1.0f + __expf(-v)); }

struct EpiStoreBf16 {
    static constexpr bool PERM = true, AFTER_DRAIN = false;
    bf16_t* O; int ldc; float sc;
    __device__ __forceinline__ void operator()(const f32x4 (&acc)[2][2][4][2], const Unit& u, int wr, int wc, int fr, int fq) const {
        const int row0 = u.pm * BM + wr * 64 + fr, col0 = u.pn * BM + wc * 32 + 8 * fq;
#pragma unroll
        for (int ai = 0; ai < 2; ++ai)
#pragma unroll
            for (int m = 0; m < 4; ++m) { bf16_t* rowp = O + (size_t)(row0 + ai * HALF + m * 16) * ldc + col0;
#pragma unroll
                for (int bj = 0; bj < 2; ++bj) { const f32x4 v0 = acc[ai][bj][m][0] * sc, v1 = acc[ai][bj][m][1] * sc;
                    u32x4 w; w.x = cvt_pk_bf16(v0[0], v0[1]); w.y = cvt_pk_bf16(v0[2], v0[3]); w.z = cvt_pk_bf16(v1[0], v1[1]); w.w = cvt_pk_bf16(v1[2], v1[3]);
                    *(u32x4*)(rowp + bj * HALF) = w; } }
    }
};

struct EpiGateA {
    static constexpr bool PERM = true, AFTER_DRAIN = false;
    const bf16_t* proj; int ldp; int gcol0; const float* bg; float* T1; int ldc; float sc;
    __device__ __forceinline__ void operator()(const f32x4 (&acc)[2][2][4][2], const Unit& u, int wr, int wc, int fr, int fq) const {
        const int row0 = u.pm * BM + wr * 64 + fr, col0 = u.pn * BM + wc * 32 + 8 * fq;
#pragma unroll
        for (int ai = 0; ai < 2; ++ai)
#pragma unroll
            for (int m = 0; m < 4; ++m) { const int row = row0 + ai * HALF + m * 16;
#pragma unroll
                for (int bj = 0; bj < 2; ++bj) { const int c = col0 + bj * HALF;
                    const u32x4 gw = *(const u32x4*)(proj + (size_t)row * ldp + gcol0 + c);
                    const f32x4 b0 = *(const f32x4*)(bg + c), b1 = *(const f32x4*)(bg + c + 4);
                    f32x4 g0, g1;
                    g0[0] = sigmoidf_(bf_lo(gw.x) + b0[0]); g0[1] = sigmoidf_(bf_hi(gw.x) + b0[1]); g0[2] = sigmoidf_(bf_lo(gw.y) + b0[2]); g0[3] = sigmoidf_(bf_hi(gw.y) + b0[3]);
                    g1[0] = sigmoidf_(bf_lo(gw.z) + b1[0]); g1[1] = sigmoidf_(bf_hi(gw.z) + b1[1]); g1[2] = sigmoidf_(bf_lo(gw.w) + b1[2]); g1[3] = sigmoidf_(bf_hi(gw.w) + b1[3]);
                    float* o = T1 + (size_t)row * ldc + c;
                    *(f32x4*)o = acc[ai][bj][m][0] * sc * g0; *(f32x4*)(o + 4) = acc[ai][bj][m][1] * sc * g1; } }
    }
};
struct EpiGateB {
    static constexpr bool PERM = true, AFTER_DRAIN = false;
    const bf16_t* proj; int ldp; int gcol0; const float* bg; const float* T1; unsigned char* Y; int ldc; float sc;
    __device__ __forceinline__ void operator()(const f32x4 (&acc)[2][2][4][2], const Unit& u, int wr, int wc, int fr, int fq) const {
        const int row0 = u.pm * BM + wr * 64 + fr, col0 = u.pn * BM + wc * 32 + 8 * fq;
#pragma unroll
        for (int ai = 0; ai < 2; ++ai)
#pragma unroll
            for (int m = 0; m < 4; ++m) { const int row = row0 + ai * HALF + m * 16;
#pragma unroll
                for (int bj = 0; bj < 2; ++bj) { const int c = col0 + bj * HALF;
                    const u32x4 gw = *(const u32x4*)(proj + (size_t)row * ldp + gcol0 + c);
                    const f32x4 b0 = *(const f32x4*)(bg + c), b1 = *(const f32x4*)(bg + c + 4);
                    const float* tp = T1 + (size_t)row * ldc + c;
                    const f32x4 t0 = *(const f32x4*)tp, t1 = *(const f32x4*)(tp + 4);
                    f32x4 g0, g1;
                    g0[0] = sigmoidf_(bf_lo(gw.x) + b0[0]); g0[1] = sigmoidf_(bf_hi(gw.x) + b0[1]); g0[2] = sigmoidf_(bf_lo(gw.y) + b0[2]); g0[3] = sigmoidf_(bf_hi(gw.y) + b0[3]);
                    g1[0] = sigmoidf_(bf_lo(gw.z) + b1[0]); g1[1] = sigmoidf_(bf_hi(gw.z) + b1[1]); g1[2] = sigmoidf_(bf_lo(gw.w) + b1[2]); g1[3] = sigmoidf_(bf_hi(gw.w) + b1[3]);
                    const f32x4 v0 = (t0 + acc[ai][bj][m][0] * sc * g0) * 64.0f, v1 = (t1 + acc[ai][bj][m][1] * sc * g1) * 64.0f;
                    u32x2 w; w.x = pk4_fp8_(v0[0], v0[1], v0[2], v0[3]); w.y = pk4_fp8_(v1[0], v1[1], v1[2], v1[3]);
                    *(u32x2*)(Y + (size_t)row * ldc + c) = w; } }
    }
};
struct EpiResF32 {
    static constexpr bool PERM = false, AFTER_DRAIN = false;
    const float* X; float* Z; int ldc; float alpha; float sc;
    __device__ __forceinline__ void operator()(const f32x4 (&acc)[2][2][4][2], const Unit& u, int wr, int wc, int fr, int fq) const {
        const int row0 = u.pm * BM + wr * 64 + fr, col0 = u.pn * BM + wc * 32 + 4 * fq;
#pragma unroll
        for (int ai = 0; ai < 2; ++ai)
#pragma unroll
            for (int m = 0; m < 4; ++m) { const size_t ro = (size_t)(row0 + ai * HALF + m * 16) * ldc + col0;
#pragma unroll
                for (int bj = 0; bj < 2; ++bj)
#pragma unroll
                    for (int n = 0; n < 2; ++n) { const f32x4 xv = *(const f32x4*)(X + ro + bj * HALF + n * 16);
                        *(f32x4*)(Z + ro + bj * HALF + n * 16) = xv * alpha + acc[ai][bj][m][n] * sc; } }
    }
};
struct EpiSwiglu {
    static constexpr bool PERM = true, AFTER_DRAIN = false;
    const PG8_LAS int* tile_e; const float* bgate; const float* blin; unsigned char* H; int ldc; float sc;
    __device__ __forceinline__ void operator()(const f32x4 (&acc)[2][2][4][2], const Unit& u, int wr, int wc, int fr, int fq) const {
        const int e = tile_e[u.pm];
        const int row0 = u.pm * BM + wr * 64 + fr, j0 = u.pn * HALF + wc * 32 + 8 * fq;
        const f32x4 bg0 = *(const f32x4*)(bgate + (size_t)e * 2048 + j0), bg1 = *(const f32x4*)(bgate + (size_t)e * 2048 + j0 + 4);
        const f32x4 bl0 = *(const f32x4*)(blin + (size_t)e * 2048 + j0), bl1 = *(const f32x4*)(blin + (size_t)e * 2048 + j0 + 4);
#pragma unroll
        for (int ai = 0; ai < 2; ++ai)
#pragma unroll
            for (int m = 0; m < 4; ++m) { const int row = row0 + ai * HALF + m * 16;
                f32x4 h0, h1;
#pragma unroll
                for (int i = 0; i < 4; ++i) {
                    float g = fminf(acc[ai][0][m][0][i] * sc + bg0[i], 7.0f); float l = fminf(fmaxf(acc[ai][1][m][0][i] * sc + bl0[i], -7.0f), 7.0f);
                    h0[i] = (l + 1.0f) * (g * sigmoidf_(1.702f * g));
                    g = fminf(acc[ai][0][m][1][i] * sc + bg1[i], 7.0f); l = fminf(fmaxf(acc[ai][1][m][1][i] * sc + bl1[i], -7.0f), 7.0f);
                    h1[i] = (l + 1.0f) * (g * sigmoidf_(1.702f * g)); }
                u32x2 w; w.x = pk4_fp8_(h0[0], h0[1], h0[2], h0[3]); w.y = pk4_fp8_(h1[0], h1[1], h1[2], h1[3]);
                *(u32x2*)(H + (size_t)row * ldc + j0) = w; }
    }
};
struct EpiDown {
    static constexpr bool PERM = true, AFTER_DRAIN = false;
    const PG8_LAS int* tile_e; const float* bdown; const float* slot_w; bf16_t* YS; int ldc; float sc;
    __device__ __forceinline__ void operator()(const f32x4 (&acc)[2][2][4][2], const Unit& u, int wr, int wc, int fr, int fq) const {
        const int e = tile_e[u.pm];
        const int row0 = u.pm * BM + wr * 64 + fr, col0 = u.pn * BM + wc * 32 + 8 * fq;
        f32x4 bv[2][2];
#pragma unroll
        for (int bj = 0; bj < 2; ++bj)
#pragma unroll
            for (int n = 0; n < 2; ++n) bv[bj][n] = *(const f32x4*)(bdown + (size_t)e * 2048 + col0 + bj * HALF + 4 * n);
#pragma unroll
        for (int ai = 0; ai < 2; ++ai)
#pragma unroll
            for (int m = 0; m < 4; ++m) { const int row = row0 + ai * HALF + m * 16; const float sw = slot_w[row];
#pragma unroll
                for (int bj = 0; bj < 2; ++bj) { const f32x4 v0 = (acc[ai][bj][m][0] * sc + bv[bj][0]) * sw, v1 = (acc[ai][bj][m][1] * sc + bv[bj][1]) * sw;
                    u32x4 w; w.x = cvt_pk_bf16(v0[0], v0[1]); w.y = cvt_pk_bf16(v0[2], v0[3]); w.z = cvt_pk_bf16(v1[0], v1[1]); w.w = cvt_pk_bf16(v1[2], v1[3]);
                    *(u32x4*)(YS + (size_t)row * ldc + col0 + bj * HALF) = w; } }
    }
};
struct MoeOrder : StaticOrder {
    const PG8_LAS int* tile_e; size_t estride;
    __device__ __forceinline__ size_t b_off(const Unit& u) const { return (size_t)__builtin_amdgcn_readfirstlane(tile_e[u.pm]) * estride; }
};
typedef int i32x4_ __attribute__((ext_vector_type(4)));
typedef int i32x8_ __attribute__((ext_vector_type(8)));
#define PG8_CAT(lo, hi) __builtin_shufflevector(__builtin_bit_cast(i32x4_, lo), __builtin_bit_cast(i32x4_, hi), 0, 1, 2, 3, 4, 5, 6, 7)
template <class Epi, class Sched, bool ALIGN_EPI = false, bool SP2 = false, bool FP8 = false, bool BTILED = false>
__device__ __forceinline__ void gemm_phase(PG8_LAS unsigned char* lds, const Gemm g, const Sched& S, const Epi& E) {
    const int tid = threadIdx.x, wid = __builtin_amdgcn_readfirstlane(tid >> 6), lane = tid & 63, wr = wid >> 2, wc = wid & 3, fr = lane & 15, fq = lane >> 4;
    const int K = g.K, nt = K / BK;
    unsigned voffA[2], voffB[2];
#pragma unroll
    for (int i = 0; i < 2; ++i) { int R, C; stage_rc(tid * 16 + i * 8192, R, C); const int Rb = Epi::PERM ? ((R & ~31) + perm32(R & 31)) : R;
        voffA[i] = (unsigned)(R * K + C) * 2u; voffB[i] = BTILED ? (unsigned)(Rb * 64 + C) * 2u : (unsigned)(Rb * K + C) * 2u; }
    const size_t kstep = (size_t)(BK * 2);
    const size_t hstep = (size_t)HALF * K * 2;
    const size_t tstep = 2 * hstep;
    const size_t kstepB = BTILED ? (size_t)32768 : kstep, hstepB = BTILED ? (size_t)16384 : hstep;
    const unsigned ldsw = (unsigned)wid * 1024u;
    const int aoff = lds_byte(wr * 64 + fr, fq * 8), boff = lds_byte(wc * 32 + fr, fq * 8);
#define PG8_SA(b, h) (((b) * 2 + (h)) * HTB)
#define PG8_SB(b, h) ((4 + (b) * 2 + (h)) * HTB)
#define PG8_STAGE(bufoff, gbase, voff) do { _Pragma("unroll") for (int _i = 0; _i < 2; ++_i) \
        __builtin_amdgcn_global_load_lds((const unsigned*)((const char*)(gbase) + (voff)[_i]), (PG8_LAS unsigned*)(lds + (bufoff) + ldsw + _i * 8192), 16, 0, 0); } while (0)
#define PG8_LDA(dst, b, h) do { _Pragma("unroll") for (int m = 0; m < 4; ++m) _Pragma("unroll") for (int k = 0; k < 2; ++k) dst[m][k] = *(const PG8_LAS bf16x8*)(lds + PG8_SA(b, h) + aoff + m * 2048 + k * 1024); } while (0)
#define PG8_LDB(dst, b, h) do { _Pragma("unroll") for (int n = 0; n < 2; ++n) _Pragma("unroll") for (int k = 0; k < 2; ++k) dst[n][k] = *(const PG8_LAS bf16x8*)(lds + PG8_SB(b, h) + boff + n * 2048 + k * 1024); } while (0)
#define PG8_MFMA8(C, Bv, Av) asm volatile("v_mfma_f32_16x16x128_f8f6f4 %0, %1, %2, %0" : "+v"(C) : "v"(Bv), "v"(Av))
#define PG8_MMA(ai, bj, At, Bt) do { __builtin_amdgcn_s_setprio(1); if constexpr (FP8) { const i32x8_ b0_ = PG8_CAT(Bt[0][0], Bt[0][1]), b1_ = PG8_CAT(Bt[1][0], Bt[1][1]); _Pragma("unroll") for (int m = 0; m < 4; ++m) { \
        const i32x8_ a_ = PG8_CAT(At[m][0], At[m][1]); PG8_MFMA8(acc[ai][bj][m][0], b0_, a_); PG8_MFMA8(acc[ai][bj][m][1], b1_, a_); } } else { \
        _Pragma("unroll") for (int m = 0; m < 4; ++m) _Pragma("unroll") for (int n = 0; n < 2; ++n) _Pragma("unroll") for (int k = 0; k < 2; ++k) \
        acc[ai][bj][m][n] = __builtin_amdgcn_mfma_f32_16x16x32_bf16(Bt[n][k], At[m][k], acc[ai][bj][m][n], 0, 0, 0); } __builtin_amdgcn_s_setprio(0); } while (0)
#define PG8_WAIT_V(n) asm volatile("s_waitcnt vmcnt(" #n ")" ::: "memory")
#define PG8_WAIT_L(n) asm volatile("s_waitcnt lgkmcnt(" #n ")" ::: "memory")
#define PG8_BAR __builtin_amdgcn_s_barrier()
#define PG8_SCHED __builtin_amdgcn_sched_barrier(0)
    Unit cur, nxt; int ui = 0;
    if (!S.next(0, cur)) return;
    f32x4 acc[2][2][4][2];
#pragma unroll
    for (int a = 0; a < 2; ++a)
#pragma unroll
        for (int b = 0; b < 2; ++b)
#pragma unroll
            for (int m = 0; m < 4; ++m)
#pragma unroll
                for (int n = 0; n < 2; ++n) acc[a][b][m][n] = (f32x4){0.f, 0.f, 0.f, 0.f};
    bf16x8 At[4][2], B0[2][2], B1[2][2];
    const char* cA = (const char*)g.A + (size_t)cur.pm * tstep; const char* cB = (const char*)g.Bt + S.b_off(cur) + (size_t)cur.pn * tstep;
    S.a_ready(cur);
    if constexpr (SP2) {
        PG8_STAGE(PG8_SB(0, 0), cB, voffB); PG8_STAGE(PG8_SB(0, 1), cB + hstepB, voffB); PG8_STAGE(PG8_SA(0, 0), cA, voffA); PG8_STAGE(PG8_SA(0, 1), cA + hstep, voffA);
        if (wr == 1) PG8_BAR;
        PG8_WAIT_V(2); PG8_BAR;
        PG8_STAGE(PG8_SB(1, 0), cB + kstepB, voffB); PG8_STAGE(PG8_SA(1, 0), cA + kstep, voffA); PG8_STAGE(PG8_SB(1, 1), cB + hstepB + kstepB, voffB);
        PG8_WAIT_V(6); PG8_BAR;
    } else {
        PG8_STAGE(PG8_SB(0, 0), cB, voffB); PG8_STAGE(PG8_SA(0, 0), cA, voffA); PG8_STAGE(PG8_SB(0, 1), cB + hstepB, voffB); PG8_STAGE(PG8_SA(0, 1), cA + hstep, voffA);
        if (wr == 1) PG8_BAR;
        PG8_WAIT_V(4); PG8_BAR;
        PG8_STAGE(PG8_SB(1, 0), cB + kstepB, voffB); PG8_STAGE(PG8_SA(1, 0), cA + kstep, voffA); PG8_STAGE(PG8_SB(1, 1), cB + hstepB + kstepB, voffB);
        PG8_WAIT_V(6); PG8_BAR;
    }
    for (;;) {
        const bool has_next = S.next(ui + 1, nxt);
        const char* nA = has_next ? (const char*)g.A + (size_t)nxt.pm * tstep : cA; const char* nB = has_next ? (const char*)g.Bt + S.b_off(nxt) + (size_t)nxt.pn * tstep : cB;
        for (int t = 0; t < nt; t += 2) {
            const bool last = (t == nt - 2);
            const char* a1 = cA + (size_t)(t + 1) * kstep;
            const char* a2 = last ? nA : cA + (size_t)(t + 2) * kstep; const char* b2 = last ? nB : cB + (size_t)(t + 2) * kstepB;
            const char* a3 = a2 + kstep; const char* b3 = b2 + kstepB;
            if (last && has_next) S.a_ready(nxt);
            if constexpr (SP2) {
            PG8_LDB(B0, 0, 0); PG8_LDB(B1, 0, 1); PG8_SCHED; PG8_LDA(At, 0, 0); PG8_STAGE(PG8_SA(1, 1), a1 + hstep, voffA);
            PG8_WAIT_V(8); PG8_WAIT_L(0); PG8_BAR; PG8_MMA(0, 0, At, B0); PG8_MMA(0, 1, At, B1); PG8_BAR; PG8_SCHED;
            PG8_LDA(At, 0, 1); PG8_STAGE(PG8_SB(0, 0), b2, voffB); PG8_STAGE(PG8_SB(0, 1), b2 + hstepB, voffB); PG8_STAGE(PG8_SA(0, 0), a2, voffA);
            PG8_WAIT_V(8); PG8_WAIT_L(0); PG8_BAR; PG8_MMA(1, 0, At, B0); PG8_MMA(1, 1, At, B1); PG8_BAR; PG8_SCHED;
            PG8_LDB(B0, 1, 0); PG8_LDB(B1, 1, 1); PG8_SCHED; PG8_LDA(At, 1, 0); PG8_STAGE(PG8_SA(0, 1), a2 + hstep, voffA);
            PG8_WAIT_V(8); PG8_WAIT_L(0); PG8_BAR; PG8_MMA(0, 0, At, B0); PG8_MMA(0, 1, At, B1); PG8_BAR; PG8_SCHED;
            PG8_LDA(At, 1, 1); PG8_STAGE(PG8_SB(1, 0), b3, voffB); PG8_STAGE(PG8_SB(1, 1), b3 + hstepB, voffB); PG8_STAGE(PG8_SA(1, 0), a3, voffA);
            PG8_WAIT_V(8); PG8_WAIT_L(0); PG8_BAR; PG8_MMA(1, 0, At, B0); PG8_MMA(1, 1, At, B1); PG8_BAR; PG8_SCHED;
            } else {
            PG8_LDB(B0, 0, 0); PG8_SCHED; PG8_LDA(At, 0, 0); PG8_STAGE(PG8_SA(1, 1), a1 + hstep, voffA);
            PG8_WAIT_L(8); PG8_BAR; PG8_WAIT_L(0); PG8_MMA(0, 0, At, B0); PG8_BAR; PG8_SCHED;
            PG8_LDB(B1, 0, 1); PG8_STAGE(PG8_SB(0, 0), b2, voffB);
            PG8_BAR; PG8_WAIT_L(0); PG8_MMA(0, 1, At, B1); PG8_BAR;
            PG8_LDA(At, 0, 1); PG8_STAGE(PG8_SA(0, 0), a2, voffA);
            PG8_BAR; PG8_WAIT_L(0); PG8_MMA(1, 0, At, B0); PG8_BAR; PG8_SCHED;
            PG8_STAGE(PG8_SB(0, 1), b2 + hstepB, voffB);
            PG8_WAIT_V(6); PG8_BAR; PG8_MMA(1, 1, At, B1); PG8_BAR;
            PG8_LDB(B0, 1, 0); PG8_SCHED; PG8_LDA(At, 1, 0); PG8_STAGE(PG8_SA(0, 1), a2 + hstep, voffA);
            PG8_WAIT_L(8); PG8_BAR; PG8_WAIT_L(0); PG8_MMA(0, 0, At, B0); PG8_BAR; PG8_SCHED;
            PG8_LDB(B1, 1, 1); PG8_STAGE(PG8_SB(1, 0), b3, voffB);
            PG8_BAR; PG8_WAIT_L(0); PG8_MMA(0, 1, At, B1); PG8_BAR;
            PG8_LDA(At, 1, 1); PG8_STAGE(PG8_SA(1, 0), a3, voffA);
            PG8_BAR; PG8_WAIT_L(0); PG8_MMA(1, 0, At, B0); PG8_BAR; PG8_SCHED;
            PG8_STAGE(PG8_SB(1, 1), b3 + hstepB, voffB);
            PG8_WAIT_V(6); PG8_BAR; PG8_MMA(1, 1, At, B1); PG8_BAR;
            }
        }
        if constexpr (ALIGN_EPI) { if (wr == 0) PG8_BAR; }
        if constexpr (FP8) { asm volatile("s_nop 15\n\ts_nop 7" ::: "memory"); PG8_SCHED; }
        if constexpr (!Epi::AFTER_DRAIN) { E(acc, cur, wr, wc, fr, fq); S.done(cur); }
        if (!has_next) break;
#pragma unroll
        for (int a = 0; a < 2; ++a)
#pragma unroll
            for (int b = 0; b < 2; ++b)
#pragma unroll
                for (int m = 0; m < 4; ++m)
#pragma unroll
                    for (int n = 0; n < 2; ++n) acc[a][b][m][n] = (f32x4){0.f, 0.f, 0.f, 0.f};
        cur = nxt; cA = nA; cB = nB; ++ui;
        if constexpr (ALIGN_EPI) { if (wr == 1) PG8_BAR; }
    }
    PG8_WAIT_V(0);
    if constexpr (!ALIGN_EPI) { if (wr == 0) PG8_BAR; }
    PG8_BAR;
    if constexpr (Epi::AFTER_DRAIN) { E.fused(acc, cur, wr, wc, fr, fq, lds, wid, lane); S.done(cur); }
#undef PG8_SA
#undef PG8_SB
#undef PG8_STAGE
#undef PG8_LDA
#undef PG8_LDB
#undef PG8_MMA
#undef PG8_WAIT_V
#undef PG8_WAIT_L
#undef PG8_BAR
#undef PG8_SCHED
}
}
namespace at {
using bf16 = __hip_bfloat16;
constexpr int   D = 128, NW = 8, QBLK = 32, KVBLK = 64;
constexpr float SCALE = 0.088388347648318440f;
constexpr float THR = 8.f;
constexpr int SDEPTH = 2;
constexpr size_t SHM_V = KVBLK * D * 2, SHM_K = KVBLK * D * 2, SHM_ATTN = 2 * SHM_V + 2 * SHM_K + NW * 64 * 4;
using bf16x8 = __attribute__((ext_vector_type(8))) short;
using s16x4  = __attribute__((ext_vector_type(4))) short;
using f32x16 = __attribute__((ext_vector_type(16))) float;
using f32x8  = __attribute__((ext_vector_type(8))) float;
using u32x4  = __attribute__((ext_vector_type(4))) unsigned;
#define KSWZ(row, colB) ((row) * 256 + ((colB) ^ (((row) & 7) << 4)))
#define SBAR() __builtin_amdgcn_sched_barrier(0)
__device__ __forceinline__ int crow(int r, int hi) { return (r & 3) + 8 * (r >> 2) + 4 * hi; }
__device__ __forceinline__ unsigned cvtpk(float lo, float hi) {
  unsigned r; asm volatile("v_cvt_pk_bf16_f32 %0, %1, %2" : "=v"(r) : "v"(lo), "v"(hi)); return r;
}
template <typename TIn> struct Stage;
template <> struct Stage<bf16>  { using T = bf16x8;
  __device__ static __forceinline__ T ld8(const bf16* p) { return *reinterpret_cast<const bf16x8*>(p); }
  __device__ static __forceinline__ bf16x8 tobf(T x) { return x; } };
template <> struct Stage<float> { using T = f32x8;
  __device__ static __forceinline__ T ld8(const float* p) { return *reinterpret_cast<const f32x8*>(p); }
  __device__ static __forceinline__ bf16x8 tobf(T x) {
    u32x4 w = {cvtpk(x[0], x[1]), cvtpk(x[2], x[3]), cvtpk(x[4], x[5]), cvtpk(x[6], x[7])}; return *reinterpret_cast<bf16x8*>(&w); } };

__device__ __forceinline__ void partialSM(f32x16& p0, f32x16& p1, float& m_reg, float& mn, float& alpha) {
  constexpr float C = SCALE * 1.4426950408889634f;
  float pmax = p0[0]; for (int r = 1; r < 16; ++r) pmax = fmaxf(pmax, p0[r]); for (int r = 0; r < 16; ++r) pmax = fmaxf(pmax, p1[r]);
  { auto rr = __builtin_amdgcn_permlane32_swap(__float_as_uint(pmax), __float_as_uint(pmax), false, false);
    pmax = fmaxf(__uint_as_float(rr[0]), __uint_as_float(rr[1])); }
  if (__builtin_expect(__all(pmax - m_reg <= THR / SCALE), 1)) { mn = m_reg; alpha = 1.f; }
  else { mn = fmaxf(m_reg, pmax); alpha = __builtin_amdgcn_exp2f((m_reg - mn) * C); m_reg = mn; }
  float mnC = -mn * C;
  for (int r = 0; r < 16; ++r) p0[r] = fmaf(p0[r], C, mnC); for (int r = 0; r < 16; ++r) p1[r] = fmaf(p1[r], C, mnC);
  for (int r = 0; r < 16; ++r) p0[r] = __builtin_amdgcn_exp2f(p0[r]);
}
__device__ __forceinline__ void finishSM(f32x16& p0, f32x16& p1, float alpha, float& l_reg, bf16x8& pa0, bf16x8& pa1, bf16x8& pa2, bf16x8& pa3) {
  for (int r = 0; r < 16; ++r) p1[r] = __builtin_amdgcn_exp2f(p1[r]);
  float ps = 0; for (int r = 0; r < 16; ++r) ps += p0[r]; for (int r = 0; r < 16; ++r) ps += p1[r];
  { auto rr = __builtin_amdgcn_permlane32_swap(__float_as_uint(ps), __float_as_uint(ps), false, false);
    ps = __uint_as_float(rr[0]) + __uint_as_float(rr[1]); }
  l_reg = l_reg * alpha + ps;
#define PK4(P, BASE, OUT) do { unsigned a0 = cvtpk(P[BASE + 0], P[BASE + 1]), a1 = cvtpk(P[BASE + 2], P[BASE + 3]);   \
    unsigned b0 = cvtpk(P[BASE + 4], P[BASE + 5]), b1 = cvtpk(P[BASE + 6], P[BASE + 7]);                              \
    auto r0 = __builtin_amdgcn_permlane32_swap(a0, b0, false, false); auto r1 = __builtin_amdgcn_permlane32_swap(a1, b1, false, false); \
    u32x4 w = {r0[0], r1[0], r0[1], r1[1]}; OUT = *reinterpret_cast<bf16x8*>(&w); } while (0)
  PK4(p0, 0, pa0); PK4(p0, 8, pa1); PK4(p1, 0, pa2); PK4(p1, 8, pa3);
#undef PK4
}
__device__ __forceinline__ void qkt(f32x16& p0, f32x16& p1, const bf16* Ks, const bf16x8* qr, int r32, int hi) {
  p0 = f32x16{}; p1 = f32x16{};
  for (int d0 = 0; d0 < 8; ++d0) { int cb = (d0 * 16 + hi * 8) * 2;
    bf16x8 b0 = *reinterpret_cast<const bf16x8*>((const char*)Ks + KSWZ(r32, cb));
    bf16x8 b1 = *reinterpret_cast<const bf16x8*>((const char*)Ks + KSWZ(32 + r32, cb));
    p0 = __builtin_amdgcn_mfma_f32_32x32x16_bf16(b0, qr[d0], p0, 0, 0, 0);
    p1 = __builtin_amdgcn_mfma_f32_32x32x16_bf16(b1, qr[d0], p1, 0, 0, 0); }
}
__device__ __forceinline__ int v_st(int k, int c) { const int kk = (k & ~0xC) | ((k & 4) << 1) | ((k & 8) >> 1); return ((kk >> 3) * 4 + (c >> 5)) * 512 + ((kk & 7) * 32 + (c & 31)) * 2; }
__device__ __forceinline__ int v_rd_base(int lane) { return ((lane & 3) << 3) | (((lane >> 2) & 3) << 6) | (((lane >> 4) & 1) << 5) | (((lane >> 5) & 1) << 8); }
constexpr int v_rd_off(int d0, int ks, int half) { return d0 * 512 + ks * 4096 + half * 2048; }
template <int OFF> __device__ __forceinline__ s16x4 tr_read(int vb) {
  s16x4 r; asm volatile("ds_read_b64_tr_b16 %0, %1 offset:%2" : "=&v"(r) : "v"(vb), "i"(OFF) : "memory"); return r;
}
template <int D0> __device__ __forceinline__ void pv_one(f32x16& od, int vb, bf16x8 pa0, bf16x8 pa1, bf16x8 pa2, bf16x8 pa3) {
  const s16x4 l0 = tr_read<v_rd_off(D0, 0, 0)>(vb), h0 = tr_read<v_rd_off(D0, 0, 1)>(vb), l1 = tr_read<v_rd_off(D0, 1, 0)>(vb), h1 = tr_read<v_rd_off(D0, 1, 1)>(vb);
  const s16x4 l2 = tr_read<v_rd_off(D0, 2, 0)>(vb), h2 = tr_read<v_rd_off(D0, 2, 1)>(vb), l3 = tr_read<v_rd_off(D0, 3, 0)>(vb), h3 = tr_read<v_rd_off(D0, 3, 1)>(vb);
  asm volatile("s_waitcnt lgkmcnt(0)" ::: "memory"); SBAR();
#define PK(L, H) (bf16x8){L[0], L[1], L[2], L[3], H[0], H[1], H[2], H[3]}
  od = __builtin_amdgcn_mfma_f32_32x32x16_bf16(pa0, PK(l0, h0), od, 0, 0, 0);
  od = __builtin_amdgcn_mfma_f32_32x32x16_bf16(pa1, PK(l1, h1), od, 0, 0, 0);
  od = __builtin_amdgcn_mfma_f32_32x32x16_bf16(pa2, PK(l2, h2), od, 0, 0, 0);
  od = __builtin_amdgcn_mfma_f32_32x32x16_bf16(pa3, PK(l3, h3), od, 0, 0, 0);
#undef PK
}
__device__ __forceinline__ void pv_d0(f32x16* o, int vb, bf16x8 pa0, bf16x8 pa1, bf16x8 pa2, bf16x8 pa3) {
  pv_one<0>(o[0], vb, pa0, pa1, pa2, pa3); pv_one<1>(o[1], vb, pa0, pa1, pa2, pa3); pv_one<2>(o[2], vb, pa0, pa1, pa2, pa3); pv_one<3>(o[3], vb, pa0, pa1, pa2, pa3);
}

template <int LDQ, int LDK, int LDV, int LDO>
__device__ __forceinline__ void attn_dense_body(const bf16* __restrict__ Qb, const bf16* __restrict__ Kh, const bf16* __restrict__ Vh,
                                                unsigned char* __restrict__ Ob, int seq, char* lds) {
  using St = Stage<bf16>; using SQ = Stage<bf16>;
  const int tid = threadIdx.x, wid = __builtin_amdgcn_readfirstlane(tid >> 6), lane = tid & 63, r32 = lane & 31, hi = lane >> 5;
  bf16* V_lds = (bf16*)lds; bf16* K_lds = (bf16*)(lds + 2 * SHM_V);
  float* ws = (float*)(lds + 2 * SHM_V + 2 * SHM_K) + wid * 64; float* li_l = ws; float* al_l = ws + 32;
  float m_reg = -1e30f, l_reg = 0; f32x16 o[4] = {}; bf16x8 qr[8];
  const bf16* Qw = Qb + (long)(wid * QBLK + r32) * LDQ + hi * 8;
#pragma unroll
  for (int d0 = 0; d0 < 8; ++d0) qr[d0] = SQ::tobf(SQ::ld8(Qw + d0 * 16));
  const int sr = tid >> 4, sc = (tid & 15) * 8, vst0 = v_st(sr, sc), vst1 = v_st(32 + sr, sc);
  const int vb0 = (int)(uintptr_t)V_lds + v_rd_base(lane);
  struct { typename St::T vs0, vs1, ks0, ks1; } sr_[SDEPTH];
#define SLOAD(i, k0) do { sr_[i].vs0 = St::ld8(&Vh[(long)((k0) + sr) * LDV + sc]); sr_[i].vs1 = St::ld8(&Vh[(long)((k0) + 32 + sr) * LDV + sc]); \
    sr_[i].ks0 = St::ld8(&Kh[(long)((k0) + sr) * LDK + sc]); sr_[i].ks1 = St::ld8(&Kh[(long)((k0) + 32 + sr) * LDK + sc]); } while (0)
#define SWRITE(b, i) do { *(bf16x8*)((char*)V_lds + (b) * SHM_V + vst0) = St::tobf(sr_[i].vs0);          \
    *(bf16x8*)((char*)V_lds + (b) * SHM_V + vst1) = St::tobf(sr_[i].vs1); int kc = sc * 2;               \
    *(bf16x8*)((char*)K_lds + (b) * SHM_K + KSWZ(sr, kc)) = St::tobf(sr_[i].ks0);                       \
    *(bf16x8*)((char*)K_lds + (b) * SHM_K + KSWZ(32 + sr, kc)) = St::tobf(sr_[i].ks1); } while (0)
#define SWAIT() do { if constexpr (SDEPTH == 2) asm volatile("s_waitcnt vmcnt(4)" ::: "memory"); else asm volatile("s_waitcnt vmcnt(0)" ::: "memory"); } while (0)
#define RESC(a) do { if (__any((a) < 1.f)) { if (hi == 0) al_l[r32] = (a); asm volatile("s_waitcnt lgkmcnt(0)" ::: "memory"); \
    for (int d = 0; d < 4; ++d) for (int r = 0; r < 16; ++r) o[d][r] *= al_l[crow(r, hi)]; } } while (0)
  f32x16 pA0, pA1, pB0, pB1; float mnA, mnB, alA, alB; bf16x8 pa0, pa1, pa2, pa3; const int NT = seq / KVBLK;
  constexpr int SE = 0, SO = SDEPTH - 1;
  SLOAD(SE, 0); asm volatile("s_waitcnt vmcnt(0)" ::: "memory"); SWRITE(0, SE); __syncthreads();
  qkt(pA0, pA1, K_lds, qr, r32, hi); partialSM(pA0, pA1, m_reg, mnA, alA);
  SLOAD(SO, KVBLK); if constexpr (SDEPTH == 2) { if (2 < NT) SLOAD(SE, 2 * KVBLK); }
  SWAIT(); SWRITE(1, SO); __syncthreads();
  for (int j = 1; j + 1 < NT; j += 2) {
    SBAR(); qkt(pB0, pB1, (bf16*)((char*)K_lds + SHM_K), qr, r32, hi);
    finishSM(pA0, pA1, alA, l_reg, pa0, pa1, pa2, pa3); SBAR();
    SLOAD(SO, (j + SDEPTH) * KVBLK); SBAR();
    pv_d0(o, vb0, pa0, pa1, pa2, pa3); partialSM(pB0, pB1, m_reg, mnB, alB);
    __syncthreads(); SWAIT(); SWRITE(0, SE);
    RESC(alB); __syncthreads();
    SBAR(); qkt(pA0, pA1, K_lds, qr, r32, hi);
    finishSM(pB0, pB1, alB, l_reg, pa0, pa1, pa2, pa3); SBAR();
    if (SDEPTH == 1 || j + 3 < NT) SLOAD(SE, (j + 1 + SDEPTH) * KVBLK); SBAR();
    pv_d0(o, vb0 + (int)SHM_V, pa0, pa1, pa2, pa3); partialSM(pA0, pA1, m_reg, mnA, alA);
    __syncthreads(); SWAIT(); SWRITE(1, SO);
    RESC(alA); __syncthreads();
  }
  SBAR(); qkt(pB0, pB1, (bf16*)((char*)K_lds + SHM_K), qr, r32, hi);
  finishSM(pA0, pA1, alA, l_reg, pa0, pa1, pa2, pa3); SBAR();
  pv_d0(o, vb0, pa0, pa1, pa2, pa3); partialSM(pB0, pB1, m_reg, mnB, alB);
  __syncthreads(); RESC(alB);
  finishSM(pB0, pB1, alB, l_reg, pa0, pa1, pa2, pa3); SBAR();
  pv_d0(o, vb0 + (int)SHM_V, pa0, pa1, pa2, pa3);
  if (hi == 0) li_l[r32] = l_reg; asm volatile("s_waitcnt lgkmcnt(0)" ::: "memory");
  float rli[16];
#pragma unroll
  for (int r = 0; r < 16; ++r) rli[r] = __builtin_amdgcn_rcpf(li_l[crow(r, hi)]);
  unsigned char* Ow = Ob + (long)(wid * QBLK) * LDO;
#pragma unroll
  for (int r = 0; r < 16; ++r) { int orow = crow(r, hi);
    for (int d0 = 0; d0 < 4; ++d0) Ow[(long)orow * LDO + d0 * 32 + r32] = (unsigned char)(__builtin_amdgcn_cvt_pk_fp8_f32(o[d0][r] * rli[r] * 64.0f, 0.f, 0, false) & 0xff); }
#undef SLOAD
#undef SWRITE
#undef SWAIT
#undef RESC
}


__device__ __forceinline__ void dilated_unit(const bf16* __restrict__ proj, const float* __restrict__ lutg, bf16* __restrict__ outg, float* __restrict__ lseg,
                                             int d, int hd12, int hh, int r, int i0, char* lds) {
  constexpr int LDP = 10240;
  constexpr float L2E = 1.4426950408889634f, C = SCALE * L2E;
  const int tid = threadIdx.x, wid = tid >> 6, lane = tid & 63, r32 = lane & 31, hi = lane >> 5;
  const int n = 8192 / d;
  char* KV = lds;
  float* lutx = (float*)(lds + 98304);
  float* wsx = (float*)(lds + 98304 + 2048) + wid * 64;
  const int qoff = hd12 * 128, koff = 1536 + hd12 * 128;
  if (tid < 320) { const int o = tid - 96; lutx[tid] = (o >= 0 && o <= 128) ? lutg[o] * L2E : -1e30f; }
  const int iq = i0 + wid * 32 + r32;
  const int sr = tid >> 4, sc = (tid & 15) * 8;
  f32x16 s00, s01, s10, s11, s20, s21;
  const int a = wid >> 1;
  {
    const bf16* Qw = proj + (size_t)(r + iq * d) * LDP + qoff + hi * 8;
    bf16x8 qr[8];
#pragma unroll
    for (int d0 = 0; d0 < 8; ++d0) qr[d0] = *reinterpret_cast<const bf16x8*>(Qw + d0 * 16);
    const int wu = __builtin_amdgcn_readfirstlane(wid);
    const unsigned kvbase = (unsigned)(uintptr_t)KV;
#pragma unroll
    for (int i = 0; i < 12; ++i) { const int P = 8 * i + wu, rit = (P & 15) * 4 + (lane >> 4), colB = ((lane & 15) << 4) ^ ((rit & 7) << 4), row = (P >> 4) * 64 + rit;
      int j = i0 - 64 + row; j = j < 0 ? 0 : (j >= n ? n - 1 : j);
      __builtin_amdgcn_global_load_lds((const unsigned*)(proj + (size_t)(r + j * d) * LDP + koff + (colB >> 1)), (__attribute__((address_space(3))) unsigned*)(kvbase + (unsigned)P * 1024u), 16, 0, 0); }
    asm volatile("s_waitcnt vmcnt(0)" ::: "memory");
    __syncthreads();
    qkt(s00, s01, (const bf16*)(KV + (a + 0) * 16384), qr, r32, hi);
    qkt(s10, s11, (const bf16*)(KV + (a + 1) * 16384), qr, r32, hi);
    qkt(s20, s21, (const bf16*)(KV + (a + 2) * 16384), qr, r32, hi);
  }
  __syncthreads();
  {
    const int wu = __builtin_amdgcn_readfirstlane(wid);
    const unsigned kvbase = (unsigned)(uintptr_t)KV;
#pragma unroll
    for (int i = 0; i < 12; ++i) { const int P = 8 * i + wu, sub = (P & 15) * 2 + (lane >> 5), kk = (sub >> 2) * 8 + ((lane & 31) >> 2), c = (sub & 3) * 32 + (lane & 3) * 8;
      const int k = (kk & ~0xC) | ((kk & 4) << 1) | ((kk & 8) >> 1), row = (P >> 4) * 64 + k;
      int j = i0 - 64 + row; j = j < 0 ? 0 : (j >= n ? n - 1 : j);
      __builtin_amdgcn_global_load_lds((const unsigned*)(proj + (size_t)(r + j * d) * LDP + koff + 1536 + c), (__attribute__((address_space(3))) unsigned*)(kvbase + (unsigned)P * 1024u), 16, 0, 0); }
  }
  SBAR();
  const int base = -32 * (wid & 1) - 64 - r32 + 4 * hi;
  const float* lp = lutx + (base + 160);
  float mx = -1e30f;
#define DIL_LOGITS(S, TT, HALF) _Pragma("unroll") for (int rr = 0; rr < 16; ++rr) { const float v = fmaf(S[rr], C, lp[64 * TT + 32 * HALF + (rr & 3) + 8 * (rr >> 2)]); S[rr] = v; }
  DIL_LOGITS(s00, 0, 0) DIL_LOGITS(s01, 0, 1) DIL_LOGITS(s10, 1, 0) DIL_LOGITS(s11, 1, 1) DIL_LOGITS(s20, 2, 0) DIL_LOGITS(s21, 2, 1)
#undef DIL_LOGITS
  if (i0 == 0 || i0 + 320 > n) {
    const int lo = -iq - base, hi_ = n - 1 - iq - base;
#define DIL_MASK(S, TT, HALF) _Pragma("unroll") for (int rr = 0; rr < 16; ++rr) { const int c = 64 * TT + 32 * HALF + (rr & 3) + 8 * (rr >> 2); S[rr] = (c >= lo && c <= hi_) ? S[rr] : -1e30f; }
    DIL_MASK(s00, 0, 0) DIL_MASK(s01, 0, 1) DIL_MASK(s10, 1, 0) DIL_MASK(s11, 1, 1) DIL_MASK(s20, 2, 0) DIL_MASK(s21, 2, 1)
#undef DIL_MASK
  }
#define DIL_MAX(S) _Pragma("unroll") for (int rr = 0; rr < 16; ++rr) mx = fmaxf(mx, S[rr]);
  DIL_MAX(s00) DIL_MAX(s01) DIL_MAX(s10) DIL_MAX(s11) DIL_MAX(s20) DIL_MAX(s21)
#undef DIL_MAX
  { auto rr = __builtin_amdgcn_permlane32_swap(__float_as_uint(mx), __float_as_uint(mx), false, false);
    mx = fmaxf(__uint_as_float(rr[0]), __uint_as_float(rr[1])); }
  float ps = 0.f;
#define DIL_EXP(S) _Pragma("unroll") for (int rr = 0; rr < 16; ++rr) { const float p = __builtin_amdgcn_exp2f(S[rr] - mx); S[rr] = p; ps += p; }
  DIL_EXP(s00) DIL_EXP(s01) DIL_EXP(s10) DIL_EXP(s11) DIL_EXP(s20) DIL_EXP(s21)
#undef DIL_EXP
  { auto rr = __builtin_amdgcn_permlane32_swap(__float_as_uint(ps), __float_as_uint(ps), false, false);
    ps = __uint_as_float(rr[0]) + __uint_as_float(rr[1]); }
  bf16x8 pa[12];
#define PK4(P, BASE, OUT) do { unsigned a0 = cvtpk(P[BASE + 0], P[BASE + 1]), a1 = cvtpk(P[BASE + 2], P[BASE + 3]);   \
    unsigned b0 = cvtpk(P[BASE + 4], P[BASE + 5]), b1 = cvtpk(P[BASE + 6], P[BASE + 7]);                              \
    auto r0 = __builtin_amdgcn_permlane32_swap(a0, b0, false, false); auto r1 = __builtin_amdgcn_permlane32_swap(a1, b1, false, false); \
    u32x4 w = {r0[0], r1[0], r0[1], r1[1]}; OUT = *reinterpret_cast<bf16x8*>(&w); } while (0)
  PK4(s00, 0, pa[0]); PK4(s00, 8, pa[1]); PK4(s01, 0, pa[2]); PK4(s01, 8, pa[3]);
  PK4(s10, 0, pa[4]); PK4(s10, 8, pa[5]); PK4(s11, 0, pa[6]); PK4(s11, 8, pa[7]);
  PK4(s20, 0, pa[8]); PK4(s20, 8, pa[9]); PK4(s21, 0, pa[10]); PK4(s21, 8, pa[11]);
#undef PK4
  SBAR();
  if (hi == 0) wsx[r32] = ps;
  asm volatile("s_waitcnt vmcnt(0)" ::: "memory");
  __syncthreads();
  f32x16 o[4] = {};
  const int vb = (int)(uintptr_t)KV + v_rd_base(lane);
  pv_d0(o, vb + (a + 0) * 16384, pa[0], pa[1], pa[2], pa[3]);
  pv_d0(o, vb + (a + 1) * 16384, pa[4], pa[5], pa[6], pa[7]);
  pv_d0(o, vb + (a + 2) * 16384, pa[8], pa[9], pa[10], pa[11]);
  float rli[16];
#pragma unroll
  for (int rr = 0; rr < 16; ++rr) rli[rr] = __builtin_amdgcn_rcpf(wsx[crow(rr, hi)]);
#pragma unroll
  for (int rr = 0; rr < 16; ++rr) { const int ir = i0 + wid * 32 + crow(rr, hi); bf16* orow = outg + (size_t)(r + ir * d) * 512 + hh * 128 + r32;
#pragma unroll
    for (int d0 = 0; d0 < 4; ++d0) orow[d0 * 32] = __float2bfloat16(o[d0][rr] * rli[rr]); }
  if (hi == 0) lseg[(size_t)(r + iq * d) * 4 + hh] = (mx + __builtin_amdgcn_logf(ps)) * 0.6931471805599453f;
  __syncthreads();
}

typedef int i32x4a __attribute__((ext_vector_type(4)));
typedef int i32x8a __attribute__((ext_vector_type(8)));
constexpr float THR8 = 3.f;
constexpr size_t SHM8_K = 64 * 128, SHM8_V = 64 * 128, SHM_ATTN8 = 2 * SHM8_K + 2 * SHM8_V + NW * 64 * 4 + NW * 4096;
#define A8_CAT(lo, hi) __builtin_shufflevector(lo, hi, 0, 1, 2, 3, 4, 5, 6, 7)
__device__ __forceinline__ f32x16 mfma8(i32x8a a, i32x8a b, f32x16 c) { return __builtin_amdgcn_mfma_scale_f32_32x32x64_f8f6f4(a, b, c, 0, 0, 0, 0, 0, 0); }
__device__ __forceinline__ int kchunk(int row, int c) { return row * 128 + ((c ^ ((row >> 1) & 7)) << 4); }
constexpr float THR8L = THR8 * 1.4426950408889634f;
__device__ __forceinline__ void partialSM8(f32x16& p0, f32x16& p1, float& m_reg, float& alpha) {
  float pmax = fmaxf(p0[0], p1[0]);
  for (int r = 1; r < 16; ++r) pmax = fmaxf(fmaxf(pmax, p0[r]), p1[r]);
  { auto rr = __builtin_amdgcn_permlane32_swap(__float_as_uint(pmax), __float_as_uint(pmax), false, false);
    pmax = fmaxf(__uint_as_float(rr[0]), __uint_as_float(rr[1])); }
  if (__builtin_expect(__all(pmax <= THR8L + 4.0f), 1)) { alpha = 1.f; }
  else { const float delta = fmaxf(pmax - 4.0f, 0.f); m_reg += delta; alpha = __builtin_amdgcn_exp2f(-delta);
    for (int r = 0; r < 16; ++r) { p0[r] -= delta; p1[r] -= delta; } }
  for (int r = 0; r < 16; ++r) p0[r] = __builtin_amdgcn_exp2f(p0[r]);
}
__device__ __forceinline__ unsigned pk4f8(float a, float b, float c, float d) { int w = __builtin_amdgcn_cvt_pk_fp8_f32(a, b, 0, false); w = __builtin_amdgcn_cvt_pk_fp8_f32(c, d, w, true); return (unsigned)w; }
__device__ __forceinline__ void finishSM8(f32x16& p0, f32x16& p1, i32x8a& pa) {
  for (int r = 0; r < 16; ++r) p1[r] = __builtin_amdgcn_exp2f(p1[r]);
  pa[0] = (int)pk4f8(p0[0], p0[1], p0[2], p0[3]);   pa[1] = (int)pk4f8(p0[4], p0[5], p0[6], p0[7]);
  pa[2] = (int)pk4f8(p0[8], p0[9], p0[10], p0[11]); pa[3] = (int)pk4f8(p0[12], p0[13], p0[14], p0[15]);
  pa[4] = (int)pk4f8(p1[0], p1[1], p1[2], p1[3]);   pa[5] = (int)pk4f8(p1[4], p1[5], p1[6], p1[7]);
  pa[6] = (int)pk4f8(p1[8], p1[9], p1[10], p1[11]); pa[7] = (int)pk4f8(p1[12], p1[13], p1[14], p1[15]);
}
__device__ __forceinline__ void qkt8(f32x16& p0, f32x16& p1, const char* Ks, const char* Qs, int r32, int hi, float init) {
  for (int r = 0; r < 16; ++r) { p0[r] = init; p1[r] = init; }
#pragma unroll
  for (int s = 0; s < 2; ++s) { const int c0 = 4 * s + 2 * hi;
    const i32x8a a0 = A8_CAT(*reinterpret_cast<const i32x4a*>(Ks + kchunk(r32, c0)), *reinterpret_cast<const i32x4a*>(Ks + kchunk(r32, c0 + 1)));
    const i32x8a a1 = A8_CAT(*reinterpret_cast<const i32x4a*>(Ks + kchunk(32 + r32, c0)), *reinterpret_cast<const i32x4a*>(Ks + kchunk(32 + r32, c0 + 1)));
    const i32x8a qs = A8_CAT(*reinterpret_cast<const i32x4a*>(Qs + (2 * s) * 1024), *reinterpret_cast<const i32x4a*>(Qs + (2 * s + 1) * 1024));
    p0 = mfma8(a0, qs, p0); p1 = mfma8(a1, qs, p1); }
}
__device__ __forceinline__ void pv8(f32x16* o, const char* Vs, i32x8a pa, int lane) {
#pragma unroll
  for (int d0 = 0; d0 < 4; ++d0) { const i32x8a b = A8_CAT(*reinterpret_cast<const i32x4a*>(Vs + d0 * 2048 + lane * 16), *reinterpret_cast<const i32x4a*>(Vs + d0 * 2048 + 1024 + lane * 16));
    o[d0] = mfma8(pa, b, o[d0]); }
  const i32x8a ones = {0x38383838, 0x38383838, 0x38383838, 0x38383838, 0x38383838, 0x38383838, 0x38383838, 0x38383838};
  o[4] = mfma8(pa, ones, o[4]);
}
template <int LDQ, int LDK, int LDO>
__device__ __forceinline__ void attn_dense_body8(const unsigned char* __restrict__ Qb, const unsigned char* __restrict__ Kh, const unsigned char* __restrict__ Vimg,
                                                 unsigned char* __restrict__ Ob, int seq, char* lds) {
  const int tid = threadIdx.x, wid = __builtin_amdgcn_readfirstlane(tid >> 6), lane = tid & 63, r32 = lane & 31, hi = lane >> 5;
  char* V_lds = lds; char* K_lds = lds + 2 * SHM8_V;
  float* ws = (float*)(lds + 2 * SHM8_V + 2 * SHM8_K) + wid * 64; float* al_l = ws + 32;
  float m_reg = 0.f; f32x16 o[5] = {};
  const unsigned char* Qw = Qb + (long)(wid * QBLK + r32) * LDQ + hi * 32;
  char* Qs = lds + 2 * SHM8_V + 2 * SHM8_K + NW * 64 * 4 + wid * 4096 + lane * 16;
#pragma unroll
  for (int s = 0; s < 2; ++s) { *reinterpret_cast<i32x4a*>(Qs + (2 * s) * 1024) = *reinterpret_cast<const i32x4a*>(Qw + 64 * s); *reinterpret_cast<i32x4a*>(Qs + (2 * s + 1) * 1024) = *reinterpret_cast<const i32x4a*>(Qw + 64 * s + 16); }
  const int sr = tid >> 3, sc = tid & 7, kst = kchunk(sr, sc);
  struct { i32x4a vs, ks; } sr_[SDEPTH];
#define SLOAD8(i, k0) do { sr_[i].vs = *reinterpret_cast<const i32x4a*>(Vimg + (long)((k0) >> 6) * 8192 + tid * 16); sr_[i].ks = *reinterpret_cast<const i32x4a*>(Kh + (long)((k0) + sr) * LDK + sc * 16); } while (0)
#define SWRITE8(b, i) do { *reinterpret_cast<i32x4a*>(V_lds + (b) * SHM8_V + tid * 16) = sr_[i].vs; *reinterpret_cast<i32x4a*>(K_lds + (b) * SHM8_K + kst) = sr_[i].ks; } while (0)
#define SWAIT8() do { if constexpr (SDEPTH == 2) asm volatile("s_waitcnt vmcnt(2)" ::: "memory"); else asm volatile("s_waitcnt vmcnt(0)" ::: "memory"); } while (0)
#define RESC8(a) do { if (__any((a) < 1.f)) { if (hi == 0) al_l[r32] = (a); asm volatile("s_waitcnt lgkmcnt(0)" ::: "memory"); \
    for (int d = 0; d < 5; ++d) for (int r = 0; r < 16; ++r) o[d][r] *= al_l[crow(r, hi)]; } } while (0)
  f32x16 pA0, pA1, pB0, pB1; float alA, alB; i32x8a pa; const int NT = seq / KVBLK;
  constexpr int SE = 0, SO = SDEPTH - 1;
  SLOAD8(SE, 0); asm volatile("s_waitcnt vmcnt(0)" ::: "memory"); SWRITE8(0, SE); __syncthreads();
  qkt8(pA0, pA1, K_lds, Qs, r32, hi, 4.0f - m_reg); partialSM8(pA0, pA1, m_reg, alA);
  SLOAD8(SO, KVBLK); if constexpr (SDEPTH == 2) { if (2 < NT) SLOAD8(SE, 2 * KVBLK); }
  SWAIT8(); SWRITE8(1, SO); __syncthreads();
  for (int j = 1; j + 1 < NT; j += 2) {
    SBAR(); qkt8(pB0, pB1, K_lds + SHM8_K, Qs, r32, hi, 4.0f - m_reg);
    finishSM8(pA0, pA1, pa); SBAR();
    SLOAD8(SO, (j + SDEPTH) * KVBLK); SBAR();
    pv8(o, V_lds, pa, lane); partialSM8(pB0, pB1, m_reg, alB);
    __syncthreads(); SWAIT8(); SWRITE8(0, SE);
    RESC8(alB); __syncthreads();
    SBAR(); qkt8(pA0, pA1, K_lds, Qs, r32, hi, 4.0f - m_reg);
    finishSM8(pB0, pB1, pa); SBAR();
    if (SDEPTH == 1 || j + 3 < NT) SLOAD8(SE, (j + 1 + SDEPTH) * KVBLK); SBAR();
    pv8(o, V_lds + SHM8_V, pa, lane); partialSM8(pA0, pA1, m_reg, alA);
    __syncthreads(); SWAIT8(); SWRITE8(1, SO);
    RESC8(alA); __syncthreads();
  }
  SBAR(); qkt8(pB0, pB1, K_lds + SHM8_K, Qs, r32, hi, 4.0f - m_reg);
  finishSM8(pA0, pA1, pa); SBAR();
  pv8(o, V_lds, pa, lane); partialSM8(pB0, pB1, m_reg, alB);
  __syncthreads(); RESC8(alB);
  finishSM8(pB0, pB1, pa); SBAR();
  pv8(o, V_lds + SHM8_V, pa, lane);
  float rli[16];
#pragma unroll
  for (int r = 0; r < 16; ++r) rli[r] = 4.0f * __builtin_amdgcn_rcpf(o[4][r]);
  unsigned char* Ow = Ob + (long)(wid * QBLK) * LDO;
#pragma unroll
  for (int r = 0; r < 16; ++r) { const int orow = crow(r, hi);
    for (int d0 = 0; d0 < 4; ++d0) Ow[(long)orow * LDO + d0 * 32 + r32] = (unsigned char)(__builtin_amdgcn_cvt_pk_fp8_f32(o[d0][r] * rli[r], 0.f, 0, false) & 0xff); }
#undef SLOAD8
#undef SWRITE8
#undef SWAIT8
#undef RESC8
}
}

#define GAS __attribute__((address_space(1)))
#define LAS __attribute__((address_space(3)))
typedef unsigned short bf16;
typedef unsigned v4u __attribute__((ext_vector_type(4)));
typedef unsigned v2u __attribute__((ext_vector_type(2)));
typedef float f32x4 __attribute__((ext_vector_type(4)));
#define LDS_WAIT() asm volatile("s_waitcnt lgkmcnt(0)" ::: "memory")
#define VM_WAIT() asm volatile("s_waitcnt vmcnt(0)" ::: "memory")
__device__ __forceinline__ unsigned pk2(float lo, float hi) { return pg8::cvt_pk_bf16(lo, hi); }
__device__ __forceinline__ float bflo(unsigned w) { return __builtin_bit_cast(float, w << 16); }
__device__ __forceinline__ float bfhi(unsigned w) { return __builtin_bit_cast(float, w & 0xffff0000u); }
#ifndef MK_Q8
#define MK_Q8 0
#endif
#ifndef MK_CHK_TOL
#define MK_CHK_TOL 0.15f
#endif
#ifndef MK_CHECK8
#define MK_CHECK8 0
#endif
__device__ __forceinline__ unsigned pk4_fp8(float a, float b, float c, float d) {
    int w = __builtin_amdgcn_cvt_pk_fp8_f32(a, b, 0, false); w = __builtin_amdgcn_cvt_pk_fp8_f32(c, d, w, true); return (unsigned)w; }
__device__ __forceinline__ float q8f(float v) { const int p = __builtin_amdgcn_cvt_pk_fp8_f32(v, v, 0, false); return __builtin_amdgcn_cvt_f32_fp8(p, 0); }
__device__ __forceinline__ float bf2f(bf16 b) { return __builtin_bit_cast(float, ((unsigned)b) << 16); }

#define XB_TMO      128
#define XB_XCNT(j)  (256  + 64 * (j))
#define XB_XSUB(j)  (1280 + 64 * (j))
#define XB_XGEN(j)  (2304 + 64 * (j))
#define XB_TOP      3328
#define XB_TOPGEN   3392
#define XCD_BAR_WORDS 3456
#define XB_SPIN_CAP (1u << 18)

__device__ __forceinline__ unsigned xb_ld(unsigned* p)              { return __hip_atomic_load(p, __ATOMIC_RELAXED, __HIP_MEMORY_SCOPE_AGENT); }
__device__ __forceinline__ unsigned xb_add(unsigned* p, unsigned v) { return __hip_atomic_fetch_add(p, v, __ATOMIC_RELAXED, __HIP_MEMORY_SCOPE_AGENT); }
__device__ __forceinline__ unsigned xb_xcc_id() { return (unsigned)__builtin_amdgcn_s_getreg((3 << 11) | 20) & 0xFu; }
#define XB_SPIN(cond, bar) do { unsigned _sp = 0; while (cond) { __builtin_amdgcn_s_sleep(1); \
    if ((++_sp & 255u) == 0u) { if (xb_ld(&(bar)[XB_TMO])) break; if (_sp > XB_SPIN_CAP) { atomicAdd(&(bar)[XB_TMO], 1u); break; } } } } while (0)

struct XcdBarrier {
    unsigned* bar; unsigned x;
    volatile LAS unsigned* st;
};

__device__ __forceinline__ XcdBarrier xcd_barrier_post(unsigned* bar, volatile LAS unsigned* st) {
    XcdBarrier b; b.bar = bar; b.x = xb_xcc_id(); b.st = st;
    if (threadIdx.x == 0) (void)xb_add(&bar[XB_XCNT(b.x)], 1u);
    return b;
}
__device__ __forceinline__ void xcd_barrier_complete(unsigned* bar, unsigned x, unsigned& nloc, unsigned& nx) {
    const unsigned G = gridDim.x * gridDim.y * gridDim.z;
    unsigned sum, cnt, mine, sp = 0u;
    for (;;) {
        sum = 0u; cnt = 0u; mine = 0u;
#pragma unroll
        for (unsigned j = 0; j < 16; ++j) { const unsigned c = xb_ld(&bar[XB_XCNT(j)]); sum += c; cnt += (c > 0u) ? 1u : 0u; mine = (j == x) ? c : mine; }
        if (sum == G) break;
        __builtin_amdgcn_s_sleep(1);
        if ((++sp & 255u) == 0u) { if (xb_ld(&bar[XB_TMO])) break; if (sp > XB_SPIN_CAP) { atomicAdd(&bar[XB_TMO], 1u); break; } }
    }
    nloc = mine > 0u ? mine : 1u; nx = cnt > 0u ? cnt : 1u;
}

__device__ __forceinline__ void xcd_barrier(const XcdBarrier& b) {
    asm volatile("s_waitcnt vmcnt(0)" ::: "memory");
    __syncthreads();
    if (threadIdx.x == 0) {
        unsigned* bar = b.bar;
        __builtin_amdgcn_s_waitcnt(0);
        unsigned nloc = b.st[0], nx = b.st[1];
        if (nloc == 0u) { xcd_barrier_complete(bar, b.x, nloc, nx); b.st[0] = nloc; b.st[1] = nx; }
        const unsigned old = xb_add(&bar[XB_XSUB(b.x)], 1u);
        const unsigned gen = old / nloc;
        if (old + 1u == (gen + 1u) * nloc) {
            __builtin_amdgcn_fence(__ATOMIC_RELEASE, "agent");
            asm volatile("s_waitcnt vmcnt(0)" ::: "memory");
            const unsigned og = xb_add(&bar[XB_TOP], 1u);
            const unsigned tg = og / nx;
            if (og + 1u == (tg + 1u) * nx) xb_add(&bar[XB_TOPGEN], 1u);
            else XB_SPIN(xb_ld(&bar[XB_TOPGEN]) == tg, bar);
            __builtin_amdgcn_fence(__ATOMIC_ACQUIRE, "agent");
            xb_add(&bar[XB_XGEN(b.x)], 1u);
            asm volatile("s_waitcnt vmcnt(0)" ::: "memory");
        } else {
            XB_SPIN(xb_ld(&bar[XB_XGEN(b.x)]) == gen, bar);
            __builtin_amdgcn_fence(__ATOMIC_ACQUIRE, "agent");
            asm volatile("s_waitcnt vmcnt(0)" ::: "memory");
        }
    }
    __syncthreads();
}

constexpr int S_ = 8192, DM = 2048, INW = 10240, NE = 32, TOPK = 4;
constexpr int A_W = 1536, A_V_OFF = 3072, B_Q_OFF = 4608, B_K_OFF = 5632, B_V_OFF = 5888, GATE_OFF = 6144;
constexpr int MAXSLOT = 40960;
constexpr float LN_EPS = 1e-5f, QK_EPS = 1e-6f;
constexpr float ALPHA = 1.189207115002721f;
constexpr int NPH = 11;

constexpr size_t MiB = 1u << 20;
constexpr size_t WS_CTL = 0, CTL_ZERO_BYTES = 32 * 1024;
constexpr int CW_BAR = 0;
constexpr int CW_CNT = 4096;
constexpr size_t WS_LUT = 1 * MiB;
constexpr size_t WS_ROPE = 1 * MiB + 8192;
constexpr size_t WS_WRT = 1 * MiB + 65536;
constexpr size_t WS_TOKE = 1 * MiB + 65536 + 262144;
constexpr size_t WS_TOKR = WS_TOKE + 131072;
constexpr size_t WS_TOKW = WS_TOKR + 131072;
constexpr size_t WS_TOKS = WS_TOKW + 131072;
constexpr size_t WS_SLOTW = WS_TOKS + 131072;
constexpr size_t WS_LSE = 3 * MiB;
constexpr size_t WS_XB = 4 * MiB;
constexpr size_t WS_WIN = WS_XB + 32 * MiB;
constexpr size_t WS_WA = WS_WIN + 40 * MiB;
constexpr size_t WS_WB = WS_WA + 2 * MiB;
constexpr size_t WS_WO = WS_WB + 4 * MiB;
constexpr size_t WS_WGL = WS_WO + 8 * MiB;
constexpr size_t WS_WD = WS_WGL + 512 * MiB;
constexpr size_t WS_PROJ = WS_WD + 256 * MiB;
constexpr size_t WS_QBR = WS_PROJ + 160 * MiB;
constexpr size_t WS_KBR = WS_QBR + 16 * MiB;
constexpr size_t WS_VBR = WS_KBR + 4 * MiB;
constexpr size_t WS_Q8 = WS_VBR + 4 * MiB;
constexpr size_t WS_K8 = WS_Q8 + 8 * MiB;
constexpr size_t WS_VIMG = WS_K8 + 2 * MiB;
constexpr size_t WS_DBG = WS_VIMG + 2 * MiB;
constexpr size_t WS_OUTA = WS_DBG + 64 * MiB;
constexpr size_t WS_YA = WS_OUTA + 24 * MiB;
constexpr size_t WS_YB = WS_YA + 8 * MiB;
constexpr size_t WS_T1 = WS_YB + 16 * MiB;
constexpr size_t WS_Y = WS_T1 + 64 * MiB;
constexpr size_t WS_X1 = WS_Y + 32 * MiB;
constexpr size_t WS_X1B = WS_X1 + 64 * MiB;
constexpr size_t WS_XS = WS_X1B + 32 * MiB;
constexpr size_t WS_H = WS_XS + 160 * MiB;
constexpr size_t WS_YS = WS_PROJ;
constexpr size_t WS_END = WS_H + 160 * MiB;

constexpr int RING_OFF = 0, RING_BYTES = 131072;
constexpr int L_XB = RING_BYTES;
constexpr int L_TILE = RING_BYTES + 64;
constexpr int L_PST = RING_BYTES + 1024;
constexpr int L_CNT = RING_BYTES + 1280;
constexpr int L_ASG = RING_BYTES + 2048;
constexpr int L_PTR = RING_BYTES + 3584;
constexpr int LDS_BYTES = 147456;

struct Frame {
    LAS unsigned char* lds; unsigned char* ldsg;
    int tid, lane, wave, G;
};
__device__ __forceinline__ unsigned char* wsp_(const Frame& F) {
    const LAS unsigned* p = (const LAS unsigned*)(F.lds + L_PTR) + 2 * 22;
    const unsigned lo = __builtin_amdgcn_readfirstlane(p[0]), hi = __builtin_amdgcn_readfirstlane(p[1]);
    return (unsigned char*)(((unsigned long long)hi << 32) | lo);
}
__device__ __forceinline__ const float* inp(const Frame& F, int i) {
    const LAS unsigned* p = (const LAS unsigned*)(F.lds + L_PTR) + 2 * i;
    const unsigned lo = __builtin_amdgcn_readfirstlane(p[0]), hi = __builtin_amdgcn_readfirstlane(p[1]);
    return (const float*)(((unsigned long long)hi << 32) | lo);
}
__device__ __forceinline__ float wave_sum(float v) {
#pragma unroll
    for (int o = 1; o < 64; o <<= 1) v += __shfl_xor(v, o);
    return v;
}

__device__ __forceinline__ void transpose_item(const float* __restrict__ W, int N, int k0, int n0, bf16* WT, int ldo, int orow0, int ocol0, LAS float* scr, int lane, const bool q8 = false) {
    f32x4 v[8];
#pragma unroll
    for (int i = 0; i < 8; ++i) v[i] = *(const f32x4*)(W + (size_t)(k0 + 8 * i + (lane >> 3)) * N + n0 + 4 * (lane & 7));
#pragma unroll
    for (int i = 0; i < 8; ++i) { LAS float* s = scr + (8 * i + (lane >> 3)) * 33 + 4 * (lane & 7); if (q8) { for (int e = 0; e < 4; ++e) v[i][e] = q8f(v[i][e] * 64.0f) * (1.0f / 64.0f); } s[0] = v[i][0]; s[1] = v[i][1]; s[2] = v[i][2]; s[3] = v[i][3]; }
    LDS_WAIT(); asm volatile("" ::: "memory");
    const int c = lane & 7;
#pragma unroll
    for (int j = 0; j < 4; ++j) { const int n = (lane >> 3) + 8 * j; const LAS float* s = scr + (8 * c) * 33 + n;
        v4u o; o.x = pk2(s[0 * 33], s[1 * 33]); o.y = pk2(s[2 * 33], s[3 * 33]); o.z = pk2(s[4 * 33], s[5 * 33]); o.w = pk2(s[6 * 33], s[7 * 33]);
        *(v4u*)(WT + (size_t)(orow0 + n) * ldo + ocol0 + 8 * c) = o; }
    LDS_WAIT(); asm volatile("" ::: "memory");
}
__device__ __forceinline__ void transpose_item8(const float* __restrict__ W, int N, int k0, int n0, unsigned char* WT, int ldo, int orow0, int ocol0, float scale, LAS float* scr, int lane) {
    f32x4 v[8];
#pragma unroll
    for (int i = 0; i < 8; ++i) v[i] = *(const f32x4*)(W + (size_t)(k0 + 8 * i + (lane >> 3)) * N + n0 + 4 * (lane & 7));
#pragma unroll
    for (int i = 0; i < 8; ++i) { LAS float* s = scr + (8 * i + (lane >> 3)) * 33 + 4 * (lane & 7); s[0] = v[i][0] * scale; s[1] = v[i][1] * scale; s[2] = v[i][2] * scale; s[3] = v[i][3] * scale; }
    LDS_WAIT(); asm volatile("" ::: "memory");
    const int c = lane & 3;
#pragma unroll
    for (int j = 0; j < 2; ++j) { const int n = (lane >> 2) + 16 * j; const LAS float* s = scr + (16 * c) * 33 + n;
        v4u o; o.x = pk4_fp8(s[0 * 33], s[1 * 33], s[2 * 33], s[3 * 33]); o.y = pk4_fp8(s[4 * 33], s[5 * 33], s[6 * 33], s[7 * 33]);
        o.z = pk4_fp8(s[8 * 33], s[9 * 33], s[10 * 33], s[11 * 33]); o.w = pk4_fp8(s[12 * 33], s[13 * 33], s[14 * 33], s[15 * 33]);
        *(v4u*)(WT + (size_t)(orow0 + n) * ldo + ocol0 + 16 * c) = o; }
    LDS_WAIT(); asm volatile("" ::: "memory");
}
__device__ __forceinline__ int t5_bucket(int rel) {
    const int n = rel < 0 ? -rel : rel; const float nf = (float)(n < 1 ? 1 : n);
    int large = 8 + (int)(logf(nf / 8.0f) / 4.852030263919617f * 8.0f); large = large < 15 ? large : 15;
    return (rel > 0 ? 16 : 0) + (n < 8 ? n : large);
}
__device__ __forceinline__ void p0_prologue(Frame& F) {
    LAS float* scr = (LAS float*)(F.lds + RING_OFF + F.wave * 16384);
    const int gw = blockIdx.x * 8 + F.wave, NGW = F.G * 8;
    const int gt = blockIdx.x * 512 + F.tid, NGT = F.G * 512;
    bf16* XB = (bf16*)(wsp_(F) + WS_XB); bf16* WIN = (bf16*)(wsp_(F) + WS_WIN); bf16* WA = (bf16*)(wsp_(F) + WS_WA); bf16* WB = (bf16*)(wsp_(F) + WS_WB); bf16* WO = (bf16*)(wsp_(F) + WS_WO);
    bf16* WGL = (bf16*)(wsp_(F) + WS_WGL); bf16* WD = (bf16*)(wsp_(F) + WS_WD);
    { float* lut = (float*)(wsp_(F) + WS_LUT); const float* rb = inp(F, 3);
      for (int i = gt; i < 3 * 4 * 129; i += NGT) { const int g = i / 516, hh = (i / 129) % 4, j = i % 129; const int d = (g == 0) ? 1 : (g == 1 ? 4 : 16);
          lut[i] = rb[t5_bucket((j - 64) * d) * 12 + g * 4 + hh]; }
      float* rope = (float*)(wsp_(F) + WS_ROPE);
      for (int i = gt; i < 128 * 32; i += NGT) { const int pos = i >> 5, fi = i & 31; const float inv = powf(10000.0f, -(float)(2 * fi) / 64.0f); const float ang = (float)pos * inv;
          rope[2 * i] = __cosf(ang); rope[2 * i + 1] = __sinf(ang); }
    }
    { const float* x = inp(F, 0);
      for (int i = gw; i < S_ * DM / 512; i += NGW) { const size_t o = (size_t)i * 512 + F.lane * 8; const f32x4 a = *(const f32x4*)(x + o), b = *(const f32x4*)(x + o + 4);
          v2u w; w.x = pk4_fp8(a[0], a[1], a[2], a[3]); w.y = pk4_fp8(b[0], b[1], b[2], b[3]); *(v2u*)((unsigned char*)XB + o) = w; } }
    constexpr int T_WIN = 16 * 80, T_WA = 4 * 16, T_WB = 8 * 16, T_WO = 16 * 16;
    constexpr int NT = T_WIN + T_WA + T_WB + T_WO;
    const float* const w_in = inp(F, 1); const float* const w_ba = inp(F, 6); const float* const w_bb = inp(F, 7); const float* const w_o = inp(F, 8);
#define P0_DECODE(T, SRC, NN, DST, LDO, SCL) do { int r_ = (T); \
        if (r_ < T_WIN) { const int kt = r_ / 80, nt = r_ % 80; SRC = w_in + (size_t)(128 * kt) * INW + 128 * nt; NN = INW; DST = (unsigned char*)WIN + (size_t)(nt >> 1) * (256 * 2048) + kt * 32768 + (nt & 1) * 16384; LDO = 128; SCL = 64.0f; break; } r_ -= T_WIN; \
        if (r_ < T_WA) { const int kt = r_ / 16, nt = r_ % 16; SRC = w_ba + (size_t)(128 * kt) * DM + 128 * nt; NN = DM; DST = (unsigned char*)WA + (size_t)(nt >> 1) * (256 * 512) + kt * 32768 + (nt & 1) * 16384; LDO = 128; SCL = 32.0f; break; } r_ -= T_WA; \
        if (r_ < T_WB) { const int kt = r_ / 16, nt = r_ % 16; SRC = w_bb + (size_t)(128 * kt) * DM + 128 * nt; NN = DM; DST = (unsigned char*)WB + (size_t)(nt >> 1) * (256 * 1024) + kt * 32768 + (nt & 1) * 16384; LDO = 128; SCL = 32.0f; break; } r_ -= T_WB; \
        { const int kt = r_ / 16, nt = r_ % 16; SRC = w_o + (size_t)(128 * kt) * DM + 128 * nt; NN = DM; DST = (unsigned char*)WO + (size_t)(nt >> 1) * (256 * 2048) + kt * 32768 + (nt & 1) * 16384; LDO = 128; SCL = 64.0f; } } while (0)
    const int nq = F.tid & 31, kq0 = F.tid >> 5;
#define P0_LOAD(V, SRC, NN) do { _Pragma("unroll") for (int p = 0; p < 2; ++p) _Pragma("unroll") for (int i = 0; i < 4; ++i) V[p * 4 + i] = __builtin_nontemporal_load((const f32x4*)(SRC + (size_t)(4 * (kq0 + 16 * p) + i) * NN + 4 * nq)); } while (0)
    if ((int)blockIdx.x < NT) {
        const int nj = (NT - (int)blockIdx.x + F.G - 1) / F.G;
        const float* src; int nn; unsigned char* dst; int ldo; float scl;
        P0_DECODE((int)blockIdx.x, src, nn, dst, ldo, scl);
        f32x4 v[8]; P0_LOAD(v, src, nn);
        for (int j = 0; j < nj; ++j) {
            const int jn = (j + 1 < nj) ? j + 1 : j;
            const float* nsrc; int nnn; unsigned char* ndst; int nldo; float nscl;
            P0_DECODE((int)blockIdx.x + jn * F.G, nsrc, nnn, ndst, nldo, nscl);
            f32x4 nv[8]; P0_LOAD(nv, nsrc, nnn);
            LAS unsigned* t32 = (LAS unsigned*)(F.lds + RING_OFF + (j & 1) * 16384);
#pragma unroll
            for (int p = 0; p < 2; ++p)
#pragma unroll
                for (int c = 0; c < 4; ++c) t32[(4 * nq + c) * 32 + ((kq0 + 16 * p) ^ nq)] = pk4_fp8(v[p * 4 + 0][c] * scl, v[p * 4 + 1][c] * scl, v[p * 4 + 2][c] * scl, v[p * 4 + 3][c] * scl);
            __syncthreads();
#pragma unroll
            for (int jj = 0; jj < 2; ++jj) { const int n = (F.tid >> 3) + 64 * jj, c8 = F.tid & 7, g = n >> 2; const LAS unsigned* rp = t32 + n * 32;
                v4u o; o.x = rp[(4 * c8 + 0) ^ g]; o.y = rp[(4 * c8 + 1) ^ g]; o.z = rp[(4 * c8 + 2) ^ g]; o.w = rp[(4 * c8 + 3) ^ g];
                __builtin_nontemporal_store(o, (v4u*)(dst + (size_t)n * ldo + 16 * c8)); }
#pragma unroll
            for (int i = 0; i < 8; ++i) v[i] = nv[i];
            src = nsrc; nn = nnn; dst = ndst; ldo = nldo; scl = nscl;
        }
        __syncthreads();
    }
#undef P0_DECODE
#undef P0_LOAD
}

constexpr int MC_T_ALL = 3 * 32 * 256;
constexpr int MC_DEFER = MK_DEFER;
constexpr int MC_TAILQ = 8;
__device__ __forceinline__ void moe_convert_share(Frame& F, const int baseA, const int strideA, const int nA, const int baseB, const int strideB, const int nB) {
    const float* const w_g = inp(F, 13); const float* const w_l = inp(F, 15); const float* const w_d = inp(F, 17);
    unsigned char* const WGL = wsp_(F) + WS_WGL; unsigned char* const WD = wsp_(F) + WS_WD;
#define MC_DECODE(T, SRC, DST) do { const int r_ = (T); const int which = r_ / (32 * 256), rr = r_ % (32 * 256), e = rr >> 8, q = rr & 255, kt = q >> 4, nt = q & 15; \
        SRC = (which == 0 ? w_g : (which == 1 ? w_l : w_d)) + (size_t)e * DM * DM + (size_t)(128 * kt) * DM + 128 * nt; \
        DST = (which < 2) ? WGL + (size_t)e * (4096 * 2048) + (size_t)nt * (256 * 2048) + kt * 32768 + which * 16384 : WD + (size_t)e * (2048 * 2048) + (size_t)(nt >> 1) * (256 * 2048) + kt * 32768 + (nt & 1) * 16384; } while (0)
    const int nq = F.tid & 31, kq0 = F.tid >> 5;
#define MC_LOAD(V, SRC) do { _Pragma("unroll") for (int p = 0; p < 2; ++p) _Pragma("unroll") for (int i = 0; i < 4; ++i) V[p * 4 + i] = __builtin_nontemporal_load((const f32x4*)(SRC + (size_t)(4 * (kq0 + 16 * p) + i) * DM + 4 * nq)); } while (0)
    if (nA + nB > 0) {
        const int nj = nA + nB;
#define MC_TILE(J) ((J) < nA ? baseA + (J) * strideA : baseB + ((J) - nA) * strideB)
        f32x4 b0[8], b1[8], b2[8], b3[8];
        unsigned char *d0, *d1, *d2, *d3 = nullptr;
        { const float* sp; MC_DECODE(MC_TILE(0 < nj ? 0 : nj - 1), sp, d0); MC_LOAD(b0, sp); }
        { const float* sp; MC_DECODE(MC_TILE(1 < nj ? 1 : nj - 1), sp, d1); MC_LOAD(b1, sp); }
        { const float* sp; MC_DECODE(MC_TILE(2 < nj ? 2 : nj - 1), sp, d2); MC_LOAD(b2, sp); }
#define MC_STEP(K, CUR, DCUR, NXT, DNXT) do { const int k_ = (K); \
            { const int kn_ = (k_ + 3 < nj) ? k_ + 3 : nj - 1; const float* sp; MC_DECODE(MC_TILE(kn_), sp, DNXT); MC_LOAD(NXT, sp); } \
            if (k_ < nj) { \
                LAS unsigned* t32 = (LAS unsigned*)(F.lds + RING_OFF + (k_ & 1) * 16384); \
                _Pragma("unroll") for (int p = 0; p < 2; ++p) _Pragma("unroll") for (int c = 0; c < 4; ++c) \
                    t32[(4 * nq + c) * 32 + ((kq0 + 16 * p) ^ nq)] = pk4_fp8(CUR[p * 4 + 0][c] * 64.0f, CUR[p * 4 + 1][c] * 64.0f, CUR[p * 4 + 2][c] * 64.0f, CUR[p * 4 + 3][c] * 64.0f); \
                __syncthreads(); \
                _Pragma("unroll") for (int jj = 0; jj < 2; ++jj) { const int n = (F.tid >> 3) + 64 * jj, c8 = F.tid & 7, g = n >> 2; const LAS unsigned* rp = t32 + n * 32; \
                    v4u o; o.x = rp[(4 * c8 + 0) ^ g]; o.y = rp[(4 * c8 + 1) ^ g]; o.z = rp[(4 * c8 + 2) ^ g]; o.w = rp[(4 * c8 + 3) ^ g]; \
                    __builtin_nontemporal_store(o, (v4u*)(DCUR + (size_t)n * 128 + 16 * c8)); } } } while (0)
        for (int j = 0; j < nj; j += 4) {
            MC_STEP(j + 0, b0, d0, b3, d3);
            MC_STEP(j + 1, b1, d1, b0, d0);
            MC_STEP(j + 2, b2, d2, b1, d1);
            MC_STEP(j + 3, b3, d3, b2, d2);
        }
#undef MC_STEP
#undef MC_TILE
        __syncthreads();
    }
#undef MC_DECODE
#undef MC_LOAD
}

__device__ __forceinline__ void p2_prep_dilated(Frame& F) {
    const bf16* proj = (const bf16*)(wsp_(F) + WS_PROJ);
    bf16* QBR = (bf16*)(wsp_(F) + WS_QBR); bf16* KBR = (bf16*)(wsp_(F) + WS_KBR); bf16* VBR = (bf16*)(wsp_(F) + WS_VBR);
    unsigned char* Q8 = wsp_(F) + WS_Q8; unsigned char* K8 = wsp_(F) + WS_K8; unsigned char* VIMG = wsp_(F) + WS_VIMG;
    const float* rope = (const float*)(wsp_(F) + WS_ROPE);
    const int gw = blockIdx.x * 8 + F.wave, NGW = F.G * 8;
    const int half = F.lane >> 5, fi = F.lane & 31, c1 = half * 64 + fi, c2 = c1 + 32;
    const float* const qn_g = inp(F, 4); const float* const kn_g = inp(F, 5);
    int tfirst, tstep_, tcount;
    if (F.G == 256) { if (blockIdx.x >= 128) { tfirst = ((int)blockIdx.x - 128) * 8 + F.wave; tstep_ = 1024; tcount = 6; } else { tfirst = 6144 + (int)blockIdx.x * 8 + F.wave; tstep_ = 1024; tcount = 2; } }
    else { tfirst = gw; tstep_ = NGW; tcount = (S_ - gw + NGW - 1) / NGW; }
    for (int ti = 0; ti < tcount; ++ti) {
        const int t = tfirst + ti * tstep_;
        const bf16* base = proj + (size_t)t * INW;
        float a1[10], a2[10], ss[10];
#pragma unroll
        for (int h = 0; h < 10; ++h) { const bf16* src = base + (h < 8 ? B_Q_OFF + h * 128 : B_K_OFF + (h - 8) * 128); a1[h] = bf2f(src[c1]); a2[h] = bf2f(src[c2]); }
        const unsigned vv0 = ((const unsigned*)(base + B_V_OFF))[F.lane], vv1 = ((const unsigned*)(base + B_V_OFF + 128))[F.lane];
        const int pos = half ? (t & 63) : (t >> 6);
        const float cs = rope[(pos * 32 + fi) * 2], sn = rope[(pos * 32 + fi) * 2 + 1];
        const float gq1 = qn_g[c1], gq2 = qn_g[c2], gk1 = kn_g[c1], gk2 = kn_g[c2];
#pragma unroll
        for (int h = 0; h < 10; ++h) ss[h] = a1[h] * a1[h] + a2[h] * a2[h];
#pragma unroll
        for (int o = 1; o < 64; o <<= 1)
#pragma unroll
            for (int h = 0; h < 10; ++h) ss[h] += __shfl_xor(ss[h], o);
#pragma unroll
        for (int h = 0; h < 10; ++h) {
            const float rs = 1.0f / sqrtf(ss[h] * (1.0f / 128.0f) + QK_EPS);
            const float v1 = a1[h] * rs * (h < 8 ? gq1 : gk1), v2 = a2[h] * rs * (h < 8 ? gq2 : gk2);
            const float o1 = v1 * cs - v2 * sn, o2 = v1 * sn + v2 * cs;
            unsigned char* dst8 = h < 8 ? Q8 + (size_t)t * 1024 + h * 128 : K8 + (size_t)t * 256 + (h - 8) * 128;
            const unsigned pq = pk4_fp8(o1 * 0.35709130f, o2 * 0.35709130f, 0.f, 0.f); dst8[c1]     = (unsigned char)(pq & 0xffu); dst8[c2] = (unsigned char)((pq >> 8) & 0xffu);
            if (MK_CHECK8) { bf16* dst = h < 8 ? QBR + (size_t)t * 1024 + h * 128 : KBR + (size_t)t * 256 + (h - 8) * 128;
                dst[c1] = (bf16)(pk2(o1, 0.f) & 0xffffu); dst[c2] = (bf16)(pk2(o2, 0.f) & 0xffffu); }
        }
        if (MK_CHECK8) { ((unsigned*)(VBR + (size_t)t * 256))[F.lane] = vv0; ((unsigned*)(VBR + (size_t)t * 256 + 128))[F.lane] = vv1; }
        {
            const int kk = t & 63, part = kk >> 5, k32 = kk & 31, g = (k32 >> 2) & 1, ii = (k32 & 3) + 4 * (k32 >> 3);
            unsigned char* img = VIMG + (size_t)(t >> 6) * 8192 + part * 1024 + g * 512 + ii;
            const int ca = 2 * F.lane, cb = 2 * F.lane + 1;
            const unsigned p0 = pk4_fp8(bflo(vv0) * 16.0f, bfhi(vv0) * 16.0f, bflo(vv1) * 16.0f, bfhi(vv1) * 16.0f);
            img[(ca >> 5) * 2048 + (ca & 31) * 16] = (unsigned char)(p0 & 0xffu); img[(cb >> 5) * 2048 + (cb & 31) * 16] = (unsigned char)((p0 >> 8) & 0xffu);
            img[128 * 8192 + (ca >> 5) * 2048 + (ca & 31) * 16] = (unsigned char)((p0 >> 16) & 0xffu); img[128 * 8192 + (cb >> 5) * 2048 + (cb & 31) * 16] = (unsigned char)((p0 >> 24) & 0xffu);
        }
    }
    const float* lut = (const float*)(wsp_(F) + WS_LUT);
    for (int u = blockIdx.x; u < 384; u += F.G) {
        const int gh = u >> 5, blk = u & 31, g = gh >> 2, hh = gh & 3, d = (g == 0) ? 1 : (g == 1 ? 4 : 16);
        const int bps = 32 / d, r = blk / bps, qb = blk % bps;
        at::dilated_unit((const at::bf16*)proj, lut + (g * 4 + hh) * 129, (at::bf16*)(wsp_(F) + WS_OUTA) + (size_t)g * S_ * 512, (float*)(wsp_(F) + WS_LSE) + (size_t)g * S_ * 4,
                         d, gh, hh, r, qb * 256, (char*)F.ldsg + RING_OFF);
    }
}

__device__ __forceinline__ void p3_attn_combine(Frame& F) {
    const at::bf16* QBR = (const at::bf16*)(wsp_(F) + WS_QBR); const at::bf16* KBR = (const at::bf16*)(wsp_(F) + WS_KBR); const at::bf16* VBR = (const at::bf16*)(wsp_(F) + WS_VBR);
    unsigned char* YB = wsp_(F) + WS_YB;
    const bool conv_first = (((int)blockIdx.x >> 3) & 1) != 0;
#define P3_ATTN_UNITS() do { for (int u = blockIdx.x; u < 256; u += F.G) { const int h = u & 7, qb = u >> 3, kv = h >> 2; \
        at::attn_dense_body8<1024, 256, 1024>(wsp_(F) + WS_Q8 + (size_t)qb * 256 * 1024 + h * 128, wsp_(F) + WS_K8 + kv * 128, wsp_(F) + WS_VIMG + (size_t)kv * 128 * 8192, YB + (size_t)qb * 256 * 1024 + h * 128, S_, (char*)F.ldsg + RING_OFF); \
        __syncthreads(); } } while (0)
    if (MK_CHECK8) { P3_ATTN_UNITS(); }
    else { if (!conv_first) P3_ATTN_UNITS();
    { const int te_ = MC_T_ALL - MC_DEFER, c_ = (int)blockIdx.x; moe_convert_share(F, c_, F.G, c_ < te_ ? (te_ - c_ + F.G - 1) / F.G : 0, 0, 0, 0); } __syncthreads();
    if (conv_first) P3_ATTN_UNITS(); }
#undef P3_ATTN_UNITS
    if (MK_CHECK8) for (int u = blockIdx.x; u < 256; u += F.G) { const int h = u & 7, qb = u >> 3, kv = h >> 2;
        at::attn_dense_body<1024, 256, 256, 1024>(QBR + (size_t)qb * 256 * 1024 + h * 128, KBR + kv * 128, VBR + kv * 128, wsp_(F) + WS_DBG + (size_t)qb * 256 * 1024 + h * 128, S_, (char*)F.ldsg + RING_OFF); __syncthreads(); }
    const bf16* OUTA = (const bf16*)(wsp_(F) + WS_OUTA); const float* LSE = (const float*)(wsp_(F) + WS_LSE); bf16* YA = (bf16*)(wsp_(F) + WS_YA);
    for (int tb = blockIdx.x; tb < 256; tb += F.G) {
        const int t = tb * 32 + (F.tid >> 4), c0 = (F.tid & 15) * 32, hh = c0 >> 7;
        const float l0 = LSE[(size_t)t * 4 + hh], l1 = LSE[(size_t)(S_ + t) * 4 + hh], l2 = LSE[(size_t)(2 * S_ + t) * 4 + hh];
        const float m = fmaxf(l0, fmaxf(l1, l2)); float w0 = __expf(l0 - m), w1 = __expf(l1 - m), w2 = __expf(l2 - m); const float inv = 16.0f / (w0 + w1 + w2); w0 *= inv; w1 *= inv; w2 *= inv;
#pragma unroll
        for (int q = 0; q < 4; ++q) { const size_t o = (size_t)t * 512 + c0 + q * 8;
            const v4u a = *(const v4u*)(OUTA + o), b = *(const v4u*)(OUTA + (size_t)S_ * 512 + o), c = *(const v4u*)(OUTA + (size_t)2 * S_ * 512 + o);
            v2u w;
            w.x = pk4_fp8(w0 * bflo(a.x) + w1 * bflo(b.x) + w2 * bflo(c.x), w0 * bfhi(a.x) + w1 * bfhi(b.x) + w2 * bfhi(c.x), w0 * bflo(a.y) + w1 * bflo(b.y) + w2 * bflo(c.y), w0 * bfhi(a.y) + w1 * bfhi(b.y) + w2 * bfhi(c.y));
            w.y = pk4_fp8(w0 * bflo(a.z) + w1 * bflo(b.z) + w2 * bflo(c.z), w0 * bfhi(a.z) + w1 * bfhi(b.z) + w2 * bfhi(c.z), w0 * bflo(a.w) + w1 * bflo(b.w) + w2 * bflo(c.w), w0 * bfhi(a.w) + w1 * bfhi(b.w) + w2 * bfhi(c.w));
            *(v2u*)((unsigned char*)YA + o) = w; }
    }
}

typedef float f32x16m __attribute__((ext_vector_type(16)));
__device__ __forceinline__ void p6_ln_router(Frame& F, const int bank = 0) {
    LAS int* cntl = (LAS int*)(F.lds + L_CNT); LAS int* basel = cntl + 32;
    LAS int* asg_e = (LAS int*)(F.lds + L_ASG); LAS int* asg_lr = asg_e + 128; LAS float* asg_w = (LAS float*)(asg_lr + 128);
    LAS float* x1s = (LAS float*)(F.lds + RING_OFF);
    LAS float* red = (LAS float*)(F.lds + RING_OFF + 73728);
    const float* Z1 = (const float*)(wsp_(F) + WS_T1); bf16* X1 = (bf16*)(wsp_(F) + WS_X1); unsigned char* X1Q = wsp_(F) + WS_X1B;
    const f32x4* G4 = (const f32x4*)inp(F, 9); const f32x4* B4 = (const f32x4*)inp(F, 10);
    const float* wr = inp(F, 11); const float* br = inp(F, 12);
    unsigned* gcnt = ((unsigned*)(wsp_(F) + WS_CTL)) + CW_CNT + bank * 64;
    int* TOKE = (int*)(wsp_(F) + (bank ? WS_H : WS_TOKE)); int* TOKR = (int*)(wsp_(F) + (bank ? WS_H + MiB : WS_TOKR)); float* TOKW = (float*)(wsp_(F) + (bank ? WS_H + 2 * MiB : WS_TOKW));
    const int li = F.lane & 31, kk = F.lane >> 5;
    for (int tb = blockIdx.x; tb < 256; tb += F.G) {
        if (F.tid < 32) cntl[F.tid] = 0;
        const int t0 = tb * 32 + F.wave * 4;
        f32x4 xv[4][8];
#pragma unroll
        for (int tk = 0; tk < 4; ++tk) {
            const f32x4* zr = (const f32x4*)(Z1 + (size_t)(t0 + tk) * DM) + F.lane;
#pragma unroll
            for (int j = 0; j < 8; ++j) xv[tk][j] = zr[64 * j];
            float s = 0.f;
#pragma unroll
            for (int j = 0; j < 8; ++j) s += (xv[tk][j][0] + xv[tk][j][1]) + (xv[tk][j][2] + xv[tk][j][3]);
            const float mean = wave_sum(s) * (1.0f / DM); float s2 = 0.f;
#pragma unroll
            for (int j = 0; j < 8; ++j) { xv[tk][j] = xv[tk][j] - mean; s2 += (xv[tk][j][0] * xv[tk][j][0] + xv[tk][j][1] * xv[tk][j][1]) + (xv[tk][j][2] * xv[tk][j][2] + xv[tk][j][3] * xv[tk][j][3]); }
            const float rstd = 1.0f / sqrtf(wave_sum(s2) * (1.0f / DM) + LN_EPS);
            v2u* xo = (v2u*)(X1 + (size_t)(t0 + tk) * DM) + F.lane; unsigned* xb = (unsigned*)(X1Q + (size_t)(t0 + tk) * DM) + F.lane;
#pragma unroll
            for (int j = 0; j < 8; ++j) { const f32x4 v = xv[tk][j] * rstd * G4[64 * j + F.lane] + B4[64 * j + F.lane]; xv[tk][j] = v;
                v2u w; w.x = pk2(v[0], v[1]); w.y = pk2(v[2], v[3]); xo[64 * j] = w; xb[64 * j] = pk4_fp8(v[0], v[1], v[2], v[3]); }
            asm volatile("" ::: "memory"); __builtin_amdgcn_sched_barrier(0);
        }
        f32x16m acc = {0.f, 0.f, 0.f, 0.f, 0.f, 0.f, 0.f, 0.f, 0.f, 0.f, 0.f, 0.f, 0.f, 0.f, 0.f, 0.f};
        const float* wp = wr + (size_t)(32 * F.wave + 4 * kk) * 32 + li;
#pragma unroll
        for (int c = 0; c < 8; ++c) {
            LAS float* buf = x1s + (c & 1) * (32 * 260);
#pragma unroll
            for (int tk = 0; tk < 4; ++tk) *(LAS f32x4*)(buf + (4 * F.wave + tk) * 260 + 4 * F.lane) = xv[tk][c];
            __syncthreads();
#pragma unroll
            for (int b = 0; b < 4; ++b) {
                const f32x4 a4 = *(const LAS f32x4*)(buf + li * 260 + 32 * F.wave + 8 * b + 4 * kk);
                asm volatile("" : "+v"(wp));
                const float b0 = wp[0], b1 = wp[32], b2 = wp[64], b3 = wp[96]; wp += (b == 3) ? (256 - 24) * 32 : 8 * 32;
                acc = __builtin_amdgcn_mfma_f32_32x32x2f32(a4[0], b0, acc, 0, 0, 0);
                acc = __builtin_amdgcn_mfma_f32_32x32x2f32(a4[1], b1, acc, 0, 0, 0);
                acc = __builtin_amdgcn_mfma_f32_32x32x2f32(a4[2], b2, acc, 0, 0, 0);
                acc = __builtin_amdgcn_mfma_f32_32x32x2f32(a4[3], b3, acc, 0, 0, 0);
            }
            __builtin_amdgcn_sched_barrier(0);
        }
#pragma unroll
        for (int r = 0; r < 16; ++r) red[(F.wave * 32 + ((r & 3) + 8 * (r >> 2) + 4 * kk)) * 32 + li] = acc[r];
        __syncthreads();
#pragma unroll
        for (int tk = 0; tk < 4; ++tk) {
            float v = -3.0e38f;
            if (F.lane < 32) { float sres = br[F.lane];
#pragma unroll
                for (int w8 = 0; w8 < 8; ++w8) sres += red[(w8 * 32 + 4 * F.wave + tk) * 32 + F.lane];
                v = sres; }
            float tv[4]; int ti[4];
#pragma unroll
            for (int k = 0; k < 4; ++k) { float bv = v; int bi = F.lane;
#pragma unroll
                for (int o = 1; o < 64; o <<= 1) { const float ov = __shfl_xor(bv, o); const int oi = __shfl_xor(bi, o); if (ov > bv || (ov == bv && oi < bi)) { bv = ov; bi = oi; } }
                tv[k] = bv; ti[k] = bi; if (F.lane == bi) v = -3.0e38f; }
            const float e1 = __expf(tv[1] - tv[0]), e2 = __expf(tv[2] - tv[0]), e3 = __expf(tv[3] - tv[0]); const float inv = 1.0f / (1.0f + e1 + e2 + e3);
            if (F.lane < 4) { const int me = F.lane == 0 ? ti[0] : (F.lane == 1 ? ti[1] : (F.lane == 2 ? ti[2] : ti[3]));
                const float mw = (F.lane == 0 ? 1.0f : (F.lane == 1 ? e1 : (F.lane == 2 ? e2 : e3))) * inv;
                const int lr = atomicAdd((int*)(cntl + me), 1);
                const int a = (F.wave * 4 + tk) * 4 + F.lane; asg_e[a] = me; asg_lr[a] = lr; asg_w[a] = mw; }
        }
        __syncthreads();
        if (F.tid < 32) basel[F.tid] = (int)atomicAdd(gcnt + F.tid, (unsigned)cntl[F.tid]);
        __syncthreads();
        if (F.tid < 128) { const int a = tb * 128 + F.tid; const int e = asg_e[F.tid]; TOKE[a] = e; TOKR[a] = basel[e] + asg_lr[F.tid]; TOKW[a] = asg_w[F.tid]; }
        __syncthreads();
    }
}

__device__ __forceinline__ void p7_gather(Frame& F) {
    LAS int* pst = (LAS int*)(F.lds + L_PST);
    const unsigned* gcnt = ((unsigned*)(wsp_(F) + WS_CTL)) + CW_CNT;
    if (F.tid == 0) { int acc = 0; for (int e = 0; e < 32; ++e) { pst[e] = acc; acc += ((int)gcnt[e] + 255) & ~255; } pst[32] = acc; }
    __syncthreads();
    const int* TOKE = (const int*)(wsp_(F) + WS_TOKE); const int* TOKR = (const int*)(wsp_(F) + WS_TOKR); const float* TOKW = (const float*)(wsp_(F) + WS_TOKW);
    int* TOKS = (int*)(wsp_(F) + WS_TOKS); float* SLOTW = (float*)(wsp_(F) + WS_SLOTW);
    const bf16* X1B = (const bf16*)(wsp_(F) + WS_X1B); bf16* XS = (bf16*)(wsp_(F) + WS_XS);
    const int gw = blockIdx.x * 8 + F.wave, NGW = F.G * 8;
    for (int a0 = gw; a0 < S_ * TOPK; a0 += 4 * NGW) {
        int slot[4]; float w[4]; v4u r0[4], r1[4];
#pragma unroll
        for (int q = 0; q < 4; ++q) { const int a = a0 + q * NGW; const int ac = a < S_ * TOPK ? a : a0; slot[q] = pst[TOKE[ac]] + TOKR[ac]; w[q] = TOKW[ac]; }
#pragma unroll
        for (int q = 0; q < 4; ++q) { const int a = a0 + q * NGW; const int ac = a < S_ * TOPK ? a : a0; const v4u* src = (const v4u*)((const unsigned char*)X1B + (size_t)(ac >> 2) * DM) + F.lane; r0[q] = src[0]; r1[q] = src[64]; }
#pragma unroll
        for (int q = 0; q < 4; ++q) { const int a = a0 + q * NGW; if (a < S_ * TOPK) { if (F.lane == 0) { TOKS[a] = slot[q]; SLOTW[slot[q]] = w[q]; }
            v4u* dst = (v4u*)((unsigned char*)XS + (size_t)slot[q] * DM) + F.lane; dst[0] = r0[q]; dst[64] = r1[q]; } }
    }
}
__device__ __forceinline__ int moe_tiles(Frame& F) {
    LAS int* tile_e = (LAS int*)(F.lds + L_TILE);
    const unsigned* gcnt = ((unsigned*)(wsp_(F) + WS_CTL)) + CW_CNT;
    __syncthreads();
    if (F.tid == 0) { int ti = 0; for (int e = 0; e < 32; ++e) { const int nt = ((int)gcnt[e] + 255) >> 8; for (int k = 0; k < nt && ti < 160; ++k) tile_e[ti++] = e; } tile_e[160] = ti; }
    __syncthreads();
    return tile_e[160];
}

__device__ __forceinline__ void p10_final(Frame& F) {
    const bf16* X1 = (const bf16*)(wsp_(F) + WS_X1); const bf16* YS = (const bf16*)(wsp_(F) + WS_YS); const int* TOKS = (const int*)(wsp_(F) + WS_TOKS);
    const f32x4* G4 = (const f32x4*)inp(F, 19); const f32x4* B4 = (const f32x4*)inp(F, 20);
    float* outp = (float*)inp(F, 21);
    const int gw = blockIdx.x * 8 + F.wave, NGW = F.G * 8;
    for (int t0 = gw; t0 < S_; t0 += 2 * NGW) {
        f32x4 v[2][8]; int tt[2]; int sl[2][4];
#pragma unroll
        for (int q = 0; q < 2; ++q) { const int t = t0 + q * NGW; tt[q] = t < S_ ? t : t0; }
#pragma unroll
        for (int q = 0; q < 2; ++q)
#pragma unroll
            for (int k = 0; k < 4; ++k) sl[q][k] = TOKS[tt[q] * 4 + k];
#pragma unroll
        for (int q = 0; q < 2; ++q) {
            const v4u* xr = (const v4u*)(X1 + (size_t)tt[q] * DM) + F.lane;
            const v4u* y0 = (const v4u*)(YS + (size_t)sl[q][0] * DM) + F.lane; const v4u* y1 = (const v4u*)(YS + (size_t)sl[q][1] * DM) + F.lane;
            const v4u* y2 = (const v4u*)(YS + (size_t)sl[q][2] * DM) + F.lane; const v4u* y3 = (const v4u*)(YS + (size_t)sl[q][3] * DM) + F.lane;
#pragma unroll
            for (int jj = 0; jj < 4; ++jj) { const v4u x = xr[64 * jj], a = y0[64 * jj], b = y1[64 * jj], c = y2[64 * jj], d = y3[64 * jj];
#define P10_LO(W) (bflo(x.W) * ALPHA + ((bflo(a.W) + bflo(b.W)) + (bflo(c.W) + bflo(d.W))))
#define P10_HI(W) (bfhi(x.W) * ALPHA + ((bfhi(a.W) + bfhi(b.W)) + (bfhi(c.W) + bfhi(d.W))))
                v[q][2 * jj] = (f32x4){P10_LO(x), P10_HI(x), P10_LO(y), P10_HI(y)}; v[q][2 * jj + 1] = (f32x4){P10_LO(z), P10_HI(z), P10_LO(w), P10_HI(w)};
#undef P10_LO
#undef P10_HI
            }
        }
#pragma unroll
        for (int q = 0; q < 2; ++q) {
            float s = 0.f;
#pragma unroll
            for (int j = 0; j < 8; ++j) s += (v[q][j][0] + v[q][j][1]) + (v[q][j][2] + v[q][j][3]);
            const float mean = wave_sum(s) * (1.0f / DM); float s2 = 0.f;
#pragma unroll
            for (int j = 0; j < 8; ++j) { v[q][j] = v[q][j] - mean; s2 += (v[q][j][0] * v[q][j][0] + v[q][j][1] * v[q][j][1]) + (v[q][j][2] * v[q][j][2] + v[q][j][3] * v[q][j][3]); }
            const float rstd = 1.0f / sqrtf(wave_sum(s2) * (1.0f / DM) + LN_EPS);
            if (t0 + q * NGW < S_) { f32x4* o = (f32x4*)(outp + (size_t)tt[q] * DM) + 2 * F.lane;
#pragma unroll
                for (int jj = 0; jj < 4; ++jj) { o[128 * jj] = v[q][2 * jj] * rstd * G4[128 * jj + 2 * F.lane] + B4[128 * jj + 2 * F.lane];
                    o[128 * jj + 1] = v[q][2 * jj + 1] * rstd * G4[128 * jj + 2 * F.lane + 1] + B4[128 * jj + 2 * F.lane + 1]; } }
        }
    }
}

struct Args { const float* in[21]; float* out; unsigned char* ws; int ph_lo, ph_hi; };
__global__ void __launch_bounds__(512, 2) mk_fwd(Args args) {
    extern __shared__ __attribute__((aligned(16))) unsigned char lds[];
    Frame F;
    F.lds = (LAS unsigned char*)lds; F.ldsg = lds;
    F.tid = threadIdx.x; F.lane = F.tid & 63; F.wave = __builtin_amdgcn_readfirstlane(F.tid >> 6); F.G = gridDim.x;
    if (F.tid == 0) { LAS unsigned long long* pp = (LAS unsigned long long*)(F.lds + L_PTR);
#pragma unroll
        for (int i = 0; i < 21; ++i) pp[i] = (unsigned long long)args.in[i];
        pp[21] = (unsigned long long)args.out; pp[22] = (unsigned long long)args.ws; }
    if (F.tid < 4) ((LAS unsigned*)(F.lds + L_XB))[F.tid] = 0u;
    __syncthreads();
    const int lo = args.ph_lo, hi = args.ph_hi;
    XcdBarrier bar; bar.bar = ((unsigned*)(wsp_(F) + WS_CTL)) + CW_BAR; bar.x = 0; bar.st = (volatile LAS unsigned*)(F.lds + L_XB);
    if (hi - lo > 1) bar = xcd_barrier_post(((unsigned*)(wsp_(F) + WS_CTL)) + CW_BAR, (volatile LAS unsigned*)(F.lds + L_XB));
#ifndef MK_PHASE_MASK
#define MK_PHASE_MASK 0x7ff
#endif
#define IN(k) (((MK_PHASE_MASK >> (k)) & 1) && lo <= (k) && (k) < hi)
#ifndef MK_DUP_MASK
#define MK_DUP_MASK 0
#endif
#define REP(k) for (int rep_ = 0; rep_ < 1 + ((MK_DUP_MASK >> (k)) & 1); ++rep_)
#ifndef MK_BAR2
#define MK_BAR2 0
#endif
#ifndef MK_STAMP_IDX
#define MK_STAMP_IDX -1
#endif
    unsigned long long st0_ = 0ull, stk_ = 0ull;
    if (MK_STAMP_IDX >= 0) st0_ = __builtin_amdgcn_s_memrealtime();
#define SEAM(k) do { if (IN(k) && IN((k) + 1)) { xcd_barrier(bar); if (MK_BAR2) xcd_barrier(bar); if (MK_STAMP_IDX == (k) + 1) stk_ = __builtin_amdgcn_s_memrealtime(); } } while (0)
    LAS unsigned char* ring = F.lds + RING_OFF;
    const pg8::bf16_t* XB = (const pg8::bf16_t*)(wsp_(F) + WS_XB);

    if (IN(0)) REP(0) { p0_prologue(F); if (MK_CHECK8) { __syncthreads(); const int te_ = MC_T_ALL - MC_DEFER, c_ = (int)blockIdx.x; moe_convert_share(F, c_, F.G, c_ < te_ ? (te_ - c_ + F.G - 1) / F.G : 0, 0, 0, 0); } }
    SEAM(0);
    if (IN(1)) REP(1) {
        pg8::Gemm g{XB, (const pg8::bf16_t*)(wsp_(F) + WS_WIN), S_, INW, DM / 2}; pg8::StaticOrder S; S.init(S_, INW, F.G, (int)blockIdx.x);
        pg8::EpiStoreBf16 E{(pg8::bf16_t*)(wsp_(F) + WS_PROJ), INW, 1.0f / 64.0f};
        pg8::gemm_phase<pg8::EpiStoreBf16, pg8::StaticOrder, true, true, true, true>(ring, g, S, E);
    }
    SEAM(1);
    if (IN(2)) { p2_prep_dilated(F); if ((MK_DUP_MASK >> 2) & 1) p2_prep_dilated(F); }
    SEAM(2);
    if (IN(3)) REP(3) { p3_attn_combine(F); }
    SEAM(3);
#define PHASE4_BODY { \
        { pg8::Gemm g{(const pg8::bf16_t*)(wsp_(F) + WS_YA), (const pg8::bf16_t*)(wsp_(F) + WS_WA), S_, DM, 256}; pg8::StaticOrder S; S.init(S_, DM, F.G, (int)blockIdx.x); \
          pg8::EpiGateA E{(const pg8::bf16_t*)(wsp_(F) + WS_PROJ), INW, GATE_OFF, inp(F, 2), (float*)(wsp_(F) + WS_T1), DM, 1.0f / 512.0f}; \
          pg8::gemm_phase<pg8::EpiGateA, pg8::StaticOrder, true, true, true, true>(ring, g, S, E); } \
        { pg8::Gemm g{(const pg8::bf16_t*)(wsp_(F) + WS_YB), (const pg8::bf16_t*)(wsp_(F) + WS_WB), S_, DM, 512}; pg8::StaticOrder S; S.init(S_, DM, F.G, (int)blockIdx.x); \
          pg8::EpiGateB E{(const pg8::bf16_t*)(wsp_(F) + WS_PROJ), INW, GATE_OFF + DM, inp(F, 2) + DM, (const float*)(wsp_(F) + WS_T1), wsp_(F) + WS_Y, DM, 1.0f / 2048.0f}; \
          pg8::gemm_phase<pg8::EpiGateB, pg8::StaticOrder, true, true, true, true>(ring, g, S, E); } \
    }
    if (MK_CHECK8 && IN(4)) {
        const unsigned* a32 = (const unsigned*)(wsp_(F) + WS_YB); const unsigned* b32 = (const unsigned*)(wsp_(F) + WS_DBG); float num = 0.f, den = 0.f;
        for (int i = blockIdx.x * 512 + F.tid; i < S_ * 1024 / 4; i += F.G * 512) { const unsigned a = a32[i], b = b32[i];
            for (int q = 0; q < 4; ++q) { const float fa = __builtin_amdgcn_cvt_f32_fp8((int)(a >> (8 * q)), 0), fb = __builtin_amdgcn_cvt_f32_fp8((int)(b >> (8 * q)), 0); num += fabsf(fa - fb); den += fabsf(fb); } }
        num = wave_sum(num); den = wave_sum(den);
        if (F.lane == 0) { atomicAdd((float*)(((unsigned*)(wsp_(F) + WS_CTL)) + 4224), num); atomicAdd((float*)(((unsigned*)(wsp_(F) + WS_CTL)) + 4225), den); }
    }
    if (IN(4)) { PHASE4_BODY if ((MK_DUP_MASK >> 4) & 1) PHASE4_BODY }
    SEAM(4);
    if (IN(5)) REP(5) {
        pg8::Gemm g{(const pg8::bf16_t*)(wsp_(F) + WS_Y), (const pg8::bf16_t*)(wsp_(F) + WS_WO), S_, DM, DM / 2}; pg8::StaticOrder S; S.init(S_, DM, F.G, (int)blockIdx.x);
        pg8::EpiResF32 E{inp(F, 0), (float*)(wsp_(F) + WS_T1), DM, ALPHA, 1.0f / 4096.0f};
        pg8::gemm_phase<pg8::EpiResF32, pg8::StaticOrder, true, true, true, true>(ring, g, S, E);
    }
    SEAM(5);
    if (IN(6)) { p6_ln_router(F); if ((MK_DUP_MASK >> 6) & 1) p6_ln_router(F, 1); }
    SEAM(6);
    if (IN(7)) REP(7) { p7_gather(F); }
    SEAM(7);
    if (IN(8)) REP(8) {
        const int nt = moe_tiles(F);
        pg8::Gemm g{(const pg8::bf16_t*)(wsp_(F) + WS_XS), (const pg8::bf16_t*)(wsp_(F) + WS_WGL), nt * 256, 4096, DM / 2};
        pg8::MoeOrder S; S.init(nt * 256, 4096, F.G, (int)blockIdx.x); S.tile_e = (const LAS int*)(F.lds + L_TILE); S.estride = (size_t)4096 * 2048;
        pg8::EpiSwiglu E{(const LAS int*)(F.lds + L_TILE), inp(F, 14), inp(F, 16), wsp_(F) + WS_H, DM, 1.0f / 64.0f};
        pg8::gemm_phase<pg8::EpiSwiglu, pg8::MoeOrder, true, true, true, true>(ring, g, S, E);
        if (MC_DEFER > 0) {
            __syncthreads();
            const int c_ = (int)blockIdx.x, r_ = (nt * 16) % F.G, ntail = r_ ? F.G - r_ : 0, T0 = MC_T_ALL - MC_DEFER;
            const int captail = ntail * MC_TAILQ < MC_DEFER ? ntail * MC_TAILQ : MC_DEFER, k_ = c_ - r_;
            const int nA = (ntail && k_ >= 0 && k_ < captail) ? (captail - k_ + ntail - 1) / ntail : 0;
            const int rest = MC_DEFER - captail, nB = c_ < rest ? (rest - c_ + F.G - 1) / F.G : 0;
            moe_convert_share(F, T0 + k_, ntail, nA, T0 + captail + c_, F.G, nB);
        }
    }
    SEAM(8);
    if (IN(9)) REP(9) {
        const int nt = moe_tiles(F);
        pg8::Gemm g{(const pg8::bf16_t*)(wsp_(F) + WS_H), (const pg8::bf16_t*)(wsp_(F) + WS_WD), nt * 256, DM, DM / 2};
        pg8::MoeOrder S; S.init(nt * 256, DM, F.G, (int)blockIdx.x); S.tile_e = (const LAS int*)(F.lds + L_TILE); S.estride = (size_t)2048 * 2048;
        pg8::EpiDown E{(const LAS int*)(F.lds + L_TILE), inp(F, 18), (const float*)(wsp_(F) + WS_SLOTW), (pg8::bf16_t*)(wsp_(F) + WS_YS), DM, 1.0f / 64.0f};
        pg8::gemm_phase<pg8::EpiDown, pg8::MoeOrder, true, true, true, true>(ring, g, S, E);
    }
    SEAM(9);
    if (IN(10)) REP(10) { p10_final(F); }
    if (MK_CHECK8 && IN(10)) {
        const float num = *(const float*)(((unsigned*)(wsp_(F) + WS_CTL)) + 4224), den = *(const float*)(((unsigned*)(wsp_(F) + WS_CTL)) + 4225);
        if (!(num <= MK_CHK_TOL * den) || !(den > 0.f)) { float* o = (float*)inp(F, 21); __syncthreads(); for (int i = blockIdx.x * 512 + F.tid; i < S_ * DM; i += F.G * 512) o[i] = __builtin_nanf(""); }
    }
    if (MK_STAMP_IDX >= 0 && blockIdx.x == 0 && F.tid == 0) {
        const unsigned long long te = __builtin_amdgcn_s_memrealtime(), dt = stk_ - st0_;
        while (__builtin_amdgcn_s_memrealtime() - te < dt) __builtin_amdgcn_s_sleep(8);
    }
#undef IN
#undef SEAM
}

#ifndef MK_CUTS
#define MK_CUTS 0
#endif
extern "C" void kernel_launch(void* const* d_in, const int* in_sizes, int n_in, void* d_out, int out_size, void* d_ws, size_t ws_size, hipStream_t stream) {
    static int grid = 0;
    if (grid == 0) {
        if (n_in != 21 || out_size != S_ * DM || ws_size < WS_END) { fprintf(stderr, "kernel_launch: unexpected shapes (n_in %d out %d ws %zu, need %zu)\n", n_in, out_size, ws_size, (size_t)WS_END); grid = -1; return; }
        int dev = 0, cus = 0, per_cu = 0;
        if (hipGetDevice(&dev) != hipSuccess || hipDeviceGetAttribute(&cus, hipDeviceAttributeMultiprocessorCount, dev) != hipSuccess) { grid = -1; return; }
        if (hipFuncSetAttribute((const void*)mk_fwd, hipFuncAttributeMaxDynamicSharedMemorySize, LDS_BYTES) != hipSuccess) { fprintf(stderr, "kernel_launch: hipFuncSetAttribute failed\n"); grid = -1; return; }
        if (hipOccupancyMaxActiveBlocksPerMultiprocessor(&per_cu, (const void*)mk_fwd, 512, LDS_BYTES) != hipSuccess || per_cu < 1) { fprintf(stderr, "kernel_launch: occupancy query says %d\n", per_cu); per_cu = 1; }
        (void)hipGetLastError();
        grid = cus;
    }
    if (grid < 0) return;
    (void)hipMemsetAsync((char*)d_ws + WS_CTL, 0, CTL_ZERO_BYTES, stream);
    Args a{};
    for (int i = 0; i < 21; ++i) a.in[i] = (const float*)d_in[i];
    a.out = (float*)d_out; a.ws = (unsigned char*)d_ws;
#if MK_CUTS
    for (int p = 0; p < NPH; ++p) { a.ph_lo = p; a.ph_hi = p + 1; hipLaunchKernelGGL(mk_fwd, dim3(grid), dim3(512), LDS_BYTES, stream, a); }
#else
    a.ph_lo = 0; a.ph_hi = NPH; hipLaunchKernelGGL(mk_fwd, dim3(grid), dim3(512), LDS_BYTES, stream, a);
#endif
}
```
